# Optimizing an MI355X kernel written in HIP

```python
import jax, jax.numpy as jnp
from jax import lax
import numpy as np

D_MODEL = 1024
BATCH = 8
SEQ = 2048
DEPTH = 2
DEC_BATCH = 128
DEC_SEQ = 1
PAST_LEN = 16384
PAGE_SIZE = 128

N_EVEN = (DEPTH + 1) // 2
N_ODD = DEPTH // 2
D_POOL = D_MODEL // 4
POOL_WINDOWS = (2, 4, 8, 16)
N_POOL_GROUPS = len(POOL_WINDOWS)
POOL_GROUP_DIM = D_POOL // N_POOL_GROUPS
POOL_BUF = max(POOL_WINDOWS) - 1
D_HGRN = D_MODEL - D_POOL
HGRN_HEAD_DIM = 128
N_HGRN_HEADS = D_HGRN // HGRN_HEAD_DIM
HGRN_CHUNK = 32
D_EVEN_IN = D_POOL + 4 * D_HGRN
D_CONV = D_MODEL
CONV_WIDTH = 3
CONV_BUF = CONV_WIDTH - 1
D_FF = 4 * D_MODEL
EPS = 1e-6

kernel_name = "pool_hgrn2_shortconv_hybrid_step"


def rmsnorm(x, g):
    xf = x.astype(jnp.float32)
    r = xf * lax.rsqrt(jnp.mean(xf * xf, axis=-1, keepdims=True) + EPS)
    return (r * g.astype(jnp.float32)).astype(x.dtype)


def pool_mix(u, prev, pos0, w_pool, scale):
    b_, t_, _ = u.shape
    ext = jnp.concatenate([prev.astype(u.dtype), u], axis=1)
    ext32 = ext.astype(jnp.float32)
    cs = jnp.pad(jnp.cumsum(ext32, axis=1), ((0, 0), (1, 0), (0, 0)))
    pos = pos0 + jnp.arange(t_, dtype=jnp.int32)
    means = []
    for g, w in enumerate(POOL_WINDOWS):
        sl = slice(g * POOL_GROUP_DIM, (g + 1) * POOL_GROUP_DIM)
        s = cs[:, POOL_BUF + 1:POOL_BUF + 1 + t_, sl] - cs[:, POOL_BUF + 1 - w:POOL_BUF + 1 - w + t_, sl]
        cnt = jnp.minimum(w, pos + 1).astype(jnp.float32)
        means.append(s / cnt[None, :, None])
    mean = jnp.stack(means, axis=2)
    diff = mean - u.astype(jnp.float32).reshape(b_, t_, N_POOL_GROUPS, POOL_GROUP_DIM)
    out = jnp.einsum('btgc,gcd->btgd', diff.astype(u.dtype), w_pool).reshape(b_, t_, D_POOL) * scale
    return out, ext[:, -POOL_BUF:]


def hgrn2_chunked(q, k, v, logf, s0):
    b_, t_, h_, _ = q.shape
    dv = v.shape[-1]
    cs = min(HGRN_CHUNK, t_)
    n = -(-t_ // cs)
    pad = n * cs - t_

    def blocks(a):
        a = jnp.pad(a, ((0, 0), (0, pad), (0, 0), (0, 0)))
        return jnp.moveaxis(a.reshape(b_, n, cs, h_, a.shape[-1]), 1, 0)

    mask = jnp.tril(jnp.ones((cs, cs), dtype=bool))

    def step(s, blk):
        qc, kc, vc, gc = blk
        bcum = jnp.cumsum(gc, axis=1)
        q_dec = qc * jnp.exp(bcum)
        k_dec = kc * jnp.exp(-bcum)
        inter = jnp.einsum('bthk,bhkv->bthv', q_dec, s)
        scores = jnp.where(mask, jnp.einsum('bthk,bshk->bhts', q_dec, k_dec), 0.0)
        intra = jnp.einsum('bhts,bshv->bthv', scores, vc)
        b_last = bcum[:, -1]
        k_end = kc * jnp.exp(b_last[:, None] - bcum)
        s_new = s * jnp.exp(b_last)[..., None] + jnp.einsum('bshk,bshv->bhkv', k_end, vc)
        return s_new, inter + intra

    s_fin, o = lax.scan(step, s0, (blocks(q), blocks(k), blocks(v), blocks(logf)))
    o = jnp.moveaxis(o, 0, 1).reshape(b_, n * cs, h_, dv)[:, :t_]
    return o, s_fin


def even_layer(h, pool_prev, s_prev, pos0, lb, w_in, w_pool, pool_scale, hgrn_gain, w_out):
    b_, t_, _ = h.shape
    proj = h @ w_in
    u = proj[..., :D_POOL]
    q, fz, iz, gz = jnp.split(proj[..., D_POOL:], 4, axis=-1)
    pool_out, pool_new = pool_mix(u, pool_prev, pos0, w_pool, pool_scale)
    lb32 = lb.astype(jnp.float32)
    fz32 = fz.astype(jnp.float32)
    logf = jnp.log(lb32 + (1.0 - lb32) * jax.nn.sigmoid(fz32))
    k = (1.0 - lb32) * jax.nn.sigmoid(-fz32)
    v = jax.nn.silu(iz.astype(jnp.float32))

    def heads(a):
        return a.reshape(b_, t_, N_HGRN_HEADS, HGRN_HEAD_DIM)

    o, s_new = hgrn2_chunked(heads(q.astype(jnp.float32)), heads(k), heads(v), heads(logf),
                             s_prev.astype(jnp.float32))
    o = o * lax.rsqrt(jnp.mean(o * o, axis=-1, keepdims=True) + EPS)
    o = o.reshape(b_, t_, D_HGRN) * hgrn_gain.astype(jnp.float32) * jax.nn.sigmoid(gz.astype(jnp.float32))
    mixed = jnp.concatenate([pool_out, o.astype(h.dtype)], axis=-1) @ w_out
    return mixed, pool_new, s_new.astype(s_prev.dtype)


def odd_layer(h, conv_prev, w_in, conv_w, w_out):
    t_ = h.shape[1]
    bg, cg, hv = jnp.split(h @ w_in, 3, axis=-1)
    z = cg * hv
    ext = jnp.concatenate([conv_prev.astype(z.dtype), z], axis=1)
    conv = conv_w[0] * ext[:, 0:t_]
    for j in range(1, CONV_WIDTH):
        conv = conv + conv_w[j] * ext[:, j:j + t_]
    return (bg * conv) @ w_out, ext[:, -CONV_BUF:]


def trunk(x, pool_st, hgrn_st, conv_st, pos0, norm_mix, norm_mlp, norm_final, even_w_in, pool_w,
          pool_scale, hgrn_lb_logits, hgrn_gain, even_w_out, odd_w_in, conv_w, odd_w_out, ff_w1, ff_w2):
    lb_all = jnp.cumsum(jax.nn.softmax(hgrn_lb_logits.astype(jnp.float32), axis=0), axis=0)
    new_pool, new_hgrn, new_conv = [], [], []
    for l in range(DEPTH):
        h = rmsnorm(x, norm_mix[l])
        if l % 2 == 0:
            e = l // 2
            mixed, p_new, s_new = even_layer(h, pool_st[e], hgrn_st[e], pos0, lb_all[l], even_w_in[e],
                                             pool_w[e], pool_scale[e], hgrn_gain[e], even_w_out[e])
            new_pool.append(p_new)
            new_hgrn.append(s_new)
        else:
            o = l // 2
            mixed, c_new = odd_layer(h, conv_st[o], odd_w_in[o], conv_w[o], odd_w_out[o])
            new_conv.append(c_new)
        x = x + mixed
        h = rmsnorm(x, norm_mlp[l])
        x = x + jnp.square(jax.nn.relu(h @ ff_w1[l])) @ ff_w2[l]
    return rmsnorm(x, norm_final), jnp.stack(new_pool), jnp.stack(new_hgrn), jnp.stack(new_conv)


def setup_inputs(seed: int = 0) -> dict:
    key = jax.random.key(seed)
    ks = jax.random.split(key, 20)
    f32 = jnp.float32

    def nrm(k, shape, scale):
        return jax.random.normal(k, shape, f32) * scale

    return {
        "x_prompt": nrm(ks[0], (BATCH, SEQ, D_MODEL), 1.0),
        "x_sample": nrm(ks[1], (DEC_BATCH, DEC_SEQ, D_MODEL), 1.0),
        "state_pool": nrm(ks[2], (N_EVEN, DEC_BATCH, POOL_BUF, D_POOL), 1.0),
        "state_hgrn": nrm(ks[3], (N_EVEN, DEC_BATCH, N_HGRN_HEADS, HGRN_HEAD_DIM, HGRN_HEAD_DIM), 0.5),
        "state_conv": nrm(ks[4], (N_ODD, DEC_BATCH, CONV_BUF, D_CONV), 0.5),
        "norm_mix": 1.0 + nrm(ks[5], (DEPTH, D_MODEL), 0.02),
        "norm_mlp": 1.0 + nrm(ks[6], (DEPTH, D_MODEL), 0.02),
        "norm_final": 1.0 + nrm(ks[7], (D_MODEL,), 0.02),
        "even_w_in": nrm(ks[8], (N_EVEN, D_MODEL, D_EVEN_IN), D_MODEL ** -0.5),
        "pool_w": nrm(ks[9], (N_EVEN, N_POOL_GROUPS, POOL_GROUP_DIM, POOL_GROUP_DIM), POOL_GROUP_DIM ** -0.5),
        "pool_scale": 0.5 + nrm(ks[10], (N_EVEN, D_POOL), 0.05),
        "hgrn_lb_logits": nrm(ks[11], (DEPTH + 1, D_HGRN), 0.1),
        "hgrn_gain": 1.0 + nrm(ks[12], (N_EVEN, D_HGRN), 0.02),
        "even_w_out": nrm(ks[13], (N_EVEN, D_MODEL, D_MODEL), D_MODEL ** -0.5),
        "odd_w_in": nrm(ks[14], (N_ODD, D_MODEL, 3 * D_CONV), D_MODEL ** -0.5),
        "conv_w": nrm(ks[15], (N_ODD, CONV_WIDTH, D_CONV), CONV_WIDTH ** -0.5),
        "odd_w_out": nrm(ks[16], (N_ODD, D_CONV, D_MODEL), D_CONV ** -0.5),
        "ff_w1": nrm(ks[17], (DEPTH, D_MODEL, D_FF), D_MODEL ** -0.5),
        "ff_w2": nrm(ks[18], (DEPTH, D_FF, D_MODEL), D_FF ** -0.5),
    }


def reference(x_prompt, x_sample, state_pool, state_hgrn, state_conv, norm_mix, norm_mlp, norm_final,
              even_w_in, pool_w, pool_scale, hgrn_lb_logits, hgrn_gain, even_w_out, odd_w_in, conv_w,
              odd_w_out, ff_w1, ff_w2):
    bp = x_prompt.shape[0]
    zero_pool = jnp.zeros((N_EVEN, bp, POOL_BUF, D_POOL), x_prompt.dtype)
    zero_hgrn = jnp.zeros((N_EVEN, bp, N_HGRN_HEADS, HGRN_HEAD_DIM, HGRN_HEAD_DIM), state_hgrn.dtype)
    zero_conv = jnp.zeros((N_ODD, bp, CONV_BUF, D_CONV), x_prompt.dtype)
    y_prompt, new_pool_prompt, new_hgrn_prompt, new_conv_prompt = trunk(
        x_prompt, zero_pool, zero_hgrn, zero_conv, 0, norm_mix, norm_mlp, norm_final, even_w_in, pool_w,
        pool_scale, hgrn_lb_logits, hgrn_gain, even_w_out, odd_w_in, conv_w, odd_w_out, ff_w1, ff_w2)
    y_sample, new_pool_sample, new_hgrn_sample, new_conv_sample = trunk(
        x_sample, state_pool, state_hgrn, state_conv, PAST_LEN, norm_mix, norm_mlp, norm_final, even_w_in,
        pool_w, pool_scale, hgrn_lb_logits, hgrn_gain, even_w_out, odd_w_in, conv_w, odd_w_out, ff_w1, ff_w2)
    return (y_prompt, y_sample, new_pool_prompt, new_hgrn_prompt, new_conv_prompt,
            new_pool_sample, new_hgrn_sample, new_conv_sample)
```

```cpp
#include <hip/hip_runtime.h>
#include <hip/hip_cooperative_groups.h>
#include <cstdio>
#include <cstdint>
namespace cg = cooperative_groups;
#ifndef DBG_O
#define DBG_O 15
#endif
namespace pg8 {
#define PG8_LAS __attribute__((address_space(3)))
typedef unsigned short bf16_t;
typedef short bf16x8 __attribute__((ext_vector_type(8)));
typedef float f32x4 __attribute__((ext_vector_type(4)));
typedef unsigned u32x4 __attribute__((ext_vector_type(4)));
constexpr int BM = 256, BK = 64, HALF = 128, HTB = HALF * BK * 2  , STAGE_BYTES = 8 * HTB, NXCD = 8, WGM = 8;

__host__ __device__ __forceinline__ int lds_byte(int r, int c) { const int st = (r >> 4) * 2 + (c >> 5), rr = r & 15, cc = c & 31, ob = rr * 64 + cc * 2; return st * 1024 + (ob ^ (((ob >> 9) & 1) << 5)); }
__host__ __device__ __forceinline__ void stage_rc(int b, int& R, int& C) { const int st = b / 1024, sb = b % 1024, swz = sb ^ (((sb >> 9) & 1) << 5); R = (st >> 1) * 16 + swz / 64; C = (st & 1) * 32 + (swz % 64) / 2; }
__host__ __device__ __forceinline__ int perm32(int rho) { const int n = rho >> 4, i = rho & 15; return 8 * (i >> 2) + 4 * n + (i & 3); }

struct Unit { int pm, pn; };
struct Gemm { const bf16_t* A; const bf16_t* Bt; int M, N, K; };

struct StaticOrder {
    int nM, nN, nwg, G, c;
    __host__ __device__ void init(int M, int N, int G_, int c_) { nM = M / BM; nN = N / BM; nwg = nM * nN; G = G_; c = c_; }
    __host__ __device__ bool next(int i, Unit& u) const {
        const long L = (long)i * G + c; if (L >= nwg) return false;
        int wgid = (int)L; { const int q = nwg / NXCD, r = nwg % NXCD, xcd = wgid % NXCD, off = wgid / NXCD; wgid = (xcd < r ? xcd * (q + 1) : r * (q + 1) + (xcd - r) * q) + off; }
        const int nig = WGM * nN, gid = wgid / nig, fm = gid * WGM, gsz = (nM - fm) < WGM ? (nM - fm) : WGM;
        u.pm = fm + ((wgid % nig) % gsz); u.pn = (wgid % nig) / gsz; return true;
    }
    __device__ __forceinline__ void a_ready(const Unit&) const {}
    __device__ __forceinline__ void done(const Unit&) const {}
};

__device__ __forceinline__ unsigned cvt_pk_bf16(float lo, float hi) { unsigned r; asm volatile("v_cvt_pk_bf16_f32 %0, %1, %2" : "=v"(r) : "v"(lo), "v"(hi)); return r; }
template <int ACT  > struct EpiScaleBf16 {
    static constexpr bool PERM = true, AFTER_DRAIN = false;
    bf16_t* O; int ldc; const float* ss;
    __device__ __forceinline__ void operator()(const f32x4 (&acc)[2][2][4][2], const Unit& u, int wr, int wc, int fr, int fq) const {
        const int row0 = u.pm * BM + wr * 64 + fr, col0 = u.pn * BM + wc * 32 + 8 * fq;
#pragma unroll
        for (int ai = 0; ai < 2; ++ai)
#pragma unroll
            for (int m = 0; m < 4; ++m) { const int row = row0 + ai * HALF + m * 16; const float rs = __builtin_amdgcn_rsqf(ss[row] * (1.0f / 1024.0f) + 1e-6f);
                bf16_t* rowp = O + (size_t)row * ldc + col0;
#pragma unroll
                for (int bj = 0; bj < 2; ++bj) { f32x4 v0 = acc[ai][bj][m][0] * rs, v1 = acc[ai][bj][m][1] * rs;
                    if (ACT == 1) {
#pragma unroll
                        for (int e = 0; e < 4; ++e) { const float a = fmaxf(v0[e], 0.f), b = fmaxf(v1[e], 0.f); v0[e] = a * a; v1[e] = b * b; } }
                    u32x4 w; w.x = cvt_pk_bf16(v0[0], v0[1]); w.y = cvt_pk_bf16(v0[2], v0[3]); w.z = cvt_pk_bf16(v1[0], v1[1]); w.w = cvt_pk_bf16(v1[2], v1[3]);
                    *(u32x4*)(rowp + bj * HALF) = w; } }
    }
};
struct EpiResid {
    static constexpr bool PERM = true, AFTER_DRAIN = false;
    const float* base; float* out; bf16_t* xb; float* ss;
    __device__ __forceinline__ void operator()(const f32x4 (&acc)[2][2][4][2], const Unit& u, int wr, int wc, int fr, int fq) const {
        const int row0 = u.pm * BM + wr * 64 + fr, col0 = u.pn * BM + wc * 32 + 8 * fq;
#pragma unroll
        for (int ai = 0; ai < 2; ++ai)
#pragma unroll
            for (int m = 0; m < 4; ++m) { const int row = row0 + ai * HALF + m * 16; const size_t off = (size_t)row * 1024 + col0; float sq = 0.f;
#pragma unroll
                for (int bj = 0; bj < 2; ++bj) { const f32x4 b0 = *(const f32x4*)(base + off + bj * HALF), b1 = *(const f32x4*)(base + off + bj * HALF + 4);
                    const f32x4 x0 = b0 + acc[ai][bj][m][0], x1 = b1 + acc[ai][bj][m][1];
                    *(f32x4*)(out + off + bj * HALF) = x0; *(f32x4*)(out + off + bj * HALF + 4) = x1;
                    sq += (x0[0] * x0[0] + x0[1] * x0[1]) + (x0[2] * x0[2] + x0[3] * x0[3]) + (x1[0] * x1[0] + x1[1] * x1[1]) + (x1[2] * x1[2] + x1[3] * x1[3]);
                    if (xb) { u32x4 w; w.x = cvt_pk_bf16(x0[0], x0[1]); w.y = cvt_pk_bf16(x0[2], x0[3]); w.z = cvt_pk_bf16(x1[0], x1[1]); w.w = cvt_pk_bf16(x1[2], x1[3]);
                        *(u32x4*)(xb + off + bj * HALF) = w; } }
                sq += __shfl_xor(sq, 16); sq += __shfl_xor(sq, 32);
                if (fq == 0) atomicAdd(ss + row, sq);
                asm volatile("" ::: "memory"); }
    }
};
template <class Epi, class Sched, bool ALIGN_EPI = false, bool SP2 = false>
__device__ __forceinline__ void gemm_phase(PG8_LAS unsigned char* lds, const Gemm g, const Sched& S, const Epi& E) {
    const int tid = threadIdx.x, wid = __builtin_amdgcn_readfirstlane(tid >> 6), lane = tid & 63, wr = wid >> 2, wc = wid & 3, fr = lane & 15, fq = lane >> 4;
    const int K = g.K, nt = K / BK;
    unsigned voffA[2], voffB[2];
#pragma unroll
    for (int i = 0; i < 2; ++i) { int R, C; stage_rc(tid * 16 + i * 8192, R, C); const int Rb = Epi::PERM ? ((R & ~31) + perm32(R & 31)) : R;
        voffA[i] = (unsigned)(R * K + C) * 2u; voffB[i] = (unsigned)(Rb * K + C) * 2u; }
    const size_t kstep = (size_t)(BK * 2);
    const size_t hstep = (size_t)HALF * K * 2;
    const size_t tstep = 2 * hstep;
    const unsigned ldsw = (unsigned)wid * 1024u;
    const int aoff = lds_byte(wr * 64 + fr, fq * 8), boff = lds_byte(wc * 32 + fr, fq * 8);
#define PG8_SA(b, h) (((b) * 2 + (h)) * HTB)
#define PG8_SB(b, h) ((4 + (b) * 2 + (h)) * HTB)
#define PG8_STAGE(bufoff, gbase, voff) do { _Pragma("unroll") for (int _i = 0; _i < 2; ++_i) \
        __builtin_amdgcn_global_load_lds((const unsigned*)((const char*)(gbase) + (voff)[_i]), (PG8_LAS unsigned*)(lds + (bufoff) + ldsw + _i * 8192), 16, 0, 0); } while (0)
#define PG8_LDA(dst, b, h) do { _Pragma("unroll") for (int m = 0; m < 4; ++m) _Pragma("unroll") for (int k = 0; k < 2; ++k) dst[m][k] = *(const PG8_LAS bf16x8*)(lds + PG8_SA(b, h) + aoff + m * 2048 + k * 1024); } while (0)
#define PG8_LDB(dst, b, h) do { _Pragma("unroll") for (int n = 0; n < 2; ++n) _Pragma("unroll") for (int k = 0; k < 2; ++k) dst[n][k] = *(const PG8_LAS bf16x8*)(lds + PG8_SB(b, h) + boff + n * 2048 + k * 1024); } while (0)
#define PG8_MMA(ai, bj, At, Bt) do { __builtin_amdgcn_s_setprio(1); _Pragma("unroll") for (int m = 0; m < 4; ++m) _Pragma("unroll") for (int n = 0; n < 2; ++n) _Pragma("unroll") for (int k = 0; k < 2; ++k) \
        acc[ai][bj][m][n] = __builtin_amdgcn_mfma_f32_16x16x32_bf16(Bt[n][k], At[m][k], acc[ai][bj][m][n], 0, 0, 0); __builtin_amdgcn_s_setprio(0); } while (0)
#define PG8_WAIT_V(n) asm volatile("s_waitcnt vmcnt(" #n ")" ::: "memory")
#define PG8_WAIT_L(n) asm volatile("s_waitcnt lgkmcnt(" #n ")" ::: "memory")
#define PG8_BAR __builtin_amdgcn_s_barrier()
#define PG8_SCHED __builtin_amdgcn_sched_barrier(0)
    Unit cur, nxt; int ui = 0;
    if (!S.next(0, cur)) return;
    f32x4 acc[2][2][4][2];
#pragma unroll
    for (int a = 0; a < 2; ++a)
#pragma unroll
        for (int b = 0; b < 2; ++b)
#pragma unroll
            for (int m = 0; m < 4; ++m)
#pragma unroll
                for (int n = 0; n < 2; ++n) acc[a][b][m][n] = (f32x4){0.f, 0.f, 0.f, 0.f};
    bf16x8 At[4][2], B0[2][2], B1[2][2];
    const char* cA = (const char*)g.A + (size_t)cur.pm * tstep; const char* cB = (const char*)g.Bt + (size_t)cur.pn * tstep;
    S.a_ready(cur);
    if constexpr (SP2) {
        PG8_STAGE(PG8_SB(0, 0), cB, voffB); PG8_STAGE(PG8_SB(0, 1), cB + hstep, voffB); PG8_STAGE(PG8_SA(0, 0), cA, voffA); PG8_STAGE(PG8_SA(0, 1), cA + hstep, voffA);
        if (wr == 1) PG8_BAR;
        PG8_WAIT_V(2); PG8_BAR;
        PG8_STAGE(PG8_SB(1, 0), cB + kstep, voffB); PG8_STAGE(PG8_SA(1, 0), cA + kstep, voffA); PG8_STAGE(PG8_SB(1, 1), cB + hstep + kstep, voffB);
        PG8_WAIT_V(6); PG8_BAR;
    } else {
        PG8_STAGE(PG8_SB(0, 0), cB, voffB); PG8_STAGE(PG8_SA(0, 0), cA, voffA); PG8_STAGE(PG8_SB(0, 1), cB + hstep, voffB); PG8_STAGE(PG8_SA(0, 1), cA + hstep, voffA);
        if (wr == 1) PG8_BAR;
        PG8_WAIT_V(4); PG8_BAR;
        PG8_STAGE(PG8_SB(1, 0), cB + kstep, voffB); PG8_STAGE(PG8_SA(1, 0), cA + kstep, voffA); PG8_STAGE(PG8_SB(1, 1), cB + hstep + kstep, voffB);
        PG8_WAIT_V(6); PG8_BAR;
    }
    for (;;) {
        const bool has_next = S.next(ui + 1, nxt);
        const char* nA = has_next ? (const char*)g.A + (size_t)nxt.pm * tstep : cA; const char* nB = has_next ? (const char*)g.Bt + (size_t)nxt.pn * tstep : cB;
        for (int t = 0; t < nt; t += 2) {
            const bool last = (t == nt - 2);
            const char* a1 = cA + (size_t)(t + 1) * kstep;
            const char* a2 = last ? nA : cA + (size_t)(t + 2) * kstep; const char* b2 = last ? nB : cB + (size_t)(t + 2) * kstep;
            const char* a3 = a2 + kstep; const char* b3 = b2 + kstep;
            if (last && has_next) S.a_ready(nxt);
            if constexpr (SP2) {
            PG8_LDB(B0, 0, 0); PG8_LDB(B1, 0, 1); PG8_SCHED; PG8_LDA(At, 0, 0); PG8_STAGE(PG8_SA(1, 1), a1 + hstep, voffA);
            PG8_WAIT_V(8); PG8_WAIT_L(0); PG8_BAR; PG8_MMA(0, 0, At, B0); PG8_MMA(0, 1, At, B1); PG8_BAR; PG8_SCHED;
            PG8_LDA(At, 0, 1); PG8_STAGE(PG8_SB(0, 0), b2, voffB); PG8_STAGE(PG8_SB(0, 1), b2 + hstep, voffB); PG8_STAGE(PG8_SA(0, 0), a2, voffA);
            PG8_WAIT_V(8); PG8_WAIT_L(0); PG8_BAR; PG8_MMA(1, 0, At, B0); PG8_MMA(1, 1, At, B1); PG8_BAR; PG8_SCHED;
            PG8_LDB(B0, 1, 0); PG8_LDB(B1, 1, 1); PG8_SCHED; PG8_LDA(At, 1, 0); PG8_STAGE(PG8_SA(0, 1), a2 + hstep, voffA);
            PG8_WAIT_V(8); PG8_WAIT_L(0); PG8_BAR; PG8_MMA(0, 0, At, B0); PG8_MMA(0, 1, At, B1); PG8_BAR; PG8_SCHED;
            PG8_LDA(At, 1, 1); PG8_STAGE(PG8_SB(1, 0), b3, voffB); PG8_STAGE(PG8_SB(1, 1), b3 + hstep, voffB); PG8_STAGE(PG8_SA(1, 0), a3, voffA);
            PG8_WAIT_V(8); PG8_WAIT_L(0); PG8_BAR; PG8_MMA(1, 0, At, B0); PG8_MMA(1, 1, At, B1); PG8_BAR; PG8_SCHED;
            } else {
            PG8_LDB(B0, 0, 0); PG8_SCHED; PG8_LDA(At, 0, 0); PG8_STAGE(PG8_SA(1, 1), a1 + hstep, voffA);
            PG8_WAIT_L(8); PG8_BAR; PG8_WAIT_L(0); PG8_MMA(0, 0, At, B0); PG8_BAR; PG8_SCHED;
            PG8_LDB(B1, 0, 1); PG8_STAGE(PG8_SB(0, 0), b2, voffB);
            PG8_BAR; PG8_WAIT_L(0); PG8_MMA(0, 1, At, B1); PG8_BAR;
            PG8_LDA(At, 0, 1); PG8_STAGE(PG8_SA(0, 0), a2, voffA);
            PG8_BAR; PG8_WAIT_L(0); PG8_MMA(1, 0, At, B0); PG8_BAR; PG8_SCHED;
            PG8_STAGE(PG8_SB(0, 1), b2 + hstep, voffB);
            PG8_WAIT_V(6); PG8_BAR; PG8_MMA(1, 1, At, B1); PG8_BAR;
            PG8_LDB(B0, 1, 0); PG8_SCHED; PG8_LDA(At, 1, 0); PG8_STAGE(PG8_SA(0, 1), a2 + hstep, voffA);
            PG8_WAIT_L(8); PG8_BAR; PG8_WAIT_L(0); PG8_MMA(0, 0, At, B0); PG8_BAR; PG8_SCHED;
            PG8_LDB(B1, 1, 1); PG8_STAGE(PG8_SB(1, 0), b3, voffB);
            PG8_BAR; PG8_WAIT_L(0); PG8_MMA(0, 1, At, B1); PG8_BAR;
            PG8_LDA(At, 1, 1); PG8_STAGE(PG8_SA(1, 0), a3, voffA);
            PG8_BAR; PG8_WAIT_L(0); PG8_MMA(1, 0, At, B0); PG8_BAR; PG8_SCHED;
            PG8_STAGE(PG8_SB(1, 1), b3 + hstep, voffB);
            PG8_WAIT_V(6); PG8_BAR; PG8_MMA(1, 1, At, B1); PG8_BAR;
            }
        }
        if constexpr (ALIGN_EPI) { if (wr == 0) PG8_BAR; }
        if constexpr (!Epi::AFTER_DRAIN) { E(acc, cur, wr, wc, fr, fq); S.done(cur); }
        if (!has_next) break;
#pragma unroll
        for (int a = 0; a < 2; ++a)
#pragma unroll
            for (int b = 0; b < 2; ++b)
#pragma unroll
                for (int m = 0; m < 4; ++m)
#pragma unroll
                    for (int n = 0; n < 2; ++n) acc[a][b][m][n] = (f32x4){0.f, 0.f, 0.f, 0.f};
        cur = nxt; cA = nA; cB = nB; ++ui;
        if constexpr (ALIGN_EPI) { if (wr == 1) PG8_BAR; }
    }
    PG8_WAIT_V(0);
    if constexpr (!ALIGN_EPI) { if (wr == 0) PG8_BAR; }
    PG8_BAR;
    if constexpr (Epi::AFTER_DRAIN) { E.fused(acc, cur, wr, wc, fr, fq, lds, wid, lane); S.done(cur); }
#undef PG8_SA
#undef PG8_SB
#undef PG8_STAGE
#undef PG8_LDA
#undef PG8_LDB
#undef PG8_MMA
#undef PG8_WAIT_V
#undef PG8_WAIT_L
#undef PG8_BAR
#undef PG8_SCHED
}
}

constexpr int NWAVES = 8, NT = 512;
constexpr int D = 1024, MP = 16384, SEQ = 2048, MS = 128, FF = 4096;
constexpr int NIN0 = 3328, NIN1 = 3072;
constexpr float EPS = 1e-6f, LOG2E = 1.4426950408889634f;
constexpr size_t MiB = 1u << 20;
constexpr size_t WS_SS = 1 * MiB, WS_XS = 2 * MiB, WS_PROJS = 3 * MiB, WS_CATS = 4 * MiB, WS_HS = 5 * MiB;
constexpr size_t WS_WIN0 = 8 * MiB, WS_WOUT0 = 15 * MiB, WS_W10 = 17 * MiB, WS_W20 = 25 * MiB, WS_WIN1 = 33 * MiB, WS_WOUT1 = 39 * MiB, WS_W11 = 41 * MiB, WS_W21 = 49 * MiB;
constexpr size_t WS_CAT = 58 * MiB, WS_SH = 90 * MiB, WS_XB = 218 * MiB, WS_END = 250 * MiB;
constexpr size_t O_Y = 0, O_YS = 16777216, O_POOLP = 16908288, O_HGP = 16939008, O_CONVP = 17725440, O_POOLS = 17741824, O_HGS = 18233344, O_CONVS = 30816256;
constexpr int LDS_BYTES = 143360;

#define LAS __attribute__((address_space(3)))
typedef unsigned short bf16;
typedef float f32x4 __attribute__((ext_vector_type(4)));
typedef short bf16x8 __attribute__((ext_vector_type(8)));
typedef unsigned u32x4 __attribute__((ext_vector_type(4)));
typedef unsigned u32x2 __attribute__((ext_vector_type(2)));
typedef unsigned short us2 __attribute__((ext_vector_type(2)));
__device__ __forceinline__ float bf2f(unsigned h) { return __uint_as_float(h << 16); }
__device__ __forceinline__ unsigned f2bf(float f) { unsigned u = __float_as_uint(f); return (u + 0x7fffu + ((u >> 16) & 1u)) >> 16; }
typedef float f32x2_t __attribute__((ext_vector_type(2)));
typedef __bf16 bf16x2_t __attribute__((ext_vector_type(2)));
__device__ __forceinline__ unsigned pk2(float lo, float hi) { const f32x2_t v = {lo, hi}; const bf16x2_t b = __builtin_convertvector(v, bf16x2_t); return __builtin_bit_cast(unsigned, b); }
__device__ __forceinline__ float fexp2(float x) { return __builtin_amdgcn_exp2f(x); }
__device__ __forceinline__ float flog2(float x) { return __builtin_amdgcn_logf(x); }
__device__ __forceinline__ float frcp(float x) { return __builtin_amdgcn_rcpf(x); }
__device__ __forceinline__ float fsigmoid(float x) { return frcp(1.0f + fexp2(-x * LOG2E)); }
__device__ __forceinline__ float wave_sum(float v) {
#pragma unroll
    for (int o = 1; o < 64; o <<= 1) v += __shfl_xor(v, o);
    return v;
}
#define MFMA16(a, b, c) __builtin_amdgcn_mfma_f32_16x16x32_bf16((a), (b), (c), 0, 0, 0)

struct PArgs { const float* in[19]; float* out; unsigned char* ws; int ph_lo, ph_hi; };

__device__ __forceinline__ void transpose_item(const float* W, const float* gk, int K, int N, bf16* WT, LAS float* scr, int item, int lane) {
    const int nblk = N / 32, kb = item / nblk, nb = item % nblk, k0 = 64 * kb, n0 = 32 * nb;
#pragma unroll 8
    for (int i = 0; i < 32; ++i) { const int kk = 2 * i + (lane >> 5); const float g = gk ? gk[k0 + kk] : 1.0f; scr[kk * 33 + (lane & 31)] = W[(size_t)(k0 + kk) * N + n0 + (lane & 31)] * g; }
    asm volatile("s_waitcnt lgkmcnt(0)" ::: "memory");
    const int c = lane & 7;
#pragma unroll
    for (int j = 0; j < 4; ++j) { const int n = (lane >> 3) + 8 * j; const LAS float* s = scr + (8 * c) * 33 + n;
        u32x4 o; o.x = pk2(s[0 * 33], s[1 * 33]); o.y = pk2(s[2 * 33], s[3 * 33]); o.z = pk2(s[4 * 33], s[5 * 33]); o.w = pk2(s[6 * 33], s[7 * 33]);
        *(u32x4*)(WT + (size_t)(n0 + n) * K + k0 + 8 * c) = o; }
    asm volatile("s_waitcnt lgkmcnt(0)" ::: "memory");
}
__device__ __forceinline__ void p0_prologue(const PArgs& a, LAS unsigned char* lds, int bid, int G, int tid, int wave, int lane) {
    LAS float* scr = (LAS float*)(lds + wave * 16384);
    const int gw = bid * NWAVES + wave, NGW = G * NWAVES;
    unsigned char* ws = a.ws;
    constexpr int I_IN0 = 16 * 104, I_O = 16 * 32, I_1 = 16 * 128, I_2 = 64 * 32, I_IN1 = 16 * 96;
    constexpr int NITEMS = I_IN0 + I_O + I_1 + I_2 + I_IN1 + I_O + I_1 + I_2;
    for (int it = gw; it < NITEMS; it += NGW) {
        int r = it;
        if (r < I_IN0) { transpose_item(a.in[8], a.in[5], D, NIN0, (bf16*)(ws + WS_WIN0), scr, r, lane); continue; } r -= I_IN0;
        if (r < I_O) { transpose_item(a.in[13], nullptr, D, D, (bf16*)(ws + WS_WOUT0), scr, r, lane); continue; } r -= I_O;
        if (r < I_1) { transpose_item(a.in[17], a.in[6], D, FF, (bf16*)(ws + WS_W10), scr, r, lane); continue; } r -= I_1;
        if (r < I_2) { transpose_item(a.in[18], nullptr, FF, D, (bf16*)(ws + WS_W20), scr, r, lane); continue; } r -= I_2;
        if (r < I_IN1) { transpose_item(a.in[14], a.in[5] + D, D, NIN1, (bf16*)(ws + WS_WIN1), scr, r, lane); continue; } r -= I_IN1;
        if (r < I_O) { transpose_item(a.in[16], nullptr, D, D, (bf16*)(ws + WS_WOUT1), scr, r, lane); continue; } r -= I_O;
        if (r < I_1) { transpose_item(a.in[17] + (size_t)D * FF, a.in[6] + D, D, FF, (bf16*)(ws + WS_W11), scr, r, lane); continue; } r -= I_1;
        transpose_item(a.in[18] + (size_t)FF * D, nullptr, FF, D, (bf16*)(ws + WS_W21), scr, r, lane);
    }
    bf16* xb0 = (bf16*)(ws + WS_CAT); float* ss = (float*)(ws + WS_SS);
    for (int m = gw; m < MP; m += NGW) {
        const f32x4* xr = (const f32x4*)(a.in[0] + (size_t)m * D) + lane; f32x4 v[4]; float s = 0.f;
#pragma unroll
        for (int j = 0; j < 4; ++j) { v[j] = xr[64 * j]; s += (v[j].x * v[j].x + v[j].y * v[j].y) + (v[j].z * v[j].z + v[j].w * v[j].w); }
        s = wave_sum(s);
        u32x2* o8 = (u32x2*)(xb0 + (size_t)m * D) + lane;
#pragma unroll
        for (int j = 0; j < 4; ++j) { u32x2 w; w.x = pk2(v[j].x, v[j].y); w.y = pk2(v[j].z, v[j].w); o8[64 * j] = w; }
        if (lane == 0) ss[m] = s;
    }
    const int gt = bid * NT + tid, NGT = G * NT;
    for (int i = gt; i < 4 * MP; i += NGT) ss[MP + i] = 0.f;
    float* xs = (float*)(ws + WS_XS);
    for (int i = gt; i < MS * D / 4; i += NGT) ((f32x4*)xs)[i] = ((const f32x4*)a.in[1])[i];
}

template <bool AF32, int EPI>
__device__ __forceinline__ void sgemm(const void* Ap, int lda, const bf16* Bt, int N, int K, int ksplit, bf16* O, int ldo, float* xs, int G, int bid, int wave, int lane) {
    const int r = lane & 15, q = lane >> 4;
    const int nstrip = N / 16, npiece = nstrip * ksplit, klen = K / ksplit;
    for (int p = G - 1 - bid; p < npiece; p += G) {
        const int strip = p % nstrip, ks = p / nstrip, n0 = strip * 16, k0 = ks * klen;
        f32x4 acc = {0.f, 0.f, 0.f, 0.f}; float sq = 0.f;
        const bf16* bp = Bt + (size_t)(n0 + r) * K + k0 + 8 * q;
        const float* apf = (const float*)Ap + (size_t)(16 * wave + r) * lda + k0 + 8 * q;
        const bf16* apb = (const bf16*)Ap + (size_t)(16 * wave + r) * lda + k0 + 8 * q;
        for (int kk = 0; kk < klen; kk += 256) {
            bf16x8 bv[8], av[8]; f32x4 af[8][2];
#pragma unroll
            for (int u = 0; u < 8; ++u) { bv[u] = *(const bf16x8*)(bp + kk + 32 * u);
                if (AF32) { af[u][0] = *(const f32x4*)(apf + kk + 32 * u); af[u][1] = *(const f32x4*)(apf + kk + 32 * u + 4); }
                else av[u] = *(const bf16x8*)(apb + kk + 32 * u); }
#pragma unroll
            for (int u = 0; u < 8; ++u) {
                if (AF32) { const f32x4 x0 = af[u][0], x1 = af[u][1];
                    sq += (x0[0] * x0[0] + x0[1] * x0[1]) + (x0[2] * x0[2] + x0[3] * x0[3]) + (x1[0] * x1[0] + x1[1] * x1[1]) + (x1[2] * x1[2] + x1[3] * x1[3]);
                    u32x4 w; w.x = pk2(x0[0], x0[1]); w.y = pk2(x0[2], x0[3]); w.z = pk2(x1[0], x1[1]); w.w = pk2(x1[2], x1[3]); av[u] = __builtin_bit_cast(bf16x8, w); }
                acc = MFMA16(av[u], bv[u], acc); }
        }
        if (EPI == 2) {
#pragma unroll
            for (int i = 0; i < 4; ++i) atomicAdd(xs + (size_t)(16 * wave + 4 * q + i) * D + n0 + r, acc[i]);
        } else {
            float tot = sq; tot += __shfl_xor(tot, 16); tot += __shfl_xor(tot, 32);
#pragma unroll
            for (int i = 0; i < 4; ++i) { const float ssr = __shfl(tot, 4 * q + i); float v = acc[i] * __builtin_amdgcn_rsqf(ssr * (1.0f / 1024.0f) + EPS);
                if (EPI == 1) { v = fmaxf(v, 0.f); v = v * v; }
                O[(size_t)(16 * wave + 4 * q + i) * ldo + n0 + r] = (bf16)f2bf(v); }
        }
    }
}

__device__ __forceinline__ float lb_of(const float* lg, int c) { const float e0 = __expf(lg[c]), e1 = __expf(lg[768 + c]), e2 = __expf(lg[1536 + c]); return e0 / (e0 + e1 + e2); }

__device__ __forceinline__ void hgrn_prompt(LAS unsigned char* lds, const bf16* proj, const float* lbl, const float* gain, bf16* cat, float* st_out, int b, int h, int tid, int wave, int lane) {
    constexpr int PQ = 272, PK = 144;
    LAS unsigned char* Qd = lds; LAS unsigned char* Kd = lds + 17408; LAS unsigned char* KeT = lds + 34816; LAS unsigned char* Vt = lds + 53248;
    LAS unsigned char* P = lds + 71680; LAS unsigned char* St = lds + 80896;
    LAS float* qsum = (LAS float*)(lds + 115712); LAS float* ebl = qsum + 512; LAS float* part = ebl + 128; LAS float* rsr = part + 512;
    const int tq = wave >> 1, k = ((wave & 1) << 6) + lane, r = lane & 15, q = lane >> 4, w = wave;
    const int ch = h * 128 + k;
    const unsigned lo_q = 256u + (unsigned)ch, lo_f = 1024u + (unsigned)ch, lo_i = 1792u + (unsigned)ch;
    const unsigned lo_g = (unsigned)(4 * q) * NIN0 + 2560u + (unsigned)(h * 128 + 16 * w + r), lo_o = (unsigned)(4 * q) * D + 256u + (unsigned)(h * 128 + 16 * w + r);
    const float lbk = lb_of(lbl, ch), oml = 1.0f - lbk;
    for (int e = tid; e < 34816 / 4; e += NT) ((LAS unsigned*)St)[e] = 0u;
    f32x4 Sacc[8];
#pragma unroll
    for (int n = 0; n < 8; ++n) Sacc[n] = (f32x4){0.f, 0.f, 0.f, 0.f};
    const bf16* pbase = proj + (size_t)(b * SEQ) * NIN0;
    const float gain_v = gain[h * 128 + 16 * w + r];
    us2 qv[8], fv[8], iv[8];
    { const bf16* prow = pbase + (size_t)(16 * tq) * NIN0;
#pragma unroll
      for (int i = 0; i < 16; ++i) { const bf16* up = prow + (size_t)i * NIN0; qv[i >> 1][i & 1] = up[lo_q]; fv[i >> 1][i & 1] = up[lo_f]; iv[i >> 1][i & 1] = up[lo_i]; } }
    for (int c = 0; c < 32; ++c) {
        float lf[16], kk[16];
#pragma unroll
        for (int i = 0; i < 16; ++i) { float fz = bf2f(fv[i >> 1][i & 1]); fz = fminf(fmaxf(fz, -30.f), 30.f); const float e = fexp2(-fz * LOG2E), sg = frcp(1.0f + e); lf[i] = flog2(lbk + oml * sg); kk[i] = oml * e * sg; }
        float run = 0.f;
#pragma unroll
        for (int i = 0; i < 16; ++i) { run += lf[i]; lf[i] = run; }
        qsum[tq * 128 + k] = run;
        { unsigned vp[8];
#pragma unroll
          for (int i = 0; i < 8; ++i) { const float z0 = bf2f(iv[i][0]), z1 = bf2f(iv[i][1]); vp[i] = pk2(z0 * fsigmoid(z0), z1 * fsigmoid(z1)); }
          *(LAS u32x4*)(Vt + k * PK + tq * 32) = (u32x4){vp[0], vp[1], vp[2], vp[3]}; *(LAS u32x4*)(Vt + k * PK + tq * 32 + 16) = (u32x4){vp[4], vp[5], vp[6], vp[7]}; }
        __syncthreads();
        float off = 0.f, tot = 0.f;
#pragma unroll
        for (int j = 0; j < 4; ++j) { const float s = qsum[j * 128 + k]; tot += s; if (j < tq) off += s; }
        if (tq == 0) ebl[k] = fexp2(tot);
        { float ke[16];
#pragma unroll
          for (int i = 0; i < 16; ++i) { const float bc = lf[i] + off; const float ed = fexp2(bc), edi = fexp2(-bc); ke[i] = kk[i] * fexp2(tot - bc);
              *(LAS unsigned short*)(Qd + (16 * tq + i) * PQ + 2 * k) = (unsigned short)f2bf(bf2f(qv[i >> 1][i & 1]) * ed);
              *(LAS unsigned short*)(Kd + (16 * tq + i) * PQ + 2 * k) = (unsigned short)f2bf(kk[i] * edi); }
          unsigned kp[8];
#pragma unroll
          for (int i = 0; i < 8; ++i) kp[i] = pk2(ke[2 * i], ke[2 * i + 1]);
          *(LAS u32x4*)(KeT + k * PK + tq * 32) = (u32x4){kp[0], kp[1], kp[2], kp[3]}; *(LAS u32x4*)(KeT + k * PK + tq * 32 + 16) = (u32x4){kp[4], kp[5], kp[6], kp[7]}; }
        const bf16* crow = pbase + (size_t)(64 * c) * NIN0;
        us2 gv[8];
#pragma unroll
        for (int ti = 0; ti < 4; ++ti)
#pragma unroll
            for (int i = 0; i < 4; ++i) { const bf16* up = crow + (size_t)(16 * ti + i) * NIN0; gv[ti * 2 + (i >> 1)][i & 1] = up[lo_g]; }
        if (c + 1 < 32) { const bf16* prow = crow + (size_t)(64 + 16 * tq) * NIN0;
#pragma unroll
            for (int i = 0; i < 16; ++i) { const bf16* up = prow + (size_t)i * NIN0; qv[i >> 1][i & 1] = up[lo_q]; fv[i >> 1][i & 1] = up[lo_f]; iv[i >> 1][i & 1] = up[lo_i]; } }
        __syncthreads();
        { const int ti = w >> 1;
#pragma unroll
          for (int sj = 0; sj < 2; ++sj) { const int si = 2 * (w & 1) + sj; f32x4 acc = {0.f, 0.f, 0.f, 0.f};
              if (si <= ti) {
#pragma unroll
                  for (int ks = 0; ks < 4; ++ks) { const bf16x8 av = *(const LAS bf16x8*)(Qd + (16 * ti + r) * PQ + ks * 64 + q * 16), bv = *(const LAS bf16x8*)(Kd + (16 * si + r) * PQ + ks * 64 + q * 16); acc = MFMA16(av, bv, acc); } }
#pragma unroll
              for (int i = 0; i < 4; ++i) { const int t = 16 * ti + 4 * q + i, s = 16 * si + r; *(LAS unsigned short*)(P + t * PK + 2 * s) = (unsigned short)f2bf(s <= t ? acc[i] : 0.f); } } }
        f32x4 o[4];
#pragma unroll
        for (int ti = 0; ti < 4; ++ti) o[ti] = (f32x4){0.f, 0.f, 0.f, 0.f};
        { bf16x8 bS[4];
#pragma unroll
          for (int ks = 0; ks < 4; ++ks) bS[ks] = *(const LAS bf16x8*)(St + (16 * w + r) * PQ + ks * 64 + q * 16);
#pragma unroll
          for (int ti = 0; ti < 4; ++ti)
#pragma unroll
              for (int ks = 0; ks < 4; ++ks) { const bf16x8 av = *(const LAS bf16x8*)(Qd + (16 * ti + r) * PQ + ks * 64 + q * 16); if (DBG_O & 1) o[ti] = MFMA16(av, bS[ks], o[ti]); } }
        __syncthreads();
        { bf16x8 bV[2];
#pragma unroll
          for (int ks = 0; ks < 2; ++ks) bV[ks] = *(const LAS bf16x8*)(Vt + (16 * w + r) * PK + ks * 64 + q * 16);
#pragma unroll
          for (int ti = 0; ti < 4; ++ti)
#pragma unroll
              for (int ks = 0; ks < 2; ++ks) { const bf16x8 av = *(const LAS bf16x8*)(P + (16 * ti + r) * PK + ks * 64 + q * 16); if (DBG_O & 2) o[ti] = MFMA16(av, bV[ks], o[ti]); } }
        { bf16x8 aK[2];
#pragma unroll
          for (int ks = 0; ks < 2; ++ks) aK[ks] = *(const LAS bf16x8*)(KeT + (16 * w + r) * PK + ks * 64 + q * 16);
          const f32x4 dk = *(const LAS f32x4*)(ebl + 16 * w + 4 * q);
#pragma unroll
          for (int n = 0; n < 8; ++n) { f32x4 s = Sacc[n] * dk;
#pragma unroll
              for (int ks = 0; ks < 2; ++ks) { const bf16x8 bv = *(const LAS bf16x8*)(Vt + (16 * n + r) * PK + ks * 64 + q * 16); s = MFMA16(aK[ks], bv, s); }
              Sacc[n] = s;
              *(LAS u32x2*)(St + (16 * n + r) * PQ + (16 * w + 4 * q) * 2) = (u32x2){pk2(s[0], s[1]), pk2(s[2], s[3])}; } }
#pragma unroll
        for (int ti = 0; ti < 4; ++ti)
#pragma unroll
            for (int i = 0; i < 4; ++i) { float p = o[ti][i] * o[ti][i]; p += __shfl_xor(p, 1); p += __shfl_xor(p, 2); p += __shfl_xor(p, 4); p += __shfl_xor(p, 8);
                if (r == 0) part[w * 64 + 16 * ti + 4 * q + i] = p; }
        __syncthreads();
        if (tid < 64) { float s = 0.f;
#pragma unroll
            for (int j = 0; j < 8; ++j) s += part[j * 64 + tid];
            rsr[tid] = __builtin_amdgcn_rsqf(s * (1.0f / 128.0f) + EPS); }
        __syncthreads();
        bf16* orow = cat + (size_t)(b * SEQ + 64 * c) * D;
#pragma unroll
        for (int ti = 0; ti < 4; ++ti)
#pragma unroll
            for (int i = 0; i < 4; ++i) { const int t = 16 * ti + 4 * q + i; const float val = o[ti][i] * ((DBG_O & 4) ? rsr[t] : 1.0f) * gain_v * ((DBG_O & 8) ? fsigmoid(bf2f(gv[ti * 2 + (i >> 1)][i & 1])) : 1.0f); bf16* up = orow + (size_t)(16 * ti + i) * D; up[lo_o] = (bf16)f2bf(val); }
    }
    float* so = st_out + (size_t)((b * 6 + h) * 128) * 128;
#pragma unroll
    for (int n = 0; n < 8; ++n)
#pragma unroll
        for (int i = 0; i < 4; ++i) so[(size_t)(16 * w + 4 * q + i) * 128 + 16 * n + r] = Sacc[n][i];
    __syncthreads();
}

__device__ __forceinline__ void hgrn_sample(LAS unsigned char* lds, const bf16* projs, const float* S0all, const float* lbl, const float* gain, bf16* cats, float* st_out, int b, int h, int tid, int wave, int lane) {
    LAS float* fk = (LAS float*)lds; LAS float* kkk = fk + 128; LAS float* qk = fk + 256; LAS float* vv = fk + 384; LAS float* red = fk + 512; LAS float* wsum = fk + 512 + 2048;
    const bf16* pr = projs + (size_t)b * NIN0;
    if (tid < 128) { const int c = h * 128 + tid; const float lbk = lb_of(lbl, c); float fz = bf2f(pr[1024 + c]); fz = fminf(fmaxf(fz, -30.f), 30.f);
        const float e = fexp2(-fz * LOG2E), sg = frcp(1.0f + e); fk[tid] = lbk + (1.0f - lbk) * sg; kkk[tid] = (1.0f - lbk) * e * sg; qk[tid] = bf2f(pr[256 + c]);
        const float z = bf2f(pr[1792 + c]); vv[tid] = z * fsigmoid(z); }
    __syncthreads();
    const int vq = tid & 31, kg = tid >> 5;
    const float* S0 = S0all + (size_t)((b * 6 + h) * 128) * 128; float* So = st_out + (size_t)((b * 6 + h) * 128) * 128;
    const f32x4 v4 = *(const LAS f32x4*)(vv + 4 * vq);
    f32x4 sv[8];
#pragma unroll
    for (int j = 0; j < 8; ++j) sv[j] = *(const f32x4*)(S0 + (size_t)(kg * 8 + j) * 128 + 4 * vq);
    f32x4 op = {0.f, 0.f, 0.f, 0.f};
#pragma unroll
    for (int j = 0; j < 8; ++j) { const int kx = kg * 8 + j; const f32x4 sn = sv[j] * fk[kx] + v4 * kkk[kx]; *(f32x4*)(So + (size_t)kx * 128 + 4 * vq) = sn; op += sn * qk[kx]; }
    *(LAS f32x4*)(red + kg * 128 + 4 * vq) = op;
    __syncthreads();
    float o = 0.f;
    if (tid < 128) {
#pragma unroll
        for (int j = 0; j < 16; ++j) o += red[j * 128 + tid];
        const float s = wave_sum(o * o); if (lane == 0) wsum[wave] = s; }
    __syncthreads();
    if (tid < 128) { const int c = h * 128 + tid; const float rs = __builtin_amdgcn_rsqf((wsum[0] + wsum[1]) * (1.0f / 128.0f) + EPS);
        cats[(size_t)b * D + 256 + c] = (bf16)f2bf(o * rs * gain[c] * fsigmoid(bf2f(pr[2560 + c]))); }
    __syncthreads();
}

__device__ __forceinline__ void pool_prompt(LAS unsigned char* lds, const bf16* proj, const float* pw, const float* pscale, bf16* cat, float* pool_out, int item, int tid) {
    LAS float* ue = (LAS float*)lds; LAS float* W = ue + 79 * 64; LAS float* df = W + 4096;
    const int g = item & 3, tt = item >> 2, b = tt >> 5, t0 = (tt & 31) * 64, wlen = 2 << g;
    for (int e = tid; e < 79 * 64; e += NT) { const int j = e >> 6, c = e & 63, t = t0 - 15 + j; ue[e] = (t >= 0) ? bf2f(proj[(size_t)(b * SEQ + t) * NIN0 + g * 64 + c]) : 0.f; }
    for (int e = tid; e < 1024; e += NT) ((LAS f32x4*)W)[e] = ((const f32x4*)(pw + g * 4096))[e];
    __syncthreads();
    const int c = tid & 63, tg = tid >> 6;
#pragma unroll
    for (int i = 0; i < 8; ++i) { const int t = tg * 8 + i; float s = 0.f;
        for (int j = 0; j < wlen; ++j) s += ue[(15 + t - j) * 64 + c];
        const int pos = t0 + t; const float cnt = (float)(wlen < pos + 1 ? wlen : pos + 1); const float u = ue[(15 + t) * 64 + c];
        df[t * 64 + c] = s / cnt - u;
        if (pos >= SEQ - 15) pool_out[(size_t)(b * 15 + (pos - (SEQ - 15))) * 256 + g * 64 + c] = u; }
    __syncthreads();
    float acc[8];
#pragma unroll
    for (int i = 0; i < 8; ++i) acc[i] = 0.f;
    for (int cc = 0; cc < 64; ++cc) { const float wv = W[cc * 64 + c];
#pragma unroll
        for (int i = 0; i < 8; ++i) acc[i] += df[(tg * 8 + i) * 64 + cc] * wv; }
    const float sc = pscale[g * 64 + c];
#pragma unroll
    for (int i = 0; i < 8; ++i) cat[(size_t)(b * SEQ + t0 + tg * 8 + i) * D + g * 64 + c] = (bf16)f2bf(acc[i] * sc);
    __syncthreads();
}
__device__ __forceinline__ void pool_sample(LAS unsigned char* lds, const bf16* projs, const float* spool, const float* pw, const float* pscale, bf16* cats, float* pool_out, int b, int tid) {
    LAS float* df = (LAS float*)lds;
    const int ch = tid & 255, g = ch >> 6, wlen = 2 << g;
    if (tid < 256) { const float u = bf2f(projs[(size_t)b * NIN0 + ch]); float s = u;
        for (int j = 0; j < wlen - 1; ++j) s += spool[(size_t)(b * 15 + 14 - j) * 256 + ch];
        df[ch] = s / (float)wlen - u;
        for (int j = 0; j < 14; ++j) pool_out[(size_t)(b * 15 + j) * 256 + ch] = spool[(size_t)(b * 15 + j + 1) * 256 + ch];
        pool_out[(size_t)(b * 15 + 14) * 256 + ch] = u; }
    __syncthreads();
    if (tid < 256) { const int d = ch & 63; float acc = 0.f;
        for (int cc = 0; cc < 64; ++cc) acc += df[g * 64 + cc] * pw[g * 4096 + cc * 64 + d];
        cats[(size_t)b * D + ch] = (bf16)f2bf(acc * pscale[ch]); }
    __syncthreads();
}

__device__ __forceinline__ void unpack8(const u32x4 w, float (&f)[8]) {
    f[0] = __uint_as_float(w.x << 16); f[1] = __uint_as_float(w.x & 0xffff0000u); f[2] = __uint_as_float(w.y << 16); f[3] = __uint_as_float(w.y & 0xffff0000u);
    f[4] = __uint_as_float(w.z << 16); f[5] = __uint_as_float(w.z & 0xffff0000u); f[6] = __uint_as_float(w.w << 16); f[7] = __uint_as_float(w.w & 0xffff0000u);
}
__device__ __forceinline__ void conv_phase(const PArgs& a, int bid, int G, int tid) {
    unsigned char* ws = a.ws;
    const bf16* proj = (const bf16*)(ws + WS_SH); bf16* cat = (bf16*)(ws + WS_CAT); const float* cw = a.in[15];
    for (int gt = bid * NT + tid; gt < 1024 * 128; gt += G * NT) {
        const int cgp = gt & 127, rb = gt >> 7, b = rb >> 7, tl0 = (rb & 127) * 16, c0 = 8 * cgp;
        float w0[8], w1[8], w2[8], zm2[8], zm1[8];
#pragma unroll
        for (int e = 0; e < 8; ++e) { w0[e] = cw[c0 + e]; w1[e] = cw[1024 + c0 + e]; w2[e] = cw[2048 + c0 + e]; zm2[e] = 0.f; zm1[e] = 0.f; }
        const bf16* pr = proj + (size_t)(b * SEQ + tl0) * NIN1 + c0;
        if (tl0 > 0) { float cgv[8], hvv[8];
            unpack8(*(const u32x4*)(pr - 2 * NIN1 + 1024), cgv); unpack8(*(const u32x4*)(pr - 2 * NIN1 + 2048), hvv);
#pragma unroll
            for (int e = 0; e < 8; ++e) zm2[e] = cgv[e] * hvv[e];
            unpack8(*(const u32x4*)(pr - NIN1 + 1024), cgv); unpack8(*(const u32x4*)(pr - NIN1 + 2048), hvv);
#pragma unroll
            for (int e = 0; e < 8; ++e) zm1[e] = cgv[e] * hvv[e]; }
#pragma unroll 1
        for (int i = 0; i < 16; ++i) { float bgv[8], cgv[8], hvv[8], o[8];
            unpack8(*(const u32x4*)(pr + (size_t)i * NIN1), bgv); unpack8(*(const u32x4*)(pr + (size_t)i * NIN1 + 1024), cgv); unpack8(*(const u32x4*)(pr + (size_t)i * NIN1 + 2048), hvv);
#pragma unroll
            for (int e = 0; e < 8; ++e) { const float z = cgv[e] * hvv[e]; o[e] = bgv[e] * (w0[e] * zm2[e] + w1[e] * zm1[e] + w2[e] * z); zm2[e] = zm1[e]; zm1[e] = z; }
            *(u32x4*)(cat + (size_t)(b * SEQ + tl0 + i) * D + c0) = (u32x4){pk2(o[0], o[1]), pk2(o[2], o[3]), pk2(o[4], o[5]), pk2(o[6], o[7])};
            const int t = tl0 + i;
            if (t >= SEQ - 2) { float* co = a.out + O_CONVP + (size_t)(b * 2 + (t - (SEQ - 2))) * 1024 + c0;
                *(f32x4*)co = (f32x4){zm1[0], zm1[1], zm1[2], zm1[3]}; *(f32x4*)(co + 4) = (f32x4){zm1[4], zm1[5], zm1[6], zm1[7]}; } }
    }
    const bf16* projs = (const bf16*)(ws + WS_PROJS); bf16* cats = (bf16*)(ws + WS_CATS); const float* sc = a.in[4];
    for (int gt = bid * NT + tid; gt < MS * 128; gt += G * NT) {
        const int cgp = gt & 127, b = gt >> 7, c0 = 8 * cgp; float bgv[8], cgv[8], hvv[8], o[8], z[8];
        const bf16* pr = projs + (size_t)b * NIN1 + c0;
        unpack8(*(const u32x4*)pr, bgv); unpack8(*(const u32x4*)(pr + 1024), cgv); unpack8(*(const u32x4*)(pr + 2048), hvv);
        const float* p0 = sc + (size_t)(b * 2) * 1024 + c0; const float* p1 = p0 + 1024;
        float* co = a.out + O_CONVS + (size_t)(b * 2) * 1024 + c0;
#pragma unroll
        for (int e = 0; e < 8; ++e) { z[e] = cgv[e] * hvv[e]; o[e] = bgv[e] * (cw[c0 + e] * p0[e] + cw[1024 + c0 + e] * p1[e] + cw[2048 + c0 + e] * z[e]); co[e] = p1[e]; co[1024 + e] = z[e]; }
        *(u32x4*)(cats + (size_t)b * D + c0) = (u32x4){pk2(o[0], o[1]), pk2(o[2], o[3]), pk2(o[4], o[5]), pk2(o[6], o[7])};
    }
}

__device__ __forceinline__ void final_norm(const PArgs& a, int bid, int G, int wave, int lane) {
    const int gw = bid * NWAVES + wave, NGW = G * NWAVES; const float* gf = a.in[7]; const float* ss4 = (const float*)(a.ws + WS_SS) + 4 * MP;
    f32x4 gv[4];
#pragma unroll
    for (int j = 0; j < 4; ++j) gv[j] = ((const f32x4*)gf)[lane + 64 * j];
    for (int m = gw; m < MP + MS; m += NGW) {
        if (m < MP) { f32x4* yr = (f32x4*)(a.out + O_Y + (size_t)m * D) + lane; const float rs = __builtin_amdgcn_rsqf(ss4[m] * (1.0f / 1024.0f) + EPS);
#pragma unroll
            for (int j = 0; j < 4; ++j) { const f32x4 v = yr[64 * j]; yr[64 * j] = v * rs * gv[j]; } }
        else { const int sr = m - MP; const f32x4* xr = (const f32x4*)((const float*)(a.ws + WS_XS) + (size_t)sr * D) + lane; f32x4* yr = (f32x4*)(a.out + O_YS + (size_t)sr * D) + lane;
            f32x4 v[4]; float s = 0.f;
#pragma unroll
            for (int j = 0; j < 4; ++j) { v[j] = xr[64 * j]; s += (v[j].x * v[j].x + v[j].y * v[j].y) + (v[j].z * v[j].z + v[j].w * v[j].w); }
            const float rs = __builtin_amdgcn_rsqf(wave_sum(s) * (1.0f / 1024.0f) + EPS);
#pragma unroll
            for (int j = 0; j < 4; ++j) yr[64 * j] = v[j] * rs * gv[j]; }
    }
}

#ifndef DIS_GEMM
#define DIS_GEMM 0
#endif
#ifndef DIS_SGEMM
#define DIS_SGEMM 0
#endif
#ifndef DIS_HGRN
#define DIS_HGRN 0
#endif
#ifndef DIS_OTHER
#define DIS_OTHER 0
#endif
#ifndef DBG_O
#define DBG_O 15
#endif
#ifndef DBG_COL
#define DBG_COL 2304
#endif
#ifndef DBG_HI
#define DBG_HI 12
#endif
#ifndef MK_MULTI
#define MK_MULTI 0
#endif
constexpr int N_PHASES = 12;
#define IN(k) (lo <= (k) && (k) < hi)
#define SEAM(k) do { if (IN(k) && IN((k) + 1)) cg::this_grid().sync(); } while (0)
template <int L>
__device__ __forceinline__ void layer_phases(const PArgs& a, LAS unsigned char* lds, int lo, int hi, int bid, int G, int tid, int wave, int lane) {
    unsigned char* ws = a.ws;
    float* ss = (float*)(ws + WS_SS);
    bf16* CAT = (bf16*)(ws + WS_CAT); bf16* SH = (bf16*)(ws + WS_SH); bf16* XB = (bf16*)(ws + WS_XB);
    float* xs = (float*)(ws + WS_XS); bf16* projs = (bf16*)(ws + WS_PROJS); bf16* cats = (bf16*)(ws + WS_CATS); bf16* hs = (bf16*)(ws + WS_HS);
    float* Y = a.out + O_Y;
    constexpr int pb = 1 + 5 * L;
    const bf16* Win = (const bf16*)(ws + (L ? WS_WIN1 : WS_WIN0)); const bf16* Wout = (const bf16*)(ws + (L ? WS_WOUT1 : WS_WOUT0));
    const bf16* W1 = (const bf16*)(ws + (L ? WS_W11 : WS_W10)); const bf16* W2 = (const bf16*)(ws + (L ? WS_W21 : WS_W20));
    constexpr int Nin = L ? NIN1 : NIN0;
    if (IN(pb)) {
        pg8::Gemm g{L ? XB : CAT, Win, MP, Nin, D}; pg8::StaticOrder S; S.init(MP, Nin, G, bid);
        pg8::EpiScaleBf16<0> E{SH, Nin, ss + (L ? 2 : 0) * MP};
        if (!DIS_GEMM) pg8::gemm_phase<pg8::EpiScaleBf16<0>, pg8::StaticOrder, true, true>(lds, g, S, E);
        if (!DIS_SGEMM) sgemm<true, 0>(L ? (const void*)xs : (const void*)a.in[1], D, Win, Nin, D, 1, projs, Nin, xs, G, bid, wave, lane);
    }
    SEAM(pb);
    if (IN(pb + 1)) {
        if (L == 0) {
            if (bid < 48) { if (!DIS_HGRN) hgrn_prompt(lds, SH, a.in[11], a.in[12], CAT, a.out + O_HGP, bid / 6, bid % 6, tid, wave, lane); }
            else if (!DIS_OTHER) { const int ob = bid - 48, NO = G - 48;
                for (int it = ob; it < MS * 6; it += NO) hgrn_sample(lds, projs, a.in[3], a.in[11], a.in[12], cats, a.out + O_HGS, it / 6, it % 6, tid, wave, lane);
                for (int it = ob; it < 1024; it += NO) pool_prompt(lds, SH, a.in[9], a.in[10], CAT, a.out + O_POOLP, it, tid);
                for (int it = ob; it < MS; it += NO) pool_sample(lds, projs, a.in[2], a.in[9], a.in[10], cats, a.out + O_POOLS, it, tid); }
        } else if (!DIS_OTHER) conv_phase(a, bid, G, tid);
    }
    SEAM(pb + 1);
    if (IN(pb + 2)) {
        pg8::Gemm g{CAT, Wout, MP, D, D}; pg8::StaticOrder S; S.init(MP, D, G, bid);
        pg8::EpiResid E{L ? (const float*)Y : a.in[0], Y, XB, ss + (L ? 3 : 1) * MP};
        if (!DIS_GEMM) pg8::gemm_phase<pg8::EpiResid, pg8::StaticOrder, true, true>(lds, g, S, E);
        if (!DIS_SGEMM) sgemm<false, 2>(cats, D, Wout, D, D, 4, nullptr, 0, xs, G, bid, wave, lane);
    }
    SEAM(pb + 2);
    if (IN(pb + 3)) {
        pg8::Gemm g{XB, W1, MP, FF, D}; pg8::StaticOrder S; S.init(MP, FF, G, bid);
        pg8::EpiScaleBf16<1> E{SH, FF, ss + (L ? 3 : 1) * MP};
        if (!DIS_GEMM) pg8::gemm_phase<pg8::EpiScaleBf16<1>, pg8::StaticOrder, true, true>(lds, g, S, E);
        if (!DIS_SGEMM) sgemm<true, 1>(xs, D, W1, FF, D, 1, hs, FF, xs, G, bid, wave, lane);
    }
    SEAM(pb + 3);
    if (IN(pb + 4)) {
        pg8::Gemm g{SH, W2, MP, D, FF}; pg8::StaticOrder S; S.init(MP, D, G, bid);
        pg8::EpiResid E{Y, Y, L ? nullptr : XB, ss + (L ? 4 : 2) * MP};
        if (!DIS_GEMM) pg8::gemm_phase<pg8::EpiResid, pg8::StaticOrder, true, true>(lds, g, S, E);
        if (!DIS_SGEMM) sgemm<false, 2>(hs, FF, W2, D, FF, 4, nullptr, 0, xs, G, bid, wave, lane);
    }
    SEAM(pb + 4);
}
__global__ void __launch_bounds__(NT, 2) mk_fwd(PArgs a) {
    extern __shared__ __attribute__((aligned(16))) unsigned char lds_raw[];
    LAS unsigned char* lds = (LAS unsigned char*)lds_raw;
    const int tid = threadIdx.x, lane = tid & 63, wave = __builtin_amdgcn_readfirstlane(tid >> 6), bid = blockIdx.x, G = gridDim.x;
    const int lo = a.ph_lo, hi = a.ph_hi;
    if (IN(0)) { p0_prologue(a, lds, bid, G, tid, wave, lane); __syncthreads(); }
    SEAM(0);
    layer_phases<0>(a, lds, lo, hi, bid, G, tid, wave, lane);
    layer_phases<1>(a, lds, lo, hi, bid, G, tid, wave, lane);
    if (IN(11)) final_norm(a, bid, G, wave, lane);
    if (hi < 12) {
        if (hi <= 3) { cg::this_grid().sync(); const bf16* C = (const bf16*)(a.ws + WS_CAT); for (size_t i = (size_t)bid * NT + tid; i < O_YS; i += (size_t)G * NT) a.out[i] = ((i & 1023) >= 256) ? bf2f(C[i]) : 0.f; }
        for (size_t i = (size_t)bid * NT + tid; i < 131072; i += (size_t)G * NT) a.out[O_YS + i] = 0.f;
        if (hi <= 2) for (size_t i = (size_t)bid * NT + tid + O_POOLP; i < O_CONVS; i += (size_t)G * NT) a.out[i] = 0.f;
        if (hi <= 7) { for (size_t i = (size_t)bid * NT + tid; i < 16384; i += (size_t)G * NT) a.out[O_CONVP + i] = 0.f;
                       for (size_t i = (size_t)bid * NT + tid; i < 262144; i += (size_t)G * NT) a.out[O_CONVS + i] = 0.f; }
    }
}
#undef IN
#undef SEAM

extern "C" void kernel_launch(void* const* d_in, const int* in_sizes, int n_in, void* d_out, int out_size, void* d_ws, size_t ws_size, hipStream_t stream) {
    static int grid = 0;
    if (grid == 0) {
        if (n_in != 19 || ws_size < WS_END) { fprintf(stderr, "kernel_launch: unexpected inputs (n_in %d, ws %zu)\n", n_in, ws_size); grid = -1; return; }
        int dev = 0, cus = 0, per_cu = 0;
        if (hipGetDevice(&dev) != hipSuccess || hipDeviceGetAttribute(&cus, hipDeviceAttributeMultiprocessorCount, dev) != hipSuccess) { grid = -1; return; }
        if (hipFuncSetAttribute((const void*)mk_fwd, hipFuncAttributeMaxDynamicSharedMemorySize, LDS_BYTES) != hipSuccess) { fprintf(stderr, "kernel_launch: hipFuncSetAttribute failed\n"); grid = -1; return; }
        if (hipOccupancyMaxActiveBlocksPerMultiprocessor(&per_cu, (const void*)mk_fwd, NT, LDS_BYTES) != hipSuccess || per_cu < 1) { fprintf(stderr, "kernel_launch: occupancy query says %d\n", per_cu); per_cu = 1; }
        (void)hipGetLastError();
        grid = cus;
    }
    if (grid < 0) return;
    PArgs a{};
    for (int i = 0; i < 19; ++i) a.in[i] = (const float*)d_in[i];
    a.out = (float*)d_out; a.ws = (unsigned char*)d_ws;
#if MK_MULTI
    for (int k = 0; k < DBG_HI; ++k) { a.ph_lo = k; a.ph_hi = k + 1; hipLaunchKernelGGL(mk_fwd, dim3(grid), dim3(NT), LDS_BYTES, stream, a); }
#else
    a.ph_lo = 0; a.ph_hi = DBG_HI;
    void* args[] = {&a};
    hipError_t e = hipLaunchCooperativeKernel((const void*)mk_fwd, dim3(grid), dim3(NT), args, LDS_BYTES, stream);
    if (e != hipSuccess) fprintf(stderr, "cooperative launch failed: %s (grid %d)\n", hipGetErrorString(e), grid);
#endif
}
```

```cpp
#include <hip/hip_runtime.h>
#include <hip/hip_cooperative_groups.h>
#include <cstdio>
#include <cstdint>
namespace cg = cooperative_groups;
#ifndef DBG_O
#define DBG_O 15
#endif
namespace pg8 {
#define PG8_LAS __attribute__((address_space(3)))
typedef unsigned short bf16_t;
typedef short bf16x8 __attribute__((ext_vector_type(8)));
typedef float f32x4 __attribute__((ext_vector_type(4)));
typedef unsigned u32x4 __attribute__((ext_vector_type(4)));
constexpr int BM = 256, BK = 64, HALF = 128, HTB = HALF * BK * 2  , STAGE_BYTES = 8 * HTB, NXCD = 8, WGM = 8;

__host__ __device__ __forceinline__ int lds_byte(int r, int c) { const int st = (r >> 4) * 2 + (c >> 5), rr = r & 15, cc = c & 31, ob = rr * 64 + cc * 2; return st * 1024 + (ob ^ (((ob >> 9) & 1) << 5)); }
__host__ __device__ __forceinline__ void stage_rc(int b, int& R, int& C) { const int st = b / 1024, sb = b % 1024, swz = sb ^ (((sb >> 9) & 1) << 5); R = (st >> 1) * 16 + swz / 64; C = (st & 1) * 32 + (swz % 64) / 2; }
__host__ __device__ __forceinline__ int perm32(int rho) { const int n = rho >> 4, i = rho & 15; return 8 * (i >> 2) + 4 * n + (i & 3); }

struct Unit { int pm, pn; };
struct Gemm { const bf16_t* A; const bf16_t* Bt; int M, N, K; };

struct StaticOrder {
    int nM, nN, nwg, G, c;
    __host__ __device__ void init(int M, int N, int G_, int c_) { nM = M / BM; nN = N / BM; nwg = nM * nN; G = G_; c = c_; }
    __host__ __device__ bool next(int i, Unit& u) const {
        const long L = (long)i * G + c; if (L >= nwg) return false;
        int wgid = (int)L; { const int q = nwg / NXCD, r = nwg % NXCD, xcd = wgid % NXCD, off = wgid / NXCD; wgid = (xcd < r ? xcd * (q + 1) : r * (q + 1) + (xcd - r) * q) + off; }
        const int nig = WGM * nN, gid = wgid / nig, fm = gid * WGM, gsz = (nM - fm) < WGM ? (nM - fm) : WGM;
        u.pm = fm + ((wgid % nig) % gsz); u.pn = (wgid % nig) / gsz; return true;
    }
    __device__ __forceinline__ void a_ready(const Unit&) const {}
    __device__ __forceinline__ void done(const Unit&) const {}
};

__device__ __forceinline__ unsigned cvt_pk_bf16(float lo, float hi) { unsigned r; asm volatile("v_cvt_pk_bf16_f32 %0, %1, %2" : "=v"(r) : "v"(lo), "v"(hi)); return r; }
template <int ACT  > struct EpiScaleBf16 {
    static constexpr bool PERM = true, AFTER_DRAIN = false;
    bf16_t* O; int ldc; const float* ss;
    __device__ __forceinline__ void operator()(const f32x4 (&acc)[2][2][4][2], const Unit& u, int wr, int wc, int fr, int fq) const {
        const int row0 = u.pm * BM + wr * 64 + fr, col0 = u.pn * BM + wc * 32 + 8 * fq;
#pragma unroll
        for (int ai = 0; ai < 2; ++ai)
#pragma unroll
            for (int m = 0; m < 4; ++m) { const int row = row0 + ai * HALF + m * 16; const float rs = __builtin_amdgcn_rsqf(ss[row] * (1.0f / 1024.0f) + 1e-6f);
                bf16_t* rowp = O + (size_t)row * ldc + col0;
#pragma unroll
                for (int bj = 0; bj < 2; ++bj) { f32x4 v0 = acc[ai][bj][m][0] * rs, v1 = acc[ai][bj][m][1] * rs;
                    if (ACT == 1) {
#pragma unroll
                        for (int e = 0; e < 4; ++e) { const float a = fmaxf(v0[e], 0.f), b = fmaxf(v1[e], 0.f); v0[e] = a * a; v1[e] = b * b; } }
                    u32x4 w; w.x = cvt_pk_bf16(v0[0], v0[1]); w.y = cvt_pk_bf16(v0[2], v0[3]); w.z = cvt_pk_bf16(v1[0], v1[1]); w.w = cvt_pk_bf16(v1[2], v1[3]);
                    *(u32x4*)(rowp + bj * HALF) = w; } }
    }
};
struct EpiResid {
    static constexpr bool PERM = true, AFTER_DRAIN = false;
    const float* base; float* out; bf16_t* xb; float* ss;
    __device__ __forceinline__ void operator()(const f32x4 (&acc)[2][2][4][2], const Unit& u, int wr, int wc, int fr, int fq) const {
        const int row0 = u.pm * BM + wr * 64 + fr, col0 = u.pn * BM + wc * 32 + 8 * fq;
#pragma unroll
        for (int ai = 0; ai < 2; ++ai)
#pragma unroll
            for (int m = 0; m < 4; ++m) { const int row = row0 + ai * HALF + m * 16; const size_t off = (size_t)row * 1024 + col0; float sq = 0.f;
#pragma unroll
                for (int bj = 0; bj < 2; ++bj) { const f32x4 b0 = *(const f32x4*)(base + off + bj * HALF), b1 = *(const f32x4*)(base + off + bj * HALF + 4);
                    const f32x4 x0 = b0 + acc[ai][bj][m][0], x1 = b1 + acc[ai][bj][m][1];
                    *(f32x4*)(out + off + bj * HALF) = x0; *(f32x4*)(out + off + bj * HALF + 4) = x1;
                    sq += (x0[0] * x0[0] + x0[1] * x0[1]) + (x0[2] * x0[2] + x0[3] * x0[3]) + (x1[0] * x1[0] + x1[1] * x1[1]) + (x1[2] * x1[2] + x1[3] * x1[3]);
                    if (xb) { u32x4 w; w.x = cvt_pk_bf16(x0[0], x0[1]); w.y = cvt_pk_bf16(x0[2], x0[3]); w.z = cvt_pk_bf16(x1[0], x1[1]); w.w = cvt_pk_bf16(x1[2], x1[3]);
                        *(u32x4*)(xb + off + bj * HALF) = w; } }
                sq += __shfl_xor(sq, 16); sq += __shfl_xor(sq, 32);
                if (fq == 0) atomicAdd(ss + row, sq);
                asm volatile("" ::: "memory"); }
    }
};
template <class Epi, class Sched, bool ALIGN_EPI = false, bool SP2 = false>
__device__ __forceinline__ void gemm_phase(PG8_LAS unsigned char* lds, const Gemm g, const Sched& S, const Epi& E) {
    const int tid = threadIdx.x, wid = __builtin_amdgcn_readfirstlane(tid >> 6), lane = tid & 63, wr = wid >> 2, wc = wid & 3, fr = lane & 15, fq = lane >> 4;
    const int K = g.K, nt = K / BK;
    unsigned voffA[2], voffB[2];
#pragma unroll
    for (int i = 0; i < 2; ++i) { int R, C; stage_rc(tid * 16 + i * 8192, R, C); const int Rb = Epi::PERM ? ((R & ~31) + perm32(R & 31)) : R;
        voffA[i] = (unsigned)(R * K + C) * 2u; voffB[i] = (unsigned)(Rb * K + C) * 2u; }
    const size_t kstep = (size_t)(BK * 2);
    const size_t hstep = (size_t)HALF * K * 2;
    const size_t tstep = 2 * hstep;
    const unsigned ldsw = (unsigned)wid * 1024u;
    const int aoff = lds_byte(wr * 64 + fr, fq * 8), boff = lds_byte(wc * 32 + fr, fq * 8);
#define PG8_SA(b, h) (((b) * 2 + (h)) * HTB)
#define PG8_SB(b, h) ((4 + (b) * 2 + (h)) * HTB)
#define PG8_STAGE(bufoff, gbase, voff) do { _Pragma("unroll") for (int _i = 0; _i < 2; ++_i) \
        __builtin_amdgcn_global_load_lds((const unsigned*)((const char*)(gbase) + (voff)[_i]), (PG8_LAS unsigned*)(lds + (bufoff) + ldsw + _i * 8192), 16, 0, 0); } while (0)
#define PG8_LDA(dst, b, h) do { _Pragma("unroll") for (int m = 0; m < 4; ++m) _Pragma("unroll") for (int k = 0; k < 2; ++k) dst[m][k] = *(const PG8_LAS bf16x8*)(lds + PG8_SA(b, h) + aoff + m * 2048 + k * 1024); } while (0)
#define PG8_LDB(dst, b, h) do { _Pragma("unroll") for (int n = 0; n < 2; ++n) _Pragma("unroll") for (int k = 0; k < 2; ++k) dst[n][k] = *(const PG8_LAS bf16x8*)(lds + PG8_SB(b, h) + boff + n * 2048 + k * 1024); } while (0)
#define PG8_MMA(ai, bj, At, Bt) do { __builtin_amdgcn_s_setprio(1); _Pragma("unroll") for (int m = 0; m < 4; ++m) _Pragma("unroll") for (int n = 0; n < 2; ++n) _Pragma("unroll") for (int k = 0; k < 2; ++k) \
        acc[ai][bj][m][n] = __builtin_amdgcn_mfma_f32_16x16x32_bf16(Bt[n][k], At[m][k], acc[ai][bj][m][n], 0, 0, 0); __builtin_amdgcn_s_setprio(0); } while (0)
#define PG8_WAIT_V(n) asm volatile("s_waitcnt vmcnt(" #n ")" ::: "memory")
#define PG8_WAIT_L(n) asm volatile("s_waitcnt lgkmcnt(" #n ")" ::: "memory")
#define PG8_BAR __builtin_amdgcn_s_barrier()
#define PG8_SCHED __builtin_amdgcn_sched_barrier(0)
    Unit cur, nxt; int ui = 0;
    if (!S.next(0, cur)) return;
    f32x4 acc[2][2][4][2];
#pragma unroll
    for (int a = 0; a < 2; ++a)
#pragma unroll
        for (int b = 0; b < 2; ++b)
#pragma unroll
            for (int m = 0; m < 4; ++m)
#pragma unroll
                for (int n = 0; n < 2; ++n) acc[a][b][m][n] = (f32x4){0.f, 0.f, 0.f, 0.f};
    bf16x8 At[4][2], B0[2][2], B1[2][2];
    const char* cA = (const char*)g.A + (size_t)cur.pm * tstep; const char* cB = (const char*)g.Bt + (size_t)cur.pn * tstep;
    S.a_ready(cur);
    if constexpr (SP2) {
        PG8_STAGE(PG8_SB(0, 0), cB, voffB); PG8_STAGE(PG8_SB(0, 1), cB + hstep, voffB); PG8_STAGE(PG8_SA(0, 0), cA, voffA); PG8_STAGE(PG8_SA(0, 1), cA + hstep, voffA);
        if (wr == 1) PG8_BAR;
        PG8_WAIT_V(2); PG8_BAR;
        PG8_STAGE(PG8_SB(1, 0), cB + kstep, voffB); PG8_STAGE(PG8_SA(1, 0), cA + kstep, voffA); PG8_STAGE(PG8_SB(1, 1), cB + hstep + kstep, voffB);
        PG8_WAIT_V(6); PG8_BAR;
    } else {
        PG8_STAGE(PG8_SB(0, 0), cB, voffB); PG8_STAGE(PG8_SA(0, 0), cA, voffA); PG8_STAGE(PG8_SB(0, 1), cB + hstep, voffB); PG8_STAGE(PG8_SA(0, 1), cA + hstep, voffA);
        if (wr == 1) PG8_BAR;
        PG8_WAIT_V(4); PG8_BAR;
        PG8_STAGE(PG8_SB(1, 0), cB + kstep, voffB); PG8_STAGE(PG8_SA(1, 0), cA + kstep, voffA); PG8_STAGE(PG8_SB(1, 1), cB + hstep + kstep, voffB);
        PG8_WAIT_V(6); PG8_BAR;
    }
    for (;;) {
        const bool has_next = S.next(ui + 1, nxt);
        const char* nA = has_next ? (const char*)g.A + (size_t)nxt.pm * tstep : cA; const char* nB = has_next ? (const char*)g.Bt + (size_t)nxt.pn * tstep : cB;
        for (int t = 0; t < nt; t += 2) {
            const bool last = (t == nt - 2);
            const char* a1 = cA + (size_t)(t + 1) * kstep;
            const char* a2 = last ? nA : cA + (size_t)(t + 2) * kstep; const char* b2 = last ? nB : cB + (size_t)(t + 2) * kstep;
            const char* a3 = a2 + kstep; const char* b3 = b2 + kstep;
            if (last && has_next) S.a_ready(nxt);
            if constexpr (SP2) {
            PG8_LDB(B0, 0, 0); PG8_LDB(B1, 0, 1); PG8_SCHED; PG8_LDA(At, 0, 0); PG8_STAGE(PG8_SA(1, 1), a1 + hstep, voffA);
            PG8_WAIT_V(8); PG8_WAIT_L(0); PG8_BAR; PG8_MMA(0, 0, At, B0); PG8_MMA(0, 1, At, B1); PG8_BAR; PG8_SCHED;
            PG8_LDA(At, 0, 1); PG8_STAGE(PG8_SB(0, 0), b2, voffB); PG8_STAGE(PG8_SB(0, 1), b2 + hstep, voffB); PG8_STAGE(PG8_SA(0, 0), a2, voffA);
            PG8_WAIT_V(8); PG8_WAIT_L(0); PG8_BAR; PG8_MMA(1, 0, At, B0); PG8_MMA(1, 1, At, B1); PG8_BAR; PG8_SCHED;
            PG8_LDB(B0, 1, 0); PG8_LDB(B1, 1, 1); PG8_SCHED; PG8_LDA(At, 1, 0); PG8_STAGE(PG8_SA(0, 1), a2 + hstep, voffA);
            PG8_WAIT_V(8); PG8_WAIT_L(0); PG8_BAR; PG8_MMA(0, 0, At, B0); PG8_MMA(0, 1, At, B1); PG8_BAR; PG8_SCHED;
            PG8_LDA(At, 1, 1); PG8_STAGE(PG8_SB(1, 0), b3, voffB); PG8_STAGE(PG8_SB(1, 1), b3 + hstep, voffB); PG8_STAGE(PG8_SA(1, 0), a3, voffA);
            PG8_WAIT_V(8); PG8_WAIT_L(0); PG8_BAR; PG8_MMA(1, 0, At, B0); PG8_MMA(1, 1, At, B1); PG8_BAR; PG8_SCHED;
            } else {
            PG8_LDB(B0, 0, 0); PG8_SCHED; PG8_LDA(At, 0, 0); PG8_STAGE(PG8_SA(1, 1), a1 + hstep, voffA);
            PG8_WAIT_L(8); PG8_BAR; PG8_WAIT_L(0); PG8_MMA(0, 0, At, B0); PG8_BAR; PG8_SCHED;
            PG8_LDB(B1, 0, 1); PG8_STAGE(PG8_SB(0, 0), b2, voffB);
            PG8_BAR; PG8_WAIT_L(0); PG8_MMA(0, 1, At, B1); PG8_BAR;
            PG8_LDA(At, 0, 1); PG8_STAGE(PG8_SA(0, 0), a2, voffA);
            PG8_BAR; PG8_WAIT_L(0); PG8_MMA(1, 0, At, B0); PG8_BAR; PG8_SCHED;
            PG8_STAGE(PG8_SB(0, 1), b2 + hstep, voffB);
            PG8_WAIT_V(6); PG8_BAR; PG8_MMA(1, 1, At, B1); PG8_BAR;
            PG8_LDB(B0, 1, 0); PG8_SCHED; PG8_LDA(At, 1, 0); PG8_STAGE(PG8_SA(0, 1), a2 + hstep, voffA);
            PG8_WAIT_L(8); PG8_BAR; PG8_WAIT_L(0); PG8_MMA(0, 0, At, B0); PG8_BAR; PG8_SCHED;
            PG8_LDB(B1, 1, 1); PG8_STAGE(PG8_SB(1, 0), b3, voffB);
            PG8_BAR; PG8_WAIT_L(0); PG8_MMA(0, 1, At, B1); PG8_BAR;
            PG8_LDA(At, 1, 1); PG8_STAGE(PG8_SA(1, 0), a3, voffA);
            PG8_BAR; PG8_WAIT_L(0); PG8_MMA(1, 0, At, B0); PG8_BAR; PG8_SCHED;
            PG8_STAGE(PG8_SB(1, 1), b3 + hstep, voffB);
            PG8_WAIT_V(6); PG8_BAR; PG8_MMA(1, 1, At, B1); PG8_BAR;
            }
        }
        if constexpr (ALIGN_EPI) { if (wr == 0) PG8_BAR; }
        if constexpr (!Epi::AFTER_DRAIN) { E(acc, cur, wr, wc, fr, fq); S.done(cur); }
        if (!has_next) break;
#pragma unroll
        for (int a = 0; a < 2; ++a)
#pragma unroll
            for (int b = 0; b < 2; ++b)
#pragma unroll
                for (int m = 0; m < 4; ++m)
#pragma unroll
                    for (int n = 0; n < 2; ++n) acc[a][b][m][n] = (f32x4){0.f, 0.f, 0.f, 0.f};
        cur = nxt; cA = nA; cB = nB; ++ui;
        if constexpr (ALIGN_EPI) { if (wr == 1) PG8_BAR; }
    }
    PG8_WAIT_V(0);
    if constexpr (!ALIGN_EPI) { if (wr == 0) PG8_BAR; }
    PG8_BAR;
    if constexpr (Epi::AFTER_DRAIN) { E.fused(acc, cur, wr, wc, fr, fq, lds, wid, lane); S.done(cur); }
#undef PG8_SA
#undef PG8_SB
#undef PG8_STAGE
#undef PG8_LDA
#undef PG8_LDB
#undef PG8_MMA
#undef PG8_WAIT_V
#undef PG8_WAIT_L
#undef PG8_BAR
#undef PG8_SCHED
}
}

constexpr int NWAVES = 8, NT = 512;
constexpr int D = 1024, MP = 16384, SEQ = 2048, MS = 128, FF = 4096;
constexpr int NIN0 = 3328, NIN1 = 3072;
constexpr float EPS = 1e-6f, LOG2E = 1.4426950408889634f;
constexpr size_t MiB = 1u << 20;
constexpr size_t WS_SS = 1 * MiB, WS_XS = 2 * MiB, WS_PROJS = 3 * MiB, WS_CATS = 4 * MiB, WS_HS = 5 * MiB;
constexpr size_t WS_WIN0 = 8 * MiB, WS_WOUT0 = 15 * MiB, WS_W10 = 17 * MiB, WS_W20 = 25 * MiB, WS_WIN1 = 33 * MiB, WS_WOUT1 = 39 * MiB, WS_W11 = 41 * MiB, WS_W21 = 49 * MiB;
constexpr size_t WS_CAT = 58 * MiB, WS_SH = 90 * MiB, WS_XB = 218 * MiB, WS_END = 250 * MiB;
constexpr size_t WS_DS = 194 * MiB, WS_EBL = 6 * MiB;
constexpr size_t O_Y = 0, O_YS = 16777216, O_POOLP = 16908288, O_HGP = 16939008, O_CONVP = 17725440, O_POOLS = 17741824, O_HGS = 18233344, O_CONVS = 30816256;
constexpr int LDS_BYTES = 143360;

#define LAS __attribute__((address_space(3)))
typedef unsigned short bf16;
typedef float f32x4 __attribute__((ext_vector_type(4)));
typedef short bf16x8 __attribute__((ext_vector_type(8)));
typedef unsigned u32x4 __attribute__((ext_vector_type(4)));
typedef unsigned u32x2 __attribute__((ext_vector_type(2)));
typedef unsigned short us2 __attribute__((ext_vector_type(2)));
__device__ __forceinline__ float bf2f(unsigned h) { return __uint_as_float(h << 16); }
__device__ __forceinline__ unsigned f2bf(float f) { unsigned u = __float_as_uint(f); return (u + 0x7fffu + ((u >> 16) & 1u)) >> 16; }
typedef float f32x2_t __attribute__((ext_vector_type(2)));
typedef __bf16 bf16x2_t __attribute__((ext_vector_type(2)));
__device__ __forceinline__ unsigned pk2(float lo, float hi) { const f32x2_t v = {lo, hi}; const bf16x2_t b = __builtin_convertvector(v, bf16x2_t); return __builtin_bit_cast(unsigned, b); }
__device__ __forceinline__ float fexp2(float x) { return __builtin_amdgcn_exp2f(x); }
__device__ __forceinline__ float flog2(float x) { return __builtin_amdgcn_logf(x); }
__device__ __forceinline__ float frcp(float x) { return __builtin_amdgcn_rcpf(x); }
__device__ __forceinline__ float fsigmoid(float x) { return frcp(1.0f + fexp2(-x * LOG2E)); }
__device__ __forceinline__ float wave_sum(float v) {
#pragma unroll
    for (int o = 1; o < 64; o <<= 1) v += __shfl_xor(v, o);
    return v;
}
#define MFMA16(a, b, c) __builtin_amdgcn_mfma_f32_16x16x32_bf16((a), (b), (c), 0, 0, 0)

struct PArgs { const float* in[19]; float* out; unsigned char* ws; int ph_lo, ph_hi; };

__device__ __forceinline__ void transpose_item(const float* W, const float* gk, int K, int N, bf16* WT, LAS float* scr, int item, int lane) {
    const int nblk = N / 32, kb = item / nblk, nb = item % nblk, k0 = 64 * kb, n0 = 32 * nb;
#pragma unroll 8
    for (int i = 0; i < 32; ++i) { const int kk = 2 * i + (lane >> 5); const float g = gk ? gk[k0 + kk] : 1.0f; scr[kk * 33 + (lane & 31)] = W[(size_t)(k0 + kk) * N + n0 + (lane & 31)] * g; }
    asm volatile("s_waitcnt lgkmcnt(0)" ::: "memory");
    const int c = lane & 7;
#pragma unroll
    for (int j = 0; j < 4; ++j) { const int n = (lane >> 3) + 8 * j; const LAS float* s = scr + (8 * c) * 33 + n;
        u32x4 o; o.x = pk2(s[0 * 33], s[1 * 33]); o.y = pk2(s[2 * 33], s[3 * 33]); o.z = pk2(s[4 * 33], s[5 * 33]); o.w = pk2(s[6 * 33], s[7 * 33]);
        *(u32x4*)(WT + (size_t)(n0 + n) * K + k0 + 8 * c) = o; }
    asm volatile("s_waitcnt lgkmcnt(0)" ::: "memory");
}
__device__ __forceinline__ void p0_prologue(const PArgs& a, LAS unsigned char* lds, int bid, int G, int tid, int wave, int lane) {
    LAS float* scr = (LAS float*)(lds + wave * 16384);
    const int gw = bid * NWAVES + wave, NGW = G * NWAVES;
    unsigned char* ws = a.ws;
    constexpr int I_IN0 = 16 * 104, I_O = 16 * 32, I_1 = 16 * 128, I_2 = 64 * 32, I_IN1 = 16 * 96;
    constexpr int NITEMS = I_IN0 + I_O + I_1 + I_2 + I_IN1 + I_O + I_1 + I_2;
    for (int it = gw; it < NITEMS; it += NGW) {
        int r = it;
        if (r < I_IN0) { transpose_item(a.in[8], a.in[5], D, NIN0, (bf16*)(ws + WS_WIN0), scr, r, lane); continue; } r -= I_IN0;
        if (r < I_O) { transpose_item(a.in[13], nullptr, D, D, (bf16*)(ws + WS_WOUT0), scr, r, lane); continue; } r -= I_O;
        if (r < I_1) { transpose_item(a.in[17], a.in[6], D, FF, (bf16*)(ws + WS_W10), scr, r, lane); continue; } r -= I_1;
        if (r < I_2) { transpose_item(a.in[18], nullptr, FF, D, (bf16*)(ws + WS_W20), scr, r, lane); continue; } r -= I_2;
        if (r < I_IN1) { transpose_item(a.in[14], a.in[5] + D, D, NIN1, (bf16*)(ws + WS_WIN1), scr, r, lane); continue; } r -= I_IN1;
        if (r < I_O) { transpose_item(a.in[16], nullptr, D, D, (bf16*)(ws + WS_WOUT1), scr, r, lane); continue; } r -= I_O;
        if (r < I_1) { transpose_item(a.in[17] + (size_t)D * FF, a.in[6] + D, D, FF, (bf16*)(ws + WS_W11), scr, r, lane); continue; } r -= I_1;
        transpose_item(a.in[18] + (size_t)FF * D, nullptr, FF, D, (bf16*)(ws + WS_W21), scr, r, lane);
    }
    bf16* xb0 = (bf16*)(ws + WS_CAT); float* ss = (float*)(ws + WS_SS);
    for (int m = gw; m < MP; m += NGW) {
        const f32x4* xr = (const f32x4*)(a.in[0] + (size_t)m * D) + lane; f32x4 v[4]; float s = 0.f;
#pragma unroll
        for (int j = 0; j < 4; ++j) { v[j] = xr[64 * j]; s += (v[j].x * v[j].x + v[j].y * v[j].y) + (v[j].z * v[j].z + v[j].w * v[j].w); }
        s = wave_sum(s);
        u32x2* o8 = (u32x2*)(xb0 + (size_t)m * D) + lane;
#pragma unroll
        for (int j = 0; j < 4; ++j) { u32x2 w; w.x = pk2(v[j].x, v[j].y); w.y = pk2(v[j].z, v[j].w); o8[64 * j] = w; }
        if (lane == 0) ss[m] = s;
    }
    const int gt = bid * NT + tid, NGT = G * NT;
    for (int i = gt; i < 4 * MP; i += NGT) ss[MP + i] = 0.f;
    float* xs = (float*)(ws + WS_XS);
    for (int i = gt; i < MS * D / 4; i += NGT) ((f32x4*)xs)[i] = ((const f32x4*)a.in[1])[i];
}

template <bool AF32, int EPI>
__device__ __forceinline__ void sgemm(const void* Ap, int lda, const bf16* Bt, int N, int K, int ksplit, bf16* O, int ldo, float* xs, int G, int bid, int wave, int lane) {
    const int r = lane & 15, q = lane >> 4;
    const int nstrip = N / 16, npiece = nstrip * ksplit, klen = K / ksplit;
    for (int p = G - 1 - bid; p < npiece; p += G) {
        const int strip = p % nstrip, ks = p / nstrip, n0 = strip * 16, k0 = ks * klen;
        f32x4 acc = {0.f, 0.f, 0.f, 0.f}; float sq = 0.f;
        const bf16* bp = Bt + (size_t)(n0 + r) * K + k0 + 8 * q;
        const float* apf = (const float*)Ap + (size_t)(16 * wave + r) * lda + k0 + 8 * q;
        const bf16* apb = (const bf16*)Ap + (size_t)(16 * wave + r) * lda + k0 + 8 * q;
        for (int kk = 0; kk < klen; kk += 256) {
            bf16x8 bv[8], av[8]; f32x4 af[8][2];
#pragma unroll
            for (int u = 0; u < 8; ++u) { bv[u] = *(const bf16x8*)(bp + kk + 32 * u);
                if (AF32) { af[u][0] = *(const f32x4*)(apf + kk + 32 * u); af[u][1] = *(const f32x4*)(apf + kk + 32 * u + 4); }
                else av[u] = *(const bf16x8*)(apb + kk + 32 * u); }
#pragma unroll
            for (int u = 0; u < 8; ++u) {
                if (AF32) { const f32x4 x0 = af[u][0], x1 = af[u][1];
                    sq += (x0[0] * x0[0] + x0[1] * x0[1]) + (x0[2] * x0[2] + x0[3] * x0[3]) + (x1[0] * x1[0] + x1[1] * x1[1]) + (x1[2] * x1[2] + x1[3] * x1[3]);
                    u32x4 w; w.x = pk2(x0[0], x0[1]); w.y = pk2(x0[2], x0[3]); w.z = pk2(x1[0], x1[1]); w.w = pk2(x1[2], x1[3]); av[u] = __builtin_bit_cast(bf16x8, w); }
                acc = MFMA16(av[u], bv[u], acc); }
        }
        if (EPI == 2) {
#pragma unroll
            for (int i = 0; i < 4; ++i) atomicAdd(xs + (size_t)(16 * wave + 4 * q + i) * D + n0 + r, acc[i]);
        } else {
            float tot = sq; tot += __shfl_xor(tot, 16); tot += __shfl_xor(tot, 32);
#pragma unroll
            for (int i = 0; i < 4; ++i) { const float ssr = __shfl(tot, 4 * q + i); float v = acc[i] * __builtin_amdgcn_rsqf(ssr * (1.0f / 1024.0f) + EPS);
                if (EPI == 1) { v = fmaxf(v, 0.f); v = v * v; }
                O[(size_t)(16 * wave + 4 * q + i) * ldo + n0 + r] = (bf16)f2bf(v); }
        }
    }
}

__device__ __forceinline__ float lb_of(const float* lg, int c) { const float e0 = __expf(lg[c]), e1 = __expf(lg[768 + c]), e2 = __expf(lg[1536 + c]); return e0 / (e0 + e1 + e2); }

__device__ __forceinline__ void hgrn_sample(LAS unsigned char* lds, const bf16* projs, const float* S0all, const float* lbl, const float* gain, bf16* cats, float* st_out, int b, int h, int tid, int wave, int lane) {
    LAS float* fk = (LAS float*)lds; LAS float* kkk = fk + 128; LAS float* qk = fk + 256; LAS float* vv = fk + 384; LAS float* red = fk + 512; LAS float* wsum = fk + 512 + 2048;
    const bf16* pr = projs + (size_t)b * NIN0;
    if (tid < 128) { const int c = h * 128 + tid; const float lbk = lb_of(lbl, c); float fz = bf2f(pr[1024 + c]); fz = fminf(fmaxf(fz, -30.f), 30.f);
        const float e = fexp2(-fz * LOG2E), sg = frcp(1.0f + e); fk[tid] = lbk + (1.0f - lbk) * sg; kkk[tid] = (1.0f - lbk) * e * sg; qk[tid] = bf2f(pr[256 + c]);
        const float z = bf2f(pr[1792 + c]); vv[tid] = z * fsigmoid(z); }
    __syncthreads();
    const int vq = tid & 31, kg = tid >> 5;
    const float* S0 = S0all + (size_t)((b * 6 + h) * 128) * 128; float* So = st_out + (size_t)((b * 6 + h) * 128) * 128;
    const f32x4 v4 = *(const LAS f32x4*)(vv + 4 * vq);
    f32x4 sv[8];
#pragma unroll
    for (int j = 0; j < 8; ++j) sv[j] = *(const f32x4*)(S0 + (size_t)(kg * 8 + j) * 128 + 4 * vq);
    f32x4 op = {0.f, 0.f, 0.f, 0.f};
#pragma unroll
    for (int j = 0; j < 8; ++j) { const int kx = kg * 8 + j; const f32x4 sn = sv[j] * fk[kx] + v4 * kkk[kx]; *(f32x4*)(So + (size_t)kx * 128 + 4 * vq) = sn; op += sn * qk[kx]; }
    *(LAS f32x4*)(red + kg * 128 + 4 * vq) = op;
    __syncthreads();
    float o = 0.f;
    if (tid < 128) {
#pragma unroll
        for (int j = 0; j < 16; ++j) o += red[j * 128 + tid];
        const float s = wave_sum(o * o); if (lane == 0) wsum[wave] = s; }
    __syncthreads();
    if (tid < 128) { const int c = h * 128 + tid; const float rs = __builtin_amdgcn_rsqf((wsum[0] + wsum[1]) * (1.0f / 128.0f) + EPS);
        cats[(size_t)b * D + 256 + c] = (bf16)f2bf(o * rs * gain[c] * fsigmoid(bf2f(pr[2560 + c]))); }
    __syncthreads();
}

__device__ __forceinline__ void pool_prompt(LAS unsigned char* lds, const bf16* proj, const float* pw, const float* pscale, bf16* cat, float* pool_out, int item, int tid) {
    LAS float* ue = (LAS float*)lds; LAS float* W = ue + 79 * 64; LAS float* df = W + 4096;
    const int g = item & 3, tt = item >> 2, b = tt >> 5, t0 = (tt & 31) * 64, wlen = 2 << g;
    for (int e = tid; e < 79 * 64; e += NT) { const int j = e >> 6, c = e & 63, t = t0 - 15 + j; ue[e] = (t >= 0) ? bf2f(proj[(size_t)(b * SEQ + t) * NIN0 + g * 64 + c]) : 0.f; }
    for (int e = tid; e < 1024; e += NT) ((LAS f32x4*)W)[e] = ((const f32x4*)(pw + g * 4096))[e];
    __syncthreads();
    const int c = tid & 63, tg = tid >> 6;
#pragma unroll
    for (int i = 0; i < 8; ++i) { const int t = tg * 8 + i; float s = 0.f;
        for (int j = 0; j < wlen; ++j) s += ue[(15 + t - j) * 64 + c];
        const int pos = t0 + t; const float cnt = (float)(wlen < pos + 1 ? wlen : pos + 1); const float u = ue[(15 + t) * 64 + c];
        df[t * 64 + c] = s / cnt - u;
        if (pos >= SEQ - 15) pool_out[(size_t)(b * 15 + (pos - (SEQ - 15))) * 256 + g * 64 + c] = u; }
    __syncthreads();
    float acc[8];
#pragma unroll
    for (int i = 0; i < 8; ++i) acc[i] = 0.f;
    for (int cc = 0; cc < 64; ++cc) { const float wv = W[cc * 64 + c];
#pragma unroll
        for (int i = 0; i < 8; ++i) acc[i] += df[(tg * 8 + i) * 64 + cc] * wv; }
    const float sc = pscale[g * 64 + c];
#pragma unroll
    for (int i = 0; i < 8; ++i) cat[(size_t)(b * SEQ + t0 + tg * 8 + i) * D + g * 64 + c] = (bf16)f2bf(acc[i] * sc);
    __syncthreads();
}
__device__ __forceinline__ void pool_sample(LAS unsigned char* lds, const bf16* projs, const float* spool, const float* pw, const float* pscale, bf16* cats, float* pool_out, int b, int tid) {
    LAS float* df = (LAS float*)lds;
    const int ch = tid & 255, g = ch >> 6, wlen = 2 << g;
    if (tid < 256) { const float u = bf2f(projs[(size_t)b * NIN0 + ch]); float s = u;
        for (int j = 0; j < wlen - 1; ++j) s += spool[(size_t)(b * 15 + 14 - j) * 256 + ch];
        df[ch] = s / (float)wlen - u;
        for (int j = 0; j < 14; ++j) pool_out[(size_t)(b * 15 + j) * 256 + ch] = spool[(size_t)(b * 15 + j + 1) * 256 + ch];
        pool_out[(size_t)(b * 15 + 14) * 256 + ch] = u; }
    __syncthreads();
    if (tid < 256) { const int d = ch & 63; float acc = 0.f;
        for (int cc = 0; cc < 64; ++cc) acc += df[g * 64 + cc] * pw[g * 4096 + cc * 64 + d];
        cats[(size_t)b * D + ch] = (bf16)f2bf(acc * pscale[ch]); }
    __syncthreads();
}

__device__ __forceinline__ void unpack8(const u32x4 w, float (&f)[8]) {
    f[0] = __uint_as_float(w.x << 16); f[1] = __uint_as_float(w.x & 0xffff0000u); f[2] = __uint_as_float(w.y << 16); f[3] = __uint_as_float(w.y & 0xffff0000u);
    f[4] = __uint_as_float(w.z << 16); f[5] = __uint_as_float(w.z & 0xffff0000u); f[6] = __uint_as_float(w.w << 16); f[7] = __uint_as_float(w.w & 0xffff0000u);
}
__device__ __forceinline__ void hgrn_stepA(LAS unsigned char* lds, const bf16* proj, const float* lbl, bf16* dS, float* eblg, int bid, int G, int wave, int lane) {
    constexpr int PK = 144;
    LAS unsigned char* KeT = lds; LAS unsigned char* Vt = lds + 18432; LAS float* qsum = (LAS float*)(lds + 36864);
    const int tq = wave >> 1, k = ((wave & 1) << 6) + lane, r = lane & 15, q = lane >> 4, w = wave;
    unsigned short fv[16], iv[16];
    int it = bid;
    if (it < 1536) { const int bh = it >> 5, c = it & 31, b = bh / 6, h = bh - 6 * b; const unsigned lo_f = 1024u + (unsigned)(h * 128 + k);
        const bf16* prow = proj + (size_t)(b * SEQ + 64 * c + 16 * tq) * NIN0;
#pragma unroll
        for (int i = 0; i < 16; ++i) { const bf16* up = prow + (size_t)i * NIN0; fv[i] = up[lo_f]; iv[i] = up[lo_f + 768u]; } }
    for (; it < 1536; it += G) {
        const int bh = it >> 5, b = bh / 6, h = bh - 6 * b, ch = h * 128 + k;
        const float lbk = lb_of(lbl, ch), oml = 1.0f - lbk;
        float lf[16], kk[16];
#pragma unroll
        for (int i = 0; i < 16; ++i) { float fz = bf2f(fv[i]); fz = fminf(fmaxf(fz, -30.f), 30.f); const float e = fexp2(-fz * LOG2E), sg = frcp(1.0f + e); lf[i] = flog2(lbk + oml * sg); kk[i] = oml * e * sg; }
        float run = 0.f;
#pragma unroll
        for (int i = 0; i < 16; ++i) { run += lf[i]; lf[i] = run; }
        qsum[tq * 128 + k] = run;
        { unsigned vp[8];
#pragma unroll
          for (int i = 0; i < 8; ++i) { const float z0 = bf2f(iv[2 * i]), z1 = bf2f(iv[2 * i + 1]); vp[i] = pk2(z0 * fsigmoid(z0), z1 * fsigmoid(z1)); }
          *(LAS u32x4*)(Vt + k * PK + tq * 32) = (u32x4){vp[0], vp[1], vp[2], vp[3]}; *(LAS u32x4*)(Vt + k * PK + tq * 32 + 16) = (u32x4){vp[4], vp[5], vp[6], vp[7]}; }
        __syncthreads();
        float off = 0.f, tot = 0.f;
#pragma unroll
        for (int j = 0; j < 4; ++j) { const float s = qsum[j * 128 + k]; tot += s; if (j < tq) off += s; }
        if (tq == 0) eblg[(size_t)it * 128 + k] = fexp2(tot);
        { unsigned kp[8];
#pragma unroll
          for (int i = 0; i < 8; ++i) { const float b0 = lf[2 * i] + off, b1 = lf[2 * i + 1] + off; kp[i] = pk2(kk[2 * i] * fexp2(tot - b0), kk[2 * i + 1] * fexp2(tot - b1)); }
          *(LAS u32x4*)(KeT + k * PK + tq * 32) = (u32x4){kp[0], kp[1], kp[2], kp[3]}; *(LAS u32x4*)(KeT + k * PK + tq * 32 + 16) = (u32x4){kp[4], kp[5], kp[6], kp[7]}; }
        { const int nit = it + G;
          if (nit < 1536) { const int nbh = nit >> 5, nc = nit & 31, nb = nbh / 6, nh = nbh - 6 * nb; const unsigned lo_f = 1024u + (unsigned)(nh * 128 + k);
              const bf16* prow = proj + (size_t)(nb * SEQ + 64 * nc + 16 * tq) * NIN0;
#pragma unroll
              for (int i = 0; i < 16; ++i) { const bf16* up = prow + (size_t)i * NIN0; fv[i] = up[lo_f]; iv[i] = up[lo_f + 768u]; } } }
        __syncthreads();
        { bf16x8 aK[2];
#pragma unroll
          for (int ks = 0; ks < 2; ++ks) aK[ks] = *(const LAS bf16x8*)(KeT + (16 * w + r) * PK + ks * 64 + q * 16);
          bf16* dst = dS + (size_t)it * 16384 + (size_t)r * 128 + 16 * w + 4 * q;
#pragma unroll
          for (int n = 0; n < 8; ++n) { f32x4 s = {0.f, 0.f, 0.f, 0.f};
#pragma unroll
              for (int ks = 0; ks < 2; ++ks) { const bf16x8 bv = *(const LAS bf16x8*)(Vt + (16 * n + r) * PK + ks * 64 + q * 16); s = MFMA16(aK[ks], bv, s); }
              *(u32x2*)(dst + n * 2048) = (u32x2){pk2(s[0], s[1]), pk2(s[2], s[3])}; } }
        __syncthreads();
    }
}
__device__ __forceinline__ void hgrn_stepB(bf16* dS, const float* eblg, float* st_out, int bid, int G, int tid) {
    for (int e = bid * NT + tid; e < 48 * 2048; e += G * NT) {
        const int k8 = e & 15, v = (e >> 4) & 127, bh = e >> 11;
        bf16* p = dS + (size_t)bh * 32 * 16384 + (size_t)v * 128 + 8 * k8; const float* eb = eblg + (size_t)bh * 32 * 128 + 8 * k8;
        float S[8];
#pragma unroll
        for (int j = 0; j < 8; ++j) S[j] = 0.f;
        for (int c0 = 0; c0 < 32; c0 += 8) {
            u32x4 d[8]; f32x4 e0[8], e1[8];
#pragma unroll
            for (int u = 0; u < 8; ++u) { d[u] = *(const u32x4*)(p + (size_t)(c0 + u) * 16384); e0[u] = *(const f32x4*)(eb + (c0 + u) * 128); e1[u] = *(const f32x4*)(eb + (c0 + u) * 128 + 4); }
#pragma unroll
            for (int u = 0; u < 8; ++u) { float dv[8]; unpack8(d[u], dv);
                *(u32x4*)(p + (size_t)(c0 + u) * 16384) = (u32x4){pk2(S[0], S[1]), pk2(S[2], S[3]), pk2(S[4], S[5]), pk2(S[6], S[7])};
#pragma unroll
                for (int j = 0; j < 4; ++j) { S[j] = S[j] * e0[u][j] + dv[j]; S[4 + j] = S[4 + j] * e1[u][j] + dv[4 + j]; } }
        }
        float* so = st_out + (size_t)bh * 16384 + (size_t)(8 * k8) * 128 + v;
#pragma unroll
        for (int j = 0; j < 8; ++j) so[j * 128] = S[j];
    }
}
__device__ __forceinline__ void hgrn_stepC(LAS unsigned char* lds, const bf16* proj, const float* lbl, const float* gain, const bf16* dS, bf16* cat, int bid, int G, int tid, int wave, int lane) {
    constexpr int PQ = 272, PK = 144;
    LAS unsigned char* Qd = lds; LAS unsigned char* Kd = lds + 17408; LAS unsigned char* Vt = lds + 34816;
    LAS unsigned char* P = lds + 53248; LAS unsigned char* St = lds + 62464;
    LAS float* qsum = (LAS float*)(lds + 97280); LAS float* part = qsum + 512; LAS float* rsr = part + 512;
    const int tq = wave >> 1, k = ((wave & 1) << 6) + lane, r = lane & 15, q = lane >> 4, w = wave;
    unsigned short qv[16], fv[16], iv[16];
    int it = bid;
    if (it < 1536) { const int bh = it >> 5, c = it & 31, b = bh / 6, h = bh - 6 * b; const unsigned lo_q = 256u + (unsigned)(h * 128 + k);
        const bf16* prow = proj + (size_t)(b * SEQ + 64 * c + 16 * tq) * NIN0;
#pragma unroll
        for (int i = 0; i < 16; ++i) { const bf16* up = prow + (size_t)i * NIN0; qv[i] = up[lo_q]; fv[i] = up[lo_q + 768u]; iv[i] = up[lo_q + 1536u]; } }
    for (; it < 1536; it += G) {
        const int bh = it >> 5, c = it & 31, b = bh / 6, h = bh - 6 * b, ch = h * 128 + k;
        const float lbk = lb_of(lbl, ch), oml = 1.0f - lbk;
        u32x4 sreg[4];
        { const u32x4* sp = (const u32x4*)(dS + (size_t)it * 16384) + tid;
#pragma unroll
          for (int j = 0; j < 4; ++j) sreg[j] = sp[512 * j]; }
        float lf[16], kk[16];
#pragma unroll
        for (int i = 0; i < 16; ++i) { float fz = bf2f(fv[i]); fz = fminf(fmaxf(fz, -30.f), 30.f); const float e = fexp2(-fz * LOG2E), sg = frcp(1.0f + e); lf[i] = flog2(lbk + oml * sg); kk[i] = oml * e * sg; }
        float run = 0.f;
#pragma unroll
        for (int i = 0; i < 16; ++i) { run += lf[i]; lf[i] = run; }
        qsum[tq * 128 + k] = run;
        { unsigned vp[8];
#pragma unroll
          for (int i = 0; i < 8; ++i) { const float z0 = bf2f(iv[2 * i]), z1 = bf2f(iv[2 * i + 1]); vp[i] = pk2(z0 * fsigmoid(z0), z1 * fsigmoid(z1)); }
          *(LAS u32x4*)(Vt + k * PK + tq * 32) = (u32x4){vp[0], vp[1], vp[2], vp[3]}; *(LAS u32x4*)(Vt + k * PK + tq * 32 + 16) = (u32x4){vp[4], vp[5], vp[6], vp[7]}; }
        __syncthreads();
        float off = 0.f;
#pragma unroll
        for (int j = 0; j < 4; ++j) { const float s = qsum[j * 128 + k]; if (j < tq) off += s; }
#pragma unroll
        for (int i = 0; i < 16; ++i) { const float bc = lf[i] + off; const float ed = fexp2(bc), edi = fexp2(-bc);
            *(LAS unsigned short*)(Qd + (16 * tq + i) * PQ + 2 * k) = (unsigned short)f2bf(bf2f(qv[i]) * ed);
            *(LAS unsigned short*)(Kd + (16 * tq + i) * PQ + 2 * k) = (unsigned short)f2bf(kk[i] * edi); }
#pragma unroll
        for (int j = 0; j < 4; ++j) { const int e = tid + 512 * j, v = e >> 4, k8 = e & 15; *(LAS u32x4*)(St + v * PQ + k8 * 16) = sreg[j]; }
        const unsigned lo_g = (unsigned)(4 * q) * NIN0 + 2560u + (unsigned)(h * 128 + 16 * w + r), lo_o = (unsigned)(4 * q) * D + 256u + (unsigned)(h * 128 + 16 * w + r);
        const bf16* crow = proj + (size_t)(b * SEQ + 64 * c) * NIN0;
        unsigned short gv[16];
#pragma unroll
        for (int ti = 0; ti < 4; ++ti)
#pragma unroll
            for (int i = 0; i < 4; ++i) { const bf16* up = crow + (size_t)(16 * ti + i) * NIN0; gv[ti * 4 + i] = up[lo_g]; }
        { const int nit = it + G;
          if (nit < 1536) { const int nbh = nit >> 5, nc = nit & 31, nb = nbh / 6, nh = nbh - 6 * nb; const unsigned lo_q = 256u + (unsigned)(nh * 128 + k);
              const bf16* prow = proj + (size_t)(nb * SEQ + 64 * nc + 16 * tq) * NIN0;
#pragma unroll
              for (int i = 0; i < 16; ++i) { const bf16* up = prow + (size_t)i * NIN0; qv[i] = up[lo_q]; fv[i] = up[lo_q + 768u]; iv[i] = up[lo_q + 1536u]; } } }
        __syncthreads();
        { const int ti = w >> 1;
#pragma unroll
          for (int sj = 0; sj < 2; ++sj) { const int si = 2 * (w & 1) + sj; f32x4 acc = {0.f, 0.f, 0.f, 0.f};
              if (si <= ti) {
#pragma unroll
                  for (int ks = 0; ks < 4; ++ks) { const bf16x8 av = *(const LAS bf16x8*)(Qd + (16 * ti + r) * PQ + ks * 64 + q * 16), bv = *(const LAS bf16x8*)(Kd + (16 * si + r) * PQ + ks * 64 + q * 16); acc = MFMA16(av, bv, acc); } }
#pragma unroll
              for (int i = 0; i < 4; ++i) { const int t = 16 * ti + 4 * q + i, s = 16 * si + r; *(LAS unsigned short*)(P + t * PK + 2 * s) = (unsigned short)f2bf(s <= t ? acc[i] : 0.f); } } }
        f32x4 o[4];
#pragma unroll
        for (int ti = 0; ti < 4; ++ti) o[ti] = (f32x4){0.f, 0.f, 0.f, 0.f};
        { bf16x8 bS[4];
#pragma unroll
          for (int ks = 0; ks < 4; ++ks) bS[ks] = *(const LAS bf16x8*)(St + (16 * w + r) * PQ + ks * 64 + q * 16);
#pragma unroll
          for (int ti = 0; ti < 4; ++ti)
#pragma unroll
              for (int ks = 0; ks < 4; ++ks) { const bf16x8 av = *(const LAS bf16x8*)(Qd + (16 * ti + r) * PQ + ks * 64 + q * 16); o[ti] = MFMA16(av, bS[ks], o[ti]); } }
        __syncthreads();
        { bf16x8 bV[2];
#pragma unroll
          for (int ks = 0; ks < 2; ++ks) bV[ks] = *(const LAS bf16x8*)(Vt + (16 * w + r) * PK + ks * 64 + q * 16);
#pragma unroll
          for (int ti = 0; ti < 4; ++ti)
#pragma unroll
              for (int ks = 0; ks < 2; ++ks) { const bf16x8 av = *(const LAS bf16x8*)(P + (16 * ti + r) * PK + ks * 64 + q * 16); o[ti] = MFMA16(av, bV[ks], o[ti]); } }
#pragma unroll
        for (int ti = 0; ti < 4; ++ti)
#pragma unroll
            for (int i = 0; i < 4; ++i) { float p = o[ti][i] * o[ti][i]; p += __shfl_xor(p, 1); p += __shfl_xor(p, 2); p += __shfl_xor(p, 4); p += __shfl_xor(p, 8);
                if (r == 0) part[w * 64 + 16 * ti + 4 * q + i] = p; }
        __syncthreads();
        if (tid < 64) { float s = 0.f;
#pragma unroll
            for (int j = 0; j < 8; ++j) s += part[j * 64 + tid];
            rsr[tid] = __builtin_amdgcn_rsqf(s * (1.0f / 128.0f) + EPS); }
        __syncthreads();
        const float gain_v = gain[h * 128 + 16 * w + r];
        bf16* orow = cat + (size_t)(b * SEQ + 64 * c) * D;
#pragma unroll
        for (int ti = 0; ti < 4; ++ti)
#pragma unroll
            for (int i = 0; i < 4; ++i) { const int t = 16 * ti + 4 * q + i; const float val = o[ti][i] * rsr[t] * gain_v * fsigmoid(bf2f(gv[ti * 4 + i]));
                bf16* up = orow + (size_t)(16 * ti + i) * D; up[lo_o] = (bf16)f2bf(val); }
    }
    __syncthreads();
}

__device__ __forceinline__ void conv_phase(const PArgs& a, int bid, int G, int tid) {
    unsigned char* ws = a.ws;
    const bf16* proj = (const bf16*)(ws + WS_SH); bf16* cat = (bf16*)(ws + WS_CAT); const float* cw = a.in[15];
    for (int gt = bid * NT + tid; gt < 1024 * 128; gt += G * NT) {
        const int cgp = gt & 127, rb = gt >> 7, b = rb >> 7, tl0 = (rb & 127) * 16, c0 = 8 * cgp;
        float w0[8], w1[8], w2[8], zm2[8], zm1[8];
#pragma unroll
        for (int e = 0; e < 8; ++e) { w0[e] = cw[c0 + e]; w1[e] = cw[1024 + c0 + e]; w2[e] = cw[2048 + c0 + e]; zm2[e] = 0.f; zm1[e] = 0.f; }
        const bf16* pr = proj + (size_t)(b * SEQ + tl0) * NIN1 + c0;
        if (tl0 > 0) { float cgv[8], hvv[8];
            unpack8(*(const u32x4*)(pr - 2 * NIN1 + 1024), cgv); unpack8(*(const u32x4*)(pr - 2 * NIN1 + 2048), hvv);
#pragma unroll
            for (int e = 0; e < 8; ++e) zm2[e] = cgv[e] * hvv[e];
            unpack8(*(const u32x4*)(pr - NIN1 + 1024), cgv); unpack8(*(const u32x4*)(pr - NIN1 + 2048), hvv);
#pragma unroll
            for (int e = 0; e < 8; ++e) zm1[e] = cgv[e] * hvv[e]; }
#pragma unroll 1
        for (int i = 0; i < 16; ++i) { float bgv[8], cgv[8], hvv[8], o[8];
            unpack8(*(const u32x4*)(pr + (size_t)i * NIN1), bgv); unpack8(*(const u32x4*)(pr + (size_t)i * NIN1 + 1024), cgv); unpack8(*(const u32x4*)(pr + (size_t)i * NIN1 + 2048), hvv);
#pragma unroll
            for (int e = 0; e < 8; ++e) { const float z = cgv[e] * hvv[e]; o[e] = bgv[e] * (w0[e] * zm2[e] + w1[e] * zm1[e] + w2[e] * z); zm2[e] = zm1[e]; zm1[e] = z; }
            *(u32x4*)(cat + (size_t)(b * SEQ + tl0 + i) * D + c0) = (u32x4){pk2(o[0], o[1]), pk2(o[2], o[3]), pk2(o[4], o[5]), pk2(o[6], o[7])};
            const int t = tl0 + i;
            if (t >= SEQ - 2) { float* co = a.out + O_CONVP + (size_t)(b * 2 + (t - (SEQ - 2))) * 1024 + c0;
                *(f32x4*)co = (f32x4){zm1[0], zm1[1], zm1[2], zm1[3]}; *(f32x4*)(co + 4) = (f32x4){zm1[4], zm1[5], zm1[6], zm1[7]}; } }
    }
    const bf16* projs = (const bf16*)(ws + WS_PROJS); bf16* cats = (bf16*)(ws + WS_CATS); const float* sc = a.in[4];
    for (int gt = bid * NT + tid; gt < MS * 128; gt += G * NT) {
        const int cgp = gt & 127, b = gt >> 7, c0 = 8 * cgp; float bgv[8], cgv[8], hvv[8], o[8], z[8];
        const bf16* pr = projs + (size_t)b * NIN1 + c0;
        unpack8(*(const u32x4*)pr, bgv); unpack8(*(const u32x4*)(pr + 1024), cgv); unpack8(*(const u32x4*)(pr + 2048), hvv);
        const float* p0 = sc + (size_t)(b * 2) * 1024 + c0; const float* p1 = p0 + 1024;
        float* co = a.out + O_CONVS + (size_t)(b * 2) * 1024 + c0;
#pragma unroll
        for (int e = 0; e < 8; ++e) { z[e] = cgv[e] * hvv[e]; o[e] = bgv[e] * (cw[c0 + e] * p0[e] + cw[1024 + c0 + e] * p1[e] + cw[2048 + c0 + e] * z[e]); co[e] = p1[e]; co[1024 + e] = z[e]; }
        *(u32x4*)(cats + (size_t)b * D + c0) = (u32x4){pk2(o[0], o[1]), pk2(o[2], o[3]), pk2(o[4], o[5]), pk2(o[6], o[7])};
    }
}

__device__ __forceinline__ void final_norm(const PArgs& a, int bid, int G, int wave, int lane) {
    const int gw = bid * NWAVES + wave, NGW = G * NWAVES; const float* gf = a.in[7]; const float* ss4 = (const float*)(a.ws + WS_SS) + 4 * MP;
    f32x4 gv[4];
#pragma unroll
    for (int j = 0; j < 4; ++j) gv[j] = ((const f32x4*)gf)[lane + 64 * j];
    for (int m = gw; m < MP + MS; m += NGW) {
        if (m < MP) { f32x4* yr = (f32x4*)(a.out + O_Y + (size_t)m * D) + lane; const float rs = __builtin_amdgcn_rsqf(ss4[m] * (1.0f / 1024.0f) + EPS);
#pragma unroll
            for (int j = 0; j < 4; ++j) { const f32x4 v = yr[64 * j]; yr[64 * j] = v * rs * gv[j]; } }
        else { const int sr = m - MP; const f32x4* xr = (const f32x4*)((const float*)(a.ws + WS_XS) + (size_t)sr * D) + lane; f32x4* yr = (f32x4*)(a.out + O_YS + (size_t)sr * D) + lane;
            f32x4 v[4]; float s = 0.f;
#pragma unroll
            for (int j = 0; j < 4; ++j) { v[j] = xr[64 * j]; s += (v[j].x * v[j].x + v[j].y * v[j].y) + (v[j].z * v[j].z + v[j].w * v[j].w); }
            const float rs = __builtin_amdgcn_rsqf(wave_sum(s) * (1.0f / 1024.0f) + EPS);
#pragma unroll
            for (int j = 0; j < 4; ++j) yr[64 * j] = v[j] * rs * gv[j]; }
    }
}

#define XB_TMO      128
#define XB_XCNT(j)  (256  + 64 * (j))
#define XB_XSUB(j)  (1280 + 64 * (j))
#define XB_XGEN(j)  (2304 + 64 * (j))
#define XB_TOP      3328
#define XB_TOPGEN   3392
#define XCD_BAR_WORDS 3456
#define XB_SPIN_CAP (1u << 18)

__device__ __forceinline__ unsigned xb_ld(unsigned* p)              { return __hip_atomic_load(p, __ATOMIC_RELAXED, __HIP_MEMORY_SCOPE_AGENT); }
__device__ __forceinline__ unsigned xb_add(unsigned* p, unsigned v) { return __hip_atomic_fetch_add(p, v, __ATOMIC_RELAXED, __HIP_MEMORY_SCOPE_AGENT); }
__device__ __forceinline__ unsigned xb_xcc_id() { return (unsigned)__builtin_amdgcn_s_getreg((3 << 11) | 20) & 0xFu; }
#define XB_SPIN(cond, bar) do { unsigned _sp = 0; while (cond) { __builtin_amdgcn_s_sleep(1); \
    if ((++_sp & 255u) == 0u) { if (xb_ld(&(bar)[XB_TMO])) break; if (_sp > XB_SPIN_CAP) { atomicAdd(&(bar)[XB_TMO], 1u); break; } } } } while (0)

struct XcdBarrier {
    unsigned* bar; unsigned x;
    volatile LAS unsigned* st;
};

__device__ __forceinline__ XcdBarrier xcd_barrier_post(unsigned* bar, volatile LAS unsigned* st) {
    XcdBarrier b; b.bar = bar; b.x = xb_xcc_id(); b.st = st;
    if (threadIdx.x == 0) (void)xb_add(&bar[XB_XCNT(b.x)], 1u);
    return b;
}
__device__ __forceinline__ void xcd_barrier_complete(unsigned* bar, unsigned x, unsigned& nloc, unsigned& nx) {
    const unsigned G = gridDim.x * gridDim.y * gridDim.z;
    unsigned sum, cnt, mine, sp = 0u;
    for (;;) {
        sum = 0u; cnt = 0u; mine = 0u;
#pragma unroll
        for (unsigned j = 0; j < 16; ++j) { const unsigned c = xb_ld(&bar[XB_XCNT(j)]); sum += c; cnt += (c > 0u) ? 1u : 0u; mine = (j == x) ? c : mine; }
        if (sum == G) break;
        __builtin_amdgcn_s_sleep(1);
        if ((++sp & 255u) == 0u) { if (xb_ld(&bar[XB_TMO])) break; if (sp > XB_SPIN_CAP) { atomicAdd(&bar[XB_TMO], 1u); break; } }
    }
    nloc = mine > 0u ? mine : 1u; nx = cnt > 0u ? cnt : 1u;
}

__device__ __forceinline__ void xcd_barrier(const XcdBarrier& b) {
    asm volatile("s_waitcnt vmcnt(0)" ::: "memory");
    __syncthreads();
    if (threadIdx.x == 0) {
        unsigned* bar = b.bar;
        __builtin_amdgcn_s_waitcnt(0);
        unsigned nloc = b.st[0], nx = b.st[1];
        if (nloc == 0u) { xcd_barrier_complete(bar, b.x, nloc, nx); b.st[0] = nloc; b.st[1] = nx; }
        const unsigned old = xb_add(&bar[XB_XSUB(b.x)], 1u);
        const unsigned gen = old / nloc;
        if (old + 1u == (gen + 1u) * nloc) {
            __builtin_amdgcn_fence(__ATOMIC_RELEASE, "agent");
            asm volatile("s_waitcnt vmcnt(0)" ::: "memory");
            const unsigned og = xb_add(&bar[XB_TOP], 1u);
            const unsigned tg = og / nx;
            if (og + 1u == (tg + 1u) * nx) xb_add(&bar[XB_TOPGEN], 1u);
            else XB_SPIN(xb_ld(&bar[XB_TOPGEN]) == tg, bar);
            __builtin_amdgcn_fence(__ATOMIC_ACQUIRE, "agent");
            xb_add(&bar[XB_XGEN(b.x)], 1u);
            asm volatile("s_waitcnt vmcnt(0)" ::: "memory");
        } else {
            XB_SPIN(xb_ld(&bar[XB_XGEN(b.x)]) == gen, bar);
            __builtin_amdgcn_fence(__ATOMIC_ACQUIRE, "agent");
            asm volatile("s_waitcnt vmcnt(0)" ::: "memory");
        }
    }
    __syncthreads();
}

#ifndef DIS_GEMM
#define DIS_GEMM 0
#endif
#ifndef DIS_SGEMM
#define DIS_SGEMM 0
#endif
#ifndef DIS_HGRN
#define DIS_HGRN 0
#endif
#ifndef DIS_OTHER
#define DIS_OTHER 0
#endif
#ifndef DBG_O
#define DBG_O 15
#endif
#ifndef DBG_COL
#define DBG_COL 2304
#endif
#ifndef DBG_HI
#define DBG_HI 12
#endif
#ifndef MK_MULTI
#define MK_MULTI 0
#endif
constexpr int N_PHASES = 12;
#define IN(k) (lo <= (k) && (k) < hi)
#define SEAM(k) do { if (IN(k) && IN((k) + 1)) xcd_barrier(xbar); } while (0)
template <int L>
__device__ __forceinline__ void layer_phases(const PArgs& a, LAS unsigned char* lds, const XcdBarrier& xbar, int lo, int hi, int bid, int G, int tid, int wave, int lane) {
    unsigned char* ws = a.ws;
    float* ss = (float*)(ws + WS_SS);
    bf16* CAT = (bf16*)(ws + WS_CAT); bf16* SH = (bf16*)(ws + WS_SH); bf16* XB = (bf16*)(ws + WS_XB);
    float* xs = (float*)(ws + WS_XS); bf16* projs = (bf16*)(ws + WS_PROJS); bf16* cats = (bf16*)(ws + WS_CATS); bf16* hs = (bf16*)(ws + WS_HS);
    float* Y = a.out + O_Y;
    constexpr int pb = 1 + 5 * L;
    const bf16* Win = (const bf16*)(ws + (L ? WS_WIN1 : WS_WIN0)); const bf16* Wout = (const bf16*)(ws + (L ? WS_WOUT1 : WS_WOUT0));
    const bf16* W1 = (const bf16*)(ws + (L ? WS_W11 : WS_W10)); const bf16* W2 = (const bf16*)(ws + (L ? WS_W21 : WS_W20));
    constexpr int Nin = L ? NIN1 : NIN0;
    if (IN(pb)) {
        pg8::Gemm g{L ? XB : CAT, Win, MP, Nin, D}; pg8::StaticOrder S; S.init(MP, Nin, G, bid);
        pg8::EpiScaleBf16<0> E{SH, Nin, ss + (L ? 2 : 0) * MP};
        if (!DIS_GEMM) pg8::gemm_phase<pg8::EpiScaleBf16<0>, pg8::StaticOrder, true, true>(lds, g, S, E);
        if (!DIS_SGEMM) sgemm<true, 0>(L ? (const void*)xs : (const void*)a.in[1], D, Win, Nin, D, 1, projs, Nin, xs, G, bid, wave, lane);
    }
    SEAM(pb);
    if (IN(pb + 1)) {
        if (L == 0) {
            bf16* dS = (bf16*)(ws + WS_DS); float* eblg = (float*)(ws + WS_EBL);
            if (!DIS_HGRN) hgrn_stepA(lds, SH, a.in[11], dS, eblg, bid, G, wave, lane);
            if (!DIS_OTHER) {
                for (int it = bid; it < MS * 6; it += G) hgrn_sample(lds, projs, a.in[3], a.in[11], a.in[12], cats, a.out + O_HGS, it / 6, it % 6, tid, wave, lane);
                for (int it = bid; it < 1024; it += G) pool_prompt(lds, SH, a.in[9], a.in[10], CAT, a.out + O_POOLP, it, tid);
                for (int it = bid; it < MS; it += G) pool_sample(lds, projs, a.in[2], a.in[9], a.in[10], cats, a.out + O_POOLS, it, tid); }
            xcd_barrier(xbar);
            if (!DIS_HGRN) hgrn_stepB(dS, eblg, a.out + O_HGP, bid, G, tid);
            xcd_barrier(xbar);
            if (!DIS_HGRN) hgrn_stepC(lds, SH, a.in[11], a.in[12], dS, CAT, bid, G, tid, wave, lane);
        } else if (!DIS_OTHER) conv_phase(a, bid, G, tid);
    }
    SEAM(pb + 1);
    if (IN(pb + 2)) {
        pg8::Gemm g{CAT, Wout, MP, D, D}; pg8::StaticOrder S; S.init(MP, D, G, bid);
        pg8::EpiResid E{L ? (const float*)Y : a.in[0], Y, XB, ss + (L ? 3 : 1) * MP};
        if (!DIS_GEMM) pg8::gemm_phase<pg8::EpiResid, pg8::StaticOrder, true, true>(lds, g, S, E);
        if (!DIS_SGEMM) sgemm<false, 2>(cats, D, Wout, D, D, 4, nullptr, 0, xs, G, bid, wave, lane);
    }
    SEAM(pb + 2);
    if (IN(pb + 3)) {
        pg8::Gemm g{XB, W1, MP, FF, D}; pg8::StaticOrder S; S.init(MP, FF, G, bid);
        pg8::EpiScaleBf16<1> E{SH, FF, ss + (L ? 3 : 1) * MP};
        if (!DIS_GEMM) pg8::gemm_phase<pg8::EpiScaleBf16<1>, pg8::StaticOrder, true, true>(lds, g, S, E);
        if (!DIS_SGEMM) sgemm<true, 1>(xs, D, W1, FF, D, 1, hs, FF, xs, G, bid, wave, lane);
    }
    SEAM(pb + 3);
    if (IN(pb + 4)) {
        pg8::Gemm g{SH, W2, MP, D, FF}; pg8::StaticOrder S; S.init(MP, D, G, bid);
        pg8::EpiResid E{Y, Y, L ? nullptr : XB, ss + (L ? 4 : 2) * MP};
        if (!DIS_GEMM) pg8::gemm_phase<pg8::EpiResid, pg8::StaticOrder, true, true>(lds, g, S, E);
        if (!DIS_SGEMM) sgemm<false, 2>(hs, FF, W2, D, FF, 4, nullptr, 0, xs, G, bid, wave, lane);
    }
    SEAM(pb + 4);
}
__global__ void __launch_bounds__(NT, 2) mk_fwd(PArgs a) {
    extern __shared__ __attribute__((aligned(16))) unsigned char lds_raw[];
    LAS unsigned char* lds = (LAS unsigned char*)lds_raw;
    const int tid = threadIdx.x, lane = tid & 63, wave = __builtin_amdgcn_readfirstlane(tid >> 6), bid = blockIdx.x, G = gridDim.x;
    const int lo = a.ph_lo, hi = a.ph_hi;
    volatile LAS unsigned* xst = (volatile LAS unsigned*)(lds + 131072 + 64);
    if (tid < 2) xst[tid] = 0u;
    __syncthreads();
    const XcdBarrier xbar = xcd_barrier_post((unsigned*)a.ws, xst);
    if (lo < 0) cg::this_grid().sync();
    if (IN(0)) { p0_prologue(a, lds, bid, G, tid, wave, lane); __syncthreads(); }
    SEAM(0);
    layer_phases<0>(a, lds, xbar, lo, hi, bid, G, tid, wave, lane);
    layer_phases<1>(a, lds, xbar, lo, hi, bid, G, tid, wave, lane);
    if (IN(11)) final_norm(a, bid, G, wave, lane);
    if (hi < 12) {
        if (hi <= 3) { cg::this_grid().sync(); const bf16* C = (const bf16*)(a.ws + WS_CAT); for (size_t i = (size_t)bid * NT + tid; i < O_YS; i += (size_t)G * NT) a.out[i] = ((i & 1023) >= 256) ? bf2f(C[i]) : 0.f; }
        for (size_t i = (size_t)bid * NT + tid; i < 131072; i += (size_t)G * NT) a.out[O_YS + i] = 0.f;
        if (hi <= 2) for (size_t i = (size_t)bid * NT + tid + O_POOLP; i < O_CONVS; i += (size_t)G * NT) a.out[i] = 0.f;
        if (hi <= 7) { for (size_t i = (size_t)bid * NT + tid; i < 16384; i += (size_t)G * NT) a.out[O_CONVP + i] = 0.f;
                       for (size_t i = (size_t)bid * NT + tid; i < 262144; i += (size_t)G * NT) a.out[O_CONVS + i] = 0.f; }
    }
}
#undef IN
#undef SEAM

extern "C" void kernel_launch(void* const* d_in, const int* in_sizes, int n_in, void* d_out, int out_size, void* d_ws, size_t ws_size, hipStream_t stream) {
    static int grid = 0;
    if (grid == 0) {
        if (n_in != 19 || ws_size < WS_END) { fprintf(stderr, "kernel_launch: unexpected inputs (n_in %d, ws %zu)\n", n_in, ws_size); grid = -1; return; }
        int dev = 0, cus = 0, per_cu = 0;
        if (hipGetDevice(&dev) != hipSuccess || hipDeviceGetAttribute(&cus, hipDeviceAttributeMultiprocessorCount, dev) != hipSuccess) { grid = -1; return; }
        if (hipFuncSetAttribute((const void*)mk_fwd, hipFuncAttributeMaxDynamicSharedMemorySize, LDS_BYTES) != hipSuccess) { fprintf(stderr, "kernel_launch: hipFuncSetAttribute failed\n"); grid = -1; return; }
        if (hipOccupancyMaxActiveBlocksPerMultiprocessor(&per_cu, (const void*)mk_fwd, NT, LDS_BYTES) != hipSuccess || per_cu < 1) { fprintf(stderr, "kernel_launch: occupancy query says %d\n", per_cu); per_cu = 1; }
        (void)hipGetLastError();
        grid = cus;
    }
    if (grid < 0) return;
    PArgs a{};
    for (int i = 0; i < 19; ++i) a.in[i] = (const float*)d_in[i];
    a.out = (float*)d_out; a.ws = (unsigned char*)d_ws;
#if MK_MULTI
    for (int k = 0; k < DBG_HI; ++k) { a.ph_lo = k; a.ph_hi = k + 1; hipLaunchKernelGGL(mk_fwd, dim3(grid), dim3(NT), LDS_BYTES, stream, a); }
#else
    a.ph_lo = 0; a.ph_hi = DBG_HI;
    if (hipMemsetAsync(d_ws, 0, 16384, stream) != hipSuccess) { fprintf(stderr, "kernel_launch: hipMemsetAsync failed\n"); return; }
    void* args[] = {&a};
    hipError_t e = hipLaunchCooperativeKernel((const void*)mk_fwd, dim3(grid), dim3(NT), args, LDS_BYTES, stream);
    if (e != hipSuccess) fprintf(stderr, "cooperative launch failed: %s (grid %d)\n", hipGetErrorString(e), grid);
#endif
}
```

```cpp
#include <hip/hip_runtime.h>
#include <hip/hip_cooperative_groups.h>
#include <cstdio>
#include <cstdint>
namespace cg = cooperative_groups;
#ifndef DBG_O
#define DBG_O 15
#endif
namespace pg8 {
#define PG8_LAS __attribute__((address_space(3)))
typedef unsigned short bf16_t;
typedef short bf16x8 __attribute__((ext_vector_type(8)));
typedef float f32x4 __attribute__((ext_vector_type(4)));
typedef unsigned u32x4 __attribute__((ext_vector_type(4)));
typedef unsigned u32x2 __attribute__((ext_vector_type(2)));
constexpr int BM = 256, BK = 64, HALF = 128, HTB = HALF * BK * 2  , STAGE_BYTES = 8 * HTB, NXCD = 8, WGM = 8;

__host__ __device__ __forceinline__ int lds_byte(int r, int c) { const int st = (r >> 4) * 2 + (c >> 5), rr = r & 15, cc = c & 31, ob = rr * 64 + cc * 2; return st * 1024 + (ob ^ (((ob >> 9) & 1) << 5)); }
__host__ __device__ __forceinline__ void stage_rc(int b, int& R, int& C) { const int st = b / 1024, sb = b % 1024, swz = sb ^ (((sb >> 9) & 1) << 5); R = (st >> 1) * 16 + swz / 64; C = (st & 1) * 32 + (swz % 64) / 2; }
__host__ __device__ __forceinline__ int perm32(int rho) { const int n = rho >> 4, i = rho & 15; return 8 * (i >> 2) + 4 * n + (i & 3); }

struct Unit { int pm, pn; };
struct Gemm { const bf16_t* A; const bf16_t* Bt; int M, N, K; };

struct StaticOrder {
    int nM, nN, nwg, G, c;
    __host__ __device__ void init(int M, int N, int G_, int c_) { nM = M / BM; nN = N / BM; nwg = nM * nN; G = G_; c = c_; }
    __host__ __device__ bool next(int i, Unit& u) const {
        const long L = (long)i * G + c; if (L >= nwg) return false;
        int wgid = (int)L; { const int q = nwg / NXCD, r = nwg % NXCD, xcd = wgid % NXCD, off = wgid / NXCD; wgid = (xcd < r ? xcd * (q + 1) : r * (q + 1) + (xcd - r) * q) + off; }
        const int nig = WGM * nN, gid = wgid / nig, fm = gid * WGM, gsz = (nM - fm) < WGM ? (nM - fm) : WGM;
        u.pm = fm + ((wgid % nig) % gsz); u.pn = (wgid % nig) / gsz; return true;
    }
    __device__ __forceinline__ void a_ready(const Unit&) const {}
    __device__ __forceinline__ void done(const Unit&) const {}
};

__device__ __forceinline__ unsigned cvt_pk_bf16(float lo, float hi) { unsigned r; asm volatile("v_cvt_pk_bf16_f32 %0, %1, %2" : "=v"(r) : "v"(lo), "v"(hi)); return r; }
template <int ACT  > struct EpiScaleBf16 {
    static constexpr bool PERM = true, AFTER_DRAIN = false;
    bf16_t* O; int ldc; const float* ss;
    __device__ __forceinline__ void operator()(const f32x4 (&acc)[2][2][4][2], const Unit& u, int wr, int wc, int fr, int fq) const {
        const int row0 = u.pm * BM + wr * 64 + fr, col0 = u.pn * BM + wc * 32 + 8 * fq;
#pragma unroll
        for (int ai = 0; ai < 2; ++ai)
#pragma unroll
            for (int m = 0; m < 4; ++m) { const int row = row0 + ai * HALF + m * 16; const float rs = __builtin_amdgcn_rsqf(ss[row] * (1.0f / 1024.0f) + 1e-6f);
                bf16_t* rowp = O + (size_t)row * ldc + col0;
#pragma unroll
                for (int bj = 0; bj < 2; ++bj) { f32x4 v0 = acc[ai][bj][m][0] * rs, v1 = acc[ai][bj][m][1] * rs;
                    if (ACT == 1) {
#pragma unroll
                        for (int e = 0; e < 4; ++e) { const float a = fmaxf(v0[e], 0.f), b = fmaxf(v1[e], 0.f); v0[e] = a * a; v1[e] = b * b; } }
                    u32x4 w; w.x = cvt_pk_bf16(v0[0], v0[1]); w.y = cvt_pk_bf16(v0[2], v0[3]); w.z = cvt_pk_bf16(v1[0], v1[1]); w.w = cvt_pk_bf16(v1[2], v1[3]);
                    *(u32x4*)(rowp + bj * HALF) = w; } }
    }
};
struct EpiNull {
    static constexpr bool PERM = true, AFTER_DRAIN = false;
    float* out; int never;
    __device__ __forceinline__ void operator()(const f32x4 (&acc)[2][2][4][2], const Unit& u, int wr, int wc, int fr, int fq) const {
        if (never) {
#pragma unroll
            for (int ai = 0; ai < 2; ++ai)
#pragma unroll
                for (int m = 0; m < 4; ++m)
#pragma unroll
                    for (int bj = 0; bj < 2; ++bj) { *(f32x4*)(out + (size_t)(u.pm * BM + wr * 64 + fr + ai * HALF + m * 16) * 1024 + u.pn * BM + wc * 32 + 8 * fq + bj * HALF) = acc[ai][bj][m][0] + acc[ai][bj][m][1]; } }
    }
};
struct EpiResid {
    static constexpr bool PERM = false, AFTER_DRAIN = false;
    const float* base; float* out; bf16_t* xb; float* ss;
    __device__ __forceinline__ void operator()(const f32x4 (&acc)[2][2][4][2], const Unit& u, int wr, int wc, int fr, int fq) const {
        typedef float f32x2v __attribute__((ext_vector_type(2))); typedef __bf16 bf16x2v __attribute__((ext_vector_type(2)));
        const int row0 = u.pm * BM + wr * 64 + fr, col0 = u.pn * BM + wc * 32 + 4 * fq;
#pragma unroll
        for (int ai = 0; ai < 2; ++ai) {
            f32x4 bv[4][2][2];
#pragma unroll
            for (int m = 0; m < 4; ++m)
#pragma unroll
                for (int bj = 0; bj < 2; ++bj)
#pragma unroll
                    for (int n = 0; n < 2; ++n) bv[m][bj][n] = *(const f32x4*)(base + (size_t)(row0 + ai * HALF + m * 16) * 1024 + col0 + bj * HALF + n * 16);
#pragma unroll
            for (int m = 0; m < 4; ++m) { const int row = row0 + ai * HALF + m * 16; const size_t off = (size_t)row * 1024 + col0; float sq = 0.f;
#pragma unroll
                for (int bj = 0; bj < 2; ++bj)
#pragma unroll
                    for (int n = 0; n < 2; ++n) { const f32x4 x = bv[m][bj][n] + acc[ai][bj][m][n];
                        *(f32x4*)(out + off + bj * HALF + n * 16) = x;
                        sq += (x[0] * x[0] + x[1] * x[1]) + (x[2] * x[2] + x[3] * x[3]);
                        if (xb) { const f32x2v lo = {x[0], x[1]}, hi = {x[2], x[3]}; u32x2 w; w.x = __builtin_bit_cast(unsigned, __builtin_convertvector(lo, bf16x2v)); w.y = __builtin_bit_cast(unsigned, __builtin_convertvector(hi, bf16x2v));
                            *(u32x2*)(xb + off + bj * HALF + n * 16) = w; } }
                sq += __shfl_xor(sq, 16); sq += __shfl_xor(sq, 32);
                if (fq == 0) atomicAdd(ss + row, sq); }
            asm volatile("" ::: "memory"); }
    }
};
template <class Epi, class Sched, bool ALIGN_EPI = false, bool SP2 = false>
__device__ __forceinline__ void gemm_phase(PG8_LAS unsigned char* lds, const Gemm g, const Sched& S, const Epi& E) {
    const int tid = threadIdx.x, wid = __builtin_amdgcn_readfirstlane(tid >> 6), lane = tid & 63, wr = wid >> 2, wc = wid & 3, fr = lane & 15, fq = lane >> 4;
    const int K = g.K, nt = K / BK;
    unsigned voffA[2], voffB[2];
#pragma unroll
    for (int i = 0; i < 2; ++i) { int R, C; stage_rc(tid * 16 + i * 8192, R, C); const int Rb = Epi::PERM ? ((R & ~31) + perm32(R & 31)) : R;
        voffA[i] = (unsigned)(R * K + C) * 2u; voffB[i] = (unsigned)(Rb * K + C) * 2u; }
    const size_t kstep = (size_t)(BK * 2);
    const size_t hstep = (size_t)HALF * K * 2;
    const size_t tstep = 2 * hstep;
    const unsigned ldsw = (unsigned)wid * 1024u;
    const int aoff = lds_byte(wr * 64 + fr, fq * 8), boff = lds_byte(wc * 32 + fr, fq * 8);
#define PG8_SA(b, h) (((b) * 2 + (h)) * HTB)
#define PG8_SB(b, h) ((4 + (b) * 2 + (h)) * HTB)
#define PG8_STAGE(bufoff, gbase, voff) do { _Pragma("unroll") for (int _i = 0; _i < 2; ++_i) \
        __builtin_amdgcn_global_load_lds((const unsigned*)((const char*)(gbase) + (voff)[_i]), (PG8_LAS unsigned*)(lds + (bufoff) + ldsw + _i * 8192), 16, 0, 0); } while (0)
#define PG8_LDA(dst, b, h) do { _Pragma("unroll") for (int m = 0; m < 4; ++m) _Pragma("unroll") for (int k = 0; k < 2; ++k) dst[m][k] = *(const PG8_LAS bf16x8*)(lds + PG8_SA(b, h) + aoff + m * 2048 + k * 1024); } while (0)
#define PG8_LDB(dst, b, h) do { _Pragma("unroll") for (int n = 0; n < 2; ++n) _Pragma("unroll") for (int k = 0; k < 2; ++k) dst[n][k] = *(const PG8_LAS bf16x8*)(lds + PG8_SB(b, h) + boff + n * 2048 + k * 1024); } while (0)
#define PG8_MMA(ai, bj, At, Bt) do { __builtin_amdgcn_s_setprio(1); _Pragma("unroll") for (int m = 0; m < 4; ++m) _Pragma("unroll") for (int n = 0; n < 2; ++n) _Pragma("unroll") for (int k = 0; k < 2; ++k) \
        acc[ai][bj][m][n] = __builtin_amdgcn_mfma_f32_16x16x32_bf16(Bt[n][k], At[m][k], acc[ai][bj][m][n], 0, 0, 0); __builtin_amdgcn_s_setprio(0); } while (0)
#define PG8_WAIT_V(n) asm volatile("s_waitcnt vmcnt(" #n ")" ::: "memory")
#define PG8_WAIT_L(n) asm volatile("s_waitcnt lgkmcnt(" #n ")" ::: "memory")
#define PG8_BAR __builtin_amdgcn_s_barrier()
#define PG8_SCHED __builtin_amdgcn_sched_barrier(0)
    Unit cur, nxt; int ui = 0;
    if (!S.next(0, cur)) return;
    f32x4 acc[2][2][4][2];
#pragma unroll
    for (int a = 0; a < 2; ++a)
#pragma unroll
        for (int b = 0; b < 2; ++b)
#pragma unroll
            for (int m = 0; m < 4; ++m)
#pragma unroll
                for (int n = 0; n < 2; ++n) acc[a][b][m][n] = (f32x4){0.f, 0.f, 0.f, 0.f};
    bf16x8 At[4][2], B0[2][2], B1[2][2];
    const char* cA = (const char*)g.A + (size_t)cur.pm * tstep; const char* cB = (const char*)g.Bt + (size_t)cur.pn * tstep;
    S.a_ready(cur);
    if constexpr (SP2) {
        PG8_STAGE(PG8_SB(0, 0), cB, voffB); PG8_STAGE(PG8_SB(0, 1), cB + hstep, voffB); PG8_STAGE(PG8_SA(0, 0), cA, voffA); PG8_STAGE(PG8_SA(0, 1), cA + hstep, voffA);
        if (wr == 1) PG8_BAR;
        PG8_WAIT_V(2); PG8_BAR;
        PG8_STAGE(PG8_SB(1, 0), cB + kstep, voffB); PG8_STAGE(PG8_SA(1, 0), cA + kstep, voffA); PG8_STAGE(PG8_SB(1, 1), cB + hstep + kstep, voffB);
        PG8_WAIT_V(6); PG8_BAR;
    } else {
        PG8_STAGE(PG8_SB(0, 0), cB, voffB); PG8_STAGE(PG8_SA(0, 0), cA, voffA); PG8_STAGE(PG8_SB(0, 1), cB + hstep, voffB); PG8_STAGE(PG8_SA(0, 1), cA + hstep, voffA);
        if (wr == 1) PG8_BAR;
        PG8_WAIT_V(4); PG8_BAR;
        PG8_STAGE(PG8_SB(1, 0), cB + kstep, voffB); PG8_STAGE(PG8_SA(1, 0), cA + kstep, voffA); PG8_STAGE(PG8_SB(1, 1), cB + hstep + kstep, voffB);
        PG8_WAIT_V(6); PG8_BAR;
    }
    for (;;) {
        const bool has_next = S.next(ui + 1, nxt);
        const char* nA = has_next ? (const char*)g.A + (size_t)nxt.pm * tstep : cA; const char* nB = has_next ? (const char*)g.Bt + (size_t)nxt.pn * tstep : cB;
        for (int t = 0; t < nt; t += 2) {
            const bool last = (t == nt - 2);
            const char* a1 = cA + (size_t)(t + 1) * kstep;
            const char* a2 = last ? nA : cA + (size_t)(t + 2) * kstep; const char* b2 = last ? nB : cB + (size_t)(t + 2) * kstep;
            const char* a3 = a2 + kstep; const char* b3 = b2 + kstep;
            if (last && has_next) S.a_ready(nxt);
            if constexpr (SP2) {
            PG8_LDB(B0, 0, 0); PG8_LDB(B1, 0, 1); PG8_SCHED; PG8_LDA(At, 0, 0); PG8_STAGE(PG8_SA(1, 1), a1 + hstep, voffA);
            PG8_WAIT_V(8); PG8_WAIT_L(0); PG8_BAR; PG8_MMA(0, 0, At, B0); PG8_MMA(0, 1, At, B1); PG8_BAR; PG8_SCHED;
            PG8_LDA(At, 0, 1); PG8_STAGE(PG8_SB(0, 0), b2, voffB); PG8_STAGE(PG8_SB(0, 1), b2 + hstep, voffB); PG8_STAGE(PG8_SA(0, 0), a2, voffA);
            PG8_WAIT_V(8); PG8_WAIT_L(0); PG8_BAR; PG8_MMA(1, 0, At, B0); PG8_MMA(1, 1, At, B1); PG8_BAR; PG8_SCHED;
            PG8_LDB(B0, 1, 0); PG8_LDB(B1, 1, 1); PG8_SCHED; PG8_LDA(At, 1, 0); PG8_STAGE(PG8_SA(0, 1), a2 + hstep, voffA);
            PG8_WAIT_V(8); PG8_WAIT_L(0); PG8_BAR; PG8_MMA(0, 0, At, B0); PG8_MMA(0, 1, At, B1); PG8_BAR; PG8_SCHED;
            PG8_LDA(At, 1, 1); PG8_STAGE(PG8_SB(1, 0), b3, voffB); PG8_STAGE(PG8_SB(1, 1), b3 + hstep, voffB); PG8_STAGE(PG8_SA(1, 0), a3, voffA);
            PG8_WAIT_V(8); PG8_WAIT_L(0); PG8_BAR; PG8_MMA(1, 0, At, B0); PG8_MMA(1, 1, At, B1); PG8_BAR; PG8_SCHED;
            } else {
            PG8_LDB(B0, 0, 0); PG8_SCHED; PG8_LDA(At, 0, 0); PG8_STAGE(PG8_SA(1, 1), a1 + hstep, voffA);
            PG8_WAIT_L(8); PG8_BAR; PG8_WAIT_L(0); PG8_MMA(0, 0, At, B0); PG8_BAR; PG8_SCHED;
            PG8_LDB(B1, 0, 1); PG8_STAGE(PG8_SB(0, 0), b2, voffB);
            PG8_BAR; PG8_WAIT_L(0); PG8_MMA(0, 1, At, B1); PG8_BAR;
            PG8_LDA(At, 0, 1); PG8_STAGE(PG8_SA(0, 0), a2, voffA);
            PG8_BAR; PG8_WAIT_L(0); PG8_MMA(1, 0, At, B0); PG8_BAR; PG8_SCHED;
            PG8_STAGE(PG8_SB(0, 1), b2 + hstep, voffB);
            PG8_WAIT_V(6); PG8_BAR; PG8_MMA(1, 1, At, B1); PG8_BAR;
            PG8_LDB(B0, 1, 0); PG8_SCHED; PG8_LDA(At, 1, 0); PG8_STAGE(PG8_SA(0, 1), a2 + hstep, voffA);
            PG8_WAIT_L(8); PG8_BAR; PG8_WAIT_L(0); PG8_MMA(0, 0, At, B0); PG8_BAR; PG8_SCHED;
            PG8_LDB(B1, 1, 1); PG8_STAGE(PG8_SB(1, 0), b3, voffB);
            PG8_BAR; PG8_WAIT_L(0); PG8_MMA(0, 1, At, B1); PG8_BAR;
            PG8_LDA(At, 1, 1); PG8_STAGE(PG8_SA(1, 0), a3, voffA);
            PG8_BAR; PG8_WAIT_L(0); PG8_MMA(1, 0, At, B0); PG8_BAR; PG8_SCHED;
            PG8_STAGE(PG8_SB(1, 1), b3 + hstep, voffB);
            PG8_WAIT_V(6); PG8_BAR; PG8_MMA(1, 1, At, B1); PG8_BAR;
            }
        }
        if constexpr (ALIGN_EPI) { if (wr == 0) PG8_BAR; }
        if constexpr (!Epi::AFTER_DRAIN) { E(acc, cur, wr, wc, fr, fq); S.done(cur); }
        if (!has_next) break;
#pragma unroll
        for (int a = 0; a < 2; ++a)
#pragma unroll
            for (int b = 0; b < 2; ++b)
#pragma unroll
                for (int m = 0; m < 4; ++m)
#pragma unroll
                    for (int n = 0; n < 2; ++n) acc[a][b][m][n] = (f32x4){0.f, 0.f, 0.f, 0.f};
        cur = nxt; cA = nA; cB = nB; ++ui;
        if constexpr (ALIGN_EPI) { if (wr == 1) PG8_BAR; }
    }
    PG8_WAIT_V(0);
    if constexpr (!ALIGN_EPI) { if (wr == 0) PG8_BAR; }
    PG8_BAR;
    if constexpr (Epi::AFTER_DRAIN) { E.fused(acc, cur, wr, wc, fr, fq, lds, wid, lane); S.done(cur); }
#undef PG8_SA
#undef PG8_SB
#undef PG8_STAGE
#undef PG8_LDA
#undef PG8_LDB
#undef PG8_MMA
#undef PG8_WAIT_V
#undef PG8_WAIT_L
#undef PG8_BAR
#undef PG8_SCHED
}
}

constexpr int NWAVES = 8, NT = 512;
constexpr int D = 1024, MP = 16384, SEQ = 2048, MS = 128, FF = 4096;
constexpr int NIN0 = 3328, NIN1 = 3072;
constexpr float EPS = 1e-6f, LOG2E = 1.4426950408889634f;
constexpr size_t MiB = 1u << 20;
constexpr size_t WS_SS = 1 * MiB, WS_XS = 2 * MiB, WS_PROJS = 3 * MiB, WS_CATS = 4 * MiB, WS_HS = 5 * MiB;
constexpr size_t WS_WIN0 = 8 * MiB, WS_WOUT0 = 15 * MiB, WS_W10 = 17 * MiB, WS_W20 = 25 * MiB, WS_WIN1 = 33 * MiB, WS_WOUT1 = 39 * MiB, WS_W11 = 41 * MiB, WS_W21 = 49 * MiB;
constexpr size_t WS_CAT = 58 * MiB, WS_SH = 90 * MiB, WS_XB = 218 * MiB, WS_END = 250 * MiB;
constexpr size_t WS_DS = 194 * MiB, WS_EBL = 6 * MiB;
constexpr size_t O_Y = 0, O_YS = 16777216, O_POOLP = 16908288, O_HGP = 16939008, O_CONVP = 17725440, O_POOLS = 17741824, O_HGS = 18233344, O_CONVS = 30816256;
constexpr int LDS_BYTES = 143360;

#define LAS __attribute__((address_space(3)))
typedef unsigned short bf16;
typedef float f32x4 __attribute__((ext_vector_type(4)));
typedef short bf16x8 __attribute__((ext_vector_type(8)));
typedef unsigned u32x4 __attribute__((ext_vector_type(4)));
typedef unsigned u32x2 __attribute__((ext_vector_type(2)));
typedef unsigned short us2 __attribute__((ext_vector_type(2)));
__device__ __forceinline__ float bf2f(unsigned h) { return __uint_as_float(h << 16); }
__device__ __forceinline__ unsigned f2bf(float f) { unsigned u = __float_as_uint(f); return (u + 0x7fffu + ((u >> 16) & 1u)) >> 16; }
typedef float f32x2_t __attribute__((ext_vector_type(2)));
typedef __bf16 bf16x2_t __attribute__((ext_vector_type(2)));
__device__ __forceinline__ unsigned pk2(float lo, float hi) { const f32x2_t v = {lo, hi}; const bf16x2_t b = __builtin_convertvector(v, bf16x2_t); return __builtin_bit_cast(unsigned, b); }
__device__ __forceinline__ float fexp2(float x) { return __builtin_amdgcn_exp2f(x); }
__device__ __forceinline__ float flog2(float x) { return __builtin_amdgcn_logf(x); }
__device__ __forceinline__ float frcp(float x) { return __builtin_amdgcn_rcpf(x); }
__device__ __forceinline__ float fsigmoid(float x) { return frcp(1.0f + fexp2(-x * LOG2E)); }
__device__ __forceinline__ float wave_sum(float v) {
#pragma unroll
    for (int o = 1; o < 64; o <<= 1) v += __shfl_xor(v, o);
    return v;
}
#define MFMA16(a, b, c) __builtin_amdgcn_mfma_f32_16x16x32_bf16((a), (b), (c), 0, 0, 0)

struct PArgs { const float* in[19]; float* out; unsigned char* ws; int ph_lo, ph_hi; };

__device__ __forceinline__ void transpose_item(const float* W, const float* gk, int K, int N, bf16* WT, LAS float* scr, int item, int lane) {
    const int nblk = N / 32, kb = item / nblk, nb = item % nblk, k0 = 64 * kb, n0 = 32 * nb;
#pragma unroll 8
    for (int i = 0; i < 32; ++i) { const int kk = 2 * i + (lane >> 5); const float g = gk ? gk[k0 + kk] : 1.0f; scr[kk * 33 + (lane & 31)] = W[(size_t)(k0 + kk) * N + n0 + (lane & 31)] * g; }
    asm volatile("s_waitcnt lgkmcnt(0)" ::: "memory");
    const int c = lane & 7;
#pragma unroll
    for (int j = 0; j < 4; ++j) { const int n = (lane >> 3) + 8 * j; const LAS float* s = scr + (8 * c) * 33 + n;
        u32x4 o; o.x = pk2(s[0 * 33], s[1 * 33]); o.y = pk2(s[2 * 33], s[3 * 33]); o.z = pk2(s[4 * 33], s[5 * 33]); o.w = pk2(s[6 * 33], s[7 * 33]);
        *(u32x4*)(WT + (size_t)(n0 + n) * K + k0 + 8 * c) = o; }
    asm volatile("s_waitcnt lgkmcnt(0)" ::: "memory");
}
__device__ __forceinline__ void p0_prologue(const PArgs& a, LAS unsigned char* lds, int bid, int G, int tid, int wave, int lane) {
    LAS float* scr = (LAS float*)(lds + wave * 16384);
    const int gw = bid * NWAVES + wave, NGW = G * NWAVES;
    unsigned char* ws = a.ws;
    constexpr int I_IN0 = 16 * 104, I_O = 16 * 32, I_1 = 16 * 128, I_2 = 64 * 32, I_IN1 = 16 * 96;
    constexpr int NITEMS = I_IN0 + I_O + I_1 + I_2 + I_IN1 + I_O + I_1 + I_2;
    for (int it = gw; it < NITEMS; it += NGW) {
        int r = it;
        if (r < I_IN0) { transpose_item(a.in[8], a.in[5], D, NIN0, (bf16*)(ws + WS_WIN0), scr, r, lane); continue; } r -= I_IN0;
        if (r < I_O) { transpose_item(a.in[13], nullptr, D, D, (bf16*)(ws + WS_WOUT0), scr, r, lane); continue; } r -= I_O;
        if (r < I_1) { transpose_item(a.in[17], a.in[6], D, FF, (bf16*)(ws + WS_W10), scr, r, lane); continue; } r -= I_1;
        if (r < I_2) { transpose_item(a.in[18], nullptr, FF, D, (bf16*)(ws + WS_W20), scr, r, lane); continue; } r -= I_2;
        if (r < I_IN1) { transpose_item(a.in[14], a.in[5] + D, D, NIN1, (bf16*)(ws + WS_WIN1), scr, r, lane); continue; } r -= I_IN1;
        if (r < I_O) { transpose_item(a.in[16], nullptr, D, D, (bf16*)(ws + WS_WOUT1), scr, r, lane); continue; } r -= I_O;
        if (r < I_1) { transpose_item(a.in[17] + (size_t)D * FF, a.in[6] + D, D, FF, (bf16*)(ws + WS_W11), scr, r, lane); continue; } r -= I_1;
        transpose_item(a.in[18] + (size_t)FF * D, nullptr, FF, D, (bf16*)(ws + WS_W21), scr, r, lane);
    }
    bf16* xb0 = (bf16*)(ws + WS_CAT); float* ss = (float*)(ws + WS_SS);
    for (int m = gw; m < MP; m += NGW) {
        const f32x4* xr = (const f32x4*)(a.in[0] + (size_t)m * D) + lane; f32x4 v[4]; float s = 0.f;
#pragma unroll
        for (int j = 0; j < 4; ++j) { v[j] = xr[64 * j]; s += (v[j].x * v[j].x + v[j].y * v[j].y) + (v[j].z * v[j].z + v[j].w * v[j].w); }
        s = wave_sum(s);
        u32x2* o8 = (u32x2*)(xb0 + (size_t)m * D) + lane;
#pragma unroll
        for (int j = 0; j < 4; ++j) { u32x2 w; w.x = pk2(v[j].x, v[j].y); w.y = pk2(v[j].z, v[j].w); o8[64 * j] = w; }
        if (lane == 0) ss[m] = s;
    }
    const int gt = bid * NT + tid, NGT = G * NT;
    for (int i = gt; i < 4 * MP; i += NGT) ss[MP + i] = 0.f;
    float* xs = (float*)(ws + WS_XS);
    for (int i = gt; i < MS * D / 4; i += NGT) ((f32x4*)xs)[i] = ((const f32x4*)a.in[1])[i];
}

template <bool AF32, int EPI, int SU>
__device__ __forceinline__ void sgemm(LAS unsigned char* lds, const void* Ap, int lda, const bf16* Bt, int N, int K, int ksplit, bf16* O, int ldo, float* xs, int G, int bid, int tid, int wave, int lane) {
    constexpr int NKS = SU;
    LAS float* red = (LAS float*)lds;
    LAS float* sqp = red + 16384;
    const int r = lane & 15, q = lane >> 4;
    const int nstrip = N / 64, npiece = 4 * nstrip * ksplit, klen = K / ksplit;
    for (int p = G - 1 - bid; p < npiece; p += G) {
        const int rb = p & 3, strip = (p >> 2) % nstrip, ks = (p >> 2) / nstrip, n0 = strip * 64, k0 = ks * klen + wave * (klen >> 3), row0 = 32 * rb;
        bf16x8 bv[4][NKS], av[2][NKS]; f32x4 af[2][NKS][2];
#pragma unroll
        for (int c = 0; c < 4; ++c)
#pragma unroll
            for (int u = 0; u < NKS; ++u) bv[c][u] = *(const bf16x8*)(Bt + (size_t)(n0 + 16 * c + r) * K + k0 + 32 * u + 8 * q);
#pragma unroll
        for (int t = 0; t < 2; ++t)
#pragma unroll
            for (int u = 0; u < NKS; ++u) {
                if (AF32) { const float* ap = (const float*)Ap + (size_t)(row0 + 16 * t + r) * lda + k0 + 32 * u + 8 * q; af[t][u][0] = *(const f32x4*)ap; af[t][u][1] = *(const f32x4*)(ap + 4); }
                else av[t][u] = *(const bf16x8*)((const bf16*)Ap + (size_t)(row0 + 16 * t + r) * lda + k0 + 32 * u + 8 * q); }
        __builtin_amdgcn_sched_barrier(0);
        float sq[2] = {0.f, 0.f};
        if (AF32) {
#pragma unroll
            for (int t = 0; t < 2; ++t)
#pragma unroll
                for (int u = 0; u < NKS; ++u) { const f32x4 x0 = af[t][u][0], x1 = af[t][u][1];
                    sq[t] += (x0[0] * x0[0] + x0[1] * x0[1]) + (x0[2] * x0[2] + x0[3] * x0[3]) + (x1[0] * x1[0] + x1[1] * x1[1]) + (x1[2] * x1[2] + x1[3] * x1[3]);
                    u32x4 w; w.x = pk2(x0[0], x0[1]); w.y = pk2(x0[2], x0[3]); w.z = pk2(x1[0], x1[1]); w.w = pk2(x1[2], x1[3]); av[t][u] = __builtin_bit_cast(bf16x8, w); } }
#pragma unroll
        for (int t = 0; t < 2; ++t)
#pragma unroll
            for (int c = 0; c < 4; ++c) { f32x4 acc = {0.f, 0.f, 0.f, 0.f};
#pragma unroll
                for (int u = 0; u < NKS; ++u) acc = MFMA16(av[t][u], bv[c][u], acc);
                *(LAS f32x4*)(red + ((wave * 8 + (c * 2 + t)) * 64 + lane) * 4) = acc; }
        if (AF32) {
#pragma unroll
            for (int t = 0; t < 2; ++t) { float v = sq[t]; v += __shfl_xor(v, 16); v += __shfl_xor(v, 32); if (q == 0) sqp[(wave * 2 + t) * 16 + r] = v; } }
        __syncthreads();
        const int t = wave & 1, c = wave >> 1;
        f32x4 acc = {0.f, 0.f, 0.f, 0.f};
#pragma unroll
        for (int w = 0; w < 8; ++w) acc += *(const LAS f32x4*)(red + ((w * 8 + wave) * 64 + lane) * 4);
        const int orow = row0 + 16 * t + 4 * q, ocol = n0 + 16 * c + r;
        if (EPI == 2) {
#pragma unroll
            for (int i = 0; i < 4; ++i) atomicAdd(xs + (size_t)(orow + i) * D + ocol, acc[i]);
        } else {
#pragma unroll
            for (int i = 0; i < 4; ++i) { float ssr = 0.f;
#pragma unroll
                for (int w = 0; w < 8; ++w) ssr += sqp[(w * 2 + t) * 16 + 4 * q + i];
                float v = acc[i] * __builtin_amdgcn_rsqf(ssr * (1.0f / 1024.0f) + EPS);
                if (EPI == 1) { v = fmaxf(v, 0.f); v = v * v; }
                O[(size_t)(orow + i) * ldo + ocol] = (bf16)f2bf(v); }
        }
        __syncthreads();
    }
}

__device__ __forceinline__ float lb_of(const float* lg, int c) { const float e0 = __expf(lg[c]), e1 = __expf(lg[768 + c]), e2 = __expf(lg[1536 + c]); return e0 / (e0 + e1 + e2); }

__device__ __forceinline__ void hgrn_sample3(LAS unsigned char* lds, const bf16* projs, const float* S0all, const float* lbl, const float* gain, bf16* cats, float* st_out, int it0, int G, int tid, int wave, int lane) {
    constexpr int STR = 2624;
    LAS float* L = (LAS float*)lds;
#pragma unroll
    for (int j = 0; j < 3; ++j) { const int it = it0 + j * G;
        if (it < MS * 6 && tid < 128) { const int b = it / 6, h = it - 6 * b, c = h * 128 + tid; const bf16* pr = projs + (size_t)b * NIN0; LAS float* B = L + j * STR;
            const float lbk = lb_of(lbl, c); float fz = bf2f(pr[1024 + c]); fz = fminf(fmaxf(fz, -30.f), 30.f);
            const float e = fexp2(-fz * LOG2E), sg = frcp(1.0f + e); B[tid] = lbk + (1.0f - lbk) * sg; B[128 + tid] = (1.0f - lbk) * e * sg; B[256 + tid] = bf2f(pr[256 + c]);
            const float z = bf2f(pr[1792 + c]); B[384 + tid] = z * fsigmoid(z); } }
    const int vq = tid & 31, kg = tid >> 5;
    f32x4 sv[3][8];
#pragma unroll
    for (int j = 0; j < 3; ++j) { const int it = it0 + j * G;
        if (it < MS * 6) { const float* S0 = S0all + (size_t)it * 16384;
#pragma unroll
            for (int i = 0; i < 8; ++i) sv[j][i] = *(const f32x4*)(S0 + (size_t)(kg * 8 + i) * 128 + 4 * vq); } }
    __syncthreads();
#pragma unroll
    for (int j = 0; j < 3; ++j) { const int it = it0 + j * G;
        if (it < MS * 6) { LAS float* B = L + j * STR; float* So = st_out + (size_t)it * 16384; const f32x4 v4 = *(const LAS f32x4*)(B + 384 + 4 * vq); f32x4 op = {0.f, 0.f, 0.f, 0.f};
#pragma unroll
            for (int i = 0; i < 8; ++i) { const int kx = kg * 8 + i; const f32x4 sn = sv[j][i] * B[kx] + v4 * B[128 + kx]; *(f32x4*)(So + (size_t)kx * 128 + 4 * vq) = sn; op += sn * B[256 + kx]; }
            *(LAS f32x4*)(B + 512 + kg * 128 + 4 * vq) = op; } }
    __syncthreads();
    float o[3];
#pragma unroll
    for (int j = 0; j < 3; ++j) { o[j] = 0.f;
        if (tid < 128) { LAS float* B = L + j * STR;
#pragma unroll
            for (int i = 0; i < 16; ++i) o[j] += B[512 + i * 128 + tid];
            const float ssum = wave_sum(o[j] * o[j]); if (lane == 0) B[2560 + wave] = ssum; } }
    __syncthreads();
#pragma unroll
    for (int j = 0; j < 3; ++j) { const int it = it0 + j * G;
        if (it < MS * 6 && tid < 128) { const int b = it / 6, h = it - 6 * b, c = h * 128 + tid; LAS float* B = L + j * STR;
            const float rs = __builtin_amdgcn_rsqf((B[2560] + B[2561]) * (1.0f / 128.0f) + EPS);
            cats[(size_t)b * D + 256 + c] = (bf16)f2bf(o[j] * rs * gain[c] * fsigmoid(bf2f(projs[(size_t)b * NIN0 + 2560 + c]))); } }
    __syncthreads();
}

__device__ __forceinline__ void pool_mm(const LAS float* W, const LAS float* df, float (&acc)[8], int c, int tg) {
#pragma unroll
    for (int i = 0; i < 8; ++i) acc[i] = 0.f;
#pragma unroll 4
    for (int cc = 0; cc < 64; cc += 4) { const float w0 = W[cc * 64 + c], w1 = W[(cc + 1) * 64 + c], w2 = W[(cc + 2) * 64 + c], w3 = W[(cc + 3) * 64 + c];
#pragma unroll
        for (int i = 0; i < 8; ++i) { const f32x4 dv = *(const LAS f32x4*)(df + (tg * 8 + i) * 64 + cc); acc[i] += (dv.x * w0 + dv.y * w1) + (dv.z * w2 + dv.w * w3); } }
}
__device__ __forceinline__ void pool_prompt(LAS unsigned char* lds, const bf16* proj, const float* pw, const float* pscale, bf16* cat, float* pool_out, int item, int tid) {
    LAS float* ue = (LAS float*)lds; LAS float* W = ue + 79 * 64; LAS float* df = W + 4096;
    const int g = item & 3, tt = item >> 2, b = tt >> 5, t0 = (tt & 31) * 64, wlen = 2 << g;
#pragma unroll
    for (int j10 = 0; j10 < 10; ++j10) { const int e = tid + NT * j10; if (e < 79 * 64) { const int j = e >> 6, c = e & 63, t = t0 - 15 + j; ue[e] = (t >= 0) ? bf2f(proj[(size_t)(b * SEQ + t) * NIN0 + g * 64 + c]) : 0.f; } }
#pragma unroll
    for (int j2 = 0; j2 < 2; ++j2) ((LAS f32x4*)W)[tid + NT * j2] = ((const f32x4*)(pw + g * 4096))[tid + NT * j2];
    __syncthreads();
    const int c = tid & 63, tg = tid >> 6;
#pragma unroll
    for (int i = 0; i < 8; ++i) { const int t = tg * 8 + i; float s = 0.f;
        for (int j = 0; j < wlen; ++j) s += ue[(15 + t - j) * 64 + c];
        const int pos = t0 + t; const float cnt = (float)(wlen < pos + 1 ? wlen : pos + 1); const float u = ue[(15 + t) * 64 + c];
        df[t * 64 + c] = s / cnt - u;
        if (pos >= SEQ - 15) pool_out[(size_t)(b * 15 + (pos - (SEQ - 15))) * 256 + g * 64 + c] = u; }
    __syncthreads();
    float acc[8]; pool_mm(W, df, acc, c, tg);
    const float sc = pscale[g * 64 + c];
#pragma unroll
    for (int i = 0; i < 8; ++i) cat[(size_t)(b * SEQ + t0 + tg * 8 + i) * D + g * 64 + c] = (bf16)f2bf(acc[i] * sc);
    __syncthreads();
}
__device__ __forceinline__ void pool_sample(LAS unsigned char* lds, const bf16* projs, const float* spool, const float* pw, const float* pscale, bf16* cats, float* pool_out, int item, int tid) {
    LAS float* W = (LAS float*)lds + 79 * 64; LAS float* df = W + 4096;
    const int g = item & 3, st = item >> 2, wlen = 2 << g, c = tid & 63, tg = tid >> 6, ch = g * 64 + c;
#pragma unroll
    for (int j2 = 0; j2 < 2; ++j2) ((LAS f32x4*)W)[tid + NT * j2] = ((const f32x4*)(pw + g * 4096))[tid + NT * j2];
#pragma unroll
    for (int i = 0; i < 8; ++i) { const int t = tg * 8 + i, b = st * 64 + t; const float u = bf2f(projs[(size_t)b * NIN0 + ch]);
        float pv[15];
#pragma unroll
        for (int j = 0; j < 15; ++j) pv[j] = spool[(size_t)(b * 15 + j) * 256 + ch];
        float s = u;
#pragma unroll
        for (int j = 0; j < 15; ++j) if (j < wlen - 1) s += pv[14 - j];
        df[t * 64 + c] = s / (float)wlen - u;
#pragma unroll
        for (int j = 0; j < 14; ++j) pool_out[(size_t)(b * 15 + j) * 256 + ch] = pv[j + 1];
        pool_out[(size_t)(b * 15 + 14) * 256 + ch] = u; }
    __syncthreads();
    float acc[8]; pool_mm(W, df, acc, c, tg);
    const float sc = pscale[ch];
#pragma unroll
    for (int i = 0; i < 8; ++i) cats[(size_t)(st * 64 + tg * 8 + i) * D + ch] = (bf16)f2bf(acc[i] * sc);
    __syncthreads();
}

__device__ __forceinline__ void unpack8(const u32x4 w, float (&f)[8]) {
    f[0] = __uint_as_float(w.x << 16); f[1] = __uint_as_float(w.x & 0xffff0000u); f[2] = __uint_as_float(w.y << 16); f[3] = __uint_as_float(w.y & 0xffff0000u);
    f[4] = __uint_as_float(w.z << 16); f[5] = __uint_as_float(w.z & 0xffff0000u); f[6] = __uint_as_float(w.w << 16); f[7] = __uint_as_float(w.w & 0xffff0000u);
}
__device__ __forceinline__ void hgrn_stepA(LAS unsigned char* lds, const bf16* proj, const float* lbl, bf16* dS, float* eblg, int bid, int G, int wave, int lane) {
    constexpr int PK = 144;
    LAS unsigned char* KeT = lds; LAS unsigned char* Vt = lds + 18432; LAS float* qsum = (LAS float*)(lds + 36864);
    const int tq = wave >> 1, k = ((wave & 1) << 6) + lane, r = lane & 15, q = lane >> 4, w = wave;
    unsigned short fv[16], iv[16];
    int it = bid;
    if (it < 1536) { const int bh = it >> 5, c = it & 31, b = bh / 6, h = bh - 6 * b; const unsigned lo_f = 1024u + (unsigned)(h * 128 + k);
        const bf16* prow = proj + (size_t)(b * SEQ + 64 * c + 16 * tq) * NIN0;
#pragma unroll
        for (int i = 0; i < 16; ++i) { const bf16* up = prow + (size_t)i * NIN0; fv[i] = up[lo_f]; iv[i] = up[lo_f + 768u]; } }
    for (; it < 1536; it += G) {
        const int bh = it >> 5, b = bh / 6, h = bh - 6 * b, ch = h * 128 + k;
        const float lbk = lb_of(lbl, ch), oml = 1.0f - lbk;
        float lf[16], kk[16];
#pragma unroll
        for (int i = 0; i < 16; ++i) { float fz = bf2f(fv[i]); fz = fminf(fmaxf(fz, -30.f), 30.f); const float e = fexp2(-fz * LOG2E), sg = frcp(1.0f + e); lf[i] = flog2(lbk + oml * sg); kk[i] = oml * e * sg; }
        float run = 0.f;
#pragma unroll
        for (int i = 0; i < 16; ++i) { run += lf[i]; lf[i] = run; }
        qsum[tq * 128 + k] = run;
        { unsigned vp[8];
#pragma unroll
          for (int i = 0; i < 8; ++i) { const float z0 = bf2f(iv[2 * i]), z1 = bf2f(iv[2 * i + 1]); vp[i] = pk2(z0 * fsigmoid(z0), z1 * fsigmoid(z1)); }
          *(LAS u32x4*)(Vt + k * PK + tq * 32) = (u32x4){vp[0], vp[1], vp[2], vp[3]}; *(LAS u32x4*)(Vt + k * PK + tq * 32 + 16) = (u32x4){vp[4], vp[5], vp[6], vp[7]}; }
        __syncthreads();
        float off = 0.f, tot = 0.f;
#pragma unroll
        for (int j = 0; j < 4; ++j) { const float s = qsum[j * 128 + k]; tot += s; if (j < tq) off += s; }
        if (tq == 0) eblg[(size_t)it * 128 + k] = fexp2(tot);
        { unsigned kp[8];
#pragma unroll
          for (int i = 0; i < 8; ++i) { const float b0 = lf[2 * i] + off, b1 = lf[2 * i + 1] + off; kp[i] = pk2(kk[2 * i] * fexp2(tot - b0), kk[2 * i + 1] * fexp2(tot - b1)); }
          *(LAS u32x4*)(KeT + k * PK + tq * 32) = (u32x4){kp[0], kp[1], kp[2], kp[3]}; *(LAS u32x4*)(KeT + k * PK + tq * 32 + 16) = (u32x4){kp[4], kp[5], kp[6], kp[7]}; }
        { const int nit = it + G;
          if (nit < 1536) { const int nbh = nit >> 5, nc = nit & 31, nb = nbh / 6, nh = nbh - 6 * nb; const unsigned lo_f = 1024u + (unsigned)(nh * 128 + k);
              const bf16* prow = proj + (size_t)(nb * SEQ + 64 * nc + 16 * tq) * NIN0;
#pragma unroll
              for (int i = 0; i < 16; ++i) { const bf16* up = prow + (size_t)i * NIN0; fv[i] = up[lo_f]; iv[i] = up[lo_f + 768u]; } } }
        __syncthreads();
        { bf16x8 aK[2];
#pragma unroll
          for (int ks = 0; ks < 2; ++ks) aK[ks] = *(const LAS bf16x8*)(KeT + (16 * w + r) * PK + ks * 64 + q * 16);
          bf16* dst = dS + (size_t)it * 16384 + (size_t)r * 128 + 16 * w + 4 * q;
#pragma unroll
          for (int n = 0; n < 8; ++n) { f32x4 s = {0.f, 0.f, 0.f, 0.f};
#pragma unroll
              for (int ks = 0; ks < 2; ++ks) { const bf16x8 bv = *(const LAS bf16x8*)(Vt + (16 * n + r) * PK + ks * 64 + q * 16); s = MFMA16(aK[ks], bv, s); }
              *(u32x2*)(dst + n * 2048) = (u32x2){pk2(s[0], s[1]), pk2(s[2], s[3])}; } }
        __syncthreads();
    }
}
__device__ __forceinline__ void hgrn_stepB(bf16* dS, const float* eblg, float* st_out, int bid, int G, int tid) {
    for (int e = bid * NT + tid; e < 48 * 2048; e += G * NT) {
        const int k8 = e & 15, v = (e >> 4) & 127, bh = e >> 11;
        bf16* p = dS + (size_t)bh * 32 * 16384 + (size_t)v * 128 + 8 * k8; const float* eb = eblg + (size_t)bh * 32 * 128 + 8 * k8;
        float S[8];
#pragma unroll
        for (int j = 0; j < 8; ++j) S[j] = 0.f;
        for (int c0 = 0; c0 < 32; c0 += 8) {
            u32x4 d[8]; f32x4 e0[8], e1[8];
#pragma unroll
            for (int u = 0; u < 8; ++u) { d[u] = *(const u32x4*)(p + (size_t)(c0 + u) * 16384); e0[u] = *(const f32x4*)(eb + (c0 + u) * 128); e1[u] = *(const f32x4*)(eb + (c0 + u) * 128 + 4); }
#pragma unroll
            for (int u = 0; u < 8; ++u) { float dv[8]; unpack8(d[u], dv);
                *(u32x4*)(p + (size_t)(c0 + u) * 16384) = (u32x4){pk2(S[0], S[1]), pk2(S[2], S[3]), pk2(S[4], S[5]), pk2(S[6], S[7])};
#pragma unroll
                for (int j = 0; j < 4; ++j) { S[j] = S[j] * e0[u][j] + dv[j]; S[4 + j] = S[4 + j] * e1[u][j] + dv[4 + j]; } }
        }
        float* so = st_out + (size_t)bh * 16384 + (size_t)(8 * k8) * 128 + v;
#pragma unroll
        for (int j = 0; j < 8; ++j) so[j * 128] = S[j];
    }
}
__device__ __forceinline__ void hgrn_stepC(LAS unsigned char* lds, const bf16* proj, const float* lbl, const float* gain, const bf16* dS, bf16* cat, int bid, int G, int tid, int wave, int lane) {
    constexpr int PQ = 272, PK = 144;
    LAS unsigned char* Qd = lds; LAS unsigned char* Kd = lds + 17408; LAS unsigned char* Vt = lds + 34816;
    LAS unsigned char* P = lds + 53248; LAS unsigned char* St = lds + 62464;
    LAS float* qsum = (LAS float*)(lds + 97280); LAS float* part = qsum + 512; LAS float* rsr = part + 512;
    const int tq = wave >> 1, k = ((wave & 1) << 6) + lane, r = lane & 15, q = lane >> 4, w = wave;
    unsigned short qv[16], fv[16], iv[16];
    int it = bid;
    if (it < 1536) { const int bh = it >> 5, c = it & 31, b = bh / 6, h = bh - 6 * b; const unsigned lo_q = 256u + (unsigned)(h * 128 + k);
        const bf16* prow = proj + (size_t)(b * SEQ + 64 * c + 16 * tq) * NIN0;
#pragma unroll
        for (int i = 0; i < 16; ++i) { const bf16* up = prow + (size_t)i * NIN0; qv[i] = up[lo_q]; fv[i] = up[lo_q + 768u]; iv[i] = up[lo_q + 1536u]; } }
    for (; it < 1536; it += G) {
        const int bh = it >> 5, c = it & 31, b = bh / 6, h = bh - 6 * b, ch = h * 128 + k;
        const float lbk = lb_of(lbl, ch), oml = 1.0f - lbk;
        u32x4 sreg[4];
        { const u32x4* sp = (const u32x4*)(dS + (size_t)it * 16384) + tid;
#pragma unroll
          for (int j = 0; j < 4; ++j) sreg[j] = sp[512 * j]; }
        float lf[16], kk[16];
#pragma unroll
        for (int i = 0; i < 16; ++i) { float fz = bf2f(fv[i]); fz = fminf(fmaxf(fz, -30.f), 30.f); const float e = fexp2(-fz * LOG2E), sg = frcp(1.0f + e); lf[i] = flog2(lbk + oml * sg); kk[i] = oml * e * sg; }
        float run = 0.f;
#pragma unroll
        for (int i = 0; i < 16; ++i) { run += lf[i]; lf[i] = run; }
        qsum[tq * 128 + k] = run;
        { unsigned vp[8];
#pragma unroll
          for (int i = 0; i < 8; ++i) { const float z0 = bf2f(iv[2 * i]), z1 = bf2f(iv[2 * i + 1]); vp[i] = pk2(z0 * fsigmoid(z0), z1 * fsigmoid(z1)); }
          *(LAS u32x4*)(Vt + k * PK + tq * 32) = (u32x4){vp[0], vp[1], vp[2], vp[3]}; *(LAS u32x4*)(Vt + k * PK + tq * 32 + 16) = (u32x4){vp[4], vp[5], vp[6], vp[7]}; }
        __syncthreads();
        float off = 0.f;
#pragma unroll
        for (int j = 0; j < 4; ++j) { const float s = qsum[j * 128 + k]; if (j < tq) off += s; }
#pragma unroll
        for (int i = 0; i < 16; ++i) { const float bc = lf[i] + off; const float ed = fexp2(bc), edi = fexp2(-bc);
            *(LAS unsigned short*)(Qd + (16 * tq + i) * PQ + 2 * k) = (unsigned short)f2bf(bf2f(qv[i]) * ed);
            *(LAS unsigned short*)(Kd + (16 * tq + i) * PQ + 2 * k) = (unsigned short)f2bf(kk[i] * edi); }
#pragma unroll
        for (int j = 0; j < 4; ++j) { const int e = tid + 512 * j, v = e >> 4, k8 = e & 15; *(LAS u32x4*)(St + v * PQ + k8 * 16) = sreg[j]; }
        const unsigned lo_g = (unsigned)(4 * q) * NIN0 + 2560u + (unsigned)(h * 128 + 16 * w + r), lo_o = (unsigned)(4 * q) * D + 256u + (unsigned)(h * 128 + 16 * w + r);
        const bf16* crow = proj + (size_t)(b * SEQ + 64 * c) * NIN0;
        unsigned short gv[16];
#pragma unroll
        for (int ti = 0; ti < 4; ++ti)
#pragma unroll
            for (int i = 0; i < 4; ++i) { const bf16* up = crow + (size_t)(16 * ti + i) * NIN0; gv[ti * 4 + i] = up[lo_g]; }
        { const int nit = it + G;
          if (nit < 1536) { const int nbh = nit >> 5, nc = nit & 31, nb = nbh / 6, nh = nbh - 6 * nb; const unsigned lo_q = 256u + (unsigned)(nh * 128 + k);
              const bf16* prow = proj + (size_t)(nb * SEQ + 64 * nc + 16 * tq) * NIN0;
#pragma unroll
              for (int i = 0; i < 16; ++i) { const bf16* up = prow + (size_t)i * NIN0; qv[i] = up[lo_q]; fv[i] = up[lo_q + 768u]; iv[i] = up[lo_q + 1536u]; } } }
        __syncthreads();
        { const int ti = w >> 1;
#pragma unroll
          for (int sj = 0; sj < 2; ++sj) { const int si = 2 * (w & 1) + sj; f32x4 acc = {0.f, 0.f, 0.f, 0.f};
              if (si <= ti) {
#pragma unroll
                  for (int ks = 0; ks < 4; ++ks) { const bf16x8 av = *(const LAS bf16x8*)(Qd + (16 * ti + r) * PQ + ks * 64 + q * 16), bv = *(const LAS bf16x8*)(Kd + (16 * si + r) * PQ + ks * 64 + q * 16); acc = MFMA16(av, bv, acc); } }
#pragma unroll
              for (int i = 0; i < 4; ++i) { const int t = 16 * ti + 4 * q + i, s = 16 * si + r; *(LAS unsigned short*)(P + t * PK + 2 * s) = (unsigned short)f2bf(s <= t ? acc[i] : 0.f); } } }
        f32x4 o[4];
#pragma unroll
        for (int ti = 0; ti < 4; ++ti) o[ti] = (f32x4){0.f, 0.f, 0.f, 0.f};
        { bf16x8 bS[4];
#pragma unroll
          for (int ks = 0; ks < 4; ++ks) bS[ks] = *(const LAS bf16x8*)(St + (16 * w + r) * PQ + ks * 64 + q * 16);
#pragma unroll
          for (int ti = 0; ti < 4; ++ti)
#pragma unroll
              for (int ks = 0; ks < 4; ++ks) { const bf16x8 av = *(const LAS bf16x8*)(Qd + (16 * ti + r) * PQ + ks * 64 + q * 16); o[ti] = MFMA16(av, bS[ks], o[ti]); } }
        __syncthreads();
        { bf16x8 bV[2];
#pragma unroll
          for (int ks = 0; ks < 2; ++ks) bV[ks] = *(const LAS bf16x8*)(Vt + (16 * w + r) * PK + ks * 64 + q * 16);
#pragma unroll
          for (int ti = 0; ti < 4; ++ti)
#pragma unroll
              for (int ks = 0; ks < 2; ++ks) { const bf16x8 av = *(const LAS bf16x8*)(P + (16 * ti + r) * PK + ks * 64 + q * 16); o[ti] = MFMA16(av, bV[ks], o[ti]); } }
#pragma unroll
        for (int ti = 0; ti < 4; ++ti)
#pragma unroll
            for (int i = 0; i < 4; ++i) { float p = o[ti][i] * o[ti][i]; p += __shfl_xor(p, 1); p += __shfl_xor(p, 2); p += __shfl_xor(p, 4); p += __shfl_xor(p, 8);
                if (r == 0) part[w * 64 + 16 * ti + 4 * q + i] = p; }
        __syncthreads();
        if (tid < 64) { float s = 0.f;
#pragma unroll
            for (int j = 0; j < 8; ++j) s += part[j * 64 + tid];
            rsr[tid] = __builtin_amdgcn_rsqf(s * (1.0f / 128.0f) + EPS); }
        __syncthreads();
        const float gain_v = gain[h * 128 + 16 * w + r];
        bf16* orow = cat + (size_t)(b * SEQ + 64 * c) * D;
#pragma unroll
        for (int ti = 0; ti < 4; ++ti)
#pragma unroll
            for (int i = 0; i < 4; ++i) { const int t = 16 * ti + 4 * q + i; const float val = o[ti][i] * rsr[t] * gain_v * fsigmoid(bf2f(gv[ti * 4 + i]));
                bf16* up = orow + (size_t)(16 * ti + i) * D; up[lo_o] = (bf16)f2bf(val); }
    }
    __syncthreads();
}

__device__ __forceinline__ void conv_phase(const PArgs& a, int bid, int G, int tid) {
    unsigned char* ws = a.ws;
    const bf16* proj = (const bf16*)(ws + WS_SH); bf16* cat = (bf16*)(ws + WS_CAT); const float* cw = a.in[15];
    for (int gt = bid * NT + tid; gt < 1024 * 128; gt += G * NT) {
        const int cgp = gt & 127, rb = gt >> 7, b = rb >> 7, tl0 = (rb & 127) * 16, c0 = 8 * cgp;
        float w0[8], w1[8], w2[8], zm2[8], zm1[8];
#pragma unroll
        for (int e = 0; e < 8; ++e) { w0[e] = cw[c0 + e]; w1[e] = cw[1024 + c0 + e]; w2[e] = cw[2048 + c0 + e]; zm2[e] = 0.f; zm1[e] = 0.f; }
        const bf16* pr = proj + (size_t)(b * SEQ + tl0) * NIN1 + c0;
        if (tl0 > 0) { float cgv[8], hvv[8];
            unpack8(*(const u32x4*)(pr - 2 * NIN1 + 1024), cgv); unpack8(*(const u32x4*)(pr - 2 * NIN1 + 2048), hvv);
#pragma unroll
            for (int e = 0; e < 8; ++e) zm2[e] = cgv[e] * hvv[e];
            unpack8(*(const u32x4*)(pr - NIN1 + 1024), cgv); unpack8(*(const u32x4*)(pr - NIN1 + 2048), hvv);
#pragma unroll
            for (int e = 0; e < 8; ++e) zm1[e] = cgv[e] * hvv[e]; }
#pragma unroll 1
        for (int i = 0; i < 16; ++i) { float bgv[8], cgv[8], hvv[8], o[8];
            unpack8(*(const u32x4*)(pr + (size_t)i * NIN1), bgv); unpack8(*(const u32x4*)(pr + (size_t)i * NIN1 + 1024), cgv); unpack8(*(const u32x4*)(pr + (size_t)i * NIN1 + 2048), hvv);
#pragma unroll
            for (int e = 0; e < 8; ++e) { const float z = cgv[e] * hvv[e]; o[e] = bgv[e] * (w0[e] * zm2[e] + w1[e] * zm1[e] + w2[e] * z); zm2[e] = zm1[e]; zm1[e] = z; }
            *(u32x4*)(cat + (size_t)(b * SEQ + tl0 + i) * D + c0) = (u32x4){pk2(o[0], o[1]), pk2(o[2], o[3]), pk2(o[4], o[5]), pk2(o[6], o[7])};
            const int t = tl0 + i;
            if (t >= SEQ - 2) { float* co = a.out + O_CONVP + (size_t)(b * 2 + (t - (SEQ - 2))) * 1024 + c0;
                *(f32x4*)co = (f32x4){zm1[0], zm1[1], zm1[2], zm1[3]}; *(f32x4*)(co + 4) = (f32x4){zm1[4], zm1[5], zm1[6], zm1[7]}; } }
    }
    const bf16* projs = (const bf16*)(ws + WS_PROJS); bf16* cats = (bf16*)(ws + WS_CATS); const float* sc = a.in[4];
    for (int gt = bid * NT + tid; gt < MS * 128; gt += G * NT) {
        const int cgp = gt & 127, b = gt >> 7, c0 = 8 * cgp; float bgv[8], cgv[8], hvv[8], o[8], z[8];
        const bf16* pr = projs + (size_t)b * NIN1 + c0;
        unpack8(*(const u32x4*)pr, bgv); unpack8(*(const u32x4*)(pr + 1024), cgv); unpack8(*(const u32x4*)(pr + 2048), hvv);
        const float* p0 = sc + (size_t)(b * 2) * 1024 + c0; const float* p1 = p0 + 1024;
        float* co = a.out + O_CONVS + (size_t)(b * 2) * 1024 + c0;
#pragma unroll
        for (int e = 0; e < 8; ++e) { z[e] = cgv[e] * hvv[e]; o[e] = bgv[e] * (cw[c0 + e] * p0[e] + cw[1024 + c0 + e] * p1[e] + cw[2048 + c0 + e] * z[e]); co[e] = p1[e]; co[1024 + e] = z[e]; }
        *(u32x4*)(cats + (size_t)b * D + c0) = (u32x4){pk2(o[0], o[1]), pk2(o[2], o[3]), pk2(o[4], o[5]), pk2(o[6], o[7])};
    }
}

__device__ __forceinline__ void final_norm(const PArgs& a, int bid, int G, int wave, int lane) {
    const int gw = bid * NWAVES + wave, NGW = G * NWAVES; const float* gf = a.in[7]; const float* ss4 = (const float*)(a.ws + WS_SS) + 4 * MP;
    f32x4 gv[4];
#pragma unroll
    for (int j = 0; j < 4; ++j) gv[j] = ((const f32x4*)gf)[lane + 64 * j];
    for (int m = gw; m < MP + MS; m += NGW) {
        if (m < MP) { f32x4* yr = (f32x4*)(a.out + O_Y + (size_t)m * D) + lane; const float rs = __builtin_amdgcn_rsqf(ss4[m] * (1.0f / 1024.0f) + EPS);
#pragma unroll
            for (int j = 0; j < 4; ++j) { const f32x4 v = yr[64 * j]; yr[64 * j] = v * rs * gv[j]; } }
        else { const int sr = m - MP; const f32x4* xr = (const f32x4*)((const float*)(a.ws + WS_XS) + (size_t)sr * D) + lane; f32x4* yr = (f32x4*)(a.out + O_YS + (size_t)sr * D) + lane;
            f32x4 v[4]; float s = 0.f;
#pragma unroll
            for (int j = 0; j < 4; ++j) { v[j] = xr[64 * j]; s += (v[j].x * v[j].x + v[j].y * v[j].y) + (v[j].z * v[j].z + v[j].w * v[j].w); }
            const float rs = __builtin_amdgcn_rsqf(wave_sum(s) * (1.0f / 1024.0f) + EPS);
#pragma unroll
            for (int j = 0; j < 4; ++j) yr[64 * j] = v[j] * rs * gv[j]; }
    }
}

#define XB_TMO      128
#define XB_XCNT(j)  (256  + 64 * (j))
#define XB_XSUB(j)  (1280 + 64 * (j))
#define XB_XGEN(j)  (2304 + 64 * (j))
#define XB_TOP      3328
#define XB_TOPGEN   3392
#define XCD_BAR_WORDS 3456
#define XB_SPIN_CAP (1u << 18)

__device__ __forceinline__ unsigned xb_ld(unsigned* p)              { return __hip_atomic_load(p, __ATOMIC_RELAXED, __HIP_MEMORY_SCOPE_AGENT); }
__device__ __forceinline__ unsigned xb_add(unsigned* p, unsigned v) { return __hip_atomic_fetch_add(p, v, __ATOMIC_RELAXED, __HIP_MEMORY_SCOPE_AGENT); }
__device__ __forceinline__ unsigned xb_xcc_id() { return (unsigned)__builtin_amdgcn_s_getreg((3 << 11) | 20) & 0xFu; }
#define XB_SPIN(cond, bar) do { unsigned _sp = 0; while (cond) { __builtin_amdgcn_s_sleep(1); \
    if ((++_sp & 255u) == 0u) { if (xb_ld(&(bar)[XB_TMO])) break; if (_sp > XB_SPIN_CAP) { atomicAdd(&(bar)[XB_TMO], 1u); break; } } } } while (0)

struct XcdBarrier {
    unsigned* bar; unsigned x;
    volatile LAS unsigned* st;
};

__device__ __forceinline__ XcdBarrier xcd_barrier_post(unsigned* bar, volatile LAS unsigned* st) {
    XcdBarrier b; b.bar = bar; b.x = xb_xcc_id(); b.st = st;
    if (threadIdx.x == 0) (void)xb_add(&bar[XB_XCNT(b.x)], 1u);
    return b;
}
__device__ __forceinline__ void xcd_barrier_complete(unsigned* bar, unsigned x, unsigned& nloc, unsigned& nx) {
    const unsigned G = gridDim.x * gridDim.y * gridDim.z;
    unsigned sum, cnt, mine, sp = 0u;
    for (;;) {
        sum = 0u; cnt = 0u; mine = 0u;
#pragma unroll
        for (unsigned j = 0; j < 16; ++j) { const unsigned c = xb_ld(&bar[XB_XCNT(j)]); sum += c; cnt += (c > 0u) ? 1u : 0u; mine = (j == x) ? c : mine; }
        if (sum == G) break;
        __builtin_amdgcn_s_sleep(1);
        if ((++sp & 255u) == 0u) { if (xb_ld(&bar[XB_TMO])) break; if (sp > XB_SPIN_CAP) { atomicAdd(&bar[XB_TMO], 1u); break; } }
    }
    nloc = mine > 0u ? mine : 1u; nx = cnt > 0u ? cnt : 1u;
}

__device__ __forceinline__ void xcd_barrier(const XcdBarrier& b) {
    asm volatile("s_waitcnt vmcnt(0)" ::: "memory");
    __syncthreads();
    if (threadIdx.x == 0) {
        unsigned* bar = b.bar;
        __builtin_amdgcn_s_waitcnt(0);
        unsigned nloc = b.st[0], nx = b.st[1];
        if (nloc == 0u) { xcd_barrier_complete(bar, b.x, nloc, nx); b.st[0] = nloc; b.st[1] = nx; }
        const unsigned old = xb_add(&bar[XB_XSUB(b.x)], 1u);
        const unsigned gen = old / nloc;
        if (old + 1u == (gen + 1u) * nloc) {
            __builtin_amdgcn_fence(__ATOMIC_RELEASE, "agent");
            asm volatile("s_waitcnt vmcnt(0)" ::: "memory");
            const unsigned og = xb_add(&bar[XB_TOP], 1u);
            const unsigned tg = og / nx;
            if (og + 1u == (tg + 1u) * nx) xb_add(&bar[XB_TOPGEN], 1u);
            else XB_SPIN(xb_ld(&bar[XB_TOPGEN]) == tg, bar);
            __builtin_amdgcn_fence(__ATOMIC_ACQUIRE, "agent");
            xb_add(&bar[XB_XGEN(b.x)], 1u);
            asm volatile("s_waitcnt vmcnt(0)" ::: "memory");
        } else {
            XB_SPIN(xb_ld(&bar[XB_XGEN(b.x)]) == gen, bar);
            __builtin_amdgcn_fence(__ATOMIC_ACQUIRE, "agent");
            asm volatile("s_waitcnt vmcnt(0)" ::: "memory");
        }
    }
    __syncthreads();
}

#ifndef DIS_GEMM
#define DIS_GEMM 0
#endif
#ifndef DIS_SGEMM
#define DIS_SGEMM 0
#endif
#ifndef DIS_HGRN
#define DIS_HGRN 0
#endif
#ifndef DIS_OTHER
#define DIS_OTHER 0
#endif
#ifndef DBG_O
#define DBG_O 15
#endif
#ifndef DUPK
#define DUPK 0
#endif
#ifndef DBG_XSYNC
#define DBG_XSYNC 0
#endif
#ifndef DBG_COL
#define DBG_COL 2304
#endif
#ifndef DBG_HI
#define DBG_HI 12
#endif
#ifndef MK_MULTI
#define MK_MULTI 0
#endif
constexpr int N_PHASES = 12;
#define IN(k) (lo <= (k) && (k) < hi)
#define SEAM(k) do { if (IN(k) && IN((k) + 1)) xcd_barrier(xbar); } while (0)
template <int L>
__device__ __forceinline__ void layer_phases(const PArgs& a, LAS unsigned char* lds, const XcdBarrier& xbar, int lo, int hi, int bid, int G, int tid, int wave, int lane) {
    unsigned char* ws = a.ws;
    float* ss = (float*)(ws + WS_SS);
    bf16* CAT = (bf16*)(ws + WS_CAT); bf16* SH = (bf16*)(ws + WS_SH); bf16* XB = (bf16*)(ws + WS_XB);
    float* xs = (float*)(ws + WS_XS); bf16* projs = (bf16*)(ws + WS_PROJS); bf16* cats = (bf16*)(ws + WS_CATS); bf16* hs = (bf16*)(ws + WS_HS);
    float* Y = a.out + O_Y;
    constexpr int pb = 1 + 5 * L;
    const bf16* Win = (const bf16*)(ws + (L ? WS_WIN1 : WS_WIN0)); const bf16* Wout = (const bf16*)(ws + (L ? WS_WOUT1 : WS_WOUT0));
    const bf16* W1 = (const bf16*)(ws + (L ? WS_W11 : WS_W10)); const bf16* W2 = (const bf16*)(ws + (L ? WS_W21 : WS_W20));
    constexpr int Nin = L ? NIN1 : NIN0;
    if (IN(pb)) {
        pg8::Gemm g{L ? XB : CAT, Win, MP, Nin, D}; pg8::StaticOrder S; S.init(MP, Nin, G, bid);
        pg8::EpiScaleBf16<0> E{SH, Nin, ss + (L ? 2 : 0) * MP};
        for (int rep = 0; rep < (DUPK == 5 ? 2 : 1); ++rep) pg8::gemm_phase<pg8::EpiScaleBf16<0>, pg8::StaticOrder, true, true>(lds, g, S, E);
        for (int rep = 0; rep < (DUPK == 1 ? 2 : 1); ++rep) sgemm<true, 0, 4>(lds, L ? (const void*)xs : (const void*)a.in[1], D, Win, Nin, D, 1, projs, Nin, xs, G, bid, tid, wave, lane);
    }
    SEAM(pb);
    if (IN(pb + 1)) {
        if (L == 0) {
            bf16* dS = (bf16*)(ws + WS_DS); float* eblg = (float*)(ws + WS_EBL);
            if (DUPK == 4) { hgrn_stepA(lds, SH, a.in[11], dS, eblg, bid, G, wave, lane); xcd_barrier(xbar); hgrn_stepB(dS, eblg, a.out + O_HGP, bid, G, tid); xcd_barrier(xbar); hgrn_stepC(lds, SH, a.in[11], a.in[12], dS, CAT, bid, G, tid, wave, lane); xcd_barrier(xbar); }
            if (!DIS_HGRN) hgrn_stepA(lds, SH, a.in[11], dS, eblg, bid, G, wave, lane);
            for (int rep = 0; rep < (DUPK == 9 ? 2 : 1); ++rep) {
                for (int it = bid; it < MS * 6; it += 3 * G) hgrn_sample3(lds, projs, a.in[3], a.in[11], a.in[12], cats, a.out + O_HGS, it, G, tid, wave, lane);
                for (int it = bid; it < 1024; it += G) pool_prompt(lds, SH, a.in[9], a.in[10], CAT, a.out + O_POOLP, it, tid);
                for (int it = bid; it < 8; it += G) pool_sample(lds, projs, a.in[2], a.in[9], a.in[10], cats, a.out + O_POOLS, it, tid); }
            xcd_barrier(xbar);
            if (!DIS_HGRN) hgrn_stepB(dS, eblg, a.out + O_HGP, bid, G, tid);
            xcd_barrier(xbar);
            if (!DIS_HGRN) hgrn_stepC(lds, SH, a.in[11], a.in[12], dS, CAT, bid, G, tid, wave, lane);
        } else { for (int rep = 0; rep < (DUPK == 8 ? 2 : 1); ++rep) conv_phase(a, bid, G, tid); }
    }
    SEAM(pb + 1);
    if (IN(pb + 2)) {
        pg8::Gemm g{CAT, Wout, MP, D, D}; pg8::StaticOrder S; S.init(MP, D, G, bid);
        pg8::EpiResid E{L ? (const float*)Y : a.in[0], Y, XB, ss + (L ? 3 : 1) * MP};
        if (DUPK == 6) { pg8::EpiNull EN{Y, a.ph_lo}; pg8::gemm_phase<pg8::EpiNull, pg8::StaticOrder, true, true>(lds, g, S, EN); }
        if (!DIS_GEMM) pg8::gemm_phase<pg8::EpiResid, pg8::StaticOrder, true, true>(lds, g, S, E);
        if (!DIS_SGEMM) sgemm<false, 2, 1>(lds, cats, D, Wout, D, D, 4, nullptr, 0, xs, G, bid, tid, wave, lane);
    }
    SEAM(pb + 2);
    if (IN(pb + 3)) {
        pg8::Gemm g{XB, W1, MP, FF, D}; pg8::StaticOrder S; S.init(MP, FF, G, bid);
        pg8::EpiScaleBf16<1> E{SH, FF, ss + (L ? 3 : 1) * MP};
        for (int rep = 0; rep < (DUPK == 2 ? 2 : 1); ++rep) pg8::gemm_phase<pg8::EpiScaleBf16<1>, pg8::StaticOrder, true, true>(lds, g, S, E);
        for (int rep = 0; rep < (DUPK == 1 ? 2 : 1); ++rep) sgemm<true, 1, 4>(lds, xs, D, W1, FF, D, 1, hs, FF, xs, G, bid, tid, wave, lane);
    }
    SEAM(pb + 3);
    if (IN(pb + 4)) {
        pg8::Gemm g{SH, W2, MP, D, FF}; pg8::StaticOrder S; S.init(MP, D, G, bid);
        pg8::EpiResid E{Y, Y, L ? nullptr : XB, ss + (L ? 4 : 2) * MP};
        if (DUPK == 7) { pg8::EpiNull EN{Y, a.ph_lo}; pg8::gemm_phase<pg8::EpiNull, pg8::StaticOrder, true, true>(lds, g, S, EN); }
        if (!DIS_GEMM) pg8::gemm_phase<pg8::EpiResid, pg8::StaticOrder, true, true>(lds, g, S, E);
        if (!DIS_SGEMM) sgemm<false, 2, 4>(lds, hs, FF, W2, D, FF, 4, nullptr, 0, xs, G, bid, tid, wave, lane);
    }
    SEAM(pb + 4);
}
__global__ void __launch_bounds__(NT, 2) mk_fwd(PArgs a) {
    extern __shared__ __attribute__((aligned(16))) unsigned char lds_raw[];
    LAS unsigned char* lds = (LAS unsigned char*)lds_raw;
    const int tid = threadIdx.x, lane = tid & 63, wave = __builtin_amdgcn_readfirstlane(tid >> 6), bid = blockIdx.x, G = gridDim.x;
    const int lo = a.ph_lo, hi = a.ph_hi;
    volatile LAS unsigned* xst = (volatile LAS unsigned*)(lds + 131072 + 64);
    if (tid < 2) xst[tid] = 0u;
    __syncthreads();
    const XcdBarrier xbar = xcd_barrier_post((unsigned*)a.ws, xst);
    if (lo < 0) cg::this_grid().sync();
    if (IN(0)) { for (int rep = 0; rep < (DUPK == 3 ? 2 : 1); ++rep) { p0_prologue(a, lds, bid, G, tid, wave, lane); __syncthreads(); } }
    SEAM(0);
    layer_phases<0>(a, lds, xbar, lo, hi, bid, G, tid, wave, lane);
    layer_phases<1>(a, lds, xbar, lo, hi, bid, G, tid, wave, lane);
    for (int xx = 0; xx < DBG_XSYNC; ++xx) xcd_barrier(xbar);
    if (IN(11)) final_norm(a, bid, G, wave, lane);
    if (hi < 12) {
        if (hi <= 3) { cg::this_grid().sync(); const bf16* C = (const bf16*)(a.ws + WS_CAT); for (size_t i = (size_t)bid * NT + tid; i < O_YS; i += (size_t)G * NT) a.out[i] = ((i & 1023) >= 256) ? bf2f(C[i]) : 0.f; }
        for (size_t i = (size_t)bid * NT + tid; i < 131072; i += (size_t)G * NT) a.out[O_YS + i] = 0.f;
        if (hi <= 2) for (size_t i = (size_t)bid * NT + tid + O_POOLP; i < O_CONVS; i += (size_t)G * NT) a.out[i] = 0.f;
        if (hi <= 7) { for (size_t i = (size_t)bid * NT + tid; i < 16384; i += (size_t)G * NT) a.out[O_CONVP + i] = 0.f;
                       for (size_t i = (size_t)bid * NT + tid; i < 262144; i += (size_t)G * NT) a.out[O_CONVS + i] = 0.f; }
    }
}
#undef IN
#undef SEAM

extern "C" void kernel_launch(void* const* d_in, const int* in_sizes, int n_in, void* d_out, int out_size, void* d_ws, size_t ws_size, hipStream_t stream) {
    static int grid = 0;
    if (grid == 0) {
        if (n_in != 19 || ws_size < WS_END) { fprintf(stderr, "kernel_launch: unexpected inputs (n_in %d, ws %zu)\n", n_in, ws_size); grid = -1; return; }
        int dev = 0, cus = 0, per_cu = 0;
        if (hipGetDevice(&dev) != hipSuccess || hipDeviceGetAttribute(&cus, hipDeviceAttributeMultiprocessorCount, dev) != hipSuccess) { grid = -1; return; }
        if (hipFuncSetAttribute((const void*)mk_fwd, hipFuncAttributeMaxDynamicSharedMemorySize, LDS_BYTES) != hipSuccess) { fprintf(stderr, "kernel_launch: hipFuncSetAttribute failed\n"); grid = -1; return; }
        if (hipOccupancyMaxActiveBlocksPerMultiprocessor(&per_cu, (const void*)mk_fwd, NT, LDS_BYTES) != hipSuccess || per_cu < 1) { fprintf(stderr, "kernel_launch: occupancy query says %d\n", per_cu); per_cu = 1; }
        (void)hipGetLastError();
        grid = cus;
    }
    if (grid < 0) return;
    PArgs a{};
    for (int i = 0; i < 19; ++i) a.in[i] = (const float*)d_in[i];
    a.out = (float*)d_out; a.ws = (unsigned char*)d_ws;
#if MK_MULTI
    for (int k = 0; k < DBG_HI; ++k) { a.ph_lo = k; a.ph_hi = k + 1; hipLaunchKernelGGL(mk_fwd, dim3(grid), dim3(NT), LDS_BYTES, stream, a); }
#else
    a.ph_lo = 0; a.ph_hi = DBG_HI;
    if (hipMemsetAsync(d_ws, 0, 16384, stream) != hipSuccess) { fprintf(stderr, "kernel_launch: hipMemsetAsync failed\n"); return; }
    void* args[] = {&a};
    hipError_t e = hipLaunchCooperativeKernel((const void*)mk_fwd, dim3(grid), dim3(NT), args, LDS_BYTES, stream);
    if (e != hipSuccess) fprintf(stderr, "cooperative launch failed: %s (grid %d)\n", hipGetErrorString(e), grid);
#endif
}
```

```cpp
#include <hip/hip_runtime.h>
#include <hip/hip_cooperative_groups.h>
#include <cstdio>
#include <cstdint>
namespace cg = cooperative_groups;
#ifndef DBG_O
#define DBG_O 15
#endif
namespace pg8 {
#define PG8_LAS __attribute__((address_space(3)))
typedef unsigned short bf16_t;
typedef short bf16x8 __attribute__((ext_vector_type(8)));
typedef float f32x4 __attribute__((ext_vector_type(4)));
typedef unsigned u32x4 __attribute__((ext_vector_type(4)));
typedef unsigned u32x2 __attribute__((ext_vector_type(2)));
constexpr int BM = 256, BK = 64, HALF = 128, HTB = HALF * BK * 2  , STAGE_BYTES = 8 * HTB, NXCD = 8, WGM = 8;

__host__ __device__ __forceinline__ int lds_byte(int r, int c) { const int st = (r >> 4) * 2 + (c >> 5), rr = r & 15, cc = c & 31, ob = rr * 64 + cc * 2; return st * 1024 + (ob ^ (((ob >> 9) & 1) << 5)); }
__host__ __device__ __forceinline__ void stage_rc(int b, int& R, int& C) { const int st = b / 1024, sb = b % 1024, swz = sb ^ (((sb >> 9) & 1) << 5); R = (st >> 1) * 16 + swz / 64; C = (st & 1) * 32 + (swz % 64) / 2; }
__host__ __device__ __forceinline__ int perm32(int rho) { const int n = rho >> 4, i = rho & 15; return 8 * (i >> 2) + 4 * n + (i & 3); }

struct Unit { int pm, pn; };
struct Gemm { const bf16_t* A; const bf16_t* Bt; int M, N, K; };

struct StaticOrder {
    int nM, nN, nwg, G, c;
    __host__ __device__ void init(int M, int N, int G_, int c_) { nM = M / BM; nN = N / BM; nwg = nM * nN; G = G_; c = c_; }
    __host__ __device__ bool next(int i, Unit& u) const {
        const long L = (long)i * G + c; if (L >= nwg) return false;
        int wgid = (int)L; { const int q = nwg / NXCD, r = nwg % NXCD, xcd = wgid % NXCD, off = wgid / NXCD; wgid = (xcd < r ? xcd * (q + 1) : r * (q + 1) + (xcd - r) * q) + off; }
        const int nig = WGM * nN, gid = wgid / nig, fm = gid * WGM, gsz = (nM - fm) < WGM ? (nM - fm) : WGM;
        u.pm = fm + ((wgid % nig) % gsz); u.pn = (wgid % nig) / gsz; return true;
    }
    __device__ __forceinline__ void a_ready(const Unit&) const {}
    __device__ __forceinline__ void done(const Unit&) const {}
};

__device__ __forceinline__ unsigned cvt_pk_bf16(float lo, float hi) { unsigned r; asm volatile("v_cvt_pk_bf16_f32 %0, %1, %2" : "=v"(r) : "v"(lo), "v"(hi)); return r; }
template <int ACT  > struct EpiScaleBf16 {
    static constexpr bool PERM = true, AFTER_DRAIN = false;
    bf16_t* O; int ldc; const float* ss;
    __device__ __forceinline__ void operator()(const f32x4 (&acc)[2][2][4][2], const Unit& u, int wr, int wc, int fr, int fq) const {
        const int row0 = u.pm * BM + wr * 64 + fr, col0 = u.pn * BM + wc * 32 + 8 * fq;
#pragma unroll
        for (int ai = 0; ai < 2; ++ai)
#pragma unroll
            for (int m = 0; m < 4; ++m) { const int row = row0 + ai * HALF + m * 16; const float rs = __builtin_amdgcn_rsqf(ss[row] * (1.0f / 1024.0f) + 1e-6f);
                bf16_t* rowp = O + (size_t)row * ldc + col0;
#pragma unroll
                for (int bj = 0; bj < 2; ++bj) { f32x4 v0 = acc[ai][bj][m][0] * rs, v1 = acc[ai][bj][m][1] * rs;
                    if (ACT == 1) {
#pragma unroll
                        for (int e = 0; e < 4; ++e) { const float a = fmaxf(v0[e], 0.f), b = fmaxf(v1[e], 0.f); v0[e] = a * a; v1[e] = b * b; } }
                    u32x4 w; w.x = cvt_pk_bf16(v0[0], v0[1]); w.y = cvt_pk_bf16(v0[2], v0[3]); w.z = cvt_pk_bf16(v1[0], v1[1]); w.w = cvt_pk_bf16(v1[2], v1[3]);
                    *(u32x4*)(rowp + bj * HALF) = w; } }
    }
};
struct EpiNull {
    static constexpr bool PERM = true, AFTER_DRAIN = false;
    float* out; int never;
    __device__ __forceinline__ void operator()(const f32x4 (&acc)[2][2][4][2], const Unit& u, int wr, int wc, int fr, int fq) const {
        if (never) {
#pragma unroll
            for (int ai = 0; ai < 2; ++ai)
#pragma unroll
                for (int m = 0; m < 4; ++m)
#pragma unroll
                    for (int bj = 0; bj < 2; ++bj) { *(f32x4*)(out + (size_t)(u.pm * BM + wr * 64 + fr + ai * HALF + m * 16) * 1024 + u.pn * BM + wc * 32 + 8 * fq + bj * HALF) = acc[ai][bj][m][0] + acc[ai][bj][m][1]; } }
    }
};
struct EpiResid {
    static constexpr bool PERM = true, AFTER_DRAIN = false;
    const float* base32; bf16_t* xb; float* ss;
    __device__ __forceinline__ void operator()(const f32x4 (&acc)[2][2][4][2], const Unit& u, int wr, int wc, int fr, int fq) const {
        typedef float f32x2v __attribute__((ext_vector_type(2))); typedef __bf16 bf16x2v __attribute__((ext_vector_type(2)));
        const int row0 = u.pm * BM + wr * 64 + fr, col0 = u.pn * BM + wc * 32 + 8 * fq;
#pragma unroll
        for (int ai = 0; ai < 2; ++ai) {
            f32x4 bv[4][2][2];
            if (base32) {
#pragma unroll
                for (int m = 0; m < 4; ++m)
#pragma unroll
                    for (int bj = 0; bj < 2; ++bj)
#pragma unroll
                        for (int n = 0; n < 2; ++n) bv[m][bj][n] = *(const f32x4*)(base32 + (size_t)(row0 + ai * HALF + m * 16) * 1024 + col0 + bj * HALF + n * 4);
            } else {
                u32x4 raw[4][2];
#pragma unroll
                for (int m = 0; m < 4; ++m)
#pragma unroll
                    for (int bj = 0; bj < 2; ++bj) raw[m][bj] = *(const u32x4*)(xb + (size_t)(row0 + ai * HALF + m * 16) * 1024 + col0 + bj * HALF);
#pragma unroll
                for (int m = 0; m < 4; ++m)
#pragma unroll
                    for (int bj = 0; bj < 2; ++bj) { const u32x4 w = raw[m][bj];
                        bv[m][bj][0] = (f32x4){__uint_as_float(w.x << 16), __uint_as_float(w.x & 0xffff0000u), __uint_as_float(w.y << 16), __uint_as_float(w.y & 0xffff0000u)};
                        bv[m][bj][1] = (f32x4){__uint_as_float(w.z << 16), __uint_as_float(w.z & 0xffff0000u), __uint_as_float(w.w << 16), __uint_as_float(w.w & 0xffff0000u)}; }
            }
#pragma unroll
            for (int m = 0; m < 4; ++m) { const int row = row0 + ai * HALF + m * 16; const size_t off = (size_t)row * 1024 + col0; float sq = 0.f;
#pragma unroll
                for (int bj = 0; bj < 2; ++bj) { const f32x4 x0 = bv[m][bj][0] + acc[ai][bj][m][0], x1 = bv[m][bj][1] + acc[ai][bj][m][1];
                    sq += (x0[0] * x0[0] + x0[1] * x0[1]) + (x0[2] * x0[2] + x0[3] * x0[3]) + (x1[0] * x1[0] + x1[1] * x1[1]) + (x1[2] * x1[2] + x1[3] * x1[3]);
                    const f32x2v a0 = {x0[0], x0[1]}, a1 = {x0[2], x0[3]}, a2 = {x1[0], x1[1]}, a3 = {x1[2], x1[3]}; u32x4 w;
                    w.x = __builtin_bit_cast(unsigned, __builtin_convertvector(a0, bf16x2v)); w.y = __builtin_bit_cast(unsigned, __builtin_convertvector(a1, bf16x2v));
                    w.z = __builtin_bit_cast(unsigned, __builtin_convertvector(a2, bf16x2v)); w.w = __builtin_bit_cast(unsigned, __builtin_convertvector(a3, bf16x2v));
                    *(u32x4*)(xb + off + bj * HALF) = w; }
                sq += __shfl_xor(sq, 16); sq += __shfl_xor(sq, 32);
                if (fq == 0) atomicAdd(ss + row, sq); }
            asm volatile("" ::: "memory"); }
    }
};
template <class Epi, class Sched, bool ALIGN_EPI = false, bool SP2 = false>
__device__ __forceinline__ void gemm_phase(PG8_LAS unsigned char* lds, const Gemm g, const Sched& S, const Epi& E) {
    const int tid = threadIdx.x, wid = __builtin_amdgcn_readfirstlane(tid >> 6), lane = tid & 63, wr = wid >> 2, wc = wid & 3, fr = lane & 15, fq = lane >> 4;
    const int K = g.K, nt = K / BK;
    unsigned voffA[2], voffB[2];
#pragma unroll
    for (int i = 0; i < 2; ++i) { int R, C; stage_rc(tid * 16 + i * 8192, R, C); const int Rb = Epi::PERM ? ((R & ~31) + perm32(R & 31)) : R;
        voffA[i] = (unsigned)(R * K + C) * 2u; voffB[i] = (unsigned)(Rb * K + C) * 2u; }
    const size_t kstep = (size_t)(BK * 2);
    const size_t hstep = (size_t)HALF * K * 2;
    const size_t tstep = 2 * hstep;
    const unsigned ldsw = (unsigned)wid * 1024u;
    const int aoff = lds_byte(wr * 64 + fr, fq * 8), boff = lds_byte(wc * 32 + fr, fq * 8);
#define PG8_SA(b, h) (((b) * 2 + (h)) * HTB)
#define PG8_SB(b, h) ((4 + (b) * 2 + (h)) * HTB)
#define PG8_STAGE(bufoff, gbase, voff) do { _Pragma("unroll") for (int _i = 0; _i < 2; ++_i) \
        __builtin_amdgcn_global_load_lds((const unsigned*)((const char*)(gbase) + (voff)[_i]), (PG8_LAS unsigned*)(lds + (bufoff) + ldsw + _i * 8192), 16, 0, 0); } while (0)
#define PG8_LDA(dst, b, h) do { _Pragma("unroll") for (int m = 0; m < 4; ++m) _Pragma("unroll") for (int k = 0; k < 2; ++k) dst[m][k] = *(const PG8_LAS bf16x8*)(lds + PG8_SA(b, h) + aoff + m * 2048 + k * 1024); } while (0)
#define PG8_LDB(dst, b, h) do { _Pragma("unroll") for (int n = 0; n < 2; ++n) _Pragma("unroll") for (int k = 0; k < 2; ++k) dst[n][k] = *(const PG8_LAS bf16x8*)(lds + PG8_SB(b, h) + boff + n * 2048 + k * 1024); } while (0)
#define PG8_MMA(ai, bj, At, Bt) do { __builtin_amdgcn_s_setprio(1); _Pragma("unroll") for (int m = 0; m < 4; ++m) _Pragma("unroll") for (int n = 0; n < 2; ++n) _Pragma("unroll") for (int k = 0; k < 2; ++k) \
        acc[ai][bj][m][n] = __builtin_amdgcn_mfma_f32_16x16x32_bf16(Bt[n][k], At[m][k], acc[ai][bj][m][n], 0, 0, 0); __builtin_amdgcn_s_setprio(0); } while (0)
#define PG8_WAIT_V(n) asm volatile("s_waitcnt vmcnt(" #n ")" ::: "memory")
#define PG8_WAIT_L(n) asm volatile("s_waitcnt lgkmcnt(" #n ")" ::: "memory")
#define PG8_BAR __builtin_amdgcn_s_barrier()
#define PG8_SCHED __builtin_amdgcn_sched_barrier(0)
    Unit cur, nxt; int ui = 0;
    if (!S.next(0, cur)) return;
    f32x4 acc[2][2][4][2];
#pragma unroll
    for (int a = 0; a < 2; ++a)
#pragma unroll
        for (int b = 0; b < 2; ++b)
#pragma unroll
            for (int m = 0; m < 4; ++m)
#pragma unroll
                for (int n = 0; n < 2; ++n) acc[a][b][m][n] = (f32x4){0.f, 0.f, 0.f, 0.f};
    bf16x8 At[4][2], B0[2][2], B1[2][2];
    const char* cA = (const char*)g.A + (size_t)cur.pm * tstep; const char* cB = (const char*)g.Bt + (size_t)cur.pn * tstep;
    S.a_ready(cur);
    if constexpr (SP2) {
        PG8_STAGE(PG8_SB(0, 0), cB, voffB); PG8_STAGE(PG8_SB(0, 1), cB + hstep, voffB); PG8_STAGE(PG8_SA(0, 0), cA, voffA); PG8_STAGE(PG8_SA(0, 1), cA + hstep, voffA);
        if (wr == 1) PG8_BAR;
        PG8_WAIT_V(2); PG8_BAR;
        PG8_STAGE(PG8_SB(1, 0), cB + kstep, voffB); PG8_STAGE(PG8_SA(1, 0), cA + kstep, voffA); PG8_STAGE(PG8_SB(1, 1), cB + hstep + kstep, voffB);
        PG8_WAIT_V(6); PG8_BAR;
    } else {
        PG8_STAGE(PG8_SB(0, 0), cB, voffB); PG8_STAGE(PG8_SA(0, 0), cA, voffA); PG8_STAGE(PG8_SB(0, 1), cB + hstep, voffB); PG8_STAGE(PG8_SA(0, 1), cA + hstep, voffA);
        if (wr == 1) PG8_BAR;
        PG8_WAIT_V(4); PG8_BAR;
        PG8_STAGE(PG8_SB(1, 0), cB + kstep, voffB); PG8_STAGE(PG8_SA(1, 0), cA + kstep, voffA); PG8_STAGE(PG8_SB(1, 1), cB + hstep + kstep, voffB);
        PG8_WAIT_V(6); PG8_BAR;
    }
    for (;;) {
        const bool has_next = S.next(ui + 1, nxt);
        const char* nA = has_next ? (const char*)g.A + (size_t)nxt.pm * tstep : cA; const char* nB = has_next ? (const char*)g.Bt + (size_t)nxt.pn * tstep : cB;
        for (int t = 0; t < nt; t += 2) {
            const bool last = (t == nt - 2);
            const char* a1 = cA + (size_t)(t + 1) * kstep;
            const char* a2 = last ? nA : cA + (size_t)(t + 2) * kstep; const char* b2 = last ? nB : cB + (size_t)(t + 2) * kstep;
            const char* a3 = a2 + kstep; const char* b3 = b2 + kstep;
            if (last && has_next) S.a_ready(nxt);
            if constexpr (SP2) {
            PG8_LDB(B0, 0, 0); PG8_LDB(B1, 0, 1); PG8_SCHED; PG8_LDA(At, 0, 0); PG8_STAGE(PG8_SA(1, 1), a1 + hstep, voffA);
            PG8_WAIT_V(8); PG8_WAIT_L(0); PG8_BAR; PG8_MMA(0, 0, At, B0); PG8_MMA(0, 1, At, B1); PG8_BAR; PG8_SCHED;
            PG8_LDA(At, 0, 1); PG8_STAGE(PG8_SB(0, 0), b2, voffB); PG8_STAGE(PG8_SB(0, 1), b2 + hstep, voffB); PG8_STAGE(PG8_SA(0, 0), a2, voffA);
            PG8_WAIT_V(8); PG8_WAIT_L(0); PG8_BAR; PG8_MMA(1, 0, At, B0); PG8_MMA(1, 1, At, B1); PG8_BAR; PG8_SCHED;
            PG8_LDB(B0, 1, 0); PG8_LDB(B1, 1, 1); PG8_SCHED; PG8_LDA(At, 1, 0); PG8_STAGE(PG8_SA(0, 1), a2 + hstep, voffA);
            PG8_WAIT_V(8); PG8_WAIT_L(0); PG8_BAR; PG8_MMA(0, 0, At, B0); PG8_MMA(0, 1, At, B1); PG8_BAR; PG8_SCHED;
            PG8_LDA(At, 1, 1); PG8_STAGE(PG8_SB(1, 0), b3, voffB); PG8_STAGE(PG8_SB(1, 1), b3 + hstep, voffB); PG8_STAGE(PG8_SA(1, 0), a3, voffA);
            PG8_WAIT_V(8); PG8_WAIT_L(0); PG8_BAR; PG8_MMA(1, 0, At, B0); PG8_MMA(1, 1, At, B1); PG8_BAR; PG8_SCHED;
            } else {
            PG8_LDB(B0, 0, 0); PG8_SCHED; PG8_LDA(At, 0, 0); PG8_STAGE(PG8_SA(1, 1), a1 + hstep, voffA);
            PG8_WAIT_L(8); PG8_BAR; PG8_WAIT_L(0); PG8_MMA(0, 0, At, B0); PG8_BAR; PG8_SCHED;
            PG8_LDB(B1, 0, 1); PG8_STAGE(PG8_SB(0, 0), b2, voffB);
            PG8_BAR; PG8_WAIT_L(0); PG8_MMA(0, 1, At, B1); PG8_BAR;
            PG8_LDA(At, 0, 1); PG8_STAGE(PG8_SA(0, 0), a2, voffA);
            PG8_BAR; PG8_WAIT_L(0); PG8_MMA(1, 0, At, B0); PG8_BAR; PG8_SCHED;
            PG8_STAGE(PG8_SB(0, 1), b2 + hstep, voffB);
            PG8_WAIT_V(6); PG8_BAR; PG8_MMA(1, 1, At, B1); PG8_BAR;
            PG8_LDB(B0, 1, 0); PG8_SCHED; PG8_LDA(At, 1, 0); PG8_STAGE(PG8_SA(0, 1), a2 + hstep, voffA);
            PG8_WAIT_L(8); PG8_BAR; PG8_WAIT_L(0); PG8_MMA(0, 0, At, B0); PG8_BAR; PG8_SCHED;
            PG8_LDB(B1, 1, 1); PG8_STAGE(PG8_SB(1, 0), b3, voffB);
            PG8_BAR; PG8_WAIT_L(0); PG8_MMA(0, 1, At, B1); PG8_BAR;
            PG8_LDA(At, 1, 1); PG8_STAGE(PG8_SA(1, 0), a3, voffA);
            PG8_BAR; PG8_WAIT_L(0); PG8_MMA(1, 0, At, B0); PG8_BAR; PG8_SCHED;
            PG8_STAGE(PG8_SB(1, 1), b3 + hstep, voffB);
            PG8_WAIT_V(6); PG8_BAR; PG8_MMA(1, 1, At, B1); PG8_BAR;
            }
        }
        if constexpr (ALIGN_EPI) { if (wr == 0) PG8_BAR; }
        if constexpr (!Epi::AFTER_DRAIN) { E(acc, cur, wr, wc, fr, fq); S.done(cur); }
        if (!has_next) break;
#pragma unroll
        for (int a = 0; a < 2; ++a)
#pragma unroll
            for (int b = 0; b < 2; ++b)
#pragma unroll
                for (int m = 0; m < 4; ++m)
#pragma unroll
                    for (int n = 0; n < 2; ++n) acc[a][b][m][n] = (f32x4){0.f, 0.f, 0.f, 0.f};
        cur = nxt; cA = nA; cB = nB; ++ui;
        if constexpr (ALIGN_EPI) { if (wr == 1) PG8_BAR; }
    }
    PG8_WAIT_V(0);
    if constexpr (!ALIGN_EPI) { if (wr == 0) PG8_BAR; }
    PG8_BAR;
    if constexpr (Epi::AFTER_DRAIN) { E.fused(acc, cur, wr, wc, fr, fq, lds, wid, lane); S.done(cur); }
#undef PG8_SA
#undef PG8_SB
#undef PG8_STAGE
#undef PG8_LDA
#undef PG8_LDB
#undef PG8_MMA
#undef PG8_WAIT_V
#undef PG8_WAIT_L
#undef PG8_BAR
#undef PG8_SCHED
}
}

constexpr int NWAVES = 8, NT = 512;
constexpr int D = 1024, MP = 16384, SEQ = 2048, MS = 128, FF = 4096;
constexpr int NIN0 = 3328, NIN1 = 3072;
constexpr float EPS = 1e-6f, LOG2E = 1.4426950408889634f;
constexpr size_t MiB = 1u << 20;
constexpr size_t WS_SS = 1 * MiB, WS_XS = 2 * MiB, WS_PROJS = 3 * MiB, WS_CATS = 4 * MiB, WS_HS = 5 * MiB;
constexpr size_t WS_WIN0 = 8 * MiB, WS_WOUT0 = 15 * MiB, WS_W10 = 17 * MiB, WS_W20 = 25 * MiB, WS_WIN1 = 33 * MiB, WS_WOUT1 = 39 * MiB, WS_W11 = 41 * MiB, WS_W21 = 49 * MiB;
constexpr size_t WS_CAT = 58 * MiB, WS_SH = 90 * MiB, WS_XB = 218 * MiB, WS_END = 250 * MiB;
constexpr size_t WS_DS = 194 * MiB, WS_EBL = 6 * MiB;
constexpr size_t O_Y = 0, O_YS = 16777216, O_POOLP = 16908288, O_HGP = 16939008, O_CONVP = 17725440, O_POOLS = 17741824, O_HGS = 18233344, O_CONVS = 30816256;
constexpr int LDS_BYTES = 143360;

#define LAS __attribute__((address_space(3)))
typedef unsigned short bf16;
typedef float f32x4 __attribute__((ext_vector_type(4)));
typedef short bf16x8 __attribute__((ext_vector_type(8)));
typedef unsigned u32x4 __attribute__((ext_vector_type(4)));
typedef unsigned u32x2 __attribute__((ext_vector_type(2)));
typedef unsigned short us2 __attribute__((ext_vector_type(2)));
__device__ __forceinline__ float bf2f(unsigned h) { return __uint_as_float(h << 16); }
__device__ __forceinline__ unsigned f2bf(float f) { unsigned u = __float_as_uint(f); return (u + 0x7fffu + ((u >> 16) & 1u)) >> 16; }
typedef float f32x2_t __attribute__((ext_vector_type(2)));
typedef __bf16 bf16x2_t __attribute__((ext_vector_type(2)));
__device__ __forceinline__ unsigned pk2(float lo, float hi) { const f32x2_t v = {lo, hi}; const bf16x2_t b = __builtin_convertvector(v, bf16x2_t); return __builtin_bit_cast(unsigned, b); }
__device__ __forceinline__ float fexp2(float x) { return __builtin_amdgcn_exp2f(x); }
__device__ __forceinline__ float flog2(float x) { return __builtin_amdgcn_logf(x); }
__device__ __forceinline__ float frcp(float x) { return __builtin_amdgcn_rcpf(x); }
__device__ __forceinline__ float fsigmoid(float x) { return frcp(1.0f + fexp2(-x * LOG2E)); }
__device__ __forceinline__ float wave_sum(float v) {
#pragma unroll
    for (int o = 1; o < 64; o <<= 1) v += __shfl_xor(v, o);
    return v;
}
#define MFMA16(a, b, c) __builtin_amdgcn_mfma_f32_16x16x32_bf16((a), (b), (c), 0, 0, 0)

struct PArgs { const float* in[19]; float* out; unsigned char* ws; int ph_lo, ph_hi; };

__device__ __forceinline__ void transpose_item(const float* W, const float* gk, int K, int N, bf16* WT, LAS float* scr, int item, int lane) {
    const int nblk = N / 32, kb = item / nblk, nb = item % nblk, k0 = 64 * kb, n0 = 32 * nb;
#pragma unroll 8
    for (int i = 0; i < 32; ++i) { const int kk = 2 * i + (lane >> 5); const float g = gk ? gk[k0 + kk] : 1.0f; scr[kk * 33 + (lane & 31)] = W[(size_t)(k0 + kk) * N + n0 + (lane & 31)] * g; }
    asm volatile("s_waitcnt lgkmcnt(0)" ::: "memory");
    const int c = lane & 7;
#pragma unroll
    for (int j = 0; j < 4; ++j) { const int n = (lane >> 3) + 8 * j; const LAS float* s = scr + (8 * c) * 33 + n;
        u32x4 o; o.x = pk2(s[0 * 33], s[1 * 33]); o.y = pk2(s[2 * 33], s[3 * 33]); o.z = pk2(s[4 * 33], s[5 * 33]); o.w = pk2(s[6 * 33], s[7 * 33]);
        *(u32x4*)(WT + (size_t)(n0 + n) * K + k0 + 8 * c) = o; }
    asm volatile("s_waitcnt lgkmcnt(0)" ::: "memory");
}
__device__ __forceinline__ void p0_prologue(const PArgs& a, LAS unsigned char* lds, int bid, int G, int tid, int wave, int lane) {
    LAS float* scr = (LAS float*)(lds + wave * 16384);
    const int gw = bid * NWAVES + wave, NGW = G * NWAVES;
    unsigned char* ws = a.ws;
    constexpr int I_IN0 = 16 * 104, I_O = 16 * 32, I_1 = 16 * 128, I_2 = 64 * 32, I_IN1 = 16 * 96;
    constexpr int NITEMS = I_IN0 + I_O + I_1 + I_2 + I_IN1 + I_O + I_1 + I_2;
    for (int it = gw; it < NITEMS; it += NGW) {
        int r = it;
        if (r < I_IN0) { transpose_item(a.in[8], a.in[5], D, NIN0, (bf16*)(ws + WS_WIN0), scr, r, lane); continue; } r -= I_IN0;
        if (r < I_O) { transpose_item(a.in[13], nullptr, D, D, (bf16*)(ws + WS_WOUT0), scr, r, lane); continue; } r -= I_O;
        if (r < I_1) { transpose_item(a.in[17], a.in[6], D, FF, (bf16*)(ws + WS_W10), scr, r, lane); continue; } r -= I_1;
        if (r < I_2) { transpose_item(a.in[18], nullptr, FF, D, (bf16*)(ws + WS_W20), scr, r, lane); continue; } r -= I_2;
        if (r < I_IN1) { transpose_item(a.in[14], a.in[5] + D, D, NIN1, (bf16*)(ws + WS_WIN1), scr, r, lane); continue; } r -= I_IN1;
        if (r < I_O) { transpose_item(a.in[16], nullptr, D, D, (bf16*)(ws + WS_WOUT1), scr, r, lane); continue; } r -= I_O;
        if (r < I_1) { transpose_item(a.in[17] + (size_t)D * FF, a.in[6] + D, D, FF, (bf16*)(ws + WS_W11), scr, r, lane); continue; } r -= I_1;
        transpose_item(a.in[18] + (size_t)FF * D, nullptr, FF, D, (bf16*)(ws + WS_W21), scr, r, lane);
    }
    bf16* xb0 = (bf16*)(ws + WS_CAT); float* ss = (float*)(ws + WS_SS);
    for (int m = gw; m < MP; m += NGW) {
        const f32x4* xr = (const f32x4*)(a.in[0] + (size_t)m * D) + lane; f32x4 v[4]; float s = 0.f;
#pragma unroll
        for (int j = 0; j < 4; ++j) { v[j] = xr[64 * j]; s += (v[j].x * v[j].x + v[j].y * v[j].y) + (v[j].z * v[j].z + v[j].w * v[j].w); }
        s = wave_sum(s);
        u32x2* o8 = (u32x2*)(xb0 + (size_t)m * D) + lane;
#pragma unroll
        for (int j = 0; j < 4; ++j) { u32x2 w; w.x = pk2(v[j].x, v[j].y); w.y = pk2(v[j].z, v[j].w); o8[64 * j] = w; }
        if (lane == 0) ss[m] = s;
    }
    const int gt = bid * NT + tid, NGT = G * NT;
    for (int i = gt; i < 4 * MP; i += NGT) ss[MP + i] = 0.f;
    float* xs = (float*)(ws + WS_XS);
    for (int i = gt; i < MS * D / 4; i += NGT) ((f32x4*)xs)[i] = ((const f32x4*)a.in[1])[i];
}

template <bool AF32, int EPI, int SU>
__device__ __forceinline__ void sgemm(LAS unsigned char* lds, const void* Ap, int lda, const bf16* Bt, int N, int K, int ksplit, bf16* O, int ldo, float* xs, int G, int bid, int tid, int wave, int lane) {
    constexpr int NKS = SU;
    LAS float* red = (LAS float*)lds;
    LAS float* sqp = red + 16384;
    const int r = lane & 15, q = lane >> 4;
    const int nstrip = N / 64, npiece = 4 * nstrip * ksplit, klen = K / ksplit;
    for (int p = G - 1 - bid; p < npiece; p += G) {
        const int rb = p & 3, strip = (p >> 2) % nstrip, ks = (p >> 2) / nstrip, n0 = strip * 64, k0 = ks * klen + wave * (klen >> 3), row0 = 32 * rb;
        bf16x8 bv[4][NKS], av[2][NKS]; f32x4 af[2][NKS][2];
#pragma unroll
        for (int c = 0; c < 4; ++c)
#pragma unroll
            for (int u = 0; u < NKS; ++u) bv[c][u] = *(const bf16x8*)(Bt + (size_t)(n0 + 16 * c + r) * K + k0 + 32 * u + 8 * q);
#pragma unroll
        for (int t = 0; t < 2; ++t)
#pragma unroll
            for (int u = 0; u < NKS; ++u) {
                if (AF32) { const float* ap = (const float*)Ap + (size_t)(row0 + 16 * t + r) * lda + k0 + 32 * u + 8 * q; af[t][u][0] = *(const f32x4*)ap; af[t][u][1] = *(const f32x4*)(ap + 4); }
                else av[t][u] = *(const bf16x8*)((const bf16*)Ap + (size_t)(row0 + 16 * t + r) * lda + k0 + 32 * u + 8 * q); }
        __builtin_amdgcn_sched_barrier(0);
        float sq[2] = {0.f, 0.f};
        if (AF32) {
#pragma unroll
            for (int t = 0; t < 2; ++t)
#pragma unroll
                for (int u = 0; u < NKS; ++u) { const f32x4 x0 = af[t][u][0], x1 = af[t][u][1];
                    sq[t] += (x0[0] * x0[0] + x0[1] * x0[1]) + (x0[2] * x0[2] + x0[3] * x0[3]) + (x1[0] * x1[0] + x1[1] * x1[1]) + (x1[2] * x1[2] + x1[3] * x1[3]);
                    u32x4 w; w.x = pk2(x0[0], x0[1]); w.y = pk2(x0[2], x0[3]); w.z = pk2(x1[0], x1[1]); w.w = pk2(x1[2], x1[3]); av[t][u] = __builtin_bit_cast(bf16x8, w); } }
#pragma unroll
        for (int t = 0; t < 2; ++t)
#pragma unroll
            for (int c = 0; c < 4; ++c) { f32x4 acc = {0.f, 0.f, 0.f, 0.f};
#pragma unroll
                for (int u = 0; u < NKS; ++u) acc = MFMA16(av[t][u], bv[c][u], acc);
                *(LAS f32x4*)(red + ((wave * 8 + (c * 2 + t)) * 64 + lane) * 4) = acc; }
        if (AF32) {
#pragma unroll
            for (int t = 0; t < 2; ++t) { float v = sq[t]; v += __shfl_xor(v, 16); v += __shfl_xor(v, 32); if (q == 0) sqp[(wave * 2 + t) * 16 + r] = v; } }
        __syncthreads();
        const int t = wave & 1, c = wave >> 1;
        f32x4 acc = {0.f, 0.f, 0.f, 0.f};
#pragma unroll
        for (int w = 0; w < 8; ++w) acc += *(const LAS f32x4*)(red + ((w * 8 + wave) * 64 + lane) * 4);
        const int orow = row0 + 16 * t + 4 * q, ocol = n0 + 16 * c + r;
        if (EPI == 2) {
#pragma unroll
            for (int i = 0; i < 4; ++i) atomicAdd(xs + (size_t)(orow + i) * D + ocol, acc[i]);
        } else {
#pragma unroll
            for (int i = 0; i < 4; ++i) { float ssr = 0.f;
#pragma unroll
                for (int w = 0; w < 8; ++w) ssr += sqp[(w * 2 + t) * 16 + 4 * q + i];
                float v = acc[i] * __builtin_amdgcn_rsqf(ssr * (1.0f / 1024.0f) + EPS);
                if (EPI == 1) { v = fmaxf(v, 0.f); v = v * v; }
                O[(size_t)(orow + i) * ldo + ocol] = (bf16)f2bf(v); }
        }
        __syncthreads();
    }
}

__device__ __forceinline__ float lb_of(const float* lg, int c) { const float e0 = __expf(lg[c]), e1 = __expf(lg[768 + c]), e2 = __expf(lg[1536 + c]); return e0 / (e0 + e1 + e2); }

__device__ __forceinline__ void hgrn_sample3(LAS unsigned char* lds, const bf16* projs, const float* S0all, const float* lbl, const float* gain, bf16* cats, float* st_out, int it0, int G, int tid, int wave, int lane) {
    constexpr int STR = 2624;
    LAS float* L = (LAS float*)lds;
#pragma unroll
    for (int j = 0; j < 3; ++j) { const int it = it0 + j * G;
        if (it < MS * 6 && tid < 128) { const int b = it / 6, h = it - 6 * b, c = h * 128 + tid; const bf16* pr = projs + (size_t)b * NIN0; LAS float* B = L + j * STR;
            const float lbk = lb_of(lbl, c); float fz = bf2f(pr[1024 + c]); fz = fminf(fmaxf(fz, -30.f), 30.f);
            const float e = fexp2(-fz * LOG2E), sg = frcp(1.0f + e); B[tid] = lbk + (1.0f - lbk) * sg; B[128 + tid] = (1.0f - lbk) * e * sg; B[256 + tid] = bf2f(pr[256 + c]);
            const float z = bf2f(pr[1792 + c]); B[384 + tid] = z * fsigmoid(z); } }
    const int vq = tid & 31, kg = tid >> 5;
    f32x4 sv[3][8];
#pragma unroll
    for (int j = 0; j < 3; ++j) { const int it = it0 + j * G;
        if (it < MS * 6) { const float* S0 = S0all + (size_t)it * 16384;
#pragma unroll
            for (int i = 0; i < 8; ++i) sv[j][i] = *(const f32x4*)(S0 + (size_t)(kg * 8 + i) * 128 + 4 * vq); } }
    __syncthreads();
#pragma unroll
    for (int j = 0; j < 3; ++j) { const int it = it0 + j * G;
        if (it < MS * 6) { LAS float* B = L + j * STR; float* So = st_out + (size_t)it * 16384; const f32x4 v4 = *(const LAS f32x4*)(B + 384 + 4 * vq); f32x4 op = {0.f, 0.f, 0.f, 0.f};
#pragma unroll
            for (int i = 0; i < 8; ++i) { const int kx = kg * 8 + i; const f32x4 sn = sv[j][i] * B[kx] + v4 * B[128 + kx]; *(f32x4*)(So + (size_t)kx * 128 + 4 * vq) = sn; op += sn * B[256 + kx]; }
            *(LAS f32x4*)(B + 512 + kg * 128 + 4 * vq) = op; } }
    __syncthreads();
    float o[3];
#pragma unroll
    for (int j = 0; j < 3; ++j) { o[j] = 0.f;
        if (tid < 128) { LAS float* B = L + j * STR;
#pragma unroll
            for (int i = 0; i < 16; ++i) o[j] += B[512 + i * 128 + tid];
            const float ssum = wave_sum(o[j] * o[j]); if (lane == 0) B[2560 + wave] = ssum; } }
    __syncthreads();
#pragma unroll
    for (int j = 0; j < 3; ++j) { const int it = it0 + j * G;
        if (it < MS * 6 && tid < 128) { const int b = it / 6, h = it - 6 * b, c = h * 128 + tid; LAS float* B = L + j * STR;
            const float rs = __builtin_amdgcn_rsqf((B[2560] + B[2561]) * (1.0f / 128.0f) + EPS);
            cats[(size_t)b * D + 256 + c] = (bf16)f2bf(o[j] * rs * gain[c] * fsigmoid(bf2f(projs[(size_t)b * NIN0 + 2560 + c]))); } }
    __syncthreads();
}

__device__ __forceinline__ void pool_mm(const LAS float* W, const LAS float* df, float (&acc)[8], int c, int tg) {
#pragma unroll
    for (int i = 0; i < 8; ++i) acc[i] = 0.f;
#pragma unroll 4
    for (int cc = 0; cc < 64; cc += 4) { const float w0 = W[cc * 64 + c], w1 = W[(cc + 1) * 64 + c], w2 = W[(cc + 2) * 64 + c], w3 = W[(cc + 3) * 64 + c];
#pragma unroll
        for (int i = 0; i < 8; ++i) { const f32x4 dv = *(const LAS f32x4*)(df + (tg * 8 + i) * 64 + cc); acc[i] += (dv.x * w0 + dv.y * w1) + (dv.z * w2 + dv.w * w3); } }
}
__device__ __forceinline__ void pool_prompt(LAS unsigned char* lds, const bf16* proj, const float* pw, const float* pscale, bf16* cat, float* pool_out, int item, int tid) {
    LAS float* ue = (LAS float*)lds; LAS float* W = ue + 79 * 64; LAS float* df = W + 4096;
    const int g = item & 3, tt = item >> 2, b = tt >> 5, t0 = (tt & 31) * 64, wlen = 2 << g;
#pragma unroll
    for (int j10 = 0; j10 < 10; ++j10) { const int e = tid + NT * j10; if (e < 79 * 64) { const int j = e >> 6, c = e & 63, t = t0 - 15 + j; ue[e] = (t >= 0) ? bf2f(proj[(size_t)(b * SEQ + t) * NIN0 + g * 64 + c]) : 0.f; } }
#pragma unroll
    for (int j2 = 0; j2 < 2; ++j2) ((LAS f32x4*)W)[tid + NT * j2] = ((const f32x4*)(pw + g * 4096))[tid + NT * j2];
    __syncthreads();
    const int c = tid & 63, tg = tid >> 6;
#pragma unroll
    for (int i = 0; i < 8; ++i) { const int t = tg * 8 + i; float s = 0.f;
        for (int j = 0; j < wlen; ++j) s += ue[(15 + t - j) * 64 + c];
        const int pos = t0 + t; const float cnt = (float)(wlen < pos + 1 ? wlen : pos + 1); const float u = ue[(15 + t) * 64 + c];
        df[t * 64 + c] = s / cnt - u;
        if (pos >= SEQ - 15) pool_out[(size_t)(b * 15 + (pos - (SEQ - 15))) * 256 + g * 64 + c] = u; }
    __syncthreads();
    float acc[8]; pool_mm(W, df, acc, c, tg);
    const float sc = pscale[g * 64 + c];
#pragma unroll
    for (int i = 0; i < 8; ++i) cat[(size_t)(b * SEQ + t0 + tg * 8 + i) * D + g * 64 + c] = (bf16)f2bf(acc[i] * sc);
    __syncthreads();
}
__device__ __forceinline__ void pool_sample(LAS unsigned char* lds, const bf16* projs, const float* spool, const float* pw, const float* pscale, bf16* cats, float* pool_out, int item, int tid) {
    LAS float* W = (LAS float*)lds + 79 * 64; LAS float* df = W + 4096;
    const int g = item & 3, st = item >> 2, wlen = 2 << g, c = tid & 63, tg = tid >> 6, ch = g * 64 + c;
#pragma unroll
    for (int j2 = 0; j2 < 2; ++j2) ((LAS f32x4*)W)[tid + NT * j2] = ((const f32x4*)(pw + g * 4096))[tid + NT * j2];
#pragma unroll
    for (int i = 0; i < 8; ++i) { const int t = tg * 8 + i, b = st * 64 + t; const float u = bf2f(projs[(size_t)b * NIN0 + ch]);
        float pv[15];
#pragma unroll
        for (int j = 0; j < 15; ++j) pv[j] = spool[(size_t)(b * 15 + j) * 256 + ch];
        float s = u;
#pragma unroll
        for (int j = 0; j < 15; ++j) if (j < wlen - 1) s += pv[14 - j];
        df[t * 64 + c] = s / (float)wlen - u;
#pragma unroll
        for (int j = 0; j < 14; ++j) pool_out[(size_t)(b * 15 + j) * 256 + ch] = pv[j + 1];
        pool_out[(size_t)(b * 15 + 14) * 256 + ch] = u; }
    __syncthreads();
    float acc[8]; pool_mm(W, df, acc, c, tg);
    const float sc = pscale[ch];
#pragma unroll
    for (int i = 0; i < 8; ++i) cats[(size_t)(st * 64 + tg * 8 + i) * D + ch] = (bf16)f2bf(acc[i] * sc);
    __syncthreads();
}

__device__ __forceinline__ void unpack8(const u32x4 w, float (&f)[8]) {
    f[0] = __uint_as_float(w.x << 16); f[1] = __uint_as_float(w.x & 0xffff0000u); f[2] = __uint_as_float(w.y << 16); f[3] = __uint_as_float(w.y & 0xffff0000u);
    f[4] = __uint_as_float(w.z << 16); f[5] = __uint_as_float(w.z & 0xffff0000u); f[6] = __uint_as_float(w.w << 16); f[7] = __uint_as_float(w.w & 0xffff0000u);
}
__device__ __forceinline__ void hgrn_stepA(LAS unsigned char* lds, const bf16* proj, const float* lbl, bf16* dS, float* eblg, int bid, int G, int wave, int lane) {
    constexpr int PK = 144;
    LAS unsigned char* KeT = lds; LAS unsigned char* Vt = lds + 18432; LAS float* qsum = (LAS float*)(lds + 36864);
    const int tq = wave >> 1, k = ((wave & 1) << 6) + lane, r = lane & 15, q = lane >> 4, w = wave;
    unsigned short fv[16], iv[16];
    int it = bid;
    if (it < 1536) { const int bh = it >> 5, c = it & 31, b = bh / 6, h = bh - 6 * b; const unsigned lo_f = 1024u + (unsigned)(h * 128 + k);
        const bf16* prow = proj + (size_t)(b * SEQ + 64 * c + 16 * tq) * NIN0;
#pragma unroll
        for (int i = 0; i < 16; ++i) { const bf16* up = prow + (size_t)i * NIN0; fv[i] = up[lo_f]; iv[i] = up[lo_f + 768u]; } }
    for (; it < 1536; it += G) {
        const int bh = it >> 5, b = bh / 6, h = bh - 6 * b, ch = h * 128 + k;
        const float lbk = lb_of(lbl, ch), oml = 1.0f - lbk;
        float lf[16], kk[16];
#pragma unroll
        for (int i = 0; i < 16; ++i) { float fz = bf2f(fv[i]); fz = fminf(fmaxf(fz, -30.f), 30.f); const float e = fexp2(-fz * LOG2E), sg = frcp(1.0f + e); lf[i] = flog2(lbk + oml * sg); kk[i] = oml * e * sg; }
        float run = 0.f;
#pragma unroll
        for (int i = 0; i < 16; ++i) { run += lf[i]; lf[i] = run; }
        qsum[tq * 128 + k] = run;
        { unsigned vp[8];
#pragma unroll
          for (int i = 0; i < 8; ++i) { const float z0 = bf2f(iv[2 * i]), z1 = bf2f(iv[2 * i + 1]); vp[i] = pk2(z0 * fsigmoid(z0), z1 * fsigmoid(z1)); }
          *(LAS u32x4*)(Vt + k * PK + tq * 32) = (u32x4){vp[0], vp[1], vp[2], vp[3]}; *(LAS u32x4*)(Vt + k * PK + tq * 32 + 16) = (u32x4){vp[4], vp[5], vp[6], vp[7]}; }
        __syncthreads();
        float off = 0.f, tot = 0.f;
#pragma unroll
        for (int j = 0; j < 4; ++j) { const float s = qsum[j * 128 + k]; tot += s; if (j < tq) off += s; }
        if (tq == 0) eblg[(size_t)it * 128 + k] = fexp2(tot);
        { unsigned kp[8];
#pragma unroll
          for (int i = 0; i < 8; ++i) { const float b0 = lf[2 * i] + off, b1 = lf[2 * i + 1] + off; kp[i] = pk2(kk[2 * i] * fexp2(tot - b0), kk[2 * i + 1] * fexp2(tot - b1)); }
          *(LAS u32x4*)(KeT + k * PK + tq * 32) = (u32x4){kp[0], kp[1], kp[2], kp[3]}; *(LAS u32x4*)(KeT + k * PK + tq * 32 + 16) = (u32x4){kp[4], kp[5], kp[6], kp[7]}; }
        { const int nit = it + G;
          if (nit < 1536) { const int nbh = nit >> 5, nc = nit & 31, nb = nbh / 6, nh = nbh - 6 * nb; const unsigned lo_f = 1024u + (unsigned)(nh * 128 + k);
              const bf16* prow = proj + (size_t)(nb * SEQ + 64 * nc + 16 * tq) * NIN0;
#pragma unroll
              for (int i = 0; i < 16; ++i) { const bf16* up = prow + (size_t)i * NIN0; fv[i] = up[lo_f]; iv[i] = up[lo_f + 768u]; } } }
        __syncthreads();
        { bf16x8 aK[2];
#pragma unroll
          for (int ks = 0; ks < 2; ++ks) aK[ks] = *(const LAS bf16x8*)(KeT + (16 * w + r) * PK + ks * 64 + q * 16);
          bf16* dst = dS + (size_t)it * 16384 + (size_t)r * 128 + 16 * w + 4 * q;
#pragma unroll
          for (int n = 0; n < 8; ++n) { f32x4 s = {0.f, 0.f, 0.f, 0.f};
#pragma unroll
              for (int ks = 0; ks < 2; ++ks) { const bf16x8 bv = *(const LAS bf16x8*)(Vt + (16 * n + r) * PK + ks * 64 + q * 16); s = MFMA16(aK[ks], bv, s); }
              *(u32x2*)(dst + n * 2048) = (u32x2){pk2(s[0], s[1]), pk2(s[2], s[3])}; } }
        __syncthreads();
    }
}
__device__ __forceinline__ void hgrn_stepB(bf16* dS, const float* eblg, float* st_out, int bid, int G, int tid) {
    for (int e = bid * NT + tid; e < 48 * 2048; e += G * NT) {
        const int k8 = e & 15, v = (e >> 4) & 127, bh = e >> 11;
        bf16* p = dS + (size_t)bh * 32 * 16384 + (size_t)v * 128 + 8 * k8; const float* eb = eblg + (size_t)bh * 32 * 128 + 8 * k8;
        float S[8];
#pragma unroll
        for (int j = 0; j < 8; ++j) S[j] = 0.f;
        for (int c0 = 0; c0 < 32; c0 += 8) {
            u32x4 d[8]; f32x4 e0[8], e1[8];
#pragma unroll
            for (int u = 0; u < 8; ++u) { d[u] = *(const u32x4*)(p + (size_t)(c0 + u) * 16384); e0[u] = *(const f32x4*)(eb + (c0 + u) * 128); e1[u] = *(const f32x4*)(eb + (c0 + u) * 128 + 4); }
#pragma unroll
            for (int u = 0; u < 8; ++u) { float dv[8]; unpack8(d[u], dv);
                *(u32x4*)(p + (size_t)(c0 + u) * 16384) = (u32x4){pk2(S[0], S[1]), pk2(S[2], S[3]), pk2(S[4], S[5]), pk2(S[6], S[7])};
#pragma unroll
                for (int j = 0; j < 4; ++j) { S[j] = S[j] * e0[u][j] + dv[j]; S[4 + j] = S[4 + j] * e1[u][j] + dv[4 + j]; } }
        }
        float* so = st_out + (size_t)bh * 16384 + (size_t)(8 * k8) * 128 + v;
#pragma unroll
        for (int j = 0; j < 8; ++j) so[j * 128] = S[j];
    }
}
__device__ __forceinline__ void hgrn_stepC(LAS unsigned char* lds, const bf16* proj, const float* lbl, const float* gain, const bf16* dS, bf16* cat, int bid, int G, int tid, int wave, int lane) {
    constexpr int PQ = 272, PK = 144;
    LAS unsigned char* Qd = lds; LAS unsigned char* Kd = lds + 17408; LAS unsigned char* Vt = lds + 34816;
    LAS unsigned char* P = lds + 53248; LAS unsigned char* St = lds + 62464;
    LAS float* qsum = (LAS float*)(lds + 97280); LAS float* part = qsum + 512; LAS float* rsr = part + 512;
    const int tq = wave >> 1, k = ((wave & 1) << 6) + lane, r = lane & 15, q = lane >> 4, w = wave;
    unsigned short qv[16], fv[16], iv[16];
    int it = bid;
    if (it < 1536) { const int bh = it >> 5, c = it & 31, b = bh / 6, h = bh - 6 * b; const unsigned lo_q = 256u + (unsigned)(h * 128 + k);
        const bf16* prow = proj + (size_t)(b * SEQ + 64 * c + 16 * tq) * NIN0;
#pragma unroll
        for (int i = 0; i < 16; ++i) { const bf16* up = prow + (size_t)i * NIN0; qv[i] = up[lo_q]; fv[i] = up[lo_q + 768u]; iv[i] = up[lo_q + 1536u]; } }
    for (; it < 1536; it += G) {
        const int bh = it >> 5, c = it & 31, b = bh / 6, h = bh - 6 * b, ch = h * 128 + k;
        const float lbk = lb_of(lbl, ch), oml = 1.0f - lbk;
        u32x4 sreg[4];
        { const u32x4* sp = (const u32x4*)(dS + (size_t)it * 16384) + tid;
#pragma unroll
          for (int j = 0; j < 4; ++j) sreg[j] = sp[512 * j]; }
        float lf[16], kk[16];
#pragma unroll
        for (int i = 0; i < 16; ++i) { float fz = bf2f(fv[i]); fz = fminf(fmaxf(fz, -30.f), 30.f); const float e = fexp2(-fz * LOG2E), sg = frcp(1.0f + e); lf[i] = flog2(lbk + oml * sg); kk[i] = oml * e * sg; }
        float run = 0.f;
#pragma unroll
        for (int i = 0; i < 16; ++i) { run += lf[i]; lf[i] = run; }
        qsum[tq * 128 + k] = run;
        { unsigned vp[8];
#pragma unroll
          for (int i = 0; i < 8; ++i) { const float z0 = bf2f(iv[2 * i]), z1 = bf2f(iv[2 * i + 1]); vp[i] = pk2(z0 * fsigmoid(z0), z1 * fsigmoid(z1)); }
          *(LAS u32x4*)(Vt + k * PK + tq * 32) = (u32x4){vp[0], vp[1], vp[2], vp[3]}; *(LAS u32x4*)(Vt + k * PK + tq * 32 + 16) = (u32x4){vp[4], vp[5], vp[6], vp[7]}; }
        __syncthreads();
        float off = 0.f;
#pragma unroll
        for (int j = 0; j < 4; ++j) { const float s = qsum[j * 128 + k]; if (j < tq) off += s; }
#pragma unroll
        for (int i = 0; i < 16; ++i) { const float bc = lf[i] + off; const float ed = fexp2(bc), edi = fexp2(-bc);
            *(LAS unsigned short*)(Qd + (16 * tq + i) * PQ + 2 * k) = (unsigned short)f2bf(bf2f(qv[i]) * ed);
            *(LAS unsigned short*)(Kd + (16 * tq + i) * PQ + 2 * k) = (unsigned short)f2bf(kk[i] * edi); }
#pragma unroll
        for (int j = 0; j < 4; ++j) { const int e = tid + 512 * j, v = e >> 4, k8 = e & 15; *(LAS u32x4*)(St + v * PQ + k8 * 16) = sreg[j]; }
        const unsigned lo_g = (unsigned)(4 * q) * NIN0 + 2560u + (unsigned)(h * 128 + 16 * w + r), lo_o = (unsigned)(4 * q) * D + 256u + (unsigned)(h * 128 + 16 * w + r);
        const bf16* crow = proj + (size_t)(b * SEQ + 64 * c) * NIN0;
        unsigned short gv[16];
#pragma unroll
        for (int ti = 0; ti < 4; ++ti)
#pragma unroll
            for (int i = 0; i < 4; ++i) { const bf16* up = crow + (size_t)(16 * ti + i) * NIN0; gv[ti * 4 + i] = up[lo_g]; }
        { const int nit = it + G;
          if (nit < 1536) { const int nbh = nit >> 5, nc = nit & 31, nb = nbh / 6, nh = nbh - 6 * nb; const unsigned lo_q = 256u + (unsigned)(nh * 128 + k);
              const bf16* prow = proj + (size_t)(nb * SEQ + 64 * nc + 16 * tq) * NIN0;
#pragma unroll
              for (int i = 0; i < 16; ++i) { const bf16* up = prow + (size_t)i * NIN0; qv[i] = up[lo_q]; fv[i] = up[lo_q + 768u]; iv[i] = up[lo_q + 1536u]; } } }
        __syncthreads();
        { const int ti = w >> 1;
#pragma unroll
          for (int sj = 0; sj < 2; ++sj) { const int si = 2 * (w & 1) + sj; f32x4 acc = {0.f, 0.f, 0.f, 0.f};
              if (si <= ti) {
#pragma unroll
                  for (int ks = 0; ks < 4; ++ks) { const bf16x8 av = *(const LAS bf16x8*)(Qd + (16 * ti + r) * PQ + ks * 64 + q * 16), bv = *(const LAS bf16x8*)(Kd + (16 * si + r) * PQ + ks * 64 + q * 16); acc = MFMA16(av, bv, acc); } }
#pragma unroll
              for (int i = 0; i < 4; ++i) { const int t = 16 * ti + 4 * q + i, s = 16 * si + r; *(LAS unsigned short*)(P + t * PK + 2 * s) = (unsigned short)f2bf(s <= t ? acc[i] : 0.f); } } }
        f32x4 o[4];
#pragma unroll
        for (int ti = 0; ti < 4; ++ti) o[ti] = (f32x4){0.f, 0.f, 0.f, 0.f};
        { bf16x8 bS[4];
#pragma unroll
          for (int ks = 0; ks < 4; ++ks) bS[ks] = *(const LAS bf16x8*)(St + (16 * w + r) * PQ + ks * 64 + q * 16);
#pragma unroll
          for (int ti = 0; ti < 4; ++ti)
#pragma unroll
              for (int ks = 0; ks < 4; ++ks) { const bf16x8 av = *(const LAS bf16x8*)(Qd + (16 * ti + r) * PQ + ks * 64 + q * 16); o[ti] = MFMA16(av, bS[ks], o[ti]); } }
        __syncthreads();
        { bf16x8 bV[2];
#pragma unroll
          for (int ks = 0; ks < 2; ++ks) bV[ks] = *(const LAS bf16x8*)(Vt + (16 * w + r) * PK + ks * 64 + q * 16);
#pragma unroll
          for (int ti = 0; ti < 4; ++ti)
#pragma unroll
              for (int ks = 0; ks < 2; ++ks) { const bf16x8 av = *(const LAS bf16x8*)(P + (16 * ti + r) * PK + ks * 64 + q * 16); o[ti] = MFMA16(av, bV[ks], o[ti]); } }
#pragma unroll
        for (int ti = 0; ti < 4; ++ti)
#pragma unroll
            for (int i = 0; i < 4; ++i) { float p = o[ti][i] * o[ti][i]; p += __shfl_xor(p, 1); p += __shfl_xor(p, 2); p += __shfl_xor(p, 4); p += __shfl_xor(p, 8);
                if (r == 0) part[w * 64 + 16 * ti + 4 * q + i] = p; }
        __syncthreads();
        if (tid < 64) { float s = 0.f;
#pragma unroll
            for (int j = 0; j < 8; ++j) s += part[j * 64 + tid];
            rsr[tid] = __builtin_amdgcn_rsqf(s * (1.0f / 128.0f) + EPS); }
        __syncthreads();
        const float gain_v = gain[h * 128 + 16 * w + r];
        bf16* orow = cat + (size_t)(b * SEQ + 64 * c) * D;
#pragma unroll
        for (int ti = 0; ti < 4; ++ti)
#pragma unroll
            for (int i = 0; i < 4; ++i) { const int t = 16 * ti + 4 * q + i; const float val = o[ti][i] * rsr[t] * gain_v * fsigmoid(bf2f(gv[ti * 4 + i]));
                bf16* up = orow + (size_t)(16 * ti + i) * D; up[lo_o] = (bf16)f2bf(val); }
    }
    __syncthreads();
}

__device__ __forceinline__ void conv_phase(const PArgs& a, int bid, int G, int tid) {
    unsigned char* ws = a.ws;
    const bf16* proj = (const bf16*)(ws + WS_SH); bf16* cat = (bf16*)(ws + WS_CAT); const float* cw = a.in[15];
    for (int gt = bid * NT + tid; gt < 1024 * 128; gt += G * NT) {
        const int cgp = gt & 127, rb = gt >> 7, b = rb >> 7, tl0 = (rb & 127) * 16, c0 = 8 * cgp;
        float w0[8], w1[8], w2[8], zm2[8], zm1[8];
#pragma unroll
        for (int e = 0; e < 8; ++e) { w0[e] = cw[c0 + e]; w1[e] = cw[1024 + c0 + e]; w2[e] = cw[2048 + c0 + e]; zm2[e] = 0.f; zm1[e] = 0.f; }
        const bf16* pr = proj + (size_t)(b * SEQ + tl0) * NIN1 + c0;
        if (tl0 > 0) { float cgv[8], hvv[8];
            unpack8(*(const u32x4*)(pr - 2 * NIN1 + 1024), cgv); unpack8(*(const u32x4*)(pr - 2 * NIN1 + 2048), hvv);
#pragma unroll
            for (int e = 0; e < 8; ++e) zm2[e] = cgv[e] * hvv[e];
            unpack8(*(const u32x4*)(pr - NIN1 + 1024), cgv); unpack8(*(const u32x4*)(pr - NIN1 + 2048), hvv);
#pragma unroll
            for (int e = 0; e < 8; ++e) zm1[e] = cgv[e] * hvv[e]; }
#pragma unroll 1
        for (int i = 0; i < 16; ++i) { float bgv[8], cgv[8], hvv[8], o[8];
            unpack8(*(const u32x4*)(pr + (size_t)i * NIN1), bgv); unpack8(*(const u32x4*)(pr + (size_t)i * NIN1 + 1024), cgv); unpack8(*(const u32x4*)(pr + (size_t)i * NIN1 + 2048), hvv);
#pragma unroll
            for (int e = 0; e < 8; ++e) { const float z = cgv[e] * hvv[e]; o[e] = bgv[e] * (w0[e] * zm2[e] + w1[e] * zm1[e] + w2[e] * z); zm2[e] = zm1[e]; zm1[e] = z; }
            *(u32x4*)(cat + (size_t)(b * SEQ + tl0 + i) * D + c0) = (u32x4){pk2(o[0], o[1]), pk2(o[2], o[3]), pk2(o[4], o[5]), pk2(o[6], o[7])};
            const int t = tl0 + i;
            if (t >= SEQ - 2) { float* co = a.out + O_CONVP + (size_t)(b * 2 + (t - (SEQ - 2))) * 1024 + c0;
                *(f32x4*)co = (f32x4){zm1[0], zm1[1], zm1[2], zm1[3]}; *(f32x4*)(co + 4) = (f32x4){zm1[4], zm1[5], zm1[6], zm1[7]}; } }
    }
    const bf16* projs = (const bf16*)(ws + WS_PROJS); bf16* cats = (bf16*)(ws + WS_CATS); const float* sc = a.in[4];
    for (int gt = bid * NT + tid; gt < MS * 128; gt += G * NT) {
        const int cgp = gt & 127, b = gt >> 7, c0 = 8 * cgp; float bgv[8], cgv[8], hvv[8], o[8], z[8];
        const bf16* pr = projs + (size_t)b * NIN1 + c0;
        unpack8(*(const u32x4*)pr, bgv); unpack8(*(const u32x4*)(pr + 1024), cgv); unpack8(*(const u32x4*)(pr + 2048), hvv);
        const float* p0 = sc + (size_t)(b * 2) * 1024 + c0; const float* p1 = p0 + 1024;
        float* co = a.out + O_CONVS + (size_t)(b * 2) * 1024 + c0;
#pragma unroll
        for (int e = 0; e < 8; ++e) { z[e] = cgv[e] * hvv[e]; o[e] = bgv[e] * (cw[c0 + e] * p0[e] + cw[1024 + c0 + e] * p1[e] + cw[2048 + c0 + e] * z[e]); co[e] = p1[e]; co[1024 + e] = z[e]; }
        *(u32x4*)(cats + (size_t)b * D + c0) = (u32x4){pk2(o[0], o[1]), pk2(o[2], o[3]), pk2(o[4], o[5]), pk2(o[6], o[7])};
    }
}

__device__ __forceinline__ void final_norm(const PArgs& a, int bid, int G, int wave, int lane) {
    const int gw = bid * NWAVES + wave, NGW = G * NWAVES; const float* gf = a.in[7]; const float* ss4 = (const float*)(a.ws + WS_SS) + 4 * MP;
    f32x4 gv[4];
#pragma unroll
    for (int j = 0; j < 4; ++j) gv[j] = ((const f32x4*)gf)[lane + 64 * j];
    for (int m = gw; m < MP + MS; m += NGW) {
        if (m < MP) { f32x4* yr = (f32x4*)(a.out + O_Y + (size_t)m * D) + lane; const u32x2* xr = (const u32x2*)((const bf16*)(a.ws + WS_XB) + (size_t)m * D) + lane;
            const float rs = __builtin_amdgcn_rsqf(ss4[m] * (1.0f / 1024.0f) + EPS);
#pragma unroll
            for (int j = 0; j < 4; ++j) { const u32x2 w = xr[64 * j]; const f32x4 v = {__uint_as_float(w.x << 16), __uint_as_float(w.x & 0xffff0000u), __uint_as_float(w.y << 16), __uint_as_float(w.y & 0xffff0000u)}; yr[64 * j] = v * rs * gv[j]; } }
        else { const int sr = m - MP; const f32x4* xr = (const f32x4*)((const float*)(a.ws + WS_XS) + (size_t)sr * D) + lane; f32x4* yr = (f32x4*)(a.out + O_YS + (size_t)sr * D) + lane;
            f32x4 v[4]; float s = 0.f;
#pragma unroll
            for (int j = 0; j < 4; ++j) { v[j] = xr[64 * j]; s += (v[j].x * v[j].x + v[j].y * v[j].y) + (v[j].z * v[j].z + v[j].w * v[j].w); }
            const float rs = __builtin_amdgcn_rsqf(wave_sum(s) * (1.0f / 1024.0f) + EPS);
#pragma unroll
            for (int j = 0; j < 4; ++j) yr[64 * j] = v[j] * rs * gv[j]; }
    }
}

#define XB_TMO      128
#define XB_XCNT(j)  (256  + 64 * (j))
#define XB_XSUB(j)  (1280 + 64 * (j))
#define XB_XGEN(j)  (2304 + 64 * (j))
#define XB_TOP      3328
#define XB_TOPGEN   3392
#define XCD_BAR_WORDS 3456
#define XB_SPIN_CAP (1u << 18)

__device__ __forceinline__ unsigned xb_ld(unsigned* p)              { return __hip_atomic_load(p, __ATOMIC_RELAXED, __HIP_MEMORY_SCOPE_AGENT); }
__device__ __forceinline__ unsigned xb_add(unsigned* p, unsigned v) { return __hip_atomic_fetch_add(p, v, __ATOMIC_RELAXED, __HIP_MEMORY_SCOPE_AGENT); }
__device__ __forceinline__ unsigned xb_xcc_id() { return (unsigned)__builtin_amdgcn_s_getreg((3 << 11) | 20) & 0xFu; }
#define XB_SPIN(cond, bar) do { unsigned _sp = 0; while (cond) { __builtin_amdgcn_s_sleep(1); \
    if ((++_sp & 255u) == 0u) { if (xb_ld(&(bar)[XB_TMO])) break; if (_sp > XB_SPIN_CAP) { atomicAdd(&(bar)[XB_TMO], 1u); break; } } } } while (0)

struct XcdBarrier {
    unsigned* bar; unsigned x;
    volatile LAS unsigned* st;
};

__device__ __forceinline__ XcdBarrier xcd_barrier_post(unsigned* bar, volatile LAS unsigned* st) {
    XcdBarrier b; b.bar = bar; b.x = xb_xcc_id(); b.st = st;
    if (threadIdx.x == 0) (void)xb_add(&bar[XB_XCNT(b.x)], 1u);
    return b;
}
__device__ __forceinline__ void xcd_barrier_complete(unsigned* bar, unsigned x, unsigned& nloc, unsigned& nx) {
    const unsigned G = gridDim.x * gridDim.y * gridDim.z;
    unsigned sum, cnt, mine, sp = 0u;
    for (;;) {
        sum = 0u; cnt = 0u; mine = 0u;
#pragma unroll
        for (unsigned j = 0; j < 16; ++j) { const unsigned c = xb_ld(&bar[XB_XCNT(j)]); sum += c; cnt += (c > 0u) ? 1u : 0u; mine = (j == x) ? c : mine; }
        if (sum == G) break;
        __builtin_amdgcn_s_sleep(1);
        if ((++sp & 255u) == 0u) { if (xb_ld(&bar[XB_TMO])) break; if (sp > XB_SPIN_CAP) { atomicAdd(&bar[XB_TMO], 1u); break; } }
    }
    nloc = mine > 0u ? mine : 1u; nx = cnt > 0u ? cnt : 1u;
}

__device__ __forceinline__ void xcd_barrier(const XcdBarrier& b) {
    asm volatile("s_waitcnt vmcnt(0)" ::: "memory");
    __syncthreads();
    if (threadIdx.x == 0) {
        unsigned* bar = b.bar;
        __builtin_amdgcn_s_waitcnt(0);
        unsigned nloc = b.st[0], nx = b.st[1];
        if (nloc == 0u) { xcd_barrier_complete(bar, b.x, nloc, nx); b.st[0] = nloc; b.st[1] = nx; }
        const unsigned old = xb_add(&bar[XB_XSUB(b.x)], 1u);
        const unsigned gen = old / nloc;
        if (old + 1u == (gen + 1u) * nloc) {
            __builtin_amdgcn_fence(__ATOMIC_RELEASE, "agent");
            asm volatile("s_waitcnt vmcnt(0)" ::: "memory");
            const unsigned og = xb_add(&bar[XB_TOP], 1u);
            const unsigned tg = og / nx;
            if (og + 1u == (tg + 1u) * nx) xb_add(&bar[XB_TOPGEN], 1u);
            else XB_SPIN(xb_ld(&bar[XB_TOPGEN]) == tg, bar);
            __builtin_amdgcn_fence(__ATOMIC_ACQUIRE, "agent");
            xb_add(&bar[XB_XGEN(b.x)], 1u);
            asm volatile("s_waitcnt vmcnt(0)" ::: "memory");
        } else {
            XB_SPIN(xb_ld(&bar[XB_XGEN(b.x)]) == gen, bar);
            __builtin_amdgcn_fence(__ATOMIC_ACQUIRE, "agent");
            asm volatile("s_waitcnt vmcnt(0)" ::: "memory");
        }
    }
    __syncthreads();
}

#ifndef DIS_GEMM
#define DIS_GEMM 0
#endif
#ifndef DIS_SGEMM
#define DIS_SGEMM 0
#endif
#ifndef DIS_HGRN
#define DIS_HGRN 0
#endif
#ifndef DIS_OTHER
#define DIS_OTHER 0
#endif
#ifndef DBG_O
#define DBG_O 15
#endif
#ifndef DUPK
#define DUPK 0
#endif
#ifndef DBG_XSYNC
#define DBG_XSYNC 0
#endif
#ifndef DBG_COL
#define DBG_COL 2304
#endif
#ifndef DBG_HI
#define DBG_HI 12
#endif
#ifndef MK_MULTI
#define MK_MULTI 0
#endif
constexpr int N_PHASES = 12;
#define IN(k) (lo <= (k) && (k) < hi)
#define SEAM(k) do { if (IN(k) && IN((k) + 1)) xcd_barrier(xbar); } while (0)
template <int L>
__device__ __forceinline__ void layer_phases(const PArgs& a, LAS unsigned char* lds, const XcdBarrier& xbar, int lo, int hi, int bid, int G, int tid, int wave, int lane) {
    unsigned char* ws = a.ws;
    float* ss = (float*)(ws + WS_SS);
    bf16* CAT = (bf16*)(ws + WS_CAT); bf16* SH = (bf16*)(ws + WS_SH); bf16* XB = (bf16*)(ws + WS_XB);
    float* xs = (float*)(ws + WS_XS); bf16* projs = (bf16*)(ws + WS_PROJS); bf16* cats = (bf16*)(ws + WS_CATS); bf16* hs = (bf16*)(ws + WS_HS);
    float* Y = a.out + O_Y;
    constexpr int pb = 1 + 5 * L;
    const bf16* Win = (const bf16*)(ws + (L ? WS_WIN1 : WS_WIN0)); const bf16* Wout = (const bf16*)(ws + (L ? WS_WOUT1 : WS_WOUT0));
    const bf16* W1 = (const bf16*)(ws + (L ? WS_W11 : WS_W10)); const bf16* W2 = (const bf16*)(ws + (L ? WS_W21 : WS_W20));
    constexpr int Nin = L ? NIN1 : NIN0;
    if (IN(pb)) {
        pg8::Gemm g{L ? XB : CAT, Win, MP, Nin, D}; pg8::StaticOrder S; S.init(MP, Nin, G, bid);
        pg8::EpiScaleBf16<0> E{SH, Nin, ss + (L ? 2 : 0) * MP};
        for (int rep = 0; rep < (DUPK == 5 ? 2 : 1); ++rep) pg8::gemm_phase<pg8::EpiScaleBf16<0>, pg8::StaticOrder, true, true>(lds, g, S, E);
        for (int rep = 0; rep < (DUPK == 1 ? 2 : 1); ++rep) sgemm<true, 0, 4>(lds, L ? (const void*)xs : (const void*)a.in[1], D, Win, Nin, D, 1, projs, Nin, xs, G, bid, tid, wave, lane);
    }
    SEAM(pb);
    if (IN(pb + 1)) {
        if (L == 0) {
            bf16* dS = (bf16*)(ws + WS_DS); float* eblg = (float*)(ws + WS_EBL);
            if (DUPK == 4) { hgrn_stepA(lds, SH, a.in[11], dS, eblg, bid, G, wave, lane); xcd_barrier(xbar); hgrn_stepB(dS, eblg, a.out + O_HGP, bid, G, tid); xcd_barrier(xbar); hgrn_stepC(lds, SH, a.in[11], a.in[12], dS, CAT, bid, G, tid, wave, lane); xcd_barrier(xbar); }
            if (!DIS_HGRN) hgrn_stepA(lds, SH, a.in[11], dS, eblg, bid, G, wave, lane);
            for (int rep = 0; rep < (DUPK == 9 ? 2 : 1); ++rep) {
                for (int it = bid; it < MS * 6; it += 3 * G) hgrn_sample3(lds, projs, a.in[3], a.in[11], a.in[12], cats, a.out + O_HGS, it, G, tid, wave, lane);
                for (int it = bid; it < 1024; it += G) pool_prompt(lds, SH, a.in[9], a.in[10], CAT, a.out + O_POOLP, it, tid);
                for (int it = bid; it < 8; it += G) pool_sample(lds, projs, a.in[2], a.in[9], a.in[10], cats, a.out + O_POOLS, it, tid); }
            xcd_barrier(xbar);
            if (!DIS_HGRN) hgrn_stepB(dS, eblg, a.out + O_HGP, bid, G, tid);
            xcd_barrier(xbar);
            if (!DIS_HGRN) hgrn_stepC(lds, SH, a.in[11], a.in[12], dS, CAT, bid, G, tid, wave, lane);
        } else { for (int rep = 0; rep < (DUPK == 8 ? 2 : 1); ++rep) conv_phase(a, bid, G, tid); }
    }
    SEAM(pb + 1);
    if (IN(pb + 2)) {
        pg8::Gemm g{CAT, Wout, MP, D, D}; pg8::StaticOrder S; S.init(MP, D, G, bid);
        pg8::EpiResid E{L ? (const float*)nullptr : a.in[0], XB, ss + (L ? 3 : 1) * MP};
        if (DUPK == 6) { pg8::EpiNull EN{Y, a.ph_lo}; pg8::gemm_phase<pg8::EpiNull, pg8::StaticOrder, true, true>(lds, g, S, EN); }
        if (!DIS_GEMM) pg8::gemm_phase<pg8::EpiResid, pg8::StaticOrder, true, true>(lds, g, S, E);
        if (!DIS_SGEMM) sgemm<false, 2, 1>(lds, cats, D, Wout, D, D, 4, nullptr, 0, xs, G, bid, tid, wave, lane);
    }
    SEAM(pb + 2);
    if (IN(pb + 3)) {
        pg8::Gemm g{XB, W1, MP, FF, D}; pg8::StaticOrder S; S.init(MP, FF, G, bid);
        pg8::EpiScaleBf16<1> E{SH, FF, ss + (L ? 3 : 1) * MP};
        for (int rep = 0; rep < (DUPK == 2 ? 2 : 1); ++rep) pg8::gemm_phase<pg8::EpiScaleBf16<1>, pg8::StaticOrder, true, true>(lds, g, S, E);
        for (int rep = 0; rep < (DUPK == 1 ? 2 : 1); ++rep) sgemm<true, 1, 4>(lds, xs, D, W1, FF, D, 1, hs, FF, xs, G, bid, tid, wave, lane);
    }
    SEAM(pb + 3);
    if (IN(pb + 4)) {
        pg8::Gemm g{SH, W2, MP, D, FF}; pg8::StaticOrder S; S.init(MP, D, G, bid);
        pg8::EpiResid E{nullptr, XB, ss + (L ? 4 : 2) * MP};
        if (DUPK == 7) { pg8::EpiNull EN{Y, a.ph_lo}; pg8::gemm_phase<pg8::EpiNull, pg8::StaticOrder, true, true>(lds, g, S, EN); }
        if (!DIS_GEMM) pg8::gemm_phase<pg8::EpiResid, pg8::StaticOrder, true, true>(lds, g, S, E);
        if (!DIS_SGEMM) sgemm<false, 2, 4>(lds, hs, FF, W2, D, FF, 4, nullptr, 0, xs, G, bid, tid, wave, lane);
    }
    SEAM(pb + 4);
}
__global__ void __launch_bounds__(NT, 2) mk_fwd(PArgs a) {
    extern __shared__ __attribute__((aligned(16))) unsigned char lds_raw[];
    LAS unsigned char* lds = (LAS unsigned char*)lds_raw;
    const int tid = threadIdx.x, lane = tid & 63, wave = __builtin_amdgcn_readfirstlane(tid >> 6), bid = blockIdx.x, G = gridDim.x;
    const int lo = a.ph_lo, hi = a.ph_hi;
    volatile LAS unsigned* xst = (volatile LAS unsigned*)(lds + 131072 + 64);
    if (tid < 2) xst[tid] = 0u;
    __syncthreads();
    const XcdBarrier xbar = xcd_barrier_post((unsigned*)a.ws, xst);
    if (lo < 0) cg::this_grid().sync();
    if (IN(0)) { for (int rep = 0; rep < (DUPK == 3 ? 2 : 1); ++rep) { p0_prologue(a, lds, bid, G, tid, wave, lane); __syncthreads(); } }
    SEAM(0);
    layer_phases<0>(a, lds, xbar, lo, hi, bid, G, tid, wave, lane);
    layer_phases<1>(a, lds, xbar, lo, hi, bid, G, tid, wave, lane);
    for (int xx = 0; xx < DBG_XSYNC; ++xx) xcd_barrier(xbar);
    if (IN(11)) final_norm(a, bid, G, wave, lane);
    if (hi < 12) {
        if (hi <= 3) { cg::this_grid().sync(); const bf16* C = (const bf16*)(a.ws + WS_CAT); for (size_t i = (size_t)bid * NT + tid; i < O_YS; i += (size_t)G * NT) a.out[i] = ((i & 1023) >= 256) ? bf2f(C[i]) : 0.f; }
        for (size_t i = (size_t)bid * NT + tid; i < 131072; i += (size_t)G * NT) a.out[O_YS + i] = 0.f;
        if (hi <= 2) for (size_t i = (size_t)bid * NT + tid + O_POOLP; i < O_CONVS; i += (size_t)G * NT) a.out[i] = 0.f;
        if (hi <= 7) { for (size_t i = (size_t)bid * NT + tid; i < 16384; i += (size_t)G * NT) a.out[O_CONVP + i] = 0.f;
                       for (size_t i = (size_t)bid * NT + tid; i < 262144; i += (size_t)G * NT) a.out[O_CONVS + i] = 0.f; }
    }
}
#undef IN
#undef SEAM

extern "C" void kernel_launch(void* const* d_in, const int* in_sizes, int n_in, void* d_out, int out_size, void* d_ws, size_t ws_size, hipStream_t stream) {
    static int grid = 0;
    if (grid == 0) {
        if (n_in != 19 || ws_size < WS_END) { fprintf(stderr, "kernel_launch: unexpected inputs (n_in %d, ws %zu)\n", n_in, ws_size); grid = -1; return; }
        int dev = 0, cus = 0, per_cu = 0;
        if (hipGetDevice(&dev) != hipSuccess || hipDeviceGetAttribute(&cus, hipDeviceAttributeMultiprocessorCount, dev) != hipSuccess) { grid = -1; return; }
        if (hipFuncSetAttribute((const void*)mk_fwd, hipFuncAttributeMaxDynamicSharedMemorySize, LDS_BYTES) != hipSuccess) { fprintf(stderr, "kernel_launch: hipFuncSetAttribute failed\n"); grid = -1; return; }
        if (hipOccupancyMaxActiveBlocksPerMultiprocessor(&per_cu, (const void*)mk_fwd, NT, LDS_BYTES) != hipSuccess || per_cu < 1) { fprintf(stderr, "kernel_launch: occupancy query says %d\n", per_cu); per_cu = 1; }
        (void)hipGetLastError();
        grid = cus;
    }
    if (grid < 0) return;
    PArgs a{};
    for (int i = 0; i < 19; ++i) a.in[i] = (const float*)d_in[i];
    a.out = (float*)d_out; a.ws = (unsigned char*)d_ws;
#if MK_MULTI
    for (int k = 0; k < DBG_HI; ++k) { a.ph_lo = k; a.ph_hi = k + 1; hipLaunchKernelGGL(mk_fwd, dim3(grid), dim3(NT), LDS_BYTES, stream, a); }
#else
    a.ph_lo = 0; a.ph_hi = DBG_HI;
    if (hipMemsetAsync(d_ws, 0, 16384, stream) != hipSuccess) { fprintf(stderr, "kernel_launch: hipMemsetAsync failed\n"); return; }
    void* args[] = {&a};
    hipError_t e = hipLaunchCooperativeKernel((const void*)mk_fwd, dim3(grid), dim3(NT), args, LDS_BYTES, stream);
    if (e != hipSuccess) fprintf(stderr, "cooperative launch failed: %s (grid %d)\n", hipGetErrorString(e), grid);
#endif
}
```

```cpp
#include <hip/hip_runtime.h>
#include <hip/hip_cooperative_groups.h>
#include <cstdio>
#include <cstdint>
namespace cg = cooperative_groups;
#ifndef DBG_O
#define DBG_O 15
#endif
namespace pg8 {
#define PG8_LAS __attribute__((address_space(3)))
typedef unsigned short bf16_t;
typedef short bf16x8 __attribute__((ext_vector_type(8)));
typedef float f32x4 __attribute__((ext_vector_type(4)));
typedef unsigned u32x4 __attribute__((ext_vector_type(4)));
typedef unsigned u32x2 __attribute__((ext_vector_type(2)));
constexpr int BM = 256, BK = 64, HALF = 128, HTB = HALF * BK * 2  , STAGE_BYTES = 8 * HTB, NXCD = 8, WGM = 8;

__host__ __device__ __forceinline__ int lds_byte(int r, int c) { const int st = (r >> 4) * 2 + (c >> 5), rr = r & 15, cc = c & 31, ob = rr * 64 + cc * 2; return st * 1024 + (ob ^ (((ob >> 9) & 1) << 5)); }
__host__ __device__ __forceinline__ void stage_rc(int b, int& R, int& C) { const int st = b / 1024, sb = b % 1024, swz = sb ^ (((sb >> 9) & 1) << 5); R = (st >> 1) * 16 + swz / 64; C = (st & 1) * 32 + (swz % 64) / 2; }
__host__ __device__ __forceinline__ int perm32(int rho) { const int n = rho >> 4, i = rho & 15; return 8 * (i >> 2) + 4 * n + (i & 3); }

struct Unit { int pm, pn; };
struct Gemm { const bf16_t* A; const bf16_t* Bt; int M, N, K; };

struct StaticOrder {
    int nM, nN, nwg, G, c;
    __host__ __device__ void init(int M, int N, int G_, int c_) { nM = M / BM; nN = N / BM; nwg = nM * nN; G = G_; c = c_; }
    __host__ __device__ bool next(int i, Unit& u) const {
        const long L = (long)i * G + c; if (L >= nwg) return false;
        int wgid = (int)L; { const int q = nwg / NXCD, r = nwg % NXCD, xcd = wgid % NXCD, off = wgid / NXCD; wgid = (xcd < r ? xcd * (q + 1) : r * (q + 1) + (xcd - r) * q) + off; }
        const int nig = WGM * nN, gid = wgid / nig, fm = gid * WGM, gsz = (nM - fm) < WGM ? (nM - fm) : WGM;
        u.pm = fm + ((wgid % nig) % gsz); u.pn = (wgid % nig) / gsz; return true;
    }
    __device__ __forceinline__ void a_ready(const Unit&) const {}
    __device__ __forceinline__ void done(const Unit&) const {}
};

__device__ __forceinline__ unsigned cvt_pk_bf16(float lo, float hi) { unsigned r; asm volatile("v_cvt_pk_bf16_f32 %0, %1, %2" : "=v"(r) : "v"(lo), "v"(hi)); return r; }
template <int ACT  > struct EpiScaleBf16 {
    static constexpr bool PERM = true, AFTER_DRAIN = false;
    bf16_t* O; int ldc; const float* ss;
    __device__ __forceinline__ void operator()(const f32x4 (&acc)[2][2][4][2], const Unit& u, int wr, int wc, int fr, int fq) const {
        const int row0 = u.pm * BM + wr * 64 + fr, col0 = u.pn * BM + wc * 32 + 8 * fq;
#pragma unroll
        for (int ai = 0; ai < 2; ++ai)
#pragma unroll
            for (int m = 0; m < 4; ++m) { const int row = row0 + ai * HALF + m * 16; const float rs = __builtin_amdgcn_rsqf(ss[row] * (1.0f / 1024.0f) + 1e-6f);
                bf16_t* rowp = O + (size_t)row * ldc + col0;
#pragma unroll
                for (int bj = 0; bj < 2; ++bj) { f32x4 v0 = acc[ai][bj][m][0] * rs, v1 = acc[ai][bj][m][1] * rs;
                    if (ACT == 1) {
#pragma unroll
                        for (int e = 0; e < 4; ++e) { const float a = fmaxf(v0[e], 0.f), b = fmaxf(v1[e], 0.f); v0[e] = a * a; v1[e] = b * b; } }
                    u32x4 w; w.x = cvt_pk_bf16(v0[0], v0[1]); w.y = cvt_pk_bf16(v0[2], v0[3]); w.z = cvt_pk_bf16(v1[0], v1[1]); w.w = cvt_pk_bf16(v1[2], v1[3]);
                    *(u32x4*)(rowp + bj * HALF) = w; } }
    }
};
struct EpiNull {
    static constexpr bool PERM = true, AFTER_DRAIN = false;
    float* out; int never;
    __device__ __forceinline__ void operator()(const f32x4 (&acc)[2][2][4][2], const Unit& u, int wr, int wc, int fr, int fq) const {
        if (never) {
#pragma unroll
            for (int ai = 0; ai < 2; ++ai)
#pragma unroll
                for (int m = 0; m < 4; ++m)
#pragma unroll
                    for (int bj = 0; bj < 2; ++bj) { *(f32x4*)(out + (size_t)(u.pm * BM + wr * 64 + fr + ai * HALF + m * 16) * 1024 + u.pn * BM + wc * 32 + 8 * fq + bj * HALF) = acc[ai][bj][m][0] + acc[ai][bj][m][1]; } }
    }
};
struct EpiResid {
    static constexpr bool PERM = true, AFTER_DRAIN = false;
    const float* base32; bf16_t* xb; float* ss;
    __device__ __forceinline__ void operator()(const f32x4 (&acc)[2][2][4][2], const Unit& u, int wr, int wc, int fr, int fq) const {
        typedef float f32x2v __attribute__((ext_vector_type(2))); typedef __bf16 bf16x2v __attribute__((ext_vector_type(2)));
        const int row0 = u.pm * BM + wr * 64 + fr, col0 = u.pn * BM + wc * 32 + 8 * fq;
#pragma unroll
        for (int ai = 0; ai < 2; ++ai) {
            f32x4 bv[4][2][2];
            if (base32) {
#pragma unroll
                for (int m = 0; m < 4; ++m)
#pragma unroll
                    for (int bj = 0; bj < 2; ++bj)
#pragma unroll
                        for (int n = 0; n < 2; ++n) bv[m][bj][n] = *(const f32x4*)(base32 + (size_t)(row0 + ai * HALF + m * 16) * 1024 + col0 + bj * HALF + n * 4);
            } else {
                u32x4 raw[4][2];
#pragma unroll
                for (int m = 0; m < 4; ++m)
#pragma unroll
                    for (int bj = 0; bj < 2; ++bj) raw[m][bj] = *(const u32x4*)(xb + (size_t)(row0 + ai * HALF + m * 16) * 1024 + col0 + bj * HALF);
#pragma unroll
                for (int m = 0; m < 4; ++m)
#pragma unroll
                    for (int bj = 0; bj < 2; ++bj) { const u32x4 w = raw[m][bj];
                        bv[m][bj][0] = (f32x4){__uint_as_float(w.x << 16), __uint_as_float(w.x & 0xffff0000u), __uint_as_float(w.y << 16), __uint_as_float(w.y & 0xffff0000u)};
                        bv[m][bj][1] = (f32x4){__uint_as_float(w.z << 16), __uint_as_float(w.z & 0xffff0000u), __uint_as_float(w.w << 16), __uint_as_float(w.w & 0xffff0000u)}; }
            }
#pragma unroll
            for (int m = 0; m < 4; ++m) { const int row = row0 + ai * HALF + m * 16; const size_t off = (size_t)row * 1024 + col0; float sq = 0.f;
#pragma unroll
                for (int bj = 0; bj < 2; ++bj) { const f32x4 x0 = bv[m][bj][0] + acc[ai][bj][m][0], x1 = bv[m][bj][1] + acc[ai][bj][m][1];
                    sq += (x0[0] * x0[0] + x0[1] * x0[1]) + (x0[2] * x0[2] + x0[3] * x0[3]) + (x1[0] * x1[0] + x1[1] * x1[1]) + (x1[2] * x1[2] + x1[3] * x1[3]);
                    const f32x2v a0 = {x0[0], x0[1]}, a1 = {x0[2], x0[3]}, a2 = {x1[0], x1[1]}, a3 = {x1[2], x1[3]}; u32x4 w;
                    w.x = __builtin_bit_cast(unsigned, __builtin_convertvector(a0, bf16x2v)); w.y = __builtin_bit_cast(unsigned, __builtin_convertvector(a1, bf16x2v));
                    w.z = __builtin_bit_cast(unsigned, __builtin_convertvector(a2, bf16x2v)); w.w = __builtin_bit_cast(unsigned, __builtin_convertvector(a3, bf16x2v));
                    *(u32x4*)(xb + off + bj * HALF) = w; }
                sq += __shfl_xor(sq, 16); sq += __shfl_xor(sq, 32);
                if (fq == 0) atomicAdd(ss + row, sq); }
            asm volatile("" ::: "memory"); }
    }
};
template <class Epi, class Sched, bool ALIGN_EPI = false, bool SP2 = false>
__device__ __forceinline__ void gemm_phase(PG8_LAS unsigned char* lds, const Gemm g, const Sched& S, const Epi& E) {
    const int tid = threadIdx.x, wid = __builtin_amdgcn_readfirstlane(tid >> 6), lane = tid & 63, wr = wid >> 2, wc = wid & 3, fr = lane & 15, fq = lane >> 4;
    const int K = g.K, nt = K / BK;
    unsigned voffA[2], voffB[2];
#pragma unroll
    for (int i = 0; i < 2; ++i) { int R, C; stage_rc(tid * 16 + i * 8192, R, C); const int Rb = Epi::PERM ? ((R & ~31) + perm32(R & 31)) : R;
        voffA[i] = (unsigned)(R * K + C) * 2u; voffB[i] = (unsigned)(Rb * K + C) * 2u; }
    const size_t kstep = (size_t)(BK * 2);
    const size_t hstep = (size_t)HALF * K * 2;
    const size_t tstep = 2 * hstep;
    const unsigned ldsw = (unsigned)wid * 1024u;
    const int aoff = lds_byte(wr * 64 + fr, fq * 8), boff = lds_byte(wc * 32 + fr, fq * 8);
#define PG8_SA(b, h) (((b) * 2 + (h)) * HTB)
#define PG8_SB(b, h) ((4 + (b) * 2 + (h)) * HTB)
#define PG8_STAGE(bufoff, gbase, voff) do { _Pragma("unroll") for (int _i = 0; _i < 2; ++_i) \
        __builtin_amdgcn_global_load_lds((const unsigned*)((const char*)(gbase) + (voff)[_i]), (PG8_LAS unsigned*)(lds + (bufoff) + ldsw + _i * 8192), 16, 0, 0); } while (0)
#define PG8_LDA(dst, b, h) do { _Pragma("unroll") for (int m = 0; m < 4; ++m) _Pragma("unroll") for (int k = 0; k < 2; ++k) dst[m][k] = *(const PG8_LAS bf16x8*)(lds + PG8_SA(b, h) + aoff + m * 2048 + k * 1024); } while (0)
#define PG8_LDB(dst, b, h) do { _Pragma("unroll") for (int n = 0; n < 2; ++n) _Pragma("unroll") for (int k = 0; k < 2; ++k) dst[n][k] = *(const PG8_LAS bf16x8*)(lds + PG8_SB(b, h) + boff + n * 2048 + k * 1024); } while (0)
#define PG8_MMA(ai, bj, At, Bt) do { __builtin_amdgcn_s_setprio(1); _Pragma("unroll") for (int m = 0; m < 4; ++m) _Pragma("unroll") for (int n = 0; n < 2; ++n) _Pragma("unroll") for (int k = 0; k < 2; ++k) \
        acc[ai][bj][m][n] = __builtin_amdgcn_mfma_f32_16x16x32_bf16(Bt[n][k], At[m][k], acc[ai][bj][m][n], 0, 0, 0); __builtin_amdgcn_s_setprio(0); } while (0)
#define PG8_WAIT_V(n) asm volatile("s_waitcnt vmcnt(" #n ")" ::: "memory")
#define PG8_WAIT_L(n) asm volatile("s_waitcnt lgkmcnt(" #n ")" ::: "memory")
#define PG8_BAR __builtin_amdgcn_s_barrier()
#define PG8_SCHED __builtin_amdgcn_sched_barrier(0)
    Unit cur, nxt; int ui = 0;
    if (!S.next(0, cur)) return;
    f32x4 acc[2][2][4][2];
#pragma unroll
    for (int a = 0; a < 2; ++a)
#pragma unroll
        for (int b = 0; b < 2; ++b)
#pragma unroll
            for (int m = 0; m < 4; ++m)
#pragma unroll
                for (int n = 0; n < 2; ++n) acc[a][b][m][n] = (f32x4){0.f, 0.f, 0.f, 0.f};
    bf16x8 At[4][2], B0[2][2], B1[2][2];
    const char* cA = (const char*)g.A + (size_t)cur.pm * tstep; const char* cB = (const char*)g.Bt + (size_t)cur.pn * tstep;
    S.a_ready(cur);
    if constexpr (SP2) {
        PG8_STAGE(PG8_SB(0, 0), cB, voffB); PG8_STAGE(PG8_SB(0, 1), cB + hstep, voffB); PG8_STAGE(PG8_SA(0, 0), cA, voffA); PG8_STAGE(PG8_SA(0, 1), cA + hstep, voffA);
        if (wr == 1) PG8_BAR;
        PG8_WAIT_V(2); PG8_BAR;
        PG8_STAGE(PG8_SB(1, 0), cB + kstep, voffB); PG8_STAGE(PG8_SA(1, 0), cA + kstep, voffA); PG8_STAGE(PG8_SB(1, 1), cB + hstep + kstep, voffB);
        PG8_WAIT_V(6); PG8_BAR;
    } else {
        PG8_STAGE(PG8_SB(0, 0), cB, voffB); PG8_STAGE(PG8_SA(0, 0), cA, voffA); PG8_STAGE(PG8_SB(0, 1), cB + hstep, voffB); PG8_STAGE(PG8_SA(0, 1), cA + hstep, voffA);
        if (wr == 1) PG8_BAR;
        PG8_WAIT_V(4); PG8_BAR;
        PG8_STAGE(PG8_SB(1, 0), cB + kstep, voffB); PG8_STAGE(PG8_SA(1, 0), cA + kstep, voffA); PG8_STAGE(PG8_SB(1, 1), cB + hstep + kstep, voffB);
        PG8_WAIT_V(6); PG8_BAR;
    }
    for (;;) {
        const bool has_next = S.next(ui + 1, nxt);
        const char* nA = has_next ? (const char*)g.A + (size_t)nxt.pm * tstep : cA; const char* nB = has_next ? (const char*)g.Bt + (size_t)nxt.pn * tstep : cB;
        for (int t = 0; t < nt; t += 2) {
            const bool last = (t == nt - 2);
            const char* a1 = cA + (size_t)(t + 1) * kstep;
            const char* a2 = last ? nA : cA + (size_t)(t + 2) * kstep; const char* b2 = last ? nB : cB + (size_t)(t + 2) * kstep;
            const char* a3 = a2 + kstep; const char* b3 = b2 + kstep;
            if (last && has_next) S.a_ready(nxt);
            if constexpr (SP2) {
            PG8_LDB(B0, 0, 0); PG8_LDB(B1, 0, 1); PG8_SCHED; PG8_LDA(At, 0, 0); PG8_STAGE(PG8_SA(1, 1), a1 + hstep, voffA);
            PG8_WAIT_V(8); PG8_WAIT_L(0); PG8_BAR; PG8_MMA(0, 0, At, B0); PG8_MMA(0, 1, At, B1); PG8_BAR; PG8_SCHED;
            PG8_LDA(At, 0, 1); PG8_STAGE(PG8_SB(0, 0), b2, voffB); PG8_STAGE(PG8_SB(0, 1), b2 + hstep, voffB); PG8_STAGE(PG8_SA(0, 0), a2, voffA);
            PG8_WAIT_V(8); PG8_WAIT_L(0); PG8_BAR; PG8_MMA(1, 0, At, B0); PG8_MMA(1, 1, At, B1); PG8_BAR; PG8_SCHED;
            PG8_LDB(B0, 1, 0); PG8_LDB(B1, 1, 1); PG8_SCHED; PG8_LDA(At, 1, 0); PG8_STAGE(PG8_SA(0, 1), a2 + hstep, voffA);
            PG8_WAIT_V(8); PG8_WAIT_L(0); PG8_BAR; PG8_MMA(0, 0, At, B0); PG8_MMA(0, 1, At, B1); PG8_BAR; PG8_SCHED;
            PG8_LDA(At, 1, 1); PG8_STAGE(PG8_SB(1, 0), b3, voffB); PG8_STAGE(PG8_SB(1, 1), b3 + hstep, voffB); PG8_STAGE(PG8_SA(1, 0), a3, voffA);
            PG8_WAIT_V(8); PG8_WAIT_L(0); PG8_BAR; PG8_MMA(1, 0, At, B0); PG8_MMA(1, 1, At, B1); PG8_BAR; PG8_SCHED;
            } else {
            PG8_LDB(B0, 0, 0); PG8_SCHED; PG8_LDA(At, 0, 0); PG8_STAGE(PG8_SA(1, 1), a1 + hstep, voffA);
            PG8_WAIT_L(8); PG8_BAR; PG8_WAIT_L(0); PG8_MMA(0, 0, At, B0); PG8_BAR; PG8_SCHED;
            PG8_LDB(B1, 0, 1); PG8_STAGE(PG8_SB(0, 0), b2, voffB);
            PG8_BAR; PG8_WAIT_L(0); PG8_MMA(0, 1, At, B1); PG8_BAR;
            PG8_LDA(At, 0, 1); PG8_STAGE(PG8_SA(0, 0), a2, voffA);
            PG8_BAR; PG8_WAIT_L(0); PG8_MMA(1, 0, At, B0); PG8_BAR; PG8_SCHED;
            PG8_STAGE(PG8_SB(0, 1), b2 + hstep, voffB);
            PG8_WAIT_V(6); PG8_BAR; PG8_MMA(1, 1, At, B1); PG8_BAR;
            PG8_LDB(B0, 1, 0); PG8_SCHED; PG8_LDA(At, 1, 0); PG8_STAGE(PG8_SA(0, 1), a2 + hstep, voffA);
            PG8_WAIT_L(8); PG8_BAR; PG8_WAIT_L(0); PG8_MMA(0, 0, At, B0); PG8_BAR; PG8_SCHED;
            PG8_LDB(B1, 1, 1); PG8_STAGE(PG8_SB(1, 0), b3, voffB);
            PG8_BAR; PG8_WAIT_L(0); PG8_MMA(0, 1, At, B1); PG8_BAR;
            PG8_LDA(At, 1, 1); PG8_STAGE(PG8_SA(1, 0), a3, voffA);
            PG8_BAR; PG8_WAIT_L(0); PG8_MMA(1, 0, At, B0); PG8_BAR; PG8_SCHED;
            PG8_STAGE(PG8_SB(1, 1), b3 + hstep, voffB);
            PG8_WAIT_V(6); PG8_BAR; PG8_MMA(1, 1, At, B1); PG8_BAR;
            }
        }
        if constexpr (ALIGN_EPI) { if (wr == 0) PG8_BAR; }
        if constexpr (!Epi::AFTER_DRAIN) { E(acc, cur, wr, wc, fr, fq); S.done(cur); }
        if (!has_next) break;
#pragma unroll
        for (int a = 0; a < 2; ++a)
#pragma unroll
            for (int b = 0; b < 2; ++b)
#pragma unroll
                for (int m = 0; m < 4; ++m)
#pragma unroll
                    for (int n = 0; n < 2; ++n) acc[a][b][m][n] = (f32x4){0.f, 0.f, 0.f, 0.f};
        cur = nxt; cA = nA; cB = nB; ++ui;
        if constexpr (ALIGN_EPI) { if (wr == 1) PG8_BAR; }
    }
    PG8_WAIT_V(0);
    if constexpr (!ALIGN_EPI) { if (wr == 0) PG8_BAR; }
    PG8_BAR;
    if constexpr (Epi::AFTER_DRAIN) { E.fused(acc, cur, wr, wc, fr, fq, lds, wid, lane); S.done(cur); }
#undef PG8_SA
#undef PG8_SB
#undef PG8_STAGE
#undef PG8_LDA
#undef PG8_LDB
#undef PG8_MMA
#undef PG8_WAIT_V
#undef PG8_WAIT_L
#undef PG8_BAR
#undef PG8_SCHED
}
}

constexpr int NWAVES = 8, NT = 512;
constexpr int D = 1024, MP = 16384, SEQ = 2048, MS = 128, FF = 4096;
constexpr int NIN0 = 3328, NIN1 = 3072;
constexpr float EPS = 1e-6f, LOG2E = 1.4426950408889634f;
constexpr size_t MiB = 1u << 20;
constexpr size_t WS_SS = 1 * MiB, WS_XS = 2 * MiB, WS_PROJS = 3 * MiB, WS_CATS = 4 * MiB, WS_HS = 5 * MiB;
constexpr size_t WS_WIN0 = 8 * MiB, WS_WOUT0 = 15 * MiB, WS_W10 = 17 * MiB, WS_W20 = 25 * MiB, WS_WIN1 = 33 * MiB, WS_WOUT1 = 39 * MiB, WS_W11 = 41 * MiB, WS_W21 = 49 * MiB;
constexpr size_t WS_CAT = 58 * MiB, WS_SH = 90 * MiB, WS_XB = 218 * MiB, WS_END = 250 * MiB;
constexpr size_t WS_DS = 194 * MiB, WS_EBL = 6 * MiB;
constexpr size_t O_Y = 0, O_YS = 16777216, O_POOLP = 16908288, O_HGP = 16939008, O_CONVP = 17725440, O_POOLS = 17741824, O_HGS = 18233344, O_CONVS = 30816256;
constexpr int LDS_BYTES = 143360;

#define LAS __attribute__((address_space(3)))
typedef unsigned short bf16;
typedef float f32x4 __attribute__((ext_vector_type(4)));
typedef short bf16x8 __attribute__((ext_vector_type(8)));
typedef unsigned u32x4 __attribute__((ext_vector_type(4)));
typedef unsigned u32x2 __attribute__((ext_vector_type(2)));
typedef unsigned short us2 __attribute__((ext_vector_type(2)));
__device__ __forceinline__ float bf2f(unsigned h) { return __uint_as_float(h << 16); }
__device__ __forceinline__ unsigned f2bf(float f) { unsigned u = __float_as_uint(f); return (u + 0x7fffu + ((u >> 16) & 1u)) >> 16; }
typedef float f32x2_t __attribute__((ext_vector_type(2)));
typedef __bf16 bf16x2_t __attribute__((ext_vector_type(2)));
__device__ __forceinline__ unsigned pk2(float lo, float hi) { const f32x2_t v = {lo, hi}; const bf16x2_t b = __builtin_convertvector(v, bf16x2_t); return __builtin_bit_cast(unsigned, b); }
__device__ __forceinline__ float fexp2(float x) { return __builtin_amdgcn_exp2f(x); }
__device__ __forceinline__ float flog2(float x) { return __builtin_amdgcn_logf(x); }
__device__ __forceinline__ float frcp(float x) { return __builtin_amdgcn_rcpf(x); }
__device__ __forceinline__ float fsigmoid(float x) { return frcp(1.0f + fexp2(-x * LOG2E)); }
__device__ __forceinline__ float wave_sum(float v) {
#pragma unroll
    for (int o = 1; o < 64; o <<= 1) v += __shfl_xor(v, o);
    return v;
}
#define MFMA16(a, b, c) __builtin_amdgcn_mfma_f32_16x16x32_bf16((a), (b), (c), 0, 0, 0)

struct PArgs { const float* in[19]; float* out; unsigned char* ws; int ph_lo, ph_hi; };

__device__ __forceinline__ void transpose_item(const float* W, const float* gk, int K, int N, bf16* WT, LAS float* scr, int item, int lane) {
    const int nblk = N / 32, kb = item / nblk, nb = item % nblk, k0 = 64 * kb, n0 = 32 * nb;
#pragma unroll 8
    for (int i = 0; i < 32; ++i) { const int kk = 2 * i + (lane >> 5); const float g = gk ? gk[k0 + kk] : 1.0f; scr[kk * 33 + (lane & 31)] = W[(size_t)(k0 + kk) * N + n0 + (lane & 31)] * g; }
    asm volatile("s_waitcnt lgkmcnt(0)" ::: "memory");
    const int c = lane & 7;
#pragma unroll
    for (int j = 0; j < 4; ++j) { const int n = (lane >> 3) + 8 * j; const LAS float* s = scr + (8 * c) * 33 + n;
        u32x4 o; o.x = pk2(s[0 * 33], s[1 * 33]); o.y = pk2(s[2 * 33], s[3 * 33]); o.z = pk2(s[4 * 33], s[5 * 33]); o.w = pk2(s[6 * 33], s[7 * 33]);
        *(u32x4*)(WT + (size_t)(n0 + n) * K + k0 + 8 * c) = o; }
    asm volatile("s_waitcnt lgkmcnt(0)" ::: "memory");
}
__device__ __forceinline__ void p0_prologue(const PArgs& a, LAS unsigned char* lds, int bid, int G, int tid, int wave, int lane) {
    LAS float* scr = (LAS float*)(lds + wave * 16384);
    const int gw = bid * NWAVES + wave, NGW = G * NWAVES;
    unsigned char* ws = a.ws;
    constexpr int I_IN0 = 16 * 104, I_O = 16 * 32, I_1 = 16 * 128, I_2 = 64 * 32, I_IN1 = 16 * 96;
    constexpr int NITEMS = I_IN0 + I_O + I_1 + I_2 + I_IN1 + I_O + I_1 + I_2;
    for (int it = gw; it < NITEMS; it += NGW) {
        int r = it;
        if (r < I_IN0) { transpose_item(a.in[8], a.in[5], D, NIN0, (bf16*)(ws + WS_WIN0), scr, r, lane); continue; } r -= I_IN0;
        if (r < I_O) { transpose_item(a.in[13], nullptr, D, D, (bf16*)(ws + WS_WOUT0), scr, r, lane); continue; } r -= I_O;
        if (r < I_1) { transpose_item(a.in[17], a.in[6], D, FF, (bf16*)(ws + WS_W10), scr, r, lane); continue; } r -= I_1;
        if (r < I_2) { transpose_item(a.in[18], nullptr, FF, D, (bf16*)(ws + WS_W20), scr, r, lane); continue; } r -= I_2;
        if (r < I_IN1) { transpose_item(a.in[14], a.in[5] + D, D, NIN1, (bf16*)(ws + WS_WIN1), scr, r, lane); continue; } r -= I_IN1;
        if (r < I_O) { transpose_item(a.in[16], nullptr, D, D, (bf16*)(ws + WS_WOUT1), scr, r, lane); continue; } r -= I_O;
        if (r < I_1) { transpose_item(a.in[17] + (size_t)D * FF, a.in[6] + D, D, FF, (bf16*)(ws + WS_W11), scr, r, lane); continue; } r -= I_1;
        transpose_item(a.in[18] + (size_t)FF * D, nullptr, FF, D, (bf16*)(ws + WS_W21), scr, r, lane);
    }
    bf16* xb0 = (bf16*)(ws + WS_CAT); float* ss = (float*)(ws + WS_SS);
    for (int m = gw; m < MP; m += NGW) {
        const f32x4* xr = (const f32x4*)(a.in[0] + (size_t)m * D) + lane; f32x4 v[4]; float s = 0.f;
#pragma unroll
        for (int j = 0; j < 4; ++j) { v[j] = xr[64 * j]; s += (v[j].x * v[j].x + v[j].y * v[j].y) + (v[j].z * v[j].z + v[j].w * v[j].w); }
        s = wave_sum(s);
        u32x2* o8 = (u32x2*)(xb0 + (size_t)m * D) + lane;
#pragma unroll
        for (int j = 0; j < 4; ++j) { u32x2 w; w.x = pk2(v[j].x, v[j].y); w.y = pk2(v[j].z, v[j].w); o8[64 * j] = w; }
        if (lane == 0) ss[m] = s;
    }
    const int gt = bid * NT + tid, NGT = G * NT;
    for (int i = gt; i < 4 * MP; i += NGT) ss[MP + i] = 0.f;
    float* xs = (float*)(ws + WS_XS);
    for (int i = gt; i < MS * D / 4; i += NGT) ((f32x4*)xs)[i] = ((const f32x4*)a.in[1])[i];
}

template <bool AF32, int EPI, int SU>
__device__ __forceinline__ void sgemm(LAS unsigned char* lds, const void* Ap, int lda, const bf16* Bt, int N, int K, int ksplit, bf16* O, int ldo, float* xs, int G, int bid, int tid, int wave, int lane) {
    constexpr int NKS = SU;
    LAS float* red = (LAS float*)lds;
    LAS float* sqp = red + 16384;
    const int r = lane & 15, q = lane >> 4;
    const int nstrip = N / 64, npiece = 4 * nstrip * ksplit, klen = K / ksplit;
    for (int p = G - 1 - bid; p < npiece; p += G) {
        const int rb = p & 3, strip = (p >> 2) % nstrip, ks = (p >> 2) / nstrip, n0 = strip * 64, k0 = ks * klen + wave * (klen >> 3), row0 = 32 * rb;
        bf16x8 bv[4][NKS], av[2][NKS]; f32x4 af[2][NKS][2];
#pragma unroll
        for (int c = 0; c < 4; ++c)
#pragma unroll
            for (int u = 0; u < NKS; ++u) bv[c][u] = *(const bf16x8*)(Bt + (size_t)(n0 + 16 * c + r) * K + k0 + 32 * u + 8 * q);
#pragma unroll
        for (int t = 0; t < 2; ++t)
#pragma unroll
            for (int u = 0; u < NKS; ++u) {
                if (AF32) { const float* ap = (const float*)Ap + (size_t)(row0 + 16 * t + r) * lda + k0 + 32 * u + 8 * q; af[t][u][0] = *(const f32x4*)ap; af[t][u][1] = *(const f32x4*)(ap + 4); }
                else av[t][u] = *(const bf16x8*)((const bf16*)Ap + (size_t)(row0 + 16 * t + r) * lda + k0 + 32 * u + 8 * q); }
        __builtin_amdgcn_sched_barrier(0);
        float sq[2] = {0.f, 0.f};
        if (AF32) {
#pragma unroll
            for (int t = 0; t < 2; ++t)
#pragma unroll
                for (int u = 0; u < NKS; ++u) { const f32x4 x0 = af[t][u][0], x1 = af[t][u][1];
                    sq[t] += (x0[0] * x0[0] + x0[1] * x0[1]) + (x0[2] * x0[2] + x0[3] * x0[3]) + (x1[0] * x1[0] + x1[1] * x1[1]) + (x1[2] * x1[2] + x1[3] * x1[3]);
                    u32x4 w; w.x = pk2(x0[0], x0[1]); w.y = pk2(x0[2], x0[3]); w.z = pk2(x1[0], x1[1]); w.w = pk2(x1[2], x1[3]); av[t][u] = __builtin_bit_cast(bf16x8, w); } }
#pragma unroll
        for (int t = 0; t < 2; ++t)
#pragma unroll
            for (int c = 0; c < 4; ++c) { f32x4 acc = {0.f, 0.f, 0.f, 0.f};
#pragma unroll
                for (int u = 0; u < NKS; ++u) acc = MFMA16(av[t][u], bv[c][u], acc);
                *(LAS f32x4*)(red + ((wave * 8 + (c * 2 + t)) * 64 + lane) * 4) = acc; }
        if (AF32) {
#pragma unroll
            for (int t = 0; t < 2; ++t) { float v = sq[t]; v += __shfl_xor(v, 16); v += __shfl_xor(v, 32); if (q == 0) sqp[(wave * 2 + t) * 16 + r] = v; } }
        __syncthreads();
        const int t = wave & 1, c = wave >> 1;
        f32x4 acc = {0.f, 0.f, 0.f, 0.f};
#pragma unroll
        for (int w = 0; w < 8; ++w) acc += *(const LAS f32x4*)(red + ((w * 8 + wave) * 64 + lane) * 4);
        const int orow = row0 + 16 * t + 4 * q, ocol = n0 + 16 * c + r;
        if (EPI == 2) {
#pragma unroll
            for (int i = 0; i < 4; ++i) atomicAdd(xs + (size_t)(orow + i) * D + ocol, acc[i]);
        } else {
#pragma unroll
            for (int i = 0; i < 4; ++i) { float ssr = 0.f;
#pragma unroll
                for (int w = 0; w < 8; ++w) ssr += sqp[(w * 2 + t) * 16 + 4 * q + i];
                float v = acc[i] * __builtin_amdgcn_rsqf(ssr * (1.0f / 1024.0f) + EPS);
                if (EPI == 1) { v = fmaxf(v, 0.f); v = v * v; }
                O[(size_t)(orow + i) * ldo + ocol] = (bf16)f2bf(v); }
        }
        __syncthreads();
    }
}

__device__ __forceinline__ float lb_of(const float* lg, int c) { const float e0 = __expf(lg[c]), e1 = __expf(lg[768 + c]), e2 = __expf(lg[1536 + c]); return e0 / (e0 + e1 + e2); }

__device__ __forceinline__ void hgrn_sample3(LAS unsigned char* lds, const bf16* projs, const float* S0all, const float* lbl, const float* gain, bf16* cats, float* st_out, int it0, int G, int tid, int wave, int lane) {
    constexpr int STR = 2624;
    LAS float* L = (LAS float*)lds;
#pragma unroll
    for (int j = 0; j < 3; ++j) { const int it = it0 + j * G;
        if (it < MS * 6 && tid < 128) { const int b = it / 6, h = it - 6 * b, c = h * 128 + tid; const bf16* pr = projs + (size_t)b * NIN0; LAS float* B = L + j * STR;
            const float lbk = lb_of(lbl, c); float fz = bf2f(pr[1024 + c]); fz = fminf(fmaxf(fz, -30.f), 30.f);
            const float e = fexp2(-fz * LOG2E), sg = frcp(1.0f + e); B[tid] = lbk + (1.0f - lbk) * sg; B[128 + tid] = (1.0f - lbk) * e * sg; B[256 + tid] = bf2f(pr[256 + c]);
            const float z = bf2f(pr[1792 + c]); B[384 + tid] = z * fsigmoid(z); } }
    const int vq = tid & 31, kg = tid >> 5;
    f32x4 sv[3][8];
#pragma unroll
    for (int j = 0; j < 3; ++j) { const int it = it0 + j * G;
        if (it < MS * 6) { const float* S0 = S0all + (size_t)it * 16384;
#pragma unroll
            for (int i = 0; i < 8; ++i) sv[j][i] = *(const f32x4*)(S0 + (size_t)(kg * 8 + i) * 128 + 4 * vq); } }
    __syncthreads();
#pragma unroll
    for (int j = 0; j < 3; ++j) { const int it = it0 + j * G;
        if (it < MS * 6) { LAS float* B = L + j * STR; float* So = st_out + (size_t)it * 16384; const f32x4 v4 = *(const LAS f32x4*)(B + 384 + 4 * vq); f32x4 op = {0.f, 0.f, 0.f, 0.f};
#pragma unroll
            for (int i = 0; i < 8; ++i) { const int kx = kg * 8 + i; const f32x4 sn = sv[j][i] * B[kx] + v4 * B[128 + kx]; *(f32x4*)(So + (size_t)kx * 128 + 4 * vq) = sn; op += sn * B[256 + kx]; }
            *(LAS f32x4*)(B + 512 + kg * 128 + 4 * vq) = op; } }
    __syncthreads();
    float o[3];
#pragma unroll
    for (int j = 0; j < 3; ++j) { o[j] = 0.f;
        if (tid < 128) { LAS float* B = L + j * STR;
#pragma unroll
            for (int i = 0; i < 16; ++i) o[j] += B[512 + i * 128 + tid];
            const float ssum = wave_sum(o[j] * o[j]); if (lane == 0) B[2560 + wave] = ssum; } }
    __syncthreads();
#pragma unroll
    for (int j = 0; j < 3; ++j) { const int it = it0 + j * G;
        if (it < MS * 6 && tid < 128) { const int b = it / 6, h = it - 6 * b, c = h * 128 + tid; LAS float* B = L + j * STR;
            const float rs = __builtin_amdgcn_rsqf((B[2560] + B[2561]) * (1.0f / 128.0f) + EPS);
            cats[(size_t)b * D + 256 + c] = (bf16)f2bf(o[j] * rs * gain[c] * fsigmoid(bf2f(projs[(size_t)b * NIN0 + 2560 + c]))); } }
    __syncthreads();
}

__device__ __forceinline__ void pool_mm(const LAS float* W, const LAS float* df, float (&acc)[8], int c, int tg) {
#pragma unroll
    for (int i = 0; i < 8; ++i) acc[i] = 0.f;
#pragma unroll 4
    for (int cc = 0; cc < 64; cc += 4) { const float w0 = W[cc * 64 + c], w1 = W[(cc + 1) * 64 + c], w2 = W[(cc + 2) * 64 + c], w3 = W[(cc + 3) * 64 + c];
#pragma unroll
        for (int i = 0; i < 8; ++i) { const f32x4 dv = *(const LAS f32x4*)(df + (tg * 8 + i) * 64 + cc); acc[i] += (dv.x * w0 + dv.y * w1) + (dv.z * w2 + dv.w * w3); } }
}
__device__ __forceinline__ void pool_prompt_all(LAS unsigned char* lds, const bf16* proj, const float* pw, const float* pscale, bf16* cat, float* pool_out, int bid, int G, int tid, int wave, int lane) {
    constexpr int PK = 144;
    LAS float* ue = (LAS float*)lds;
    LAS unsigned char* Dfb = lds + 20224;
    LAS unsigned char* Wtb = lds + 20224 + 9216;
    const int r = lane & 15, q = lane >> 4, c = tid & 63, tg = tid >> 6;
    unsigned short uv[10]; f32x4 wv[2];
    int it = bid;
    if (it < 1024) { const int g = it & 3, tt = it >> 2, b = tt >> 5, t0 = (tt & 31) * 64;
#pragma unroll
        for (int j10 = 0; j10 < 10; ++j10) { const int e = tid + NT * j10, j = e >> 6, t = t0 - 15 + j; uv[j10] = (e < 79 * 64 && t >= 0) ? proj[(size_t)(b * SEQ + t) * NIN0 + g * 64 + (e & 63)] : (unsigned short)0; }
#pragma unroll
        for (int j2 = 0; j2 < 2; ++j2) wv[j2] = ((const f32x4*)(pw + g * 4096))[tid + NT * j2]; }
    for (; it < 1024; it += G) {
        const int g = it & 3, tt = it >> 2, b = tt >> 5, t0 = (tt & 31) * 64, wlen = 2 << g;
#pragma unroll
        for (int j10 = 0; j10 < 10; ++j10) { const int e = tid + NT * j10; if (e < 79 * 64) ue[e] = bf2f(uv[j10]); }
#pragma unroll
        for (int j2 = 0; j2 < 2; ++j2) { const int e4 = tid + NT * j2, cc = e4 >> 4, d0 = (e4 & 15) * 4;
#pragma unroll
            for (int k = 0; k < 4; ++k) *(LAS unsigned short*)(Wtb + (d0 + k) * PK + 2 * cc) = (unsigned short)f2bf(wv[j2][k]); }
        { const int nit = it + G;
          if (nit < 1024) { const int ng = nit & 3, ntt = nit >> 2, nb = ntt >> 5, nt0 = (ntt & 31) * 64;
#pragma unroll
              for (int j10 = 0; j10 < 10; ++j10) { const int e = tid + NT * j10, j = e >> 6, t = nt0 - 15 + j; uv[j10] = (e < 79 * 64 && t >= 0) ? proj[(size_t)(nb * SEQ + t) * NIN0 + ng * 64 + (e & 63)] : (unsigned short)0; }
#pragma unroll
              for (int j2 = 0; j2 < 2; ++j2) wv[j2] = ((const f32x4*)(pw + ng * 4096))[tid + NT * j2]; } }
        __syncthreads();
#pragma unroll
        for (int i = 0; i < 8; ++i) { const int t = tg * 8 + i; float s = 0.f;
#pragma unroll
            for (int j = 0; j < 16; ++j) { const float x = ue[(15 + t - j) * 64 + c]; s += (j < wlen) ? x : 0.f; }
            const int pos = t0 + t; const float rc = (pos + 1 >= wlen) ? 1.0f / (float)wlen : 1.0f / (float)(pos + 1); const float u = ue[(15 + t) * 64 + c];
            *(LAS unsigned short*)(Dfb + t * PK + 2 * c) = (unsigned short)f2bf(s * rc - u);
            if (pos >= SEQ - 15) pool_out[(size_t)(b * 15 + (pos - (SEQ - 15))) * 256 + g * 64 + c] = u; }
        __syncthreads();
        { const int ti = wave >> 1;
#pragma unroll
          for (int dj2 = 0; dj2 < 2; ++dj2) { const int dj = 2 * (wave & 1) + dj2; f32x4 acc = {0.f, 0.f, 0.f, 0.f};
#pragma unroll
              for (int ks = 0; ks < 2; ++ks) { const bf16x8 av = *(const LAS bf16x8*)(Dfb + (16 * ti + r) * PK + ks * 64 + q * 16), bv = *(const LAS bf16x8*)(Wtb + (16 * dj + r) * PK + ks * 64 + q * 16); acc = MFMA16(av, bv, acc); }
              const float sc = pscale[g * 64 + 16 * dj + r];
#pragma unroll
              for (int i = 0; i < 4; ++i) cat[(size_t)(b * SEQ + t0 + 16 * ti + 4 * q + i) * D + g * 64 + 16 * dj + r] = (bf16)f2bf(acc[i] * sc); } }
        __syncthreads();
    }
}
__device__ __forceinline__ void pool_sample(LAS unsigned char* lds, const bf16* projs, const float* spool, const float* pw, const float* pscale, bf16* cats, float* pool_out, int item, int tid) {
    LAS float* W = (LAS float*)lds + 79 * 64; LAS float* df = W + 4096;
    const int g = item & 3, st = item >> 2, wlen = 2 << g, c = tid & 63, tg = tid >> 6, ch = g * 64 + c;
#pragma unroll
    for (int j2 = 0; j2 < 2; ++j2) ((LAS f32x4*)W)[tid + NT * j2] = ((const f32x4*)(pw + g * 4096))[tid + NT * j2];
#pragma unroll
    for (int i = 0; i < 8; ++i) { const int t = tg * 8 + i, b = st * 64 + t; const float u = bf2f(projs[(size_t)b * NIN0 + ch]);
        float pv[15];
#pragma unroll
        for (int j = 0; j < 15; ++j) pv[j] = spool[(size_t)(b * 15 + j) * 256 + ch];
        float s = u;
#pragma unroll
        for (int j = 0; j < 15; ++j) if (j < wlen - 1) s += pv[14 - j];
        df[t * 64 + c] = s / (float)wlen - u;
#pragma unroll
        for (int j = 0; j < 14; ++j) pool_out[(size_t)(b * 15 + j) * 256 + ch] = pv[j + 1];
        pool_out[(size_t)(b * 15 + 14) * 256 + ch] = u; }
    __syncthreads();
    float acc[8]; pool_mm(W, df, acc, c, tg);
    const float sc = pscale[ch];
#pragma unroll
    for (int i = 0; i < 8; ++i) cats[(size_t)(st * 64 + tg * 8 + i) * D + ch] = (bf16)f2bf(acc[i] * sc);
    __syncthreads();
}

__device__ __forceinline__ void unpack8(const u32x4 w, float (&f)[8]) {
    f[0] = __uint_as_float(w.x << 16); f[1] = __uint_as_float(w.x & 0xffff0000u); f[2] = __uint_as_float(w.y << 16); f[3] = __uint_as_float(w.y & 0xffff0000u);
    f[4] = __uint_as_float(w.z << 16); f[5] = __uint_as_float(w.z & 0xffff0000u); f[6] = __uint_as_float(w.w << 16); f[7] = __uint_as_float(w.w & 0xffff0000u);
}
__device__ __forceinline__ void hgrn_stepA(LAS unsigned char* lds, const bf16* proj, const float* lbl, bf16* dS, float* eblg, int bid, int G, int wave, int lane) {
    constexpr int PK = 144;
    LAS unsigned char* KeT = lds; LAS unsigned char* Vt = lds + 18432; LAS float* qsum = (LAS float*)(lds + 36864);
    const int tq = wave >> 1, k = ((wave & 1) << 6) + lane, r = lane & 15, q = lane >> 4, w = wave;
    unsigned short fv[16], iv[16];
    int it = bid;
    if (it < 1536) { const int bh = it >> 5, c = it & 31, b = bh / 6, h = bh - 6 * b; const unsigned lo_f = 1024u + (unsigned)(h * 128 + k);
        const bf16* prow = proj + (size_t)(b * SEQ + 64 * c + 16 * tq) * NIN0;
#pragma unroll
        for (int i = 0; i < 16; ++i) { const bf16* up = prow + (size_t)i * NIN0; fv[i] = up[lo_f]; iv[i] = up[lo_f + 768u]; } }
    for (; it < 1536; it += G) {
        const int bh = it >> 5, b = bh / 6, h = bh - 6 * b, ch = h * 128 + k;
        const float lbk = lb_of(lbl, ch), oml = 1.0f - lbk;
        float lf[16], kk[16];
#pragma unroll
        for (int i = 0; i < 16; ++i) { float fz = bf2f(fv[i]); fz = fminf(fmaxf(fz, -30.f), 30.f); const float e = fexp2(-fz * LOG2E), sg = frcp(1.0f + e); lf[i] = flog2(lbk + oml * sg); kk[i] = oml * e * sg; }
        float run = 0.f;
#pragma unroll
        for (int i = 0; i < 16; ++i) { run += lf[i]; lf[i] = run; }
        qsum[tq * 128 + k] = run;
        { unsigned vp[8];
#pragma unroll
          for (int i = 0; i < 8; ++i) { const float z0 = bf2f(iv[2 * i]), z1 = bf2f(iv[2 * i + 1]); vp[i] = pk2(z0 * fsigmoid(z0), z1 * fsigmoid(z1)); }
          *(LAS u32x4*)(Vt + k * PK + tq * 32) = (u32x4){vp[0], vp[1], vp[2], vp[3]}; *(LAS u32x4*)(Vt + k * PK + tq * 32 + 16) = (u32x4){vp[4], vp[5], vp[6], vp[7]}; }
        __syncthreads();
        float off = 0.f, tot = 0.f;
#pragma unroll
        for (int j = 0; j < 4; ++j) { const float s = qsum[j * 128 + k]; tot += s; if (j < tq) off += s; }
        if (tq == 0) eblg[(size_t)it * 128 + k] = fexp2(tot);
        { unsigned kp[8];
#pragma unroll
          for (int i = 0; i < 8; ++i) { const float b0 = lf[2 * i] + off, b1 = lf[2 * i + 1] + off; kp[i] = pk2(kk[2 * i] * fexp2(tot - b0), kk[2 * i + 1] * fexp2(tot - b1)); }
          *(LAS u32x4*)(KeT + k * PK + tq * 32) = (u32x4){kp[0], kp[1], kp[2], kp[3]}; *(LAS u32x4*)(KeT + k * PK + tq * 32 + 16) = (u32x4){kp[4], kp[5], kp[6], kp[7]}; }
        { const int nit = it + G;
          if (nit < 1536) { const int nbh = nit >> 5, nc = nit & 31, nb = nbh / 6, nh = nbh - 6 * nb; const unsigned lo_f = 1024u + (unsigned)(nh * 128 + k);
              const bf16* prow = proj + (size_t)(nb * SEQ + 64 * nc + 16 * tq) * NIN0;
#pragma unroll
              for (int i = 0; i < 16; ++i) { const bf16* up = prow + (size_t)i * NIN0; fv[i] = up[lo_f]; iv[i] = up[lo_f + 768u]; } } }
        __syncthreads();
        { bf16x8 aK[2];
#pragma unroll
          for (int ks = 0; ks < 2; ++ks) aK[ks] = *(const LAS bf16x8*)(KeT + (16 * w + r) * PK + ks * 64 + q * 16);
          bf16* dst = dS + (size_t)it * 16384 + (size_t)r * 128 + 16 * w + 4 * q;
#pragma unroll
          for (int n = 0; n < 8; ++n) { f32x4 s = {0.f, 0.f, 0.f, 0.f};
#pragma unroll
              for (int ks = 0; ks < 2; ++ks) { const bf16x8 bv = *(const LAS bf16x8*)(Vt + (16 * n + r) * PK + ks * 64 + q * 16); s = MFMA16(aK[ks], bv, s); }
              *(u32x2*)(dst + n * 2048) = (u32x2){pk2(s[0], s[1]), pk2(s[2], s[3])}; } }
        __syncthreads();
    }
}
__device__ __forceinline__ void hgrn_stepB(bf16* dS, const float* eblg, float* st_out, int bid, int G, int tid) {
    for (int e = bid * NT + tid; e < 48 * 2048; e += G * NT) {
        const int k8 = e & 15, v = (e >> 4) & 127, bh = e >> 11;
        bf16* p = dS + (size_t)bh * 32 * 16384 + (size_t)v * 128 + 8 * k8; const float* eb = eblg + (size_t)bh * 32 * 128 + 8 * k8;
        float S[8];
#pragma unroll
        for (int j = 0; j < 8; ++j) S[j] = 0.f;
        for (int c0 = 0; c0 < 32; c0 += 8) {
            u32x4 d[8]; f32x4 e0[8], e1[8];
#pragma unroll
            for (int u = 0; u < 8; ++u) { d[u] = *(const u32x4*)(p + (size_t)(c0 + u) * 16384); e0[u] = *(const f32x4*)(eb + (c0 + u) * 128); e1[u] = *(const f32x4*)(eb + (c0 + u) * 128 + 4); }
#pragma unroll
            for (int u = 0; u < 8; ++u) { float dv[8]; unpack8(d[u], dv);
                *(u32x4*)(p + (size_t)(c0 + u) * 16384) = (u32x4){pk2(S[0], S[1]), pk2(S[2], S[3]), pk2(S[4], S[5]), pk2(S[6], S[7])};
#pragma unroll
                for (int j = 0; j < 4; ++j) { S[j] = S[j] * e0[u][j] + dv[j]; S[4 + j] = S[4 + j] * e1[u][j] + dv[4 + j]; } }
        }
        float* so = st_out + (size_t)bh * 16384 + (size_t)(8 * k8) * 128 + v;
#pragma unroll
        for (int j = 0; j < 8; ++j) so[j * 128] = S[j];
    }
}
__device__ __forceinline__ void hgrn_stepC(LAS unsigned char* lds, const bf16* proj, const float* lbl, const float* gain, const bf16* dS, bf16* cat, int bid, int G, int tid, int wave, int lane) {
    constexpr int PQ = 272, PK = 144;
    LAS unsigned char* Qd = lds; LAS unsigned char* Kd = lds + 17408; LAS unsigned char* Vt = lds + 34816;
    LAS unsigned char* P = lds + 53248; LAS unsigned char* St = lds + 62464;
    LAS float* qsum = (LAS float*)(lds + 97280); LAS float* part = qsum + 512; LAS float* rsr = part + 512;
    const int tq = wave >> 1, k = ((wave & 1) << 6) + lane, r = lane & 15, q = lane >> 4, w = wave;
    unsigned short qv[16], fv[16], iv[16];
    int it = bid;
    if (it < 1536) { const int bh = it >> 5, c = it & 31, b = bh / 6, h = bh - 6 * b; const unsigned lo_q = 256u + (unsigned)(h * 128 + k);
        const bf16* prow = proj + (size_t)(b * SEQ + 64 * c + 16 * tq) * NIN0;
#pragma unroll
        for (int i = 0; i < 16; ++i) { const bf16* up = prow + (size_t)i * NIN0; qv[i] = up[lo_q]; fv[i] = up[lo_q + 768u]; iv[i] = up[lo_q + 1536u]; } }
    for (; it < 1536; it += G) {
        const int bh = it >> 5, c = it & 31, b = bh / 6, h = bh - 6 * b, ch = h * 128 + k;
        const float lbk = lb_of(lbl, ch), oml = 1.0f - lbk;
        u32x4 sreg[4];
        { const u32x4* sp = (const u32x4*)(dS + (size_t)it * 16384) + tid;
#pragma unroll
          for (int j = 0; j < 4; ++j) sreg[j] = sp[512 * j]; }
        float lf[16], kk[16];
#pragma unroll
        for (int i = 0; i < 16; ++i) { float fz = bf2f(fv[i]); fz = fminf(fmaxf(fz, -30.f), 30.f); const float e = fexp2(-fz * LOG2E), sg = frcp(1.0f + e); lf[i] = flog2(lbk + oml * sg); kk[i] = oml * e * sg; }
        float run = 0.f;
#pragma unroll
        for (int i = 0; i < 16; ++i) { run += lf[i]; lf[i] = run; }
        qsum[tq * 128 + k] = run;
        { unsigned vp[8];
#pragma unroll
          for (int i = 0; i < 8; ++i) { const float z0 = bf2f(iv[2 * i]), z1 = bf2f(iv[2 * i + 1]); vp[i] = pk2(z0 * fsigmoid(z0), z1 * fsigmoid(z1)); }
          *(LAS u32x4*)(Vt + k * PK + tq * 32) = (u32x4){vp[0], vp[1], vp[2], vp[3]}; *(LAS u32x4*)(Vt + k * PK + tq * 32 + 16) = (u32x4){vp[4], vp[5], vp[6], vp[7]}; }
        __syncthreads();
        float off = 0.f;
#pragma unroll
        for (int j = 0; j < 4; ++j) { const float s = qsum[j * 128 + k]; if (j < tq) off += s; }
#pragma unroll
        for (int i = 0; i < 16; ++i) { const float bc = lf[i] + off; const float ed = fexp2(bc), edi = fexp2(-bc);
            *(LAS unsigned short*)(Qd + (16 * tq + i) * PQ + 2 * k) = (unsigned short)f2bf(bf2f(qv[i]) * ed);
            *(LAS unsigned short*)(Kd + (16 * tq + i) * PQ + 2 * k) = (unsigned short)f2bf(kk[i] * edi); }
#pragma unroll
        for (int j = 0; j < 4; ++j) { const int e = tid + 512 * j, v = e >> 4, k8 = e & 15; *(LAS u32x4*)(St + v * PQ + k8 * 16) = sreg[j]; }
        const unsigned lo_g = (unsigned)(4 * q) * NIN0 + 2560u + (unsigned)(h * 128 + 16 * w + r), lo_o = (unsigned)(4 * q) * D + 256u + (unsigned)(h * 128 + 16 * w + r);
        const bf16* crow = proj + (size_t)(b * SEQ + 64 * c) * NIN0;
        unsigned short gv[16];
#pragma unroll
        for (int ti = 0; ti < 4; ++ti)
#pragma unroll
            for (int i = 0; i < 4; ++i) { const bf16* up = crow + (size_t)(16 * ti + i) * NIN0; gv[ti * 4 + i] = up[lo_g]; }
        { const int nit = it + G;
          if (nit < 1536) { const int nbh = nit >> 5, nc = nit & 31, nb = nbh / 6, nh = nbh - 6 * nb; const unsigned lo_q = 256u + (unsigned)(nh * 128 + k);
              const bf16* prow = proj + (size_t)(nb * SEQ + 64 * nc + 16 * tq) * NIN0;
#pragma unroll
              for (int i = 0; i < 16; ++i) { const bf16* up = prow + (size_t)i * NIN0; qv[i] = up[lo_q]; fv[i] = up[lo_q + 768u]; iv[i] = up[lo_q + 1536u]; } } }
        __syncthreads();
        { const int ti = w >> 1;
#pragma unroll
          for (int sj = 0; sj < 2; ++sj) { const int si = 2 * (w & 1) + sj; f32x4 acc = {0.f, 0.f, 0.f, 0.f};
              if (si <= ti) {
#pragma unroll
                  for (int ks = 0; ks < 4; ++ks) { const bf16x8 av = *(const LAS bf16x8*)(Qd + (16 * ti + r) * PQ + ks * 64 + q * 16), bv = *(const LAS bf16x8*)(Kd + (16 * si + r) * PQ + ks * 64 + q * 16); acc = MFMA16(av, bv, acc); } }
#pragma unroll
              for (int i = 0; i < 4; ++i) { const int t = 16 * ti + 4 * q + i, s = 16 * si + r; *(LAS unsigned short*)(P + t * PK + 2 * s) = (unsigned short)f2bf(s <= t ? acc[i] : 0.f); } } }
        f32x4 o[4];
#pragma unroll
        for (int ti = 0; ti < 4; ++ti) o[ti] = (f32x4){0.f, 0.f, 0.f, 0.f};
        { bf16x8 bS[4];
#pragma unroll
          for (int ks = 0; ks < 4; ++ks) bS[ks] = *(const LAS bf16x8*)(St + (16 * w + r) * PQ + ks * 64 + q * 16);
#pragma unroll
          for (int ti = 0; ti < 4; ++ti)
#pragma unroll
              for (int ks = 0; ks < 4; ++ks) { const bf16x8 av = *(const LAS bf16x8*)(Qd + (16 * ti + r) * PQ + ks * 64 + q * 16); o[ti] = MFMA16(av, bS[ks], o[ti]); } }
        __syncthreads();
        { bf16x8 bV[2];
#pragma unroll
          for (int ks = 0; ks < 2; ++ks) bV[ks] = *(const LAS bf16x8*)(Vt + (16 * w + r) * PK + ks * 64 + q * 16);
#pragma unroll
          for (int ti = 0; ti < 4; ++ti)
#pragma unroll
              for (int ks = 0; ks < 2; ++ks) { const bf16x8 av = *(const LAS bf16x8*)(P + (16 * ti + r) * PK + ks * 64 + q * 16); o[ti] = MFMA16(av, bV[ks], o[ti]); } }
#pragma unroll
        for (int ti = 0; ti < 4; ++ti)
#pragma unroll
            for (int i = 0; i < 4; ++i) { float p = o[ti][i] * o[ti][i]; p += __shfl_xor(p, 1); p += __shfl_xor(p, 2); p += __shfl_xor(p, 4); p += __shfl_xor(p, 8);
                if (r == 0) part[w * 64 + 16 * ti + 4 * q + i] = p; }
        __syncthreads();
        if (tid < 64) { float s = 0.f;
#pragma unroll
            for (int j = 0; j < 8; ++j) s += part[j * 64 + tid];
            rsr[tid] = __builtin_amdgcn_rsqf(s * (1.0f / 128.0f) + EPS); }
        __syncthreads();
        const float gain_v = gain[h * 128 + 16 * w + r];
        bf16* orow = cat + (size_t)(b * SEQ + 64 * c) * D;
#pragma unroll
        for (int ti = 0; ti < 4; ++ti)
#pragma unroll
            for (int i = 0; i < 4; ++i) { const int t = 16 * ti + 4 * q + i; const float val = o[ti][i] * rsr[t] * gain_v * fsigmoid(bf2f(gv[ti * 4 + i]));
                bf16* up = orow + (size_t)(16 * ti + i) * D; up[lo_o] = (bf16)f2bf(val); }
    }
    __syncthreads();
}

__device__ __forceinline__ void conv_phase(const PArgs& a, int bid, int G, int tid) {
    unsigned char* ws = a.ws;
    const bf16* proj = (const bf16*)(ws + WS_SH); bf16* cat = (bf16*)(ws + WS_CAT); const float* cw = a.in[15];
    for (int gt = bid * NT + tid; gt < 1024 * 128; gt += G * NT) {
        const int cgp = gt & 127, rb = gt >> 7, b = rb >> 7, tl0 = (rb & 127) * 16, c0 = 8 * cgp;
        float w0[8], w1[8], w2[8], zm2[8], zm1[8];
#pragma unroll
        for (int e = 0; e < 8; ++e) { w0[e] = cw[c0 + e]; w1[e] = cw[1024 + c0 + e]; w2[e] = cw[2048 + c0 + e]; zm2[e] = 0.f; zm1[e] = 0.f; }
        const bf16* pr = proj + (size_t)(b * SEQ + tl0) * NIN1 + c0;
        if (tl0 > 0) { float cgv[8], hvv[8];
            unpack8(*(const u32x4*)(pr - 2 * NIN1 + 1024), cgv); unpack8(*(const u32x4*)(pr - 2 * NIN1 + 2048), hvv);
#pragma unroll
            for (int e = 0; e < 8; ++e) zm2[e] = cgv[e] * hvv[e];
            unpack8(*(const u32x4*)(pr - NIN1 + 1024), cgv); unpack8(*(const u32x4*)(pr - NIN1 + 2048), hvv);
#pragma unroll
            for (int e = 0; e < 8; ++e) zm1[e] = cgv[e] * hvv[e]; }
#pragma unroll 1
        for (int i = 0; i < 16; ++i) { float bgv[8], cgv[8], hvv[8], o[8];
            unpack8(*(const u32x4*)(pr + (size_t)i * NIN1), bgv); unpack8(*(const u32x4*)(pr + (size_t)i * NIN1 + 1024), cgv); unpack8(*(const u32x4*)(pr + (size_t)i * NIN1 + 2048), hvv);
#pragma unroll
            for (int e = 0; e < 8; ++e) { const float z = cgv[e] * hvv[e]; o[e] = bgv[e] * (w0[e] * zm2[e] + w1[e] * zm1[e] + w2[e] * z); zm2[e] = zm1[e]; zm1[e] = z; }
            *(u32x4*)(cat + (size_t)(b * SEQ + tl0 + i) * D + c0) = (u32x4){pk2(o[0], o[1]), pk2(o[2], o[3]), pk2(o[4], o[5]), pk2(o[6], o[7])};
            const int t = tl0 + i;
            if (t >= SEQ - 2) { float* co = a.out + O_CONVP + (size_t)(b * 2 + (t - (SEQ - 2))) * 1024 + c0;
                *(f32x4*)co = (f32x4){zm1[0], zm1[1], zm1[2], zm1[3]}; *(f32x4*)(co + 4) = (f32x4){zm1[4], zm1[5], zm1[6], zm1[7]}; } }
    }
    const bf16* projs = (const bf16*)(ws + WS_PROJS); bf16* cats = (bf16*)(ws + WS_CATS); const float* sc = a.in[4];
    for (int gt = bid * NT + tid; gt < MS * 128; gt += G * NT) {
        const int cgp = gt & 127, b = gt >> 7, c0 = 8 * cgp; float bgv[8], cgv[8], hvv[8], o[8], z[8];
        const bf16* pr = projs + (size_t)b * NIN1 + c0;
        unpack8(*(const u32x4*)pr, bgv); unpack8(*(const u32x4*)(pr + 1024), cgv); unpack8(*(const u32x4*)(pr + 2048), hvv);
        const float* p0 = sc + (size_t)(b * 2) * 1024 + c0; const float* p1 = p0 + 1024;
        float* co = a.out + O_CONVS + (size_t)(b * 2) * 1024 + c0;
#pragma unroll
        for (int e = 0; e < 8; ++e) { z[e] = cgv[e] * hvv[e]; o[e] = bgv[e] * (cw[c0 + e] * p0[e] + cw[1024 + c0 + e] * p1[e] + cw[2048 + c0 + e] * z[e]); co[e] = p1[e]; co[1024 + e] = z[e]; }
        *(u32x4*)(cats + (size_t)b * D + c0) = (u32x4){pk2(o[0], o[1]), pk2(o[2], o[3]), pk2(o[4], o[5]), pk2(o[6], o[7])};
    }
}

__device__ __forceinline__ void final_norm(const PArgs& a, int bid, int G, int wave, int lane) {
    const int gw = bid * NWAVES + wave, NGW = G * NWAVES; const float* gf = a.in[7]; const float* ss4 = (const float*)(a.ws + WS_SS) + 4 * MP;
    f32x4 gv[4];
#pragma unroll
    for (int j = 0; j < 4; ++j) gv[j] = ((const f32x4*)gf)[lane + 64 * j];
    for (int m = gw; m < MP + MS; m += NGW) {
        if (m < MP) { f32x4* yr = (f32x4*)(a.out + O_Y + (size_t)m * D) + lane; const u32x2* xr = (const u32x2*)((const bf16*)(a.ws + WS_XB) + (size_t)m * D) + lane;
            const float rs = __builtin_amdgcn_rsqf(ss4[m] * (1.0f / 1024.0f) + EPS);
#pragma unroll
            for (int j = 0; j < 4; ++j) { const u32x2 w = xr[64 * j]; const f32x4 v = {__uint_as_float(w.x << 16), __uint_as_float(w.x & 0xffff0000u), __uint_as_float(w.y << 16), __uint_as_float(w.y & 0xffff0000u)}; yr[64 * j] = v * rs * gv[j]; } }
        else { const int sr = m - MP; const f32x4* xr = (const f32x4*)((const float*)(a.ws + WS_XS) + (size_t)sr * D) + lane; f32x4* yr = (f32x4*)(a.out + O_YS + (size_t)sr * D) + lane;
            f32x4 v[4]; float s = 0.f;
#pragma unroll
            for (int j = 0; j < 4; ++j) { v[j] = xr[64 * j]; s += (v[j].x * v[j].x + v[j].y * v[j].y) + (v[j].z * v[j].z + v[j].w * v[j].w); }
            const float rs = __builtin_amdgcn_rsqf(wave_sum(s) * (1.0f / 1024.0f) + EPS);
#pragma unroll
            for (int j = 0; j < 4; ++j) yr[64 * j] = v[j] * rs * gv[j]; }
    }
}

#define XB_TMO      128
#define XB_XCNT(j)  (256  + 64 * (j))
#define XB_XSUB(j)  (1280 + 64 * (j))
#define XB_XGEN(j)  (2304 + 64 * (j))
#define XB_TOP      3328
#define XB_TOPGEN   3392
#define XCD_BAR_WORDS 3456
#define XB_SPIN_CAP (1u << 18)

__device__ __forceinline__ unsigned xb_ld(unsigned* p)              { return __hip_atomic_load(p, __ATOMIC_RELAXED, __HIP_MEMORY_SCOPE_AGENT); }
__device__ __forceinline__ unsigned xb_add(unsigned* p, unsigned v) { return __hip_atomic_fetch_add(p, v, __ATOMIC_RELAXED, __HIP_MEMORY_SCOPE_AGENT); }
__device__ __forceinline__ unsigned xb_xcc_id() { return (unsigned)__builtin_amdgcn_s_getreg((3 << 11) | 20) & 0xFu; }
#define XB_SPIN(cond, bar) do { unsigned _sp = 0; while (cond) { __builtin_amdgcn_s_sleep(1); \
    if ((++_sp & 255u) == 0u) { if (xb_ld(&(bar)[XB_TMO])) break; if (_sp > XB_SPIN_CAP) { atomicAdd(&(bar)[XB_TMO], 1u); break; } } } } while (0)

struct XcdBarrier {
    unsigned* bar; unsigned x;
    volatile LAS unsigned* st;
};

__device__ __forceinline__ XcdBarrier xcd_barrier_post(unsigned* bar, volatile LAS unsigned* st) {
    XcdBarrier b; b.bar = bar; b.x = xb_xcc_id(); b.st = st;
    if (threadIdx.x == 0) (void)xb_add(&bar[XB_XCNT(b.x)], 1u);
    return b;
}
__device__ __forceinline__ void xcd_barrier_complete(unsigned* bar, unsigned x, unsigned& nloc, unsigned& nx) {
    const unsigned G = gridDim.x * gridDim.y * gridDim.z;
    unsigned sum, cnt, mine, sp = 0u;
    for (;;) {
        sum = 0u; cnt = 0u; mine = 0u;
#pragma unroll
        for (unsigned j = 0; j < 16; ++j) { const unsigned c = xb_ld(&bar[XB_XCNT(j)]); sum += c; cnt += (c > 0u) ? 1u : 0u; mine = (j == x) ? c : mine; }
        if (sum == G) break;
        __builtin_amdgcn_s_sleep(1);
        if ((++sp & 255u) == 0u) { if (xb_ld(&bar[XB_TMO])) break; if (sp > XB_SPIN_CAP) { atomicAdd(&bar[XB_TMO], 1u); break; } }
    }
    nloc = mine > 0u ? mine : 1u; nx = cnt > 0u ? cnt : 1u;
}

__device__ __forceinline__ void xcd_barrier(const XcdBarrier& b) {
    asm volatile("s_waitcnt vmcnt(0)" ::: "memory");
    __syncthreads();
    if (threadIdx.x == 0) {
        unsigned* bar = b.bar;
        __builtin_amdgcn_s_waitcnt(0);
        unsigned nloc = b.st[0], nx = b.st[1];
        if (nloc == 0u) { xcd_barrier_complete(bar, b.x, nloc, nx); b.st[0] = nloc; b.st[1] = nx; }
        const unsigned old = xb_add(&bar[XB_XSUB(b.x)], 1u);
        const unsigned gen = old / nloc;
        if (old + 1u == (gen + 1u) * nloc) {
            __builtin_amdgcn_fence(__ATOMIC_RELEASE, "agent");
            asm volatile("s_waitcnt vmcnt(0)" ::: "memory");
            const unsigned og = xb_add(&bar[XB_TOP], 1u);
            const unsigned tg = og / nx;
            if (og + 1u == (tg + 1u) * nx) xb_add(&bar[XB_TOPGEN], 1u);
            else XB_SPIN(xb_ld(&bar[XB_TOPGEN]) == tg, bar);
            __builtin_amdgcn_fence(__ATOMIC_ACQUIRE, "agent");
            xb_add(&bar[XB_XGEN(b.x)], 1u);
            asm volatile("s_waitcnt vmcnt(0)" ::: "memory");
        } else {
            XB_SPIN(xb_ld(&bar[XB_XGEN(b.x)]) == gen, bar);
            __builtin_amdgcn_fence(__ATOMIC_ACQUIRE, "agent");
            asm volatile("s_waitcnt vmcnt(0)" ::: "memory");
        }
    }
    __syncthreads();
}

#ifndef DIS_GEMM
#define DIS_GEMM 0
#endif
#ifndef DIS_SGEMM
#define DIS_SGEMM 0
#endif
#ifndef DIS_HGRN
#define DIS_HGRN 0
#endif
#ifndef DIS_OTHER
#define DIS_OTHER 0
#endif
#ifndef DBG_O
#define DBG_O 15
#endif
#ifndef DUPK
#define DUPK 0
#endif
#ifndef DBG_XSYNC
#define DBG_XSYNC 0
#endif
#ifndef DBG_COL
#define DBG_COL 2304
#endif
#ifndef DBG_HI
#define DBG_HI 12
#endif
#ifndef MK_MULTI
#define MK_MULTI 0
#endif
constexpr int N_PHASES = 12;
#define IN(k) (lo <= (k) && (k) < hi)
#define SEAM(k) do { if (IN(k) && IN((k) + 1)) xcd_barrier(xbar); } while (0)
template <int L>
__device__ __forceinline__ void layer_phases(const PArgs& a, LAS unsigned char* lds, const XcdBarrier& xbar, int lo, int hi, int bid, int G, int tid, int wave, int lane) {
    unsigned char* ws = a.ws;
    float* ss = (float*)(ws + WS_SS);
    bf16* CAT = (bf16*)(ws + WS_CAT); bf16* SH = (bf16*)(ws + WS_SH); bf16* XB = (bf16*)(ws + WS_XB);
    float* xs = (float*)(ws + WS_XS); bf16* projs = (bf16*)(ws + WS_PROJS); bf16* cats = (bf16*)(ws + WS_CATS); bf16* hs = (bf16*)(ws + WS_HS);
    float* Y = a.out + O_Y;
    constexpr int pb = 1 + 5 * L;
    const bf16* Win = (const bf16*)(ws + (L ? WS_WIN1 : WS_WIN0)); const bf16* Wout = (const bf16*)(ws + (L ? WS_WOUT1 : WS_WOUT0));
    const bf16* W1 = (const bf16*)(ws + (L ? WS_W11 : WS_W10)); const bf16* W2 = (const bf16*)(ws + (L ? WS_W21 : WS_W20));
    constexpr int Nin = L ? NIN1 : NIN0;
    if (IN(pb)) {
        pg8::Gemm g{L ? XB : CAT, Win, MP, Nin, D}; pg8::StaticOrder S; S.init(MP, Nin, G, bid);
        pg8::EpiScaleBf16<0> E{SH, Nin, ss + (L ? 2 : 0) * MP};
        for (int rep = 0; rep < (DUPK == 5 ? 2 : 1); ++rep) pg8::gemm_phase<pg8::EpiScaleBf16<0>, pg8::StaticOrder, true, true>(lds, g, S, E);
        for (int rep = 0; rep < (DUPK == 1 ? 2 : 1); ++rep) sgemm<true, 0, 4>(lds, L ? (const void*)xs : (const void*)a.in[1], D, Win, Nin, D, 1, projs, Nin, xs, G, bid, tid, wave, lane);
    }
    SEAM(pb);
    if (IN(pb + 1)) {
        if (L == 0) {
            bf16* dS = (bf16*)(ws + WS_DS); float* eblg = (float*)(ws + WS_EBL);
            if (DUPK == 4) { hgrn_stepA(lds, SH, a.in[11], dS, eblg, bid, G, wave, lane); xcd_barrier(xbar); hgrn_stepB(dS, eblg, a.out + O_HGP, bid, G, tid); xcd_barrier(xbar); hgrn_stepC(lds, SH, a.in[11], a.in[12], dS, CAT, bid, G, tid, wave, lane); xcd_barrier(xbar); }
            if (!DIS_HGRN) hgrn_stepA(lds, SH, a.in[11], dS, eblg, bid, G, wave, lane);
            for (int rep = 0; rep < (DUPK == 9 ? 2 : 1); ++rep)
                for (int it = bid; it < MS * 6; it += 3 * G) hgrn_sample3(lds, projs, a.in[3], a.in[11], a.in[12], cats, a.out + O_HGS, it, G, tid, wave, lane);
            pool_prompt_all(lds, SH, a.in[9], a.in[10], CAT, a.out + O_POOLP, bid, G, tid, wave, lane);
            xcd_barrier(xbar);
            if (!DIS_HGRN) hgrn_stepB(dS, eblg, a.out + O_HGP, bid, G, tid);
            if (bid >= 192) for (int it = bid - 192; it < 8; it += G - 192) pool_sample(lds, projs, a.in[2], a.in[9], a.in[10], cats, a.out + O_POOLS, it, tid);
            else if (G <= 192) for (int it = bid; it < 8; it += G) pool_sample(lds, projs, a.in[2], a.in[9], a.in[10], cats, a.out + O_POOLS, it, tid);
            xcd_barrier(xbar);
            if (!DIS_HGRN) hgrn_stepC(lds, SH, a.in[11], a.in[12], dS, CAT, bid, G, tid, wave, lane);
        } else { conv_phase(a, bid, G, tid); }
    }
    SEAM(pb + 1);
    if (IN(pb + 2)) {
        pg8::Gemm g{CAT, Wout, MP, D, D}; pg8::StaticOrder S; S.init(MP, D, G, bid);
        pg8::EpiResid E{L ? (const float*)nullptr : a.in[0], XB, ss + (L ? 3 : 1) * MP};
        if (DUPK == 6) { pg8::EpiNull EN{Y, a.ph_lo}; pg8::gemm_phase<pg8::EpiNull, pg8::StaticOrder, true, true>(lds, g, S, EN); }
        if (!DIS_GEMM) pg8::gemm_phase<pg8::EpiResid, pg8::StaticOrder, true, true>(lds, g, S, E);
        if (!DIS_SGEMM) sgemm<false, 2, 1>(lds, cats, D, Wout, D, D, 4, nullptr, 0, xs, G, bid, tid, wave, lane);
    }
    SEAM(pb + 2);
    if (IN(pb + 3)) {
        pg8::Gemm g{XB, W1, MP, FF, D}; pg8::StaticOrder S; S.init(MP, FF, G, bid);
        pg8::EpiScaleBf16<1> E{SH, FF, ss + (L ? 3 : 1) * MP};
        for (int rep = 0; rep < (DUPK == 2 ? 2 : 1); ++rep) pg8::gemm_phase<pg8::EpiScaleBf16<1>, pg8::StaticOrder, true, true>(lds, g, S, E);
        for (int rep = 0; rep < (DUPK == 1 ? 2 : 1); ++rep) sgemm<true, 1, 4>(lds, xs, D, W1, FF, D, 1, hs, FF, xs, G, bid, tid, wave, lane);
    }
    SEAM(pb + 3);
    if (IN(pb + 4)) {
        pg8::Gemm g{SH, W2, MP, D, FF}; pg8::StaticOrder S; S.init(MP, D, G, bid);
        pg8::EpiResid E{nullptr, XB, ss + (L ? 4 : 2) * MP};
        if (DUPK == 7) { pg8::EpiNull EN{Y, a.ph_lo}; pg8::gemm_phase<pg8::EpiNull, pg8::StaticOrder, true, true>(lds, g, S, EN); }
        if (!DIS_GEMM) pg8::gemm_phase<pg8::EpiResid, pg8::StaticOrder, true, true>(lds, g, S, E);
        if (!DIS_SGEMM) sgemm<false, 2, 4>(lds, hs, FF, W2, D, FF, 4, nullptr, 0, xs, G, bid, tid, wave, lane);
    }
    SEAM(pb + 4);
}
__global__ void __launch_bounds__(NT, 2) mk_fwd(PArgs a) {
    extern __shared__ __attribute__((aligned(16))) unsigned char lds_raw[];
    LAS unsigned char* lds = (LAS unsigned char*)lds_raw;
    const int tid = threadIdx.x, lane = tid & 63, wave = __builtin_amdgcn_readfirstlane(tid >> 6), bid = blockIdx.x, G = gridDim.x;
    const int lo = a.ph_lo, hi = a.ph_hi;
    volatile LAS unsigned* xst = (volatile LAS unsigned*)(lds + 131072 + 64);
    if (tid < 2) xst[tid] = 0u;
    __syncthreads();
    const XcdBarrier xbar = xcd_barrier_post((unsigned*)a.ws, xst);
    if (lo < 0) cg::this_grid().sync();
    if (IN(0)) { for (int rep = 0; rep < (DUPK == 3 ? 2 : 1); ++rep) { p0_prologue(a, lds, bid, G, tid, wave, lane); __syncthreads(); } }
    SEAM(0);
    layer_phases<0>(a, lds, xbar, lo, hi, bid, G, tid, wave, lane);
    layer_phases<1>(a, lds, xbar, lo, hi, bid, G, tid, wave, lane);
    for (int xx = 0; xx < DBG_XSYNC; ++xx) xcd_barrier(xbar);
    if (IN(11)) final_norm(a, bid, G, wave, lane);
    if (hi < 12) {
        if (hi <= 3) { cg::this_grid().sync(); const bf16* C = (const bf16*)(a.ws + WS_CAT); for (size_t i = (size_t)bid * NT + tid; i < O_YS; i += (size_t)G * NT) a.out[i] = ((i & 1023) >= 256) ? bf2f(C[i]) : 0.f; }
        for (size_t i = (size_t)bid * NT + tid; i < 131072; i += (size_t)G * NT) a.out[O_YS + i] = 0.f;
        if (hi <= 2) for (size_t i = (size_t)bid * NT + tid + O_POOLP; i < O_CONVS; i += (size_t)G * NT) a.out[i] = 0.f;
        if (hi <= 7) { for (size_t i = (size_t)bid * NT + tid; i < 16384; i += (size_t)G * NT) a.out[O_CONVP + i] = 0.f;
                       for (size_t i = (size_t)bid * NT + tid; i < 262144; i += (size_t)G * NT) a.out[O_CONVS + i] = 0.f; }
    }
}
#undef IN
#undef SEAM

extern "C" void kernel_launch(void* const* d_in, const int* in_sizes, int n_in, void* d_out, int out_size, void* d_ws, size_t ws_size, hipStream_t stream) {
    static int grid = 0;
    if (grid == 0) {
        if (n_in != 19 || ws_size < WS_END) { fprintf(stderr, "kernel_launch: unexpected inputs (n_in %d, ws %zu)\n", n_in, ws_size); grid = -1; return; }
        int dev = 0, cus = 0, per_cu = 0;
        if (hipGetDevice(&dev) != hipSuccess || hipDeviceGetAttribute(&cus, hipDeviceAttributeMultiprocessorCount, dev) != hipSuccess) { grid = -1; return; }
        if (hipFuncSetAttribute((const void*)mk_fwd, hipFuncAttributeMaxDynamicSharedMemorySize, LDS_BYTES) != hipSuccess) { fprintf(stderr, "kernel_launch: hipFuncSetAttribute failed\n"); grid = -1; return; }
        if (hipOccupancyMaxActiveBlocksPerMultiprocessor(&per_cu, (const void*)mk_fwd, NT, LDS_BYTES) != hipSuccess || per_cu < 1) { fprintf(stderr, "kernel_launch: occupancy query says %d\n", per_cu); per_cu = 1; }
        (void)hipGetLastError();
        grid = cus;
    }
    if (grid < 0) return;
    PArgs a{};
    for (int i = 0; i < 19; ++i) a.in[i] = (const float*)d_in[i];
    a.out = (float*)d_out; a.ws = (unsigned char*)d_ws;
#if MK_MULTI
    for (int k = 0; k < DBG_HI; ++k) { a.ph_lo = k; a.ph_hi = k + 1; hipLaunchKernelGGL(mk_fwd, dim3(grid), dim3(NT), LDS_BYTES, stream, a); }
#else
    a.ph_lo = 0; a.ph_hi = DBG_HI;
    if (hipMemsetAsync(d_ws, 0, 16384, stream) != hipSuccess) { fprintf(stderr, "kernel_launch: hipMemsetAsync failed\n"); return; }
    void* args[] = {&a};
    hipError_t e = hipLaunchCooperativeKernel((const void*)mk_fwd, dim3(grid), dim3(NT), args, LDS_BYTES, stream);
    if (e != hipSuccess) fprintf(stderr, "cooperative launch failed: %s (grid %d)\n", hipGetErrorString(e), grid);
#endif
}
```

```cpp
#include <hip/hip_runtime.h>
#include <hip/hip_cooperative_groups.h>
#include <cstdio>
#include <cstdint>
namespace cg = cooperative_groups;
#ifndef DBG_O
#define DBG_O 15
#endif
namespace pg8 {
#define PG8_LAS __attribute__((address_space(3)))
typedef unsigned short bf16_t;
typedef short bf16x8 __attribute__((ext_vector_type(8)));
typedef float f32x4 __attribute__((ext_vector_type(4)));
typedef unsigned u32x4 __attribute__((ext_vector_type(4)));
typedef unsigned u32x2 __attribute__((ext_vector_type(2)));
constexpr int BM = 256, BK = 64, HALF = 128, HTB = HALF * BK * 2  , STAGE_BYTES = 8 * HTB, NXCD = 8, WGM = 8;

__host__ __device__ __forceinline__ int lds_byte(int r, int c) { const int st = (r >> 4) * 2 + (c >> 5), rr = r & 15, cc = c & 31, ob = rr * 64 + cc * 2; return st * 1024 + (ob ^ (((ob >> 9) & 1) << 5)); }
__host__ __device__ __forceinline__ void stage_rc(int b, int& R, int& C) { const int st = b / 1024, sb = b % 1024, swz = sb ^ (((sb >> 9) & 1) << 5); R = (st >> 1) * 16 + swz / 64; C = (st & 1) * 32 + (swz % 64) / 2; }
__host__ __device__ __forceinline__ int perm32(int rho) { const int n = rho >> 4, i = rho & 15; return 8 * (i >> 2) + 4 * n + (i & 3); }

struct Unit { int pm, pn; };
struct Gemm { const bf16_t* A; const bf16_t* Bt; int M, N, K; };

struct StaticOrder {
    int nM, nN, nwg, G, c;
    __host__ __device__ void init(int M, int N, int G_, int c_) { nM = M / BM; nN = N / BM; nwg = nM * nN; G = G_; c = c_; }
    __host__ __device__ bool next(int i, Unit& u) const {
        const long L = (long)i * G + c; if (L >= nwg) return false;
        int wgid = (int)L; { const int q = nwg / NXCD, r = nwg % NXCD, xcd = wgid % NXCD, off = wgid / NXCD; wgid = (xcd < r ? xcd * (q + 1) : r * (q + 1) + (xcd - r) * q) + off; }
        const int nig = WGM * nN, gid = wgid / nig, fm = gid * WGM, gsz = (nM - fm) < WGM ? (nM - fm) : WGM;
        u.pm = fm + ((wgid % nig) % gsz); u.pn = (wgid % nig) / gsz; return true;
    }
    __device__ __forceinline__ void a_ready(const Unit&) const {}
    __device__ __forceinline__ void done(const Unit&) const {}
};

__device__ __forceinline__ unsigned cvt_pk_bf16(float lo, float hi) { unsigned r; asm volatile("v_cvt_pk_bf16_f32 %0, %1, %2" : "=v"(r) : "v"(lo), "v"(hi)); return r; }
template <int ACT  > struct EpiScaleBf16 {
    static constexpr bool PERM = true, AFTER_DRAIN = false;
    bf16_t* O; int ldc; const float* ss;
    __device__ __forceinline__ void operator()(const f32x4 (&acc)[2][2][4][2], const Unit& u, int wr, int wc, int fr, int fq) const {
        const int row0 = u.pm * BM + wr * 64 + fr, col0 = u.pn * BM + wc * 32 + 8 * fq;
#pragma unroll
        for (int ai = 0; ai < 2; ++ai)
#pragma unroll
            for (int m = 0; m < 4; ++m) { const int row = row0 + ai * HALF + m * 16; const float rs = __builtin_amdgcn_rsqf(ss[row] * (1.0f / 1024.0f) + 1e-6f);
                bf16_t* rowp = O + (size_t)row * ldc + col0;
#pragma unroll
                for (int bj = 0; bj < 2; ++bj) { f32x4 v0 = acc[ai][bj][m][0] * rs, v1 = acc[ai][bj][m][1] * rs;
                    if (ACT == 1) {
#pragma unroll
                        for (int e = 0; e < 4; ++e) { const float a = fmaxf(v0[e], 0.f), b = fmaxf(v1[e], 0.f); v0[e] = a * a; v1[e] = b * b; } }
                    u32x4 w; w.x = cvt_pk_bf16(v0[0], v0[1]); w.y = cvt_pk_bf16(v0[2], v0[3]); w.z = cvt_pk_bf16(v1[0], v1[1]); w.w = cvt_pk_bf16(v1[2], v1[3]);
                    *(u32x4*)(rowp + bj * HALF) = w; } }
    }
};
struct EpiNull {
    static constexpr bool PERM = true, AFTER_DRAIN = false;
    float* out; int never;
    __device__ __forceinline__ void operator()(const f32x4 (&acc)[2][2][4][2], const Unit& u, int wr, int wc, int fr, int fq) const {
        if (never) {
#pragma unroll
            for (int ai = 0; ai < 2; ++ai)
#pragma unroll
                for (int m = 0; m < 4; ++m)
#pragma unroll
                    for (int bj = 0; bj < 2; ++bj) { *(f32x4*)(out + (size_t)(u.pm * BM + wr * 64 + fr + ai * HALF + m * 16) * 1024 + u.pn * BM + wc * 32 + 8 * fq + bj * HALF) = acc[ai][bj][m][0] + acc[ai][bj][m][1]; } }
    }
};
struct EpiResid {
    static constexpr bool PERM = true, AFTER_DRAIN = false;
    const float* base32; bf16_t* xb; float* ss;
    __device__ __forceinline__ void operator()(const f32x4 (&acc)[2][2][4][2], const Unit& u, int wr, int wc, int fr, int fq) const {
        typedef float f32x2v __attribute__((ext_vector_type(2))); typedef __bf16 bf16x2v __attribute__((ext_vector_type(2)));
        const int row0 = u.pm * BM + wr * 64 + fr, col0 = u.pn * BM + wc * 32 + 8 * fq;
#pragma unroll
        for (int ai = 0; ai < 2; ++ai) {
            f32x4 bv[4][2][2];
            if (base32) {
#pragma unroll
                for (int m = 0; m < 4; ++m)
#pragma unroll
                    for (int bj = 0; bj < 2; ++bj)
#pragma unroll
                        for (int n = 0; n < 2; ++n) bv[m][bj][n] = *(const f32x4*)(base32 + (size_t)(row0 + ai * HALF + m * 16) * 1024 + col0 + bj * HALF + n * 4);
            } else {
                u32x4 raw[4][2];
#pragma unroll
                for (int m = 0; m < 4; ++m)
#pragma unroll
                    for (int bj = 0; bj < 2; ++bj) raw[m][bj] = *(const u32x4*)(xb + (size_t)(row0 + ai * HALF + m * 16) * 1024 + col0 + bj * HALF);
#pragma unroll
                for (int m = 0; m < 4; ++m)
#pragma unroll
                    for (int bj = 0; bj < 2; ++bj) { const u32x4 w = raw[m][bj];
                        bv[m][bj][0] = (f32x4){__uint_as_float(w.x << 16), __uint_as_float(w.x & 0xffff0000u), __uint_as_float(w.y << 16), __uint_as_float(w.y & 0xffff0000u)};
                        bv[m][bj][1] = (f32x4){__uint_as_float(w.z << 16), __uint_as_float(w.z & 0xffff0000u), __uint_as_float(w.w << 16), __uint_as_float(w.w & 0xffff0000u)}; }
            }
#pragma unroll
            for (int m = 0; m < 4; ++m) { const int row = row0 + ai * HALF + m * 16; const size_t off = (size_t)row * 1024 + col0; float sq = 0.f;
#pragma unroll
                for (int bj = 0; bj < 2; ++bj) { const f32x4 x0 = bv[m][bj][0] + acc[ai][bj][m][0], x1 = bv[m][bj][1] + acc[ai][bj][m][1];
                    sq += (x0[0] * x0[0] + x0[1] * x0[1]) + (x0[2] * x0[2] + x0[3] * x0[3]) + (x1[0] * x1[0] + x1[1] * x1[1]) + (x1[2] * x1[2] + x1[3] * x1[3]);
                    const f32x2v a0 = {x0[0], x0[1]}, a1 = {x0[2], x0[3]}, a2 = {x1[0], x1[1]}, a3 = {x1[2], x1[3]}; u32x4 w;
                    w.x = __builtin_bit_cast(unsigned, __builtin_convertvector(a0, bf16x2v)); w.y = __builtin_bit_cast(unsigned, __builtin_convertvector(a1, bf16x2v));
                    w.z = __builtin_bit_cast(unsigned, __builtin_convertvector(a2, bf16x2v)); w.w = __builtin_bit_cast(unsigned, __builtin_convertvector(a3, bf16x2v));
                    *(u32x4*)(xb + off + bj * HALF) = w; }
                sq += __shfl_xor(sq, 16); sq += __shfl_xor(sq, 32);
                if (fq == 0) atomicAdd(ss + row, sq); }
            asm volatile("" ::: "memory"); }
    }
};
template <class Epi, class Sched, bool ALIGN_EPI = false, bool SP2 = false>
__device__ __forceinline__ void gemm_phase(PG8_LAS unsigned char* lds, const Gemm g, const Sched& S, const Epi& E) {
    const int tid = threadIdx.x, wid = __builtin_amdgcn_readfirstlane(tid >> 6), lane = tid & 63, wr = wid >> 2, wc = wid & 3, fr = lane & 15, fq = lane >> 4;
    const int K = g.K, nt = K / BK;
    unsigned voffA[2], voffB[2];
#pragma unroll
    for (int i = 0; i < 2; ++i) { int R, C; stage_rc(tid * 16 + i * 8192, R, C); const int Rb = Epi::PERM ? ((R & ~31) + perm32(R & 31)) : R;
        voffA[i] = (unsigned)(R * K + C) * 2u; voffB[i] = (unsigned)(Rb * K + C) * 2u; }
    const size_t kstep = (size_t)(BK * 2);
    const size_t hstep = (size_t)HALF * K * 2;
    const size_t tstep = 2 * hstep;
    const unsigned ldsw = (unsigned)wid * 1024u;
    const int aoff = lds_byte(wr * 64 + fr, fq * 8), boff = lds_byte(wc * 32 + fr, fq * 8);
#define PG8_SA(b, h) (((b) * 2 + (h)) * HTB)
#define PG8_SB(b, h) ((4 + (b) * 2 + (h)) * HTB)
#define PG8_STAGE(bufoff, gbase, voff) do { _Pragma("unroll") for (int _i = 0; _i < 2; ++_i) \
        __builtin_amdgcn_global_load_lds((const unsigned*)((const char*)(gbase) + (voff)[_i]), (PG8_LAS unsigned*)(lds + (bufoff) + ldsw + _i * 8192), 16, 0, 0); } while (0)
#define PG8_LDA(dst, b, h) do { _Pragma("unroll") for (int m = 0; m < 4; ++m) _Pragma("unroll") for (int k = 0; k < 2; ++k) dst[m][k] = *(const PG8_LAS bf16x8*)(lds + PG8_SA(b, h) + aoff + m * 2048 + k * 1024); } while (0)
#define PG8_LDB(dst, b, h) do { _Pragma("unroll") for (int n = 0; n < 2; ++n) _Pragma("unroll") for (int k = 0; k < 2; ++k) dst[n][k] = *(const PG8_LAS bf16x8*)(lds + PG8_SB(b, h) + boff + n * 2048 + k * 1024); } while (0)
#define PG8_MMA(ai, bj, At, Bt) do { __builtin_amdgcn_s_setprio(1); _Pragma("unroll") for (int m = 0; m < 4; ++m) _Pragma("unroll") for (int n = 0; n < 2; ++n) _Pragma("unroll") for (int k = 0; k < 2; ++k) \
        acc[ai][bj][m][n] = __builtin_amdgcn_mfma_f32_16x16x32_bf16(Bt[n][k], At[m][k], acc[ai][bj][m][n], 0, 0, 0); __builtin_amdgcn_s_setprio(0); } while (0)
#define PG8_WAIT_V(n) asm volatile("s_waitcnt vmcnt(" #n ")" ::: "memory")
#define PG8_WAIT_L(n) asm volatile("s_waitcnt lgkmcnt(" #n ")" ::: "memory")
#define PG8_BAR __builtin_amdgcn_s_barrier()
#define PG8_SCHED __builtin_amdgcn_sched_barrier(0)
    Unit cur, nxt; int ui = 0;
    if (!S.next(0, cur)) return;
    f32x4 acc[2][2][4][2];
#pragma unroll
    for (int a = 0; a < 2; ++a)
#pragma unroll
        for (int b = 0; b < 2; ++b)
#pragma unroll
            for (int m = 0; m < 4; ++m)
#pragma unroll
                for (int n = 0; n < 2; ++n) acc[a][b][m][n] = (f32x4){0.f, 0.f, 0.f, 0.f};
    bf16x8 At[4][2], B0[2][2], B1[2][2];
    const char* cA = (const char*)g.A + (size_t)cur.pm * tstep; const char* cB = (const char*)g.Bt + (size_t)cur.pn * tstep;
    S.a_ready(cur);
    if constexpr (SP2) {
        PG8_STAGE(PG8_SB(0, 0), cB, voffB); PG8_STAGE(PG8_SB(0, 1), cB + hstep, voffB); PG8_STAGE(PG8_SA(0, 0), cA, voffA); PG8_STAGE(PG8_SA(0, 1), cA + hstep, voffA);
        if (wr == 1) PG8_BAR;
        PG8_WAIT_V(2); PG8_BAR;
        PG8_STAGE(PG8_SB(1, 0), cB + kstep, voffB); PG8_STAGE(PG8_SA(1, 0), cA + kstep, voffA); PG8_STAGE(PG8_SB(1, 1), cB + hstep + kstep, voffB);
        PG8_WAIT_V(6); PG8_BAR;
    } else {
        PG8_STAGE(PG8_SB(0, 0), cB, voffB); PG8_STAGE(PG8_SA(0, 0), cA, voffA); PG8_STAGE(PG8_SB(0, 1), cB + hstep, voffB); PG8_STAGE(PG8_SA(0, 1), cA + hstep, voffA);
        if (wr == 1) PG8_BAR;
        PG8_WAIT_V(4); PG8_BAR;
        PG8_STAGE(PG8_SB(1, 0), cB + kstep, voffB); PG8_STAGE(PG8_SA(1, 0), cA + kstep, voffA); PG8_STAGE(PG8_SB(1, 1), cB + hstep + kstep, voffB);
        PG8_WAIT_V(6); PG8_BAR;
    }
    for (;;) {
        const bool has_next = S.next(ui + 1, nxt);
        const char* nA = has_next ? (const char*)g.A + (size_t)nxt.pm * tstep : cA; const char* nB = has_next ? (const char*)g.Bt + (size_t)nxt.pn * tstep : cB;
        for (int t = 0; t < nt; t += 2) {
            const bool last = (t == nt - 2);
            const char* a1 = cA + (size_t)(t + 1) * kstep;
            const char* a2 = last ? nA : cA + (size_t)(t + 2) * kstep; const char* b2 = last ? nB : cB + (size_t)(t + 2) * kstep;
            const char* a3 = a2 + kstep; const char* b3 = b2 + kstep;
            if (last && has_next) S.a_ready(nxt);
            if constexpr (SP2) {
            PG8_LDB(B0, 0, 0); PG8_LDB(B1, 0, 1); PG8_SCHED; PG8_LDA(At, 0, 0); PG8_STAGE(PG8_SA(1, 1), a1 + hstep, voffA);
            PG8_WAIT_V(8); PG8_WAIT_L(0); PG8_BAR; PG8_MMA(0, 0, At, B0); PG8_MMA(0, 1, At, B1); PG8_BAR; PG8_SCHED;
            PG8_LDA(At, 0, 1); PG8_STAGE(PG8_SB(0, 0), b2, voffB); PG8_STAGE(PG8_SB(0, 1), b2 + hstep, voffB); PG8_STAGE(PG8_SA(0, 0), a2, voffA);
            PG8_WAIT_V(8); PG8_WAIT_L(0); PG8_BAR; PG8_MMA(1, 0, At, B0); PG8_MMA(1, 1, At, B1); PG8_BAR; PG8_SCHED;
            PG8_LDB(B0, 1, 0); PG8_LDB(B1, 1, 1); PG8_SCHED; PG8_LDA(At, 1, 0); PG8_STAGE(PG8_SA(0, 1), a2 + hstep, voffA);
            PG8_WAIT_V(8); PG8_WAIT_L(0); PG8_BAR; PG8_MMA(0, 0, At, B0); PG8_MMA(0, 1, At, B1); PG8_BAR; PG8_SCHED;
            PG8_LDA(At, 1, 1); PG8_STAGE(PG8_SB(1, 0), b3, voffB); PG8_STAGE(PG8_SB(1, 1), b3 + hstep, voffB); PG8_STAGE(PG8_SA(1, 0), a3, voffA);
            PG8_WAIT_V(8); PG8_WAIT_L(0); PG8_BAR; PG8_MMA(1, 0, At, B0); PG8_MMA(1, 1, At, B1); PG8_BAR; PG8_SCHED;
            } else {
            PG8_LDB(B0, 0, 0); PG8_SCHED; PG8_LDA(At, 0, 0); PG8_STAGE(PG8_SA(1, 1), a1 + hstep, voffA);
            PG8_WAIT_L(8); PG8_BAR; PG8_WAIT_L(0); PG8_MMA(0, 0, At, B0); PG8_BAR; PG8_SCHED;
            PG8_LDB(B1, 0, 1); PG8_STAGE(PG8_SB(0, 0), b2, voffB);
            PG8_BAR; PG8_WAIT_L(0); PG8_MMA(0, 1, At, B1); PG8_BAR;
            PG8_LDA(At, 0, 1); PG8_STAGE(PG8_SA(0, 0), a2, voffA);
            PG8_BAR; PG8_WAIT_L(0); PG8_MMA(1, 0, At, B0); PG8_BAR; PG8_SCHED;
            PG8_STAGE(PG8_SB(0, 1), b2 + hstep, voffB);
            PG8_WAIT_V(6); PG8_BAR; PG8_MMA(1, 1, At, B1); PG8_BAR;
            PG8_LDB(B0, 1, 0); PG8_SCHED; PG8_LDA(At, 1, 0); PG8_STAGE(PG8_SA(0, 1), a2 + hstep, voffA);
            PG8_WAIT_L(8); PG8_BAR; PG8_WAIT_L(0); PG8_MMA(0, 0, At, B0); PG8_BAR; PG8_SCHED;
            PG8_LDB(B1, 1, 1); PG8_STAGE(PG8_SB(1, 0), b3, voffB);
            PG8_BAR; PG8_WAIT_L(0); PG8_MMA(0, 1, At, B1); PG8_BAR;
            PG8_LDA(At, 1, 1); PG8_STAGE(PG8_SA(1, 0), a3, voffA);
            PG8_BAR; PG8_WAIT_L(0); PG8_MMA(1, 0, At, B0); PG8_BAR; PG8_SCHED;
            PG8_STAGE(PG8_SB(1, 1), b3 + hstep, voffB);
            PG8_WAIT_V(6); PG8_BAR; PG8_MMA(1, 1, At, B1); PG8_BAR;
            }
        }
        if constexpr (ALIGN_EPI) { if (wr == 0) PG8_BAR; }
        if constexpr (!Epi::AFTER_DRAIN) { E(acc, cur, wr, wc, fr, fq); S.done(cur); }
        if (!has_next) break;
#pragma unroll
        for (int a = 0; a < 2; ++a)
#pragma unroll
            for (int b = 0; b < 2; ++b)
#pragma unroll
                for (int m = 0; m < 4; ++m)
#pragma unroll
                    for (int n = 0; n < 2; ++n) acc[a][b][m][n] = (f32x4){0.f, 0.f, 0.f, 0.f};
        cur = nxt; cA = nA; cB = nB; ++ui;
        if constexpr (ALIGN_EPI) { if (wr == 1) PG8_BAR; }
    }
    PG8_WAIT_V(0);
    if constexpr (!ALIGN_EPI) { if (wr == 0) PG8_BAR; }
    PG8_BAR;
    if constexpr (Epi::AFTER_DRAIN) { E.fused(acc, cur, wr, wc, fr, fq, lds, wid, lane); S.done(cur); }
#undef PG8_SA
#undef PG8_SB
#undef PG8_STAGE
#undef PG8_LDA
#undef PG8_LDB
#undef PG8_MMA
#undef PG8_WAIT_V
#undef PG8_WAIT_L
#undef PG8_BAR
#undef PG8_SCHED
}
}

constexpr int NWAVES = 8, NT = 512;
constexpr int D = 1024, MP = 16384, SEQ = 2048, MS = 128, FF = 4096;
constexpr int NIN0 = 3328, NIN1 = 3072;
constexpr float EPS = 1e-6f, LOG2E = 1.4426950408889634f;
constexpr size_t MiB = 1u << 20;
constexpr size_t WS_SS = 1 * MiB, WS_XS = 2 * MiB, WS_PROJS = 3 * MiB, WS_CATS = 4 * MiB, WS_HS = 5 * MiB;
constexpr size_t WS_WIN0 = 8 * MiB, WS_WOUT0 = 15 * MiB, WS_W10 = 17 * MiB, WS_W20 = 25 * MiB, WS_WIN1 = 33 * MiB, WS_WOUT1 = 39 * MiB, WS_W11 = 41 * MiB, WS_W21 = 49 * MiB;
constexpr size_t WS_CAT = 58 * MiB, WS_SH = 90 * MiB, WS_XB = 218 * MiB, WS_END = 250 * MiB;
constexpr size_t WS_DS = 194 * MiB, WS_EBL = 6 * MiB;
constexpr size_t O_Y = 0, O_YS = 16777216, O_POOLP = 16908288, O_HGP = 16939008, O_CONVP = 17725440, O_POOLS = 17741824, O_HGS = 18233344, O_CONVS = 30816256;
constexpr int LDS_BYTES = 143360;

#define LAS __attribute__((address_space(3)))
typedef unsigned short bf16;
typedef float f32x4 __attribute__((ext_vector_type(4)));
typedef short bf16x8 __attribute__((ext_vector_type(8)));
typedef unsigned u32x4 __attribute__((ext_vector_type(4)));
typedef unsigned u32x2 __attribute__((ext_vector_type(2)));
typedef unsigned short us2 __attribute__((ext_vector_type(2)));
__device__ __forceinline__ float bf2f(unsigned h) { return __uint_as_float(h << 16); }
__device__ __forceinline__ unsigned f2bf(float f) { unsigned u = __float_as_uint(f); return (u + 0x7fffu + ((u >> 16) & 1u)) >> 16; }
typedef float f32x2_t __attribute__((ext_vector_type(2)));
typedef __bf16 bf16x2_t __attribute__((ext_vector_type(2)));
__device__ __forceinline__ unsigned pk2(float lo, float hi) { const f32x2_t v = {lo, hi}; const bf16x2_t b = __builtin_convertvector(v, bf16x2_t); return __builtin_bit_cast(unsigned, b); }
__device__ __forceinline__ float fexp2(float x) { return __builtin_amdgcn_exp2f(x); }
__device__ __forceinline__ float flog2(float x) { return __builtin_amdgcn_logf(x); }
__device__ __forceinline__ float frcp(float x) { return __builtin_amdgcn_rcpf(x); }
__device__ __forceinline__ float fsigmoid(float x) { return frcp(1.0f + fexp2(-x * LOG2E)); }
__device__ __forceinline__ float wave_sum(float v) {
#pragma unroll
    for (int o = 1; o < 64; o <<= 1) v += __shfl_xor(v, o);
    return v;
}
#define MFMA16(a, b, c) __builtin_amdgcn_mfma_f32_16x16x32_bf16((a), (b), (c), 0, 0, 0)

struct PArgs { const float* in[19]; float* out; unsigned char* ws; int ph_lo, ph_hi; };

__device__ __forceinline__ void transpose_item(const float* W, const float* gk, int K, int N, bf16* WT, LAS float* scr, int item, int lane) {
    const int nblk = N / 32, kb = item / nblk, nb = item % nblk, k0 = 64 * kb, n0 = 32 * nb;
#pragma unroll 8
    for (int i = 0; i < 32; ++i) { const int kk = 2 * i + (lane >> 5); const float g = gk ? gk[k0 + kk] : 1.0f; scr[kk * 33 + (lane & 31)] = W[(size_t)(k0 + kk) * N + n0 + (lane & 31)] * g; }
    asm volatile("s_waitcnt lgkmcnt(0)" ::: "memory");
    const int c = lane & 7;
#pragma unroll
    for (int j = 0; j < 4; ++j) { const int n = (lane >> 3) + 8 * j; const LAS float* s = scr + (8 * c) * 33 + n;
        u32x4 o; o.x = pk2(s[0 * 33], s[1 * 33]); o.y = pk2(s[2 * 33], s[3 * 33]); o.z = pk2(s[4 * 33], s[5 * 33]); o.w = pk2(s[6 * 33], s[7 * 33]);
        *(u32x4*)(WT + (size_t)(n0 + n) * K + k0 + 8 * c) = o; }
    asm volatile("s_waitcnt lgkmcnt(0)" ::: "memory");
}
__device__ __forceinline__ void p0_prologue(const PArgs& a, LAS unsigned char* lds, int bid, int G, int tid, int wave, int lane) {
    LAS float* scr = (LAS float*)(lds + wave * 16384);
    const int gw = bid * NWAVES + wave, NGW = G * NWAVES;
    unsigned char* ws = a.ws;
    constexpr int I_IN0 = 16 * 104, I_O = 16 * 32, I_1 = 16 * 128, I_2 = 64 * 32, I_IN1 = 16 * 96;
    constexpr int NITEMS = I_IN0 + I_O + I_1 + I_2 + I_IN1 + I_O + I_1 + I_2;
    for (int it = gw; it < NITEMS; it += NGW) {
        int r = it;
        if (r < I_IN0) { transpose_item(a.in[8], a.in[5], D, NIN0, (bf16*)(ws + WS_WIN0), scr, r, lane); continue; } r -= I_IN0;
        if (r < I_O) { transpose_item(a.in[13], nullptr, D, D, (bf16*)(ws + WS_WOUT0), scr, r, lane); continue; } r -= I_O;
        if (r < I_1) { transpose_item(a.in[17], a.in[6], D, FF, (bf16*)(ws + WS_W10), scr, r, lane); continue; } r -= I_1;
        if (r < I_2) { transpose_item(a.in[18], nullptr, FF, D, (bf16*)(ws + WS_W20), scr, r, lane); continue; } r -= I_2;
        if (r < I_IN1) { transpose_item(a.in[14], a.in[5] + D, D, NIN1, (bf16*)(ws + WS_WIN1), scr, r, lane); continue; } r -= I_IN1;
        if (r < I_O) { transpose_item(a.in[16], nullptr, D, D, (bf16*)(ws + WS_WOUT1), scr, r, lane); continue; } r -= I_O;
        if (r < I_1) { transpose_item(a.in[17] + (size_t)D * FF, a.in[6] + D, D, FF, (bf16*)(ws + WS_W11), scr, r, lane); continue; } r -= I_1;
        transpose_item(a.in[18] + (size_t)FF * D, nullptr, FF, D, (bf16*)(ws + WS_W21), scr, r, lane);
    }
    bf16* xb0 = (bf16*)(ws + WS_CAT); float* ss = (float*)(ws + WS_SS);
    for (int m = gw; m < MP; m += NGW) {
        const f32x4* xr = (const f32x4*)(a.in[0] + (size_t)m * D) + lane; f32x4 v[4]; float s = 0.f;
#pragma unroll
        for (int j = 0; j < 4; ++j) { v[j] = xr[64 * j]; s += (v[j].x * v[j].x + v[j].y * v[j].y) + (v[j].z * v[j].z + v[j].w * v[j].w); }
        s = wave_sum(s);
        u32x2* o8 = (u32x2*)(xb0 + (size_t)m * D) + lane;
#pragma unroll
        for (int j = 0; j < 4; ++j) { u32x2 w; w.x = pk2(v[j].x, v[j].y); w.y = pk2(v[j].z, v[j].w); o8[64 * j] = w; }
        if (lane == 0) ss[m] = s;
    }
    const int gt = bid * NT + tid, NGT = G * NT;
    for (int i = gt; i < 4 * MP; i += NGT) ss[MP + i] = 0.f;
    float* xs = (float*)(ws + WS_XS);
    for (int i = gt; i < MS * D / 4; i += NGT) ((f32x4*)xs)[i] = ((const f32x4*)a.in[1])[i];
}

template <bool AF32, int EPI, int SU>
__device__ __forceinline__ void sgemm(LAS unsigned char* lds, const void* Ap, int lda, const bf16* Bt, int N, int K, int ksplit, bf16* O, int ldo, float* xs, int G, int bid, int tid, int wave, int lane, int skip = 0) {
    constexpr int NKS = SU;
    LAS float* red = (LAS float*)lds;
    LAS float* sqp = red + 16384;
    const int r = lane & 15, q = lane >> 4;
    const int nstrip = N / 64, npiece = 4 * nstrip * ksplit, klen = K / ksplit;
    for (int p = (bid >= skip) ? G - 1 - bid : npiece; p < npiece; p += G - skip) {
        const int rb = p & 3, strip = (p >> 2) % nstrip, ks = (p >> 2) / nstrip, n0 = strip * 64, k0 = ks * klen + wave * (klen >> 3), row0 = 32 * rb;
        bf16x8 bv[4][NKS], av[2][NKS]; f32x4 af[2][NKS][2];
#pragma unroll
        for (int c = 0; c < 4; ++c)
#pragma unroll
            for (int u = 0; u < NKS; ++u) bv[c][u] = *(const bf16x8*)(Bt + (size_t)(n0 + 16 * c + r) * K + k0 + 32 * u + 8 * q);
#pragma unroll
        for (int t = 0; t < 2; ++t)
#pragma unroll
            for (int u = 0; u < NKS; ++u) {
                if (AF32) { const float* ap = (const float*)Ap + (size_t)(row0 + 16 * t + r) * lda + k0 + 32 * u + 8 * q; af[t][u][0] = *(const f32x4*)ap; af[t][u][1] = *(const f32x4*)(ap + 4); }
                else av[t][u] = *(const bf16x8*)((const bf16*)Ap + (size_t)(row0 + 16 * t + r) * lda + k0 + 32 * u + 8 * q); }
        __builtin_amdgcn_sched_barrier(0);
        float sq[2] = {0.f, 0.f};
        if (AF32) {
#pragma unroll
            for (int t = 0; t < 2; ++t)
#pragma unroll
                for (int u = 0; u < NKS; ++u) { const f32x4 x0 = af[t][u][0], x1 = af[t][u][1];
                    sq[t] += (x0[0] * x0[0] + x0[1] * x0[1]) + (x0[2] * x0[2] + x0[3] * x0[3]) + (x1[0] * x1[0] + x1[1] * x1[1]) + (x1[2] * x1[2] + x1[3] * x1[3]);
                    u32x4 w; w.x = pk2(x0[0], x0[1]); w.y = pk2(x0[2], x0[3]); w.z = pk2(x1[0], x1[1]); w.w = pk2(x1[2], x1[3]); av[t][u] = __builtin_bit_cast(bf16x8, w); } }
#pragma unroll
        for (int t = 0; t < 2; ++t)
#pragma unroll
            for (int c = 0; c < 4; ++c) { f32x4 acc = {0.f, 0.f, 0.f, 0.f};
#pragma unroll
                for (int u = 0; u < NKS; ++u) acc = MFMA16(av[t][u], bv[c][u], acc);
                *(LAS f32x4*)(red + ((wave * 8 + (c * 2 + t)) * 64 + lane) * 4) = acc; }
        if (AF32) {
#pragma unroll
            for (int t = 0; t < 2; ++t) { float v = sq[t]; v += __shfl_xor(v, 16); v += __shfl_xor(v, 32); if (q == 0) sqp[(wave * 2 + t) * 16 + r] = v; } }
        __syncthreads();
        const int t = wave & 1, c = wave >> 1;
        f32x4 acc = {0.f, 0.f, 0.f, 0.f};
#pragma unroll
        for (int w = 0; w < 8; ++w) acc += *(const LAS f32x4*)(red + ((w * 8 + wave) * 64 + lane) * 4);
        const int orow = row0 + 16 * t + 4 * q, ocol = n0 + 16 * c + r;
        if (EPI == 2) {
#pragma unroll
            for (int i = 0; i < 4; ++i) atomicAdd(xs + (size_t)(orow + i) * D + ocol, acc[i]);
        } else {
#pragma unroll
            for (int i = 0; i < 4; ++i) { float ssr = 0.f;
#pragma unroll
                for (int w = 0; w < 8; ++w) ssr += sqp[(w * 2 + t) * 16 + 4 * q + i];
                float v = acc[i] * __builtin_amdgcn_rsqf(ssr * (1.0f / 1024.0f) + EPS);
                if (EPI == 1) { v = fmaxf(v, 0.f); v = v * v; }
                O[(size_t)(orow + i) * ldo + ocol] = (bf16)f2bf(v); }
        }
        __syncthreads();
    }
}

__device__ __forceinline__ float lb_of(const float* lg, int c) { const float e0 = __expf(lg[c]), e1 = __expf(lg[768 + c]), e2 = __expf(lg[1536 + c]); return e0 / (e0 + e1 + e2); }

__device__ __forceinline__ void hgrn_sample3(LAS unsigned char* lds, const bf16* projs, const float* S0all, const float* lbl, const float* gain, bf16* cats, float* st_out, int it0, int G, int tid, int wave, int lane) {
    constexpr int STR = 2624;
    LAS float* L = (LAS float*)lds;
#pragma unroll
    for (int j = 0; j < 3; ++j) { const int it = it0 + j * G;
        if (it < MS * 6 && tid < 128) { const int b = it / 6, h = it - 6 * b, c = h * 128 + tid; const bf16* pr = projs + (size_t)b * NIN0; LAS float* B = L + j * STR;
            const float lbk = lb_of(lbl, c); float fz = bf2f(pr[1024 + c]); fz = fminf(fmaxf(fz, -30.f), 30.f);
            const float e = fexp2(-fz * LOG2E), sg = frcp(1.0f + e); B[tid] = lbk + (1.0f - lbk) * sg; B[128 + tid] = (1.0f - lbk) * e * sg; B[256 + tid] = bf2f(pr[256 + c]);
            const float z = bf2f(pr[1792 + c]); B[384 + tid] = z * fsigmoid(z); } }
    const int vq = tid & 31, kg = tid >> 5;
    f32x4 sv[3][8];
#pragma unroll
    for (int j = 0; j < 3; ++j) { const int it = it0 + j * G;
        if (it < MS * 6) { const float* S0 = S0all + (size_t)it * 16384;
#pragma unroll
            for (int i = 0; i < 8; ++i) sv[j][i] = *(const f32x4*)(S0 + (size_t)(kg * 8 + i) * 128 + 4 * vq); } }
    __syncthreads();
#pragma unroll
    for (int j = 0; j < 3; ++j) { const int it = it0 + j * G;
        if (it < MS * 6) { LAS float* B = L + j * STR; float* So = st_out + (size_t)it * 16384; const f32x4 v4 = *(const LAS f32x4*)(B + 384 + 4 * vq); f32x4 op = {0.f, 0.f, 0.f, 0.f};
#pragma unroll
            for (int i = 0; i < 8; ++i) { const int kx = kg * 8 + i; const f32x4 sn = sv[j][i] * B[kx] + v4 * B[128 + kx]; *(f32x4*)(So + (size_t)kx * 128 + 4 * vq) = sn; op += sn * B[256 + kx]; }
            *(LAS f32x4*)(B + 512 + kg * 128 + 4 * vq) = op; } }
    __syncthreads();
    float o[3];
#pragma unroll
    for (int j = 0; j < 3; ++j) { o[j] = 0.f;
        if (tid < 128) { LAS float* B = L + j * STR;
#pragma unroll
            for (int i = 0; i < 16; ++i) o[j] += B[512 + i * 128 + tid];
            const float ssum = wave_sum(o[j] * o[j]); if (lane == 0) B[2560 + wave] = ssum; } }
    __syncthreads();
#pragma unroll
    for (int j = 0; j < 3; ++j) { const int it = it0 + j * G;
        if (it < MS * 6 && tid < 128) { const int b = it / 6, h = it - 6 * b, c = h * 128 + tid; LAS float* B = L + j * STR;
            const float rs = __builtin_amdgcn_rsqf((B[2560] + B[2561]) * (1.0f / 128.0f) + EPS);
            cats[(size_t)b * D + 256 + c] = (bf16)f2bf(o[j] * rs * gain[c] * fsigmoid(bf2f(projs[(size_t)b * NIN0 + 2560 + c]))); } }
    __syncthreads();
}

__device__ __forceinline__ void pool_mm(const LAS float* W, const LAS float* df, float (&acc)[8], int c, int tg) {
#pragma unroll
    for (int i = 0; i < 8; ++i) acc[i] = 0.f;
#pragma unroll 4
    for (int cc = 0; cc < 64; cc += 4) { const float w0 = W[cc * 64 + c], w1 = W[(cc + 1) * 64 + c], w2 = W[(cc + 2) * 64 + c], w3 = W[(cc + 3) * 64 + c];
#pragma unroll
        for (int i = 0; i < 8; ++i) { const f32x4 dv = *(const LAS f32x4*)(df + (tg * 8 + i) * 64 + cc); acc[i] += (dv.x * w0 + dv.y * w1) + (dv.z * w2 + dv.w * w3); } }
}
__device__ __forceinline__ void pool_prompt_all(LAS unsigned char* lds, const bf16* proj, const float* pw, const float* pscale, bf16* cat, float* pool_out, int bid, int G, int tid, int wave, int lane) {
    constexpr int PK = 144;
    LAS float* ue = (LAS float*)lds;
    LAS unsigned char* Dfb = lds + 20224;
    LAS unsigned char* Wtb = lds + 20224 + 9216;
    const int r = lane & 15, q = lane >> 4, c = tid & 63, tg = tid >> 6;
    unsigned short uv[10]; f32x4 wv[2];
    int it = bid;
    if (it < 1024) { const int g = it & 3, tt = it >> 2, b = tt >> 5, t0 = (tt & 31) * 64;
#pragma unroll
        for (int j10 = 0; j10 < 10; ++j10) { const int e = tid + NT * j10, j = e >> 6, t = t0 - 15 + j; uv[j10] = (e < 79 * 64 && t >= 0) ? proj[(size_t)(b * SEQ + t) * NIN0 + g * 64 + (e & 63)] : (unsigned short)0; }
#pragma unroll
        for (int j2 = 0; j2 < 2; ++j2) wv[j2] = ((const f32x4*)(pw + g * 4096))[tid + NT * j2]; }
    for (; it < 1024; it += G) {
        const int g = it & 3, tt = it >> 2, b = tt >> 5, t0 = (tt & 31) * 64, wlen = 2 << g;
#pragma unroll
        for (int j10 = 0; j10 < 10; ++j10) { const int e = tid + NT * j10; if (e < 79 * 64) ue[e] = bf2f(uv[j10]); }
#pragma unroll
        for (int j2 = 0; j2 < 2; ++j2) { const int e4 = tid + NT * j2, cc = e4 >> 4, d0 = (e4 & 15) * 4;
#pragma unroll
            for (int k = 0; k < 4; ++k) *(LAS unsigned short*)(Wtb + (d0 + k) * PK + 2 * cc) = (unsigned short)f2bf(wv[j2][k]); }
        { const int nit = it + G;
          if (nit < 1024) { const int ng = nit & 3, ntt = nit >> 2, nb = ntt >> 5, nt0 = (ntt & 31) * 64;
#pragma unroll
              for (int j10 = 0; j10 < 10; ++j10) { const int e = tid + NT * j10, j = e >> 6, t = nt0 - 15 + j; uv[j10] = (e < 79 * 64 && t >= 0) ? proj[(size_t)(nb * SEQ + t) * NIN0 + ng * 64 + (e & 63)] : (unsigned short)0; }
#pragma unroll
              for (int j2 = 0; j2 < 2; ++j2) wv[j2] = ((const f32x4*)(pw + ng * 4096))[tid + NT * j2]; } }
        __syncthreads();
#pragma unroll
        for (int i = 0; i < 8; ++i) { const int t = tg * 8 + i; float s = 0.f;
#pragma unroll
            for (int j = 0; j < 16; ++j) { const float x = ue[(15 + t - j) * 64 + c]; s += (j < wlen) ? x : 0.f; }
            const int pos = t0 + t; const float rc = (pos + 1 >= wlen) ? 1.0f / (float)wlen : 1.0f / (float)(pos + 1); const float u = ue[(15 + t) * 64 + c];
            *(LAS unsigned short*)(Dfb + t * PK + 2 * c) = (unsigned short)f2bf(s * rc - u);
            if (pos >= SEQ - 15) pool_out[(size_t)(b * 15 + (pos - (SEQ - 15))) * 256 + g * 64 + c] = u; }
        __syncthreads();
        { const int ti = wave >> 1;
#pragma unroll
          for (int dj2 = 0; dj2 < 2; ++dj2) { const int dj = 2 * (wave & 1) + dj2; f32x4 acc = {0.f, 0.f, 0.f, 0.f};
#pragma unroll
              for (int ks = 0; ks < 2; ++ks) { const bf16x8 av = *(const LAS bf16x8*)(Dfb + (16 * ti + r) * PK + ks * 64 + q * 16), bv = *(const LAS bf16x8*)(Wtb + (16 * dj + r) * PK + ks * 64 + q * 16); acc = MFMA16(av, bv, acc); }
              const float sc = pscale[g * 64 + 16 * dj + r];
#pragma unroll
              for (int i = 0; i < 4; ++i) cat[(size_t)(b * SEQ + t0 + 16 * ti + 4 * q + i) * D + g * 64 + 16 * dj + r] = (bf16)f2bf(acc[i] * sc); } }
        __syncthreads();
    }
}
__device__ __forceinline__ void pool_sample(LAS unsigned char* lds, const bf16* projs, const float* spool, const float* pw, const float* pscale, bf16* cats, float* pool_out, int item, int tid) {
    LAS float* W = (LAS float*)lds + 79 * 64; LAS float* df = W + 4096;
    const int g = item & 3, st = item >> 2, wlen = 2 << g, c = tid & 63, tg = tid >> 6, ch = g * 64 + c;
#pragma unroll
    for (int j2 = 0; j2 < 2; ++j2) ((LAS f32x4*)W)[tid + NT * j2] = ((const f32x4*)(pw + g * 4096))[tid + NT * j2];
#pragma unroll
    for (int i = 0; i < 8; ++i) { const int t = tg * 8 + i, b = st * 64 + t; const float u = bf2f(projs[(size_t)b * NIN0 + ch]);
        float pv[15];
#pragma unroll
        for (int j = 0; j < 15; ++j) pv[j] = spool[(size_t)(b * 15 + j) * 256 + ch];
        float s = u;
#pragma unroll
        for (int j = 0; j < 15; ++j) if (j < wlen - 1) s += pv[14 - j];
        df[t * 64 + c] = s / (float)wlen - u;
#pragma unroll
        for (int j = 0; j < 14; ++j) pool_out[(size_t)(b * 15 + j) * 256 + ch] = pv[j + 1];
        pool_out[(size_t)(b * 15 + 14) * 256 + ch] = u; }
    __syncthreads();
    float acc[8]; pool_mm(W, df, acc, c, tg);
    const float sc = pscale[ch];
#pragma unroll
    for (int i = 0; i < 8; ++i) cats[(size_t)(st * 64 + tg * 8 + i) * D + ch] = (bf16)f2bf(acc[i] * sc);
    __syncthreads();
}

__device__ __forceinline__ void unpack8(const u32x4 w, float (&f)[8]) {
    f[0] = __uint_as_float(w.x << 16); f[1] = __uint_as_float(w.x & 0xffff0000u); f[2] = __uint_as_float(w.y << 16); f[3] = __uint_as_float(w.y & 0xffff0000u);
    f[4] = __uint_as_float(w.z << 16); f[5] = __uint_as_float(w.z & 0xffff0000u); f[6] = __uint_as_float(w.w << 16); f[7] = __uint_as_float(w.w & 0xffff0000u);
}
__device__ __forceinline__ void hgrn_stepA(LAS unsigned char* lds, const bf16* proj, const float* lbl, bf16* dS, float* eblg, int bid, int G, int wave, int lane) {
    constexpr int PK = 144;
    LAS unsigned char* KeT = lds; LAS unsigned char* Vt = lds + 18432; LAS float* qsum = (LAS float*)(lds + 36864);
    const int tq = wave >> 1, k = ((wave & 1) << 6) + lane, r = lane & 15, q = lane >> 4, w = wave;
    unsigned short fv[16], iv[16];
    int it = bid;
    if (it < 1536) { const int bh = it >> 5, c = it & 31, b = bh / 6, h = bh - 6 * b; const unsigned lo_f = 1024u + (unsigned)(h * 128 + k);
        const bf16* prow = proj + (size_t)(b * SEQ + 64 * c + 16 * tq) * NIN0;
#pragma unroll
        for (int i = 0; i < 16; ++i) { const bf16* up = prow + (size_t)i * NIN0; fv[i] = up[lo_f]; iv[i] = up[lo_f + 768u]; } }
    for (; it < 1536; it += G) {
        const int bh = it >> 5, b = bh / 6, h = bh - 6 * b, ch = h * 128 + k;
        const float lbk = lb_of(lbl, ch), oml = 1.0f - lbk;
        float lf[16], kk[16];
#pragma unroll
        for (int i = 0; i < 16; ++i) { float fz = bf2f(fv[i]); fz = fminf(fmaxf(fz, -30.f), 30.f); const float e = fexp2(-fz * LOG2E), sg = frcp(1.0f + e); lf[i] = flog2(lbk + oml * sg); kk[i] = oml * e * sg; }
        float run = 0.f;
#pragma unroll
        for (int i = 0; i < 16; ++i) { run += lf[i]; lf[i] = run; }
        qsum[tq * 128 + k] = run;
        { unsigned vp[8];
#pragma unroll
          for (int i = 0; i < 8; ++i) { const float z0 = bf2f(iv[2 * i]), z1 = bf2f(iv[2 * i + 1]); vp[i] = pk2(z0 * fsigmoid(z0), z1 * fsigmoid(z1)); }
          *(LAS u32x4*)(Vt + k * PK + tq * 32) = (u32x4){vp[0], vp[1], vp[2], vp[3]}; *(LAS u32x4*)(Vt + k * PK + tq * 32 + 16) = (u32x4){vp[4], vp[5], vp[6], vp[7]}; }
        __syncthreads();
        float off = 0.f, tot = 0.f;
#pragma unroll
        for (int j = 0; j < 4; ++j) { const float s = qsum[j * 128 + k]; tot += s; if (j < tq) off += s; }
        if (tq == 0) eblg[(size_t)it * 128 + k] = fexp2(tot);
        { unsigned kp[8];
#pragma unroll
          for (int i = 0; i < 8; ++i) { const float b0 = lf[2 * i] + off, b1 = lf[2 * i + 1] + off; kp[i] = pk2(kk[2 * i] * fexp2(tot - b0), kk[2 * i + 1] * fexp2(tot - b1)); }
          *(LAS u32x4*)(KeT + k * PK + tq * 32) = (u32x4){kp[0], kp[1], kp[2], kp[3]}; *(LAS u32x4*)(KeT + k * PK + tq * 32 + 16) = (u32x4){kp[4], kp[5], kp[6], kp[7]}; }
        { const int nit = it + G;
          if (nit < 1536) { const int nbh = nit >> 5, nc = nit & 31, nb = nbh / 6, nh = nbh - 6 * nb; const unsigned lo_f = 1024u + (unsigned)(nh * 128 + k);
              const bf16* prow = proj + (size_t)(nb * SEQ + 64 * nc + 16 * tq) * NIN0;
#pragma unroll
              for (int i = 0; i < 16; ++i) { const bf16* up = prow + (size_t)i * NIN0; fv[i] = up[lo_f]; iv[i] = up[lo_f + 768u]; } } }
        __syncthreads();
        { bf16x8 aK[2];
#pragma unroll
          for (int ks = 0; ks < 2; ++ks) aK[ks] = *(const LAS bf16x8*)(KeT + (16 * w + r) * PK + ks * 64 + q * 16);
          bf16* dst = dS + (size_t)it * 16384 + (size_t)r * 128 + 16 * w + 4 * q;
#pragma unroll
          for (int n = 0; n < 8; ++n) { f32x4 s = {0.f, 0.f, 0.f, 0.f};
#pragma unroll
              for (int ks = 0; ks < 2; ++ks) { const bf16x8 bv = *(const LAS bf16x8*)(Vt + (16 * n + r) * PK + ks * 64 + q * 16); s = MFMA16(aK[ks], bv, s); }
              *(u32x2*)(dst + n * 2048) = (u32x2){pk2(s[0], s[1]), pk2(s[2], s[3])}; } }
        __syncthreads();
    }
}
__device__ __forceinline__ void hgrn_stepB(bf16* dS, const float* eblg, float* st_out, int bid, int G, int tid) {
    for (int e = bid * NT + tid; e < 48 * 2048; e += G * NT) {
        const int k8 = e & 15, v = (e >> 4) & 127, bh = e >> 11;
        bf16* p = dS + (size_t)bh * 32 * 16384 + (size_t)v * 128 + 8 * k8; const float* eb = eblg + (size_t)bh * 32 * 128 + 8 * k8;
        float S[8];
#pragma unroll
        for (int j = 0; j < 8; ++j) S[j] = 0.f;
        for (int c0 = 0; c0 < 32; c0 += 8) {
            u32x4 d[8]; f32x4 e0[8], e1[8];
#pragma unroll
            for (int u = 0; u < 8; ++u) { d[u] = *(const u32x4*)(p + (size_t)(c0 + u) * 16384); e0[u] = *(const f32x4*)(eb + (c0 + u) * 128); e1[u] = *(const f32x4*)(eb + (c0 + u) * 128 + 4); }
#pragma unroll
            for (int u = 0; u < 8; ++u) { float dv[8]; unpack8(d[u], dv);
                *(u32x4*)(p + (size_t)(c0 + u) * 16384) = (u32x4){pk2(S[0], S[1]), pk2(S[2], S[3]), pk2(S[4], S[5]), pk2(S[6], S[7])};
#pragma unroll
                for (int j = 0; j < 4; ++j) { S[j] = S[j] * e0[u][j] + dv[j]; S[4 + j] = S[4 + j] * e1[u][j] + dv[4 + j]; } }
        }
        float* so = st_out + (size_t)bh * 16384 + (size_t)(8 * k8) * 128 + v;
#pragma unroll
        for (int j = 0; j < 8; ++j) so[j * 128] = S[j];
    }
}
__device__ __forceinline__ void hgrn_stepC(LAS unsigned char* lds, const bf16* proj, const float* lbl, const float* gain, const bf16* dS, bf16* cat, int bid, int G, int tid, int wave, int lane) {
    constexpr int PQ = 272, PK = 144;
    LAS unsigned char* Qd = lds; LAS unsigned char* Kd = lds + 17408; LAS unsigned char* Vt = lds + 34816;
    LAS unsigned char* P = lds + 53248; LAS unsigned char* St = lds + 62464;
    LAS float* qsum = (LAS float*)(lds + 97280); LAS float* part = qsum + 512; LAS float* rsr = part + 512;
    const int tq = wave >> 1, k = ((wave & 1) << 6) + lane, r = lane & 15, q = lane >> 4, w = wave;
    unsigned short qv[16], fv[16], iv[16];
    int it = bid;
    if (it < 1536) { const int bh = it >> 5, c = it & 31, b = bh / 6, h = bh - 6 * b; const unsigned lo_q = 256u + (unsigned)(h * 128 + k);
        const bf16* prow = proj + (size_t)(b * SEQ + 64 * c + 16 * tq) * NIN0;
#pragma unroll
        for (int i = 0; i < 16; ++i) { const bf16* up = prow + (size_t)i * NIN0; qv[i] = up[lo_q]; fv[i] = up[lo_q + 768u]; iv[i] = up[lo_q + 1536u]; } }
    for (; it < 1536; it += G) {
        const int bh = it >> 5, c = it & 31, b = bh / 6, h = bh - 6 * b, ch = h * 128 + k;
        const float lbk = lb_of(lbl, ch), oml = 1.0f - lbk;
        u32x4 sreg[4];
        { const u32x4* sp = (const u32x4*)(dS + (size_t)it * 16384) + tid;
#pragma unroll
          for (int j = 0; j < 4; ++j) sreg[j] = sp[512 * j]; }
        float lf[16], kk[16];
#pragma unroll
        for (int i = 0; i < 16; ++i) { float fz = bf2f(fv[i]); fz = fminf(fmaxf(fz, -30.f), 30.f); const float e = fexp2(-fz * LOG2E), sg = frcp(1.0f + e); lf[i] = flog2(lbk + oml * sg); kk[i] = oml * e * sg; }
        float run = 0.f;
#pragma unroll
        for (int i = 0; i < 16; ++i) { run += lf[i]; lf[i] = run; }
        qsum[tq * 128 + k] = run;
        { unsigned vp[8];
#pragma unroll
          for (int i = 0; i < 8; ++i) { const float z0 = bf2f(iv[2 * i]), z1 = bf2f(iv[2 * i + 1]); vp[i] = pk2(z0 * fsigmoid(z0), z1 * fsigmoid(z1)); }
          *(LAS u32x4*)(Vt + k * PK + tq * 32) = (u32x4){vp[0], vp[1], vp[2], vp[3]}; *(LAS u32x4*)(Vt + k * PK + tq * 32 + 16) = (u32x4){vp[4], vp[5], vp[6], vp[7]}; }
        __syncthreads();
        float off = 0.f;
#pragma unroll
        for (int j = 0; j < 4; ++j) { const float s = qsum[j * 128 + k]; if (j < tq) off += s; }
#pragma unroll
        for (int i = 0; i < 16; ++i) { const float bc = lf[i] + off; const float ed = fexp2(bc), edi = fexp2(-bc);
            *(LAS unsigned short*)(Qd + (16 * tq + i) * PQ + 2 * k) = (unsigned short)f2bf(bf2f(qv[i]) * ed);
            *(LAS unsigned short*)(Kd + (16 * tq + i) * PQ + 2 * k) = (unsigned short)f2bf(kk[i] * edi); }
#pragma unroll
        for (int j = 0; j < 4; ++j) { const int e = tid + 512 * j, v = e >> 4, k8 = e & 15; *(LAS u32x4*)(St + v * PQ + k8 * 16) = sreg[j]; }
        const unsigned lo_g = (unsigned)(4 * q) * NIN0 + 2560u + (unsigned)(h * 128 + 16 * w + r), lo_o = (unsigned)(4 * q) * D + 256u + (unsigned)(h * 128 + 16 * w + r);
        const bf16* crow = proj + (size_t)(b * SEQ + 64 * c) * NIN0;
        unsigned short gv[16];
#pragma unroll
        for (int ti = 0; ti < 4; ++ti)
#pragma unroll
            for (int i = 0; i < 4; ++i) { const bf16* up = crow + (size_t)(16 * ti + i) * NIN0; gv[ti * 4 + i] = up[lo_g]; }
        { const int nit = it + G;
          if (nit < 1536) { const int nbh = nit >> 5, nc = nit & 31, nb = nbh / 6, nh = nbh - 6 * nb; const unsigned lo_q = 256u + (unsigned)(nh * 128 + k);
              const bf16* prow = proj + (size_t)(nb * SEQ + 64 * nc + 16 * tq) * NIN0;
#pragma unroll
              for (int i = 0; i < 16; ++i) { const bf16* up = prow + (size_t)i * NIN0; qv[i] = up[lo_q]; fv[i] = up[lo_q + 768u]; iv[i] = up[lo_q + 1536u]; } } }
        __syncthreads();
        { const int ti = w >> 1;
#pragma unroll
          for (int sj = 0; sj < 2; ++sj) { const int si = 2 * (w & 1) + sj; f32x4 acc = {0.f, 0.f, 0.f, 0.f};
              if (si <= ti) {
#pragma unroll
                  for (int ks = 0; ks < 4; ++ks) { const bf16x8 av = *(const LAS bf16x8*)(Qd + (16 * ti + r) * PQ + ks * 64 + q * 16), bv = *(const LAS bf16x8*)(Kd + (16 * si + r) * PQ + ks * 64 + q * 16); acc = MFMA16(av, bv, acc); } }
#pragma unroll
              for (int i = 0; i < 4; ++i) { const int t = 16 * ti + 4 * q + i, s = 16 * si + r; *(LAS unsigned short*)(P + t * PK + 2 * s) = (unsigned short)f2bf(s <= t ? acc[i] : 0.f); } } }
        f32x4 o[4];
#pragma unroll
        for (int ti = 0; ti < 4; ++ti) o[ti] = (f32x4){0.f, 0.f, 0.f, 0.f};
        { bf16x8 bS[4];
#pragma unroll
          for (int ks = 0; ks < 4; ++ks) bS[ks] = *(const LAS bf16x8*)(St + (16 * w + r) * PQ + ks * 64 + q * 16);
#pragma unroll
          for (int ti = 0; ti < 4; ++ti)
#pragma unroll
              for (int ks = 0; ks < 4; ++ks) { const bf16x8 av = *(const LAS bf16x8*)(Qd + (16 * ti + r) * PQ + ks * 64 + q * 16); o[ti] = MFMA16(av, bS[ks], o[ti]); } }
        __syncthreads();
        { bf16x8 bV[2];
#pragma unroll
          for (int ks = 0; ks < 2; ++ks) bV[ks] = *(const LAS bf16x8*)(Vt + (16 * w + r) * PK + ks * 64 + q * 16);
#pragma unroll
          for (int ti = 0; ti < 4; ++ti)
#pragma unroll
              for (int ks = 0; ks < 2; ++ks) { const bf16x8 av = *(const LAS bf16x8*)(P + (16 * ti + r) * PK + ks * 64 + q * 16); o[ti] = MFMA16(av, bV[ks], o[ti]); } }
#pragma unroll
        for (int ti = 0; ti < 4; ++ti)
#pragma unroll
            for (int i = 0; i < 4; ++i) { float p = o[ti][i] * o[ti][i]; p += __shfl_xor(p, 1); p += __shfl_xor(p, 2); p += __shfl_xor(p, 4); p += __shfl_xor(p, 8);
                if (r == 0) part[w * 64 + 16 * ti + 4 * q + i] = p; }
        __syncthreads();
        if (tid < 64) { float s = 0.f;
#pragma unroll
            for (int j = 0; j < 8; ++j) s += part[j * 64 + tid];
            rsr[tid] = __builtin_amdgcn_rsqf(s * (1.0f / 128.0f) + EPS); }
        __syncthreads();
        const float gain_v = gain[h * 128 + 16 * w + r];
        bf16* orow = cat + (size_t)(b * SEQ + 64 * c) * D;
#pragma unroll
        for (int ti = 0; ti < 4; ++ti)
#pragma unroll
            for (int i = 0; i < 4; ++i) { const int t = 16 * ti + 4 * q + i; const float val = o[ti][i] * rsr[t] * gain_v * fsigmoid(bf2f(gv[ti * 4 + i]));
                bf16* up = orow + (size_t)(16 * ti + i) * D; up[lo_o] = (bf16)f2bf(val); }
    }
    __syncthreads();
}

__device__ __forceinline__ void conv_phase(const PArgs& a, int bid, int G, int tid) {
    unsigned char* ws = a.ws;
    const bf16* proj = (const bf16*)(ws + WS_SH); bf16* cat = (bf16*)(ws + WS_CAT); const float* cw = a.in[15];
    for (int gt = bid * NT + tid; gt < 1024 * 128; gt += G * NT) {
        const int cgp = gt & 127, rb = gt >> 7, b = rb >> 7, tl0 = (rb & 127) * 16, c0 = 8 * cgp;
        float w0[8], w1[8], w2[8], zm2[8], zm1[8];
#pragma unroll
        for (int e = 0; e < 8; ++e) { w0[e] = cw[c0 + e]; w1[e] = cw[1024 + c0 + e]; w2[e] = cw[2048 + c0 + e]; zm2[e] = 0.f; zm1[e] = 0.f; }
        const bf16* pr = proj + (size_t)(b * SEQ + tl0) * NIN1 + c0;
        if (tl0 > 0) { float cgv[8], hvv[8];
            unpack8(*(const u32x4*)(pr - 2 * NIN1 + 1024), cgv); unpack8(*(const u32x4*)(pr - 2 * NIN1 + 2048), hvv);
#pragma unroll
            for (int e = 0; e < 8; ++e) zm2[e] = cgv[e] * hvv[e];
            unpack8(*(const u32x4*)(pr - NIN1 + 1024), cgv); unpack8(*(const u32x4*)(pr - NIN1 + 2048), hvv);
#pragma unroll
            for (int e = 0; e < 8; ++e) zm1[e] = cgv[e] * hvv[e]; }
#pragma unroll 1
        for (int i = 0; i < 16; ++i) { float bgv[8], cgv[8], hvv[8], o[8];
            unpack8(*(const u32x4*)(pr + (size_t)i * NIN1), bgv); unpack8(*(const u32x4*)(pr + (size_t)i * NIN1 + 1024), cgv); unpack8(*(const u32x4*)(pr + (size_t)i * NIN1 + 2048), hvv);
#pragma unroll
            for (int e = 0; e < 8; ++e) { const float z = cgv[e] * hvv[e]; o[e] = bgv[e] * (w0[e] * zm2[e] + w1[e] * zm1[e] + w2[e] * z); zm2[e] = zm1[e]; zm1[e] = z; }
            *(u32x4*)(cat + (size_t)(b * SEQ + tl0 + i) * D + c0) = (u32x4){pk2(o[0], o[1]), pk2(o[2], o[3]), pk2(o[4], o[5]), pk2(o[6], o[7])};
            const int t = tl0 + i;
            if (t >= SEQ - 2) { float* co = a.out + O_CONVP + (size_t)(b * 2 + (t - (SEQ - 2))) * 1024 + c0;
                *(f32x4*)co = (f32x4){zm1[0], zm1[1], zm1[2], zm1[3]}; *(f32x4*)(co + 4) = (f32x4){zm1[4], zm1[5], zm1[6], zm1[7]}; } }
    }
    const bf16* projs = (const bf16*)(ws + WS_PROJS); bf16* cats = (bf16*)(ws + WS_CATS); const float* sc = a.in[4];
    for (int gt = bid * NT + tid; gt < MS * 128; gt += G * NT) {
        const int cgp = gt & 127, b = gt >> 7, c0 = 8 * cgp; float bgv[8], cgv[8], hvv[8], o[8], z[8];
        const bf16* pr = projs + (size_t)b * NIN1 + c0;
        unpack8(*(const u32x4*)pr, bgv); unpack8(*(const u32x4*)(pr + 1024), cgv); unpack8(*(const u32x4*)(pr + 2048), hvv);
        const float* p0 = sc + (size_t)(b * 2) * 1024 + c0; const float* p1 = p0 + 1024;
        float* co = a.out + O_CONVS + (size_t)(b * 2) * 1024 + c0;
#pragma unroll
        for (int e = 0; e < 8; ++e) { z[e] = cgv[e] * hvv[e]; o[e] = bgv[e] * (cw[c0 + e] * p0[e] + cw[1024 + c0 + e] * p1[e] + cw[2048 + c0 + e] * z[e]); co[e] = p1[e]; co[1024 + e] = z[e]; }
        *(u32x4*)(cats + (size_t)b * D + c0) = (u32x4){pk2(o[0], o[1]), pk2(o[2], o[3]), pk2(o[4], o[5]), pk2(o[6], o[7])};
    }
}

__device__ __forceinline__ void final_norm(const PArgs& a, int bid, int G, int wave, int lane) {
    const int gw = bid * NWAVES + wave, NGW = G * NWAVES; const float* gf = a.in[7]; const float* ss4 = (const float*)(a.ws + WS_SS) + 4 * MP;
    f32x4 gv[4];
#pragma unroll
    for (int j = 0; j < 4; ++j) gv[j] = ((const f32x4*)gf)[lane + 64 * j];
    for (int m = gw; m < MP + MS; m += NGW) {
        if (m < MP) { f32x4* yr = (f32x4*)(a.out + O_Y + (size_t)m * D) + lane; const u32x2* xr = (const u32x2*)((const bf16*)(a.ws + WS_XB) + (size_t)m * D) + lane;
            const float rs = __builtin_amdgcn_rsqf(ss4[m] * (1.0f / 1024.0f) + EPS);
#pragma unroll
            for (int j = 0; j < 4; ++j) { const u32x2 w = xr[64 * j]; const f32x4 v = {__uint_as_float(w.x << 16), __uint_as_float(w.x & 0xffff0000u), __uint_as_float(w.y << 16), __uint_as_float(w.y & 0xffff0000u)}; yr[64 * j] = v * rs * gv[j]; } }
        else { const int sr = m - MP; const f32x4* xr = (const f32x4*)((const float*)(a.ws + WS_XS) + (size_t)sr * D) + lane; f32x4* yr = (f32x4*)(a.out + O_YS + (size_t)sr * D) + lane;
            f32x4 v[4]; float s = 0.f;
#pragma unroll
            for (int j = 0; j < 4; ++j) { v[j] = xr[64 * j]; s += (v[j].x * v[j].x + v[j].y * v[j].y) + (v[j].z * v[j].z + v[j].w * v[j].w); }
            const float rs = __builtin_amdgcn_rsqf(wave_sum(s) * (1.0f / 1024.0f) + EPS);
#pragma unroll
            for (int j = 0; j < 4; ++j) yr[64 * j] = v[j] * rs * gv[j]; }
    }
}

#define XB_TMO      128
#define XB_XCNT(j)  (256  + 64 * (j))
#define XB_XSUB(j)  (1280 + 64 * (j))
#define XB_XGEN(j)  (2304 + 64 * (j))
#define XB_TOP      3328
#define XB_TOPGEN   3392
#define XCD_BAR_WORDS 3456
#define XB_SPIN_CAP (1u << 18)

__device__ __forceinline__ unsigned xb_ld(unsigned* p)              { return __hip_atomic_load(p, __ATOMIC_RELAXED, __HIP_MEMORY_SCOPE_AGENT); }
__device__ __forceinline__ unsigned xb_add(unsigned* p, unsigned v) { return __hip_atomic_fetch_add(p, v, __ATOMIC_RELAXED, __HIP_MEMORY_SCOPE_AGENT); }
__device__ __forceinline__ unsigned xb_xcc_id() { return (unsigned)__builtin_amdgcn_s_getreg((3 << 11) | 20) & 0xFu; }
#define XB_SPIN(cond, bar) do { unsigned _sp = 0; while (cond) { __builtin_amdgcn_s_sleep(1); \
    if ((++_sp & 255u) == 0u) { if (xb_ld(&(bar)[XB_TMO])) break; if (_sp > XB_SPIN_CAP) { atomicAdd(&(bar)[XB_TMO], 1u); break; } } } } while (0)

struct XcdBarrier {
    unsigned* bar; unsigned x;
    volatile LAS unsigned* st;
};

__device__ __forceinline__ XcdBarrier xcd_barrier_post(unsigned* bar, volatile LAS unsigned* st) {
    XcdBarrier b; b.bar = bar; b.x = xb_xcc_id(); b.st = st;
    if (threadIdx.x == 0) (void)xb_add(&bar[XB_XCNT(b.x)], 1u);
    return b;
}
__device__ __forceinline__ void xcd_barrier_complete(unsigned* bar, unsigned x, unsigned& nloc, unsigned& nx) {
    const unsigned G = gridDim.x * gridDim.y * gridDim.z;
    unsigned sum, cnt, mine, sp = 0u;
    for (;;) {
        sum = 0u; cnt = 0u; mine = 0u;
#pragma unroll
        for (unsigned j = 0; j < 16; ++j) { const unsigned c = xb_ld(&bar[XB_XCNT(j)]); sum += c; cnt += (c > 0u) ? 1u : 0u; mine = (j == x) ? c : mine; }
        if (sum == G) break;
        __builtin_amdgcn_s_sleep(1);
        if ((++sp & 255u) == 0u) { if (xb_ld(&bar[XB_TMO])) break; if (sp > XB_SPIN_CAP) { atomicAdd(&bar[XB_TMO], 1u); break; } }
    }
    nloc = mine > 0u ? mine : 1u; nx = cnt > 0u ? cnt : 1u;
}

__device__ __forceinline__ void xcd_barrier(const XcdBarrier& b) {
    asm volatile("s_waitcnt vmcnt(0)" ::: "memory");
    __syncthreads();
    if (threadIdx.x == 0) {
        unsigned* bar = b.bar;
        __builtin_amdgcn_s_waitcnt(0);
        unsigned nloc = b.st[0], nx = b.st[1];
        if (nloc == 0u) { xcd_barrier_complete(bar, b.x, nloc, nx); b.st[0] = nloc; b.st[1] = nx; }
        const unsigned old = xb_add(&bar[XB_XSUB(b.x)], 1u);
        const unsigned gen = old / nloc;
        if (old + 1u == (gen + 1u) * nloc) {
            __builtin_amdgcn_fence(__ATOMIC_RELEASE, "agent");
            asm volatile("s_waitcnt vmcnt(0)" ::: "memory");
            const unsigned og = xb_add(&bar[XB_TOP], 1u);
            const unsigned tg = og / nx;
            if (og + 1u == (tg + 1u) * nx) xb_add(&bar[XB_TOPGEN], 1u);
            else XB_SPIN(xb_ld(&bar[XB_TOPGEN]) == tg, bar);
            __builtin_amdgcn_fence(__ATOMIC_ACQUIRE, "agent");
            xb_add(&bar[XB_XGEN(b.x)], 1u);
            asm volatile("s_waitcnt vmcnt(0)" ::: "memory");
        } else {
            XB_SPIN(xb_ld(&bar[XB_XGEN(b.x)]) == gen, bar);
            __builtin_amdgcn_fence(__ATOMIC_ACQUIRE, "agent");
            asm volatile("s_waitcnt vmcnt(0)" ::: "memory");
        }
    }
    __syncthreads();
}

#ifndef DIS_GEMM
#define DIS_GEMM 0
#endif
#ifndef DIS_SGEMM
#define DIS_SGEMM 0
#endif
#ifndef DIS_HGRN
#define DIS_HGRN 0
#endif
#ifndef DIS_OTHER
#define DIS_OTHER 0
#endif
#ifndef DBG_O
#define DBG_O 15
#endif
#ifndef DUPK
#define DUPK 0
#endif
#ifndef DBG_XSYNC
#define DBG_XSYNC 0
#endif
#ifndef DBG_COL
#define DBG_COL 2304
#endif
#ifndef DBG_HI
#define DBG_HI 12
#endif
#ifndef MK_MULTI
#define MK_MULTI 0
#endif
constexpr int N_PHASES = 12;
#define IN(k) (lo <= (k) && (k) < hi)
#define SEAM(k) do { if (IN(k) && IN((k) + 1)) xcd_barrier(xbar); } while (0)
template <int L>
__device__ __forceinline__ void layer_phases(const PArgs& a, LAS unsigned char* lds, const XcdBarrier& xbar, int lo, int hi, int bid, int G, int tid, int wave, int lane) {
    unsigned char* ws = a.ws;
    float* ss = (float*)(ws + WS_SS);
    bf16* CAT = (bf16*)(ws + WS_CAT); bf16* SH = (bf16*)(ws + WS_SH); bf16* XB = (bf16*)(ws + WS_XB);
    float* xs = (float*)(ws + WS_XS); bf16* projs = (bf16*)(ws + WS_PROJS); bf16* cats = (bf16*)(ws + WS_CATS); bf16* hs = (bf16*)(ws + WS_HS);
    float* Y = a.out + O_Y;
    constexpr int pb = 1 + 5 * L;
    const bf16* Win = (const bf16*)(ws + (L ? WS_WIN1 : WS_WIN0)); const bf16* Wout = (const bf16*)(ws + (L ? WS_WOUT1 : WS_WOUT0));
    const bf16* W1 = (const bf16*)(ws + (L ? WS_W11 : WS_W10)); const bf16* W2 = (const bf16*)(ws + (L ? WS_W21 : WS_W20));
    constexpr int Nin = L ? NIN1 : NIN0;
    if (IN(pb)) {
        pg8::Gemm g{L ? XB : CAT, Win, MP, Nin, D}; pg8::StaticOrder S; S.init(MP, Nin, G, bid);
        pg8::EpiScaleBf16<0> E{SH, Nin, ss + (L ? 2 : 0) * MP};
        for (int rep = 0; rep < (DUPK == 5 ? 2 : 1); ++rep) pg8::gemm_phase<pg8::EpiScaleBf16<0>, pg8::StaticOrder, true, true>(lds, g, S, E);
        for (int rep = 0; rep < (DUPK == 1 ? 2 : 1); ++rep) sgemm<true, 0, 4>(lds, L ? (const void*)xs : (const void*)a.in[1], D, Win, Nin, D, 1, projs, Nin, xs, G, bid, tid, wave, lane, (L == 0 && G == 256) ? 64 : 0);
    }
    SEAM(pb);
    if (IN(pb + 1)) {
        if (L == 0) {
            bf16* dS = (bf16*)(ws + WS_DS); float* eblg = (float*)(ws + WS_EBL);
            if (bid & 1) for (int it = bid; it < MS * 6; it += 3 * G) hgrn_sample3(lds, projs, a.in[3], a.in[11], a.in[12], cats, a.out + O_HGS, it, G, tid, wave, lane);
            hgrn_stepA(lds, SH, a.in[11], dS, eblg, bid, G, wave, lane);
            if (!(bid & 1)) for (int it = bid; it < MS * 6; it += 3 * G) hgrn_sample3(lds, projs, a.in[3], a.in[11], a.in[12], cats, a.out + O_HGS, it, G, tid, wave, lane);
            pool_prompt_all(lds, SH, a.in[9], a.in[10], CAT, a.out + O_POOLP, bid, G, tid, wave, lane);
            xcd_barrier(xbar);
            if (!DIS_HGRN) hgrn_stepB(dS, eblg, a.out + O_HGP, bid, G, tid);
            if (bid >= 192) for (int it = bid - 192; it < 8; it += G - 192) pool_sample(lds, projs, a.in[2], a.in[9], a.in[10], cats, a.out + O_POOLS, it, tid);
            else if (G <= 192) for (int it = bid; it < 8; it += G) pool_sample(lds, projs, a.in[2], a.in[9], a.in[10], cats, a.out + O_POOLS, it, tid);
            xcd_barrier(xbar);
            if (!DIS_HGRN) hgrn_stepC(lds, SH, a.in[11], a.in[12], dS, CAT, bid, G, tid, wave, lane);
        } else { conv_phase(a, bid, G, tid); }
    }
    SEAM(pb + 1);
    if (IN(pb + 2)) {
        pg8::Gemm g{CAT, Wout, MP, D, D}; pg8::StaticOrder S; S.init(MP, D, G, bid);
        pg8::EpiResid E{L ? (const float*)nullptr : a.in[0], XB, ss + (L ? 3 : 1) * MP};
        if (DUPK == 6) { pg8::EpiNull EN{Y, a.ph_lo}; pg8::gemm_phase<pg8::EpiNull, pg8::StaticOrder, true, true>(lds, g, S, EN); }
        if (!DIS_GEMM) pg8::gemm_phase<pg8::EpiResid, pg8::StaticOrder, true, true>(lds, g, S, E);
        if (!DIS_SGEMM) sgemm<false, 2, 1>(lds, cats, D, Wout, D, D, 4, nullptr, 0, xs, G, bid, tid, wave, lane);
    }
    SEAM(pb + 2);
    if (IN(pb + 3)) {
        pg8::Gemm g{XB, W1, MP, FF, D}; pg8::StaticOrder S; S.init(MP, FF, G, bid);
        pg8::EpiScaleBf16<1> E{SH, FF, ss + (L ? 3 : 1) * MP};
        for (int rep = 0; rep < (DUPK == 2 ? 2 : 1); ++rep) pg8::gemm_phase<pg8::EpiScaleBf16<1>, pg8::StaticOrder, true, true>(lds, g, S, E);
        for (int rep = 0; rep < (DUPK == 1 ? 2 : 1); ++rep) sgemm<true, 1, 4>(lds, xs, D, W1, FF, D, 1, hs, FF, xs, G, bid, tid, wave, lane);
    }
    SEAM(pb + 3);
    if (IN(pb + 4)) {
        pg8::Gemm g{SH, W2, MP, D, FF}; pg8::StaticOrder S; S.init(MP, D, G, bid);
        pg8::EpiResid E{nullptr, XB, ss + (L ? 4 : 2) * MP};
        if (DUPK == 7) { pg8::EpiNull EN{Y, a.ph_lo}; pg8::gemm_phase<pg8::EpiNull, pg8::StaticOrder, true, true>(lds, g, S, EN); }
        if (!DIS_GEMM) pg8::gemm_phase<pg8::EpiResid, pg8::StaticOrder, true, true>(lds, g, S, E);
        if (!DIS_SGEMM) sgemm<false, 2, 4>(lds, hs, FF, W2, D, FF, 4, nullptr, 0, xs, G, bid, tid, wave, lane);
    }
    SEAM(pb + 4);
}
__global__ void __launch_bounds__(NT, 2) mk_fwd(PArgs a) {
    extern __shared__ __attribute__((aligned(16))) unsigned char lds_raw[];
    LAS unsigned char* lds = (LAS unsigned char*)lds_raw;
    const int tid = threadIdx.x, lane = tid & 63, wave = __builtin_amdgcn_readfirstlane(tid >> 6), bid = blockIdx.x, G = gridDim.x;
    const int lo = a.ph_lo, hi = a.ph_hi;
    volatile LAS unsigned* xst = (volatile LAS unsigned*)(lds + 131072 + 64);
    if (tid < 2) xst[tid] = 0u;
    __syncthreads();
    const XcdBarrier xbar = xcd_barrier_post((unsigned*)a.ws, xst);
    if (lo < 0) cg::this_grid().sync();
    if (IN(0)) { for (int rep = 0; rep < (DUPK == 3 ? 2 : 1); ++rep) { p0_prologue(a, lds, bid, G, tid, wave, lane); __syncthreads(); } }
    SEAM(0);
    layer_phases<0>(a, lds, xbar, lo, hi, bid, G, tid, wave, lane);
    layer_phases<1>(a, lds, xbar, lo, hi, bid, G, tid, wave, lane);
    for (int xx = 0; xx < DBG_XSYNC; ++xx) xcd_barrier(xbar);
    if (IN(11)) final_norm(a, bid, G, wave, lane);
    if (hi < 12) {
        if (hi <= 3) { cg::this_grid().sync(); const bf16* C = (const bf16*)(a.ws + WS_CAT); for (size_t i = (size_t)bid * NT + tid; i < O_YS; i += (size_t)G * NT) a.out[i] = ((i & 1023) >= 256) ? bf2f(C[i]) : 0.f; }
        for (size_t i = (size_t)bid * NT + tid; i < 131072; i += (size_t)G * NT) a.out[O_YS + i] = 0.f;
        if (hi <= 2) for (size_t i = (size_t)bid * NT + tid + O_POOLP; i < O_CONVS; i += (size_t)G * NT) a.out[i] = 0.f;
        if (hi <= 7) { for (size_t i = (size_t)bid * NT + tid; i < 16384; i += (size_t)G * NT) a.out[O_CONVP + i] = 0.f;
                       for (size_t i = (size_t)bid * NT + tid; i < 262144; i += (size_t)G * NT) a.out[O_CONVS + i] = 0.f; }
    }
}
#undef IN
#undef SEAM

extern "C" void kernel_launch(void* const* d_in, const int* in_sizes, int n_in, void* d_out, int out_size, void* d_ws, size_t ws_size, hipStream_t stream) {
    static int grid = 0;
    if (grid == 0) {
        if (n_in != 19 || ws_size < WS_END) { fprintf(stderr, "kernel_launch: unexpected inputs (n_in %d, ws %zu)\n", n_in, ws_size); grid = -1; return; }
        int dev = 0, cus = 0, per_cu = 0;
        if (hipGetDevice(&dev) != hipSuccess || hipDeviceGetAttribute(&cus, hipDeviceAttributeMultiprocessorCount, dev) != hipSuccess) { grid = -1; return; }
        if (hipFuncSetAttribute((const void*)mk_fwd, hipFuncAttributeMaxDynamicSharedMemorySize, LDS_BYTES) != hipSuccess) { fprintf(stderr, "kernel_launch: hipFuncSetAttribute failed\n"); grid = -1; return; }
        if (hipOccupancyMaxActiveBlocksPerMultiprocessor(&per_cu, (const void*)mk_fwd, NT, LDS_BYTES) != hipSuccess || per_cu < 1) { fprintf(stderr, "kernel_launch: occupancy query says %d\n", per_cu); per_cu = 1; }
        (void)hipGetLastError();
        grid = cus;
    }
    if (grid < 0) return;
    PArgs a{};
    for (int i = 0; i < 19; ++i) a.in[i] = (const float*)d_in[i];
    a.out = (float*)d_out; a.ws = (unsigned char*)d_ws;
#if MK_MULTI
    for (int k = 0; k < DBG_HI; ++k) { a.ph_lo = k; a.ph_hi = k + 1; hipLaunchKernelGGL(mk_fwd, dim3(grid), dim3(NT), LDS_BYTES, stream, a); }
#else
    a.ph_lo = 0; a.ph_hi = DBG_HI;
    if (hipMemsetAsync(d_ws, 0, 16384, stream) != hipSuccess) { fprintf(stderr, "kernel_launch: hipMemsetAsync failed\n"); return; }
    void* args[] = {&a};
    hipError_t e = hipLaunchCooperativeKernel((const void*)mk_fwd, dim3(grid), dim3(NT), args, LDS_BYTES, stream);
    if (e != hipSuccess) fprintf(stderr, "cooperative launch failed: %s (grid %d)\n", hipGetErrorString(e), grid);
#endif
}
```

```cpp
#include <hip/hip_runtime.h>
#include <hip/hip_cooperative_groups.h>
#include <cstdio>
#include <cstdint>
namespace cg = cooperative_groups;
#ifndef DBG_O
#define DBG_O 15
#endif
namespace pg8 {
#define PG8_LAS __attribute__((address_space(3)))
typedef unsigned short bf16_t;
typedef short bf16x8 __attribute__((ext_vector_type(8)));
typedef float f32x4 __attribute__((ext_vector_type(4)));
typedef unsigned u32x4 __attribute__((ext_vector_type(4)));
typedef unsigned u32x2 __attribute__((ext_vector_type(2)));
constexpr int BM = 256, BK = 64, HALF = 128, HTB = HALF * BK * 2  , STAGE_BYTES = 8 * HTB, NXCD = 8, WGM = 8;

__host__ __device__ __forceinline__ int lds_byte(int r, int c) { const int st = (r >> 4) * 2 + (c >> 5), rr = r & 15, cc = c & 31, ob = rr * 64 + cc * 2; return st * 1024 + (ob ^ (((ob >> 9) & 1) << 5)); }
__host__ __device__ __forceinline__ void stage_rc(int b, int& R, int& C) { const int st = b / 1024, sb = b % 1024, swz = sb ^ (((sb >> 9) & 1) << 5); R = (st >> 1) * 16 + swz / 64; C = (st & 1) * 32 + (swz % 64) / 2; }
__host__ __device__ __forceinline__ int perm32(int rho) { const int n = rho >> 4, i = rho & 15; return 8 * (i >> 2) + 4 * n + (i & 3); }

struct Unit { int pm, pn; };
struct Gemm { const bf16_t* A; const bf16_t* Bt; int M, N, K; };

struct StaticOrder {
    int nM, nN, nwg, G, c;
    __host__ __device__ void init(int M, int N, int G_, int c_) { nM = M / BM; nN = N / BM; nwg = nM * nN; G = G_; c = c_; }
    __host__ __device__ bool next(int i, Unit& u) const {
        const long L = (long)i * G + c; if (L >= nwg) return false;
        int wgid = (int)L; { const int q = nwg / NXCD, r = nwg % NXCD, xcd = wgid % NXCD, off = wgid / NXCD; wgid = (xcd < r ? xcd * (q + 1) : r * (q + 1) + (xcd - r) * q) + off; }
        const int nig = WGM * nN, gid = wgid / nig, fm = gid * WGM, gsz = (nM - fm) < WGM ? (nM - fm) : WGM;
        u.pm = fm + ((wgid % nig) % gsz); u.pn = (wgid % nig) / gsz; return true;
    }
    __device__ __forceinline__ void a_ready(const Unit&) const {}
    __device__ __forceinline__ void done(const Unit&) const {}
};

__device__ __forceinline__ unsigned cvt_pk_bf16(float lo, float hi) { unsigned r; asm volatile("v_cvt_pk_bf16_f32 %0, %1, %2" : "=v"(r) : "v"(lo), "v"(hi)); return r; }
template <int ACT  > struct EpiScaleBf16 {
    static constexpr bool PERM = true, AFTER_DRAIN = false;
    bf16_t* O; int ldc; const float* ss;
    __device__ __forceinline__ void operator()(const f32x4 (&acc)[2][2][4][2], const Unit& u, int wr, int wc, int fr, int fq) const {
        const int row0 = u.pm * BM + wr * 64 + fr, col0 = u.pn * BM + wc * 32 + 8 * fq;
#pragma unroll
        for (int ai = 0; ai < 2; ++ai)
#pragma unroll
            for (int m = 0; m < 4; ++m) { const int row = row0 + ai * HALF + m * 16; const float rs = __builtin_amdgcn_rsqf(ss[row] * (1.0f / 1024.0f) + 1e-6f);
                bf16_t* rowp = O + (size_t)row * ldc + col0;
#pragma unroll
                for (int bj = 0; bj < 2; ++bj) { f32x4 v0 = acc[ai][bj][m][0] * rs, v1 = acc[ai][bj][m][1] * rs;
                    if (ACT == 1) {
#pragma unroll
                        for (int e = 0; e < 4; ++e) { const float a = fmaxf(v0[e], 0.f), b = fmaxf(v1[e], 0.f); v0[e] = a * a; v1[e] = b * b; } }
                    u32x4 w; w.x = cvt_pk_bf16(v0[0], v0[1]); w.y = cvt_pk_bf16(v0[2], v0[3]); w.z = cvt_pk_bf16(v1[0], v1[1]); w.w = cvt_pk_bf16(v1[2], v1[3]);
                    *(u32x4*)(rowp + bj * HALF) = w; } }
    }
};
struct EpiNull {
    static constexpr bool PERM = true, AFTER_DRAIN = false;
    float* out; int never;
    __device__ __forceinline__ void operator()(const f32x4 (&acc)[2][2][4][2], const Unit& u, int wr, int wc, int fr, int fq) const {
        if (never) {
#pragma unroll
            for (int ai = 0; ai < 2; ++ai)
#pragma unroll
                for (int m = 0; m < 4; ++m)
#pragma unroll
                    for (int bj = 0; bj < 2; ++bj) { *(f32x4*)(out + (size_t)(u.pm * BM + wr * 64 + fr + ai * HALF + m * 16) * 1024 + u.pn * BM + wc * 32 + 8 * fq + bj * HALF) = acc[ai][bj][m][0] + acc[ai][bj][m][1]; } }
    }
};
struct EpiResid {
    static constexpr bool PERM = true, AFTER_DRAIN = false;
    const float* base32; bf16_t* xb; float* ss;
    __device__ __forceinline__ void operator()(const f32x4 (&acc)[2][2][4][2], const Unit& u, int wr, int wc, int fr, int fq) const {
        typedef float f32x2v __attribute__((ext_vector_type(2))); typedef __bf16 bf16x2v __attribute__((ext_vector_type(2)));
        const int row0 = u.pm * BM + wr * 64 + fr, col0 = u.pn * BM + wc * 32 + 8 * fq;
#pragma unroll
        for (int ai = 0; ai < 2; ++ai) {
            f32x4 bv[4][2][2];
            if (base32) {
#pragma unroll
                for (int m = 0; m < 4; ++m)
#pragma unroll
                    for (int bj = 0; bj < 2; ++bj)
#pragma unroll
                        for (int n = 0; n < 2; ++n) bv[m][bj][n] = *(const f32x4*)(base32 + (size_t)(row0 + ai * HALF + m * 16) * 1024 + col0 + bj * HALF + n * 4);
            } else {
                u32x4 raw[4][2];
#pragma unroll
                for (int m = 0; m < 4; ++m)
#pragma unroll
                    for (int bj = 0; bj < 2; ++bj) raw[m][bj] = *(const u32x4*)(xb + (size_t)(row0 + ai * HALF + m * 16) * 1024 + col0 + bj * HALF);
#pragma unroll
                for (int m = 0; m < 4; ++m)
#pragma unroll
                    for (int bj = 0; bj < 2; ++bj) { const u32x4 w = raw[m][bj];
                        bv[m][bj][0] = (f32x4){__uint_as_float(w.x << 16), __uint_as_float(w.x & 0xffff0000u), __uint_as_float(w.y << 16), __uint_as_float(w.y & 0xffff0000u)};
                        bv[m][bj][1] = (f32x4){__uint_as_float(w.z << 16), __uint_as_float(w.z & 0xffff0000u), __uint_as_float(w.w << 16), __uint_as_float(w.w & 0xffff0000u)}; }
            }
#pragma unroll
            for (int m = 0; m < 4; ++m) { const int row = row0 + ai * HALF + m * 16; const size_t off = (size_t)row * 1024 + col0; float sq = 0.f;
#pragma unroll
                for (int bj = 0; bj < 2; ++bj) { const f32x4 x0 = bv[m][bj][0] + acc[ai][bj][m][0], x1 = bv[m][bj][1] + acc[ai][bj][m][1];
                    sq += (x0[0] * x0[0] + x0[1] * x0[1]) + (x0[2] * x0[2] + x0[3] * x0[3]) + (x1[0] * x1[0] + x1[1] * x1[1]) + (x1[2] * x1[2] + x1[3] * x1[3]);
                    const f32x2v a0 = {x0[0], x0[1]}, a1 = {x0[2], x0[3]}, a2 = {x1[0], x1[1]}, a3 = {x1[2], x1[3]}; u32x4 w;
                    w.x = __builtin_bit_cast(unsigned, __builtin_convertvector(a0, bf16x2v)); w.y = __builtin_bit_cast(unsigned, __builtin_convertvector(a1, bf16x2v));
                    w.z = __builtin_bit_cast(unsigned, __builtin_convertvector(a2, bf16x2v)); w.w = __builtin_bit_cast(unsigned, __builtin_convertvector(a3, bf16x2v));
                    *(u32x4*)(xb + off + bj * HALF) = w; }
                sq += __shfl_xor(sq, 16); sq += __shfl_xor(sq, 32);
                if (fq == 0) atomicAdd(ss + row, sq); }
            asm volatile("" ::: "memory"); }
    }
};
template <class Epi, class Sched, bool ALIGN_EPI = false, bool SP2 = false>
__device__ __forceinline__ void gemm_phase(PG8_LAS unsigned char* lds, const Gemm g, const Sched& S, const Epi& E) {
    const int tid = threadIdx.x, wid = __builtin_amdgcn_readfirstlane(tid >> 6), lane = tid & 63, wr = wid >> 2, wc = wid & 3, fr = lane & 15, fq = lane >> 4;
    const int K = g.K, nt = K / BK;
    unsigned voffA[2], voffB[2];
#pragma unroll
    for (int i = 0; i < 2; ++i) { int R, C; stage_rc(tid * 16 + i * 8192, R, C); const int Rb = Epi::PERM ? ((R & ~31) + perm32(R & 31)) : R;
        voffA[i] = (unsigned)(R * K + C) * 2u; voffB[i] = (unsigned)(Rb * K + C) * 2u; }
    const size_t kstep = (size_t)(BK * 2);
    const size_t hstep = (size_t)HALF * K * 2;
    const size_t tstep = 2 * hstep;
    const unsigned ldsw = (unsigned)wid * 1024u;
    const int aoff = lds_byte(wr * 64 + fr, fq * 8), boff = lds_byte(wc * 32 + fr, fq * 8);
#define PG8_SA(b, h) (((b) * 2 + (h)) * HTB)
#define PG8_SB(b, h) ((4 + (b) * 2 + (h)) * HTB)
#define PG8_STAGE(bufoff, gbase, voff) do { _Pragma("unroll") for (int _i = 0; _i < 2; ++_i) \
        __builtin_amdgcn_global_load_lds((const unsigned*)((const char*)(gbase) + (voff)[_i]), (PG8_LAS unsigned*)(lds + (bufoff) + ldsw + _i * 8192), 16, 0, 0); } while (0)
#define PG8_LDA(dst, b, h) do { _Pragma("unroll") for (int m = 0; m < 4; ++m) _Pragma("unroll") for (int k = 0; k < 2; ++k) dst[m][k] = *(const PG8_LAS bf16x8*)(lds + PG8_SA(b, h) + aoff + m * 2048 + k * 1024); } while (0)
#define PG8_LDB(dst, b, h) do { _Pragma("unroll") for (int n = 0; n < 2; ++n) _Pragma("unroll") for (int k = 0; k < 2; ++k) dst[n][k] = *(const PG8_LAS bf16x8*)(lds + PG8_SB(b, h) + boff + n * 2048 + k * 1024); } while (0)
#define PG8_MMA(ai, bj, At, Bt) do { __builtin_amdgcn_s_setprio(1); _Pragma("unroll") for (int m = 0; m < 4; ++m) _Pragma("unroll") for (int n = 0; n < 2; ++n) _Pragma("unroll") for (int k = 0; k < 2; ++k) \
        acc[ai][bj][m][n] = __builtin_amdgcn_mfma_f32_16x16x32_bf16(Bt[n][k], At[m][k], acc[ai][bj][m][n], 0, 0, 0); __builtin_amdgcn_s_setprio(0); } while (0)
#define PG8_WAIT_V(n) asm volatile("s_waitcnt vmcnt(" #n ")" ::: "memory")
#define PG8_WAIT_L(n) asm volatile("s_waitcnt lgkmcnt(" #n ")" ::: "memory")
#define PG8_BAR __builtin_amdgcn_s_barrier()
#define PG8_SCHED __builtin_amdgcn_sched_barrier(0)
    Unit cur, nxt; int ui = 0;
    if (!S.next(0, cur)) return;
    f32x4 acc[2][2][4][2];
#pragma unroll
    for (int a = 0; a < 2; ++a)
#pragma unroll
        for (int b = 0; b < 2; ++b)
#pragma unroll
            for (int m = 0; m < 4; ++m)
#pragma unroll
                for (int n = 0; n < 2; ++n) acc[a][b][m][n] = (f32x4){0.f, 0.f, 0.f, 0.f};
    bf16x8 At[4][2], B0[2][2], B1[2][2];
    const char* cA = (const char*)g.A + (size_t)cur.pm * tstep; const char* cB = (const char*)g.Bt + (size_t)cur.pn * tstep;
    S.a_ready(cur);
    if constexpr (SP2) {
        PG8_STAGE(PG8_SB(0, 0), cB, voffB); PG8_STAGE(PG8_SB(0, 1), cB + hstep, voffB); PG8_STAGE(PG8_SA(0, 0), cA, voffA); PG8_STAGE(PG8_SA(0, 1), cA + hstep, voffA);
        if (wr == 1) PG8_BAR;
        PG8_WAIT_V(2); PG8_BAR;
        PG8_STAGE(PG8_SB(1, 0), cB + kstep, voffB); PG8_STAGE(PG8_SA(1, 0), cA + kstep, voffA); PG8_STAGE(PG8_SB(1, 1), cB + hstep + kstep, voffB);
        PG8_WAIT_V(6); PG8_BAR;
    } else {
        PG8_STAGE(PG8_SB(0, 0), cB, voffB); PG8_STAGE(PG8_SA(0, 0), cA, voffA); PG8_STAGE(PG8_SB(0, 1), cB + hstep, voffB); PG8_STAGE(PG8_SA(0, 1), cA + hstep, voffA);
        if (wr == 1) PG8_BAR;
        PG8_WAIT_V(4); PG8_BAR;
        PG8_STAGE(PG8_SB(1, 0), cB + kstep, voffB); PG8_STAGE(PG8_SA(1, 0), cA + kstep, voffA); PG8_STAGE(PG8_SB(1, 1), cB + hstep + kstep, voffB);
        PG8_WAIT_V(6); PG8_BAR;
    }
    for (;;) {
        const bool has_next = S.next(ui + 1, nxt);
        const char* nA = has_next ? (const char*)g.A + (size_t)nxt.pm * tstep : cA; const char* nB = has_next ? (const char*)g.Bt + (size_t)nxt.pn * tstep : cB;
        for (int t = 0; t < nt; t += 2) {
            const bool last = (t == nt - 2);
            const char* a1 = cA + (size_t)(t + 1) * kstep;
            const char* a2 = last ? nA : cA + (size_t)(t + 2) * kstep; const char* b2 = last ? nB : cB + (size_t)(t + 2) * kstep;
            const char* a3 = a2 + kstep; const char* b3 = b2 + kstep;
            if (last && has_next) S.a_ready(nxt);
            if constexpr (SP2) {
            PG8_LDB(B0, 0, 0); PG8_LDB(B1, 0, 1); PG8_SCHED; PG8_LDA(At, 0, 0); PG8_STAGE(PG8_SA(1, 1), a1 + hstep, voffA);
            PG8_WAIT_V(8); PG8_WAIT_L(0); PG8_BAR; PG8_MMA(0, 0, At, B0); PG8_MMA(0, 1, At, B1); PG8_BAR; PG8_SCHED;
            PG8_LDA(At, 0, 1); PG8_STAGE(PG8_SB(0, 0), b2, voffB); PG8_STAGE(PG8_SB(0, 1), b2 + hstep, voffB); PG8_STAGE(PG8_SA(0, 0), a2, voffA);
            PG8_WAIT_V(8); PG8_WAIT_L(0); PG8_BAR; PG8_MMA(1, 0, At, B0); PG8_MMA(1, 1, At, B1); PG8_BAR; PG8_SCHED;
            PG8_LDB(B0, 1, 0); PG8_LDB(B1, 1, 1); PG8_SCHED; PG8_LDA(At, 1, 0); PG8_STAGE(PG8_SA(0, 1), a2 + hstep, voffA);
            PG8_WAIT_V(8); PG8_WAIT_L(0); PG8_BAR; PG8_MMA(0, 0, At, B0); PG8_MMA(0, 1, At, B1); PG8_BAR; PG8_SCHED;
            PG8_LDA(At, 1, 1); PG8_STAGE(PG8_SB(1, 0), b3, voffB); PG8_STAGE(PG8_SB(1, 1), b3 + hstep, voffB); PG8_STAGE(PG8_SA(1, 0), a3, voffA);
            PG8_WAIT_V(8); PG8_WAIT_L(0); PG8_BAR; PG8_MMA(1, 0, At, B0); PG8_MMA(1, 1, At, B1); PG8_BAR; PG8_SCHED;
            } else {
            PG8_LDB(B0, 0, 0); PG8_SCHED; PG8_LDA(At, 0, 0); PG8_STAGE(PG8_SA(1, 1), a1 + hstep, voffA);
            PG8_WAIT_L(8); PG8_BAR; PG8_WAIT_L(0); PG8_MMA(0, 0, At, B0); PG8_BAR; PG8_SCHED;
            PG8_LDB(B1, 0, 1); PG8_STAGE(PG8_SB(0, 0), b2, voffB);
            PG8_BAR; PG8_WAIT_L(0); PG8_MMA(0, 1, At, B1); PG8_BAR;
            PG8_LDA(At, 0, 1); PG8_STAGE(PG8_SA(0, 0), a2, voffA);
            PG8_BAR; PG8_WAIT_L(0); PG8_MMA(1, 0, At, B0); PG8_BAR; PG8_SCHED;
            PG8_STAGE(PG8_SB(0, 1), b2 + hstep, voffB);
            PG8_WAIT_V(6); PG8_BAR; PG8_MMA(1, 1, At, B1); PG8_BAR;
            PG8_LDB(B0, 1, 0); PG8_SCHED; PG8_LDA(At, 1, 0); PG8_STAGE(PG8_SA(0, 1), a2 + hstep, voffA);
            PG8_WAIT_L(8); PG8_BAR; PG8_WAIT_L(0); PG8_MMA(0, 0, At, B0); PG8_BAR; PG8_SCHED;
            PG8_LDB(B1, 1, 1); PG8_STAGE(PG8_SB(1, 0), b3, voffB);
            PG8_BAR; PG8_WAIT_L(0); PG8_MMA(0, 1, At, B1); PG8_BAR;
            PG8_LDA(At, 1, 1); PG8_STAGE(PG8_SA(1, 0), a3, voffA);
            PG8_BAR; PG8_WAIT_L(0); PG8_MMA(1, 0, At, B0); PG8_BAR; PG8_SCHED;
            PG8_STAGE(PG8_SB(1, 1), b3 + hstep, voffB);
            PG8_WAIT_V(6); PG8_BAR; PG8_MMA(1, 1, At, B1); PG8_BAR;
            }
        }
        if constexpr (ALIGN_EPI) { if (wr == 0) PG8_BAR; }
        if constexpr (!Epi::AFTER_DRAIN) { E(acc, cur, wr, wc, fr, fq); S.done(cur); }
        if (!has_next) break;
#pragma unroll
        for (int a = 0; a < 2; ++a)
#pragma unroll
            for (int b = 0; b < 2; ++b)
#pragma unroll
                for (int m = 0; m < 4; ++m)
#pragma unroll
                    for (int n = 0; n < 2; ++n) acc[a][b][m][n] = (f32x4){0.f, 0.f, 0.f, 0.f};
        cur = nxt; cA = nA; cB = nB; ++ui;
        if constexpr (ALIGN_EPI) { if (wr == 1) PG8_BAR; }
    }
    PG8_WAIT_V(0);
    if constexpr (!ALIGN_EPI) { if (wr == 0) PG8_BAR; }
    PG8_BAR;
    if constexpr (Epi::AFTER_DRAIN) { E.fused(acc, cur, wr, wc, fr, fq, lds, wid, lane); S.done(cur); }
#undef PG8_SA
#undef PG8_SB
#undef PG8_STAGE
#undef PG8_LDA
#undef PG8_LDB
#undef PG8_MMA
#undef PG8_WAIT_V
#undef PG8_WAIT_L
#undef PG8_BAR
#undef PG8_SCHED
}
}

constexpr int NWAVES = 8, NT = 512;
constexpr int D = 1024, MP = 16384, SEQ = 2048, MS = 128, FF = 4096;
constexpr int NIN0 = 3328, NIN1 = 3072;
constexpr float EPS = 1e-6f, LOG2E = 1.4426950408889634f;
constexpr size_t MiB = 1u << 20;
constexpr size_t WS_SS = 1 * MiB, WS_XS = 2 * MiB, WS_PROJS = 3 * MiB, WS_CATS = 4 * MiB, WS_HS = 5 * MiB;
constexpr size_t WS_WIN0 = 8 * MiB, WS_WOUT0 = 15 * MiB, WS_W10 = 17 * MiB, WS_W20 = 25 * MiB, WS_WIN1 = 33 * MiB, WS_WOUT1 = 39 * MiB, WS_W11 = 41 * MiB, WS_W21 = 49 * MiB;
constexpr size_t WS_CAT = 58 * MiB, WS_SH = 90 * MiB, WS_XB = 218 * MiB, WS_END = 250 * MiB;
constexpr size_t WS_DS = 194 * MiB, WS_EBL = 6 * MiB;
constexpr size_t O_Y = 0, O_YS = 16777216, O_POOLP = 16908288, O_HGP = 16939008, O_CONVP = 17725440, O_POOLS = 17741824, O_HGS = 18233344, O_CONVS = 30816256;
constexpr int LDS_BYTES = 143360;

#define LAS __attribute__((address_space(3)))
typedef unsigned short bf16;
typedef float f32x4 __attribute__((ext_vector_type(4)));
typedef short bf16x8 __attribute__((ext_vector_type(8)));
typedef unsigned u32x4 __attribute__((ext_vector_type(4)));
typedef unsigned u32x2 __attribute__((ext_vector_type(2)));
typedef unsigned short us2 __attribute__((ext_vector_type(2)));
__device__ __forceinline__ float bf2f(unsigned h) { return __uint_as_float(h << 16); }
__device__ __forceinline__ unsigned f2bf(float f) { unsigned u = __float_as_uint(f); return (u + 0x7fffu + ((u >> 16) & 1u)) >> 16; }
typedef float f32x2_t __attribute__((ext_vector_type(2)));
typedef __bf16 bf16x2_t __attribute__((ext_vector_type(2)));
__device__ __forceinline__ unsigned pk2(float lo, float hi) { const f32x2_t v = {lo, hi}; const bf16x2_t b = __builtin_convertvector(v, bf16x2_t); return __builtin_bit_cast(unsigned, b); }
__device__ __forceinline__ float fexp2(float x) { return __builtin_amdgcn_exp2f(x); }
__device__ __forceinline__ float flog2(float x) { return __builtin_amdgcn_logf(x); }
__device__ __forceinline__ float frcp(float x) { return __builtin_amdgcn_rcpf(x); }
__device__ __forceinline__ float fsigmoid(float x) { return frcp(1.0f + fexp2(-x * LOG2E)); }
__device__ __forceinline__ float wave_sum(float v) {
#pragma unroll
    for (int o = 1; o < 64; o <<= 1) v += __shfl_xor(v, o);
    return v;
}
#define MFMA16(a, b, c) __builtin_amdgcn_mfma_f32_16x16x32_bf16((a), (b), (c), 0, 0, 0)

struct PArgs { const float* in[19]; float* out; unsigned char* ws; int ph_lo, ph_hi; };

__device__ __forceinline__ void transpose_item(const float* W, const float* gk, int K, int N, bf16* WT, LAS float* scr, int item, int lane) {
    const int nblk = N / 32, kb = item / nblk, nb = item % nblk, k0 = 64 * kb, n0 = 32 * nb;
#pragma unroll 8
    for (int i = 0; i < 32; ++i) { const int kk = 2 * i + (lane >> 5); const float g = gk ? gk[k0 + kk] : 1.0f; scr[kk * 33 + (lane & 31)] = W[(size_t)(k0 + kk) * N + n0 + (lane & 31)] * g; }
    asm volatile("s_waitcnt lgkmcnt(0)" ::: "memory");
    const int c = lane & 7;
#pragma unroll
    for (int j = 0; j < 4; ++j) { const int n = (lane >> 3) + 8 * j; const LAS float* s = scr + (8 * c) * 33 + n;
        u32x4 o; o.x = pk2(s[0 * 33], s[1 * 33]); o.y = pk2(s[2 * 33], s[3 * 33]); o.z = pk2(s[4 * 33], s[5 * 33]); o.w = pk2(s[6 * 33], s[7 * 33]);
        *(u32x4*)(WT + (size_t)(n0 + n) * K + k0 + 8 * c) = o; }
    asm volatile("s_waitcnt lgkmcnt(0)" ::: "memory");
}
__device__ __forceinline__ void p0_prologue(const PArgs& a, LAS unsigned char* lds, int bid, int G, int tid, int wave, int lane) {
    LAS float* scr = (LAS float*)(lds + wave * 16384);
    const int gw = bid * NWAVES + wave, NGW = G * NWAVES;
    unsigned char* ws = a.ws;
    constexpr int I_IN0 = 16 * 104, I_O = 16 * 32, I_1 = 16 * 128, I_2 = 64 * 32, I_IN1 = 16 * 96;
    constexpr int NITEMS = I_IN0 + I_O + I_1 + I_2 + I_IN1 + I_O + I_1 + I_2;
    for (int it = gw; it < NITEMS; it += NGW) {
        int r = it;
        if (r < I_IN0) { transpose_item(a.in[8], a.in[5], D, NIN0, (bf16*)(ws + WS_WIN0), scr, r, lane); continue; } r -= I_IN0;
        if (r < I_O) { transpose_item(a.in[13], nullptr, D, D, (bf16*)(ws + WS_WOUT0), scr, r, lane); continue; } r -= I_O;
        if (r < I_1) { transpose_item(a.in[17], a.in[6], D, FF, (bf16*)(ws + WS_W10), scr, r, lane); continue; } r -= I_1;
        if (r < I_2) { transpose_item(a.in[18], nullptr, FF, D, (bf16*)(ws + WS_W20), scr, r, lane); continue; } r -= I_2;
        if (r < I_IN1) { transpose_item(a.in[14], a.in[5] + D, D, NIN1, (bf16*)(ws + WS_WIN1), scr, r, lane); continue; } r -= I_IN1;
        if (r < I_O) { transpose_item(a.in[16], nullptr, D, D, (bf16*)(ws + WS_WOUT1), scr, r, lane); continue; } r -= I_O;
        if (r < I_1) { transpose_item(a.in[17] + (size_t)D * FF, a.in[6] + D, D, FF, (bf16*)(ws + WS_W11), scr, r, lane); continue; } r -= I_1;
        transpose_item(a.in[18] + (size_t)FF * D, nullptr, FF, D, (bf16*)(ws + WS_W21), scr, r, lane);
    }
    bf16* xb0 = (bf16*)(ws + WS_CAT); float* ss = (float*)(ws + WS_SS);
    for (int m = gw; m < MP; m += NGW) {
        const f32x4* xr = (const f32x4*)(a.in[0] + (size_t)m * D) + lane; f32x4 v[4]; float s = 0.f;
#pragma unroll
        for (int j = 0; j < 4; ++j) { v[j] = xr[64 * j]; s += (v[j].x * v[j].x + v[j].y * v[j].y) + (v[j].z * v[j].z + v[j].w * v[j].w); }
        s = wave_sum(s);
        u32x2* o8 = (u32x2*)(xb0 + (size_t)m * D) + lane;
#pragma unroll
        for (int j = 0; j < 4; ++j) { u32x2 w; w.x = pk2(v[j].x, v[j].y); w.y = pk2(v[j].z, v[j].w); o8[64 * j] = w; }
        if (lane == 0) ss[m] = s;
    }
    const int gt = bid * NT + tid, NGT = G * NT;
    for (int i = gt; i < 4 * MP; i += NGT) ss[MP + i] = 0.f;
    float* xs = (float*)(ws + WS_XS);
    for (int i = gt; i < MS * D / 4; i += NGT) ((f32x4*)xs)[i] = ((const f32x4*)a.in[1])[i];
}

template <bool AF32, int EPI, int SU>
__device__ __forceinline__ void sgemm(LAS unsigned char* lds, const void* Ap, int lda, const bf16* Bt, int N, int K, int ksplit, bf16* O, int ldo, float* xs, int G, int bid, int tid, int wave, int lane, int skip = 0) {
    constexpr int NKS = SU;
    LAS float* red = (LAS float*)lds;
    LAS float* sqp = red + 16384;
    const int r = lane & 15, q = lane >> 4;
    const int nstrip = N / 64, npiece = 4 * nstrip * ksplit, klen = K / ksplit;
    for (int p = (bid >= skip) ? G - 1 - bid : npiece; p < npiece; p += G - skip) {
        const int rb = p & 3, strip = (p >> 2) % nstrip, ks = (p >> 2) / nstrip, n0 = strip * 64, k0 = ks * klen + wave * (klen >> 3), row0 = 32 * rb;
        bf16x8 bv[4][NKS], av[2][NKS]; f32x4 af[2][NKS][2];
#pragma unroll
        for (int c = 0; c < 4; ++c)
#pragma unroll
            for (int u = 0; u < NKS; ++u) bv[c][u] = *(const bf16x8*)(Bt + (size_t)(n0 + 16 * c + r) * K + k0 + 32 * u + 8 * q);
#pragma unroll
        for (int t = 0; t < 2; ++t)
#pragma unroll
            for (int u = 0; u < NKS; ++u) {
                if (AF32) { const float* ap = (const float*)Ap + (size_t)(row0 + 16 * t + r) * lda + k0 + 32 * u + 8 * q; af[t][u][0] = *(const f32x4*)ap; af[t][u][1] = *(const f32x4*)(ap + 4); }
                else av[t][u] = *(const bf16x8*)((const bf16*)Ap + (size_t)(row0 + 16 * t + r) * lda + k0 + 32 * u + 8 * q); }
        __builtin_amdgcn_sched_barrier(0);
        float sq[2] = {0.f, 0.f};
        if (AF32) {
#pragma unroll
            for (int t = 0; t < 2; ++t)
#pragma unroll
                for (int u = 0; u < NKS; ++u) { const f32x4 x0 = af[t][u][0], x1 = af[t][u][1];
                    sq[t] += (x0[0] * x0[0] + x0[1] * x0[1]) + (x0[2] * x0[2] + x0[3] * x0[3]) + (x1[0] * x1[0] + x1[1] * x1[1]) + (x1[2] * x1[2] + x1[3] * x1[3]);
                    u32x4 w; w.x = pk2(x0[0], x0[1]); w.y = pk2(x0[2], x0[3]); w.z = pk2(x1[0], x1[1]); w.w = pk2(x1[2], x1[3]); av[t][u] = __builtin_bit_cast(bf16x8, w); } }
#pragma unroll
        for (int t = 0; t < 2; ++t)
#pragma unroll
            for (int c = 0; c < 4; ++c) { f32x4 acc = {0.f, 0.f, 0.f, 0.f};
#pragma unroll
                for (int u = 0; u < NKS; ++u) acc = MFMA16(av[t][u], bv[c][u], acc);
                *(LAS f32x4*)(red + ((wave * 8 + (c * 2 + t)) * 64 + lane) * 4) = acc; }
        if (AF32) {
#pragma unroll
            for (int t = 0; t < 2; ++t) { float v = sq[t]; v += __shfl_xor(v, 16); v += __shfl_xor(v, 32); if (q == 0) sqp[(wave * 2 + t) * 16 + r] = v; } }
        __syncthreads();
        const int t = wave & 1, c = wave >> 1;
        f32x4 acc = {0.f, 0.f, 0.f, 0.f};
#pragma unroll
        for (int w = 0; w < 8; ++w) acc += *(const LAS f32x4*)(red + ((w * 8 + wave) * 64 + lane) * 4);
        const int orow = row0 + 16 * t + 4 * q, ocol = n0 + 16 * c + r;
        if (EPI == 2) {
#pragma unroll
            for (int i = 0; i < 4; ++i) atomicAdd(xs + (size_t)(orow + i) * D + ocol, acc[i]);
        } else {
#pragma unroll
            for (int i = 0; i < 4; ++i) { float ssr = 0.f;
#pragma unroll
                for (int w = 0; w < 8; ++w) ssr += sqp[(w * 2 + t) * 16 + 4 * q + i];
                float v = acc[i] * __builtin_amdgcn_rsqf(ssr * (1.0f / 1024.0f) + EPS);
                if (EPI == 1) { v = fmaxf(v, 0.f); v = v * v; }
                O[(size_t)(orow + i) * ldo + ocol] = (bf16)f2bf(v); }
        }
        __syncthreads();
    }
}

__device__ __forceinline__ float lb_of(const float* lg, int c) { const float e0 = __expf(lg[c]), e1 = __expf(lg[768 + c]), e2 = __expf(lg[1536 + c]); return e0 / (e0 + e1 + e2); }

__device__ __forceinline__ void hgrn_sample3(LAS unsigned char* lds, const bf16* projs, const float* S0all, const float* lbl, const float* gain, bf16* cats, float* st_out, int it0, int G, int tid, int wave, int lane) {
    constexpr int STR = 2624;
    LAS float* L = (LAS float*)lds;
#pragma unroll
    for (int j = 0; j < 3; ++j) { const int it = it0 + j * G;
        if (it < MS * 6 && tid < 128) { const int b = it / 6, h = it - 6 * b, c = h * 128 + tid; const bf16* pr = projs + (size_t)b * NIN0; LAS float* B = L + j * STR;
            const float lbk = lb_of(lbl, c); float fz = bf2f(pr[1024 + c]); fz = fminf(fmaxf(fz, -30.f), 30.f);
            const float e = fexp2(-fz * LOG2E), sg = frcp(1.0f + e); B[tid] = lbk + (1.0f - lbk) * sg; B[128 + tid] = (1.0f - lbk) * e * sg; B[256 + tid] = bf2f(pr[256 + c]);
            const float z = bf2f(pr[1792 + c]); B[384 + tid] = z * fsigmoid(z); } }
    const int vq = tid & 31, kg = tid >> 5;
    f32x4 sv[3][8];
#pragma unroll
    for (int j = 0; j < 3; ++j) { const int it = it0 + j * G;
        if (it < MS * 6) { const float* S0 = S0all + (size_t)it * 16384;
#pragma unroll
            for (int i = 0; i < 8; ++i) sv[j][i] = *(const f32x4*)(S0 + (size_t)(kg * 8 + i) * 128 + 4 * vq); } }
    __syncthreads();
#pragma unroll
    for (int j = 0; j < 3; ++j) { const int it = it0 + j * G;
        if (it < MS * 6) { LAS float* B = L + j * STR; float* So = st_out + (size_t)it * 16384; const f32x4 v4 = *(const LAS f32x4*)(B + 384 + 4 * vq); f32x4 op = {0.f, 0.f, 0.f, 0.f};
#pragma unroll
            for (int i = 0; i < 8; ++i) { const int kx = kg * 8 + i; const f32x4 sn = sv[j][i] * B[kx] + v4 * B[128 + kx]; *(f32x4*)(So + (size_t)kx * 128 + 4 * vq) = sn; op += sn * B[256 + kx]; }
            *(LAS f32x4*)(B + 512 + kg * 128 + 4 * vq) = op; } }
    __syncthreads();
    float o[3];
#pragma unroll
    for (int j = 0; j < 3; ++j) { o[j] = 0.f;
        if (tid < 128) { LAS float* B = L + j * STR;
#pragma unroll
            for (int i = 0; i < 16; ++i) o[j] += B[512 + i * 128 + tid];
            const float ssum = wave_sum(o[j] * o[j]); if (lane == 0) B[2560 + wave] = ssum; } }
    __syncthreads();
#pragma unroll
    for (int j = 0; j < 3; ++j) { const int it = it0 + j * G;
        if (it < MS * 6 && tid < 128) { const int b = it / 6, h = it - 6 * b, c = h * 128 + tid; LAS float* B = L + j * STR;
            const float rs = __builtin_amdgcn_rsqf((B[2560] + B[2561]) * (1.0f / 128.0f) + EPS);
            cats[(size_t)b * D + 256 + c] = (bf16)f2bf(o[j] * rs * gain[c] * fsigmoid(bf2f(projs[(size_t)b * NIN0 + 2560 + c]))); } }
    __syncthreads();
}

__device__ __forceinline__ void pool_mm(const LAS float* W, const LAS float* df, float (&acc)[8], int c, int tg) {
#pragma unroll
    for (int i = 0; i < 8; ++i) acc[i] = 0.f;
#pragma unroll 4
    for (int cc = 0; cc < 64; cc += 4) { const float w0 = W[cc * 64 + c], w1 = W[(cc + 1) * 64 + c], w2 = W[(cc + 2) * 64 + c], w3 = W[(cc + 3) * 64 + c];
#pragma unroll
        for (int i = 0; i < 8; ++i) { const f32x4 dv = *(const LAS f32x4*)(df + (tg * 8 + i) * 64 + cc); acc[i] += (dv.x * w0 + dv.y * w1) + (dv.z * w2 + dv.w * w3); } }
}
__device__ __forceinline__ void pool_prompt_all(LAS unsigned char* lds, const bf16* proj, const float* pw, const float* pscale, bf16* cat, float* pool_out, int bid, int G, int tid, int wave, int lane) {
    constexpr int PK = 144;
    LAS float* ue = (LAS float*)lds;
    LAS unsigned char* Dfb = lds + 20224;
    LAS unsigned char* Wtb = lds + 20224 + 9216;
    const int r = lane & 15, q = lane >> 4, c = tid & 63, tg = tid >> 6;
    unsigned short uv[10]; f32x4 wv[2];
    int it = bid;
    if (it < 1024) { const int g = it & 3, tt = it >> 2, b = tt >> 5, t0 = (tt & 31) * 64;
#pragma unroll
        for (int j10 = 0; j10 < 10; ++j10) { const int e = tid + NT * j10, j = e >> 6, t = t0 - 15 + j; uv[j10] = (e < 79 * 64 && t >= 0) ? proj[(size_t)(b * SEQ + t) * NIN0 + g * 64 + (e & 63)] : (unsigned short)0; }
#pragma unroll
        for (int j2 = 0; j2 < 2; ++j2) wv[j2] = ((const f32x4*)(pw + g * 4096))[tid + NT * j2]; }
    for (; it < 1024; it += G) {
        const int g = it & 3, tt = it >> 2, b = tt >> 5, t0 = (tt & 31) * 64, wlen = 2 << g;
#pragma unroll
        for (int j10 = 0; j10 < 10; ++j10) { const int e = tid + NT * j10; if (e < 79 * 64) ue[e] = bf2f(uv[j10]); }
#pragma unroll
        for (int j2 = 0; j2 < 2; ++j2) { const int e4 = tid + NT * j2, cc = e4 >> 4, d0 = (e4 & 15) * 4;
#pragma unroll
            for (int k = 0; k < 4; ++k) *(LAS unsigned short*)(Wtb + (d0 + k) * PK + 2 * cc) = (unsigned short)f2bf(wv[j2][k]); }
        { const int nit = it + G;
          if (nit < 1024) { const int ng = nit & 3, ntt = nit >> 2, nb = ntt >> 5, nt0 = (ntt & 31) * 64;
#pragma unroll
              for (int j10 = 0; j10 < 10; ++j10) { const int e = tid + NT * j10, j = e >> 6, t = nt0 - 15 + j; uv[j10] = (e < 79 * 64 && t >= 0) ? proj[(size_t)(nb * SEQ + t) * NIN0 + ng * 64 + (e & 63)] : (unsigned short)0; }
#pragma unroll
              for (int j2 = 0; j2 < 2; ++j2) wv[j2] = ((const f32x4*)(pw + ng * 4096))[tid + NT * j2]; } }
        __syncthreads();
#pragma unroll
        for (int i = 0; i < 8; ++i) { const int t = tg * 8 + i; float s = 0.f;
#pragma unroll
            for (int j = 0; j < 16; ++j) { const float x = ue[(15 + t - j) * 64 + c]; s += (j < wlen) ? x : 0.f; }
            const int pos = t0 + t; const float rc = (pos + 1 >= wlen) ? 1.0f / (float)wlen : 1.0f / (float)(pos + 1); const float u = ue[(15 + t) * 64 + c];
            *(LAS unsigned short*)(Dfb + t * PK + 2 * c) = (unsigned short)f2bf(s * rc - u);
            if (pos >= SEQ - 15) pool_out[(size_t)(b * 15 + (pos - (SEQ - 15))) * 256 + g * 64 + c] = u; }
        __syncthreads();
        { const int ti = wave >> 1;
#pragma unroll
          for (int dj2 = 0; dj2 < 2; ++dj2) { const int dj = 2 * (wave & 1) + dj2; f32x4 acc = {0.f, 0.f, 0.f, 0.f};
#pragma unroll
              for (int ks = 0; ks < 2; ++ks) { const bf16x8 av = *(const LAS bf16x8*)(Dfb + (16 * ti + r) * PK + ks * 64 + q * 16), bv = *(const LAS bf16x8*)(Wtb + (16 * dj + r) * PK + ks * 64 + q * 16); acc = MFMA16(av, bv, acc); }
              const float sc = pscale[g * 64 + 16 * dj + r];
#pragma unroll
              for (int i = 0; i < 4; ++i) cat[(size_t)(b * SEQ + t0 + 16 * ti + 4 * q + i) * D + g * 64 + 16 * dj + r] = (bf16)f2bf(acc[i] * sc); } }
        __syncthreads();
    }
}
__device__ __forceinline__ void pool_sample(LAS unsigned char* lds, const bf16* projs, const float* spool, const float* pw, const float* pscale, bf16* cats, float* pool_out, int item, int tid) {
    LAS float* W = (LAS float*)lds + 79 * 64; LAS float* df = W + 4096;
    const int g = item & 3, st = item >> 2, wlen = 2 << g, c = tid & 63, tg = tid >> 6, ch = g * 64 + c;
#pragma unroll
    for (int j2 = 0; j2 < 2; ++j2) ((LAS f32x4*)W)[tid + NT * j2] = ((const f32x4*)(pw + g * 4096))[tid + NT * j2];
#pragma unroll
    for (int i = 0; i < 8; ++i) { const int t = tg * 8 + i, b = st * 64 + t; const float u = bf2f(projs[(size_t)b * NIN0 + ch]);
        float pv[15];
#pragma unroll
        for (int j = 0; j < 15; ++j) pv[j] = spool[(size_t)(b * 15 + j) * 256 + ch];
        float s = u;
#pragma unroll
        for (int j = 0; j < 15; ++j) if (j < wlen - 1) s += pv[14 - j];
        df[t * 64 + c] = s / (float)wlen - u;
#pragma unroll
        for (int j = 0; j < 14; ++j) pool_out[(size_t)(b * 15 + j) * 256 + ch] = pv[j + 1];
        pool_out[(size_t)(b * 15 + 14) * 256 + ch] = u; }
    __syncthreads();
    float acc[8]; pool_mm(W, df, acc, c, tg);
    const float sc = pscale[ch];
#pragma unroll
    for (int i = 0; i < 8; ++i) cats[(size_t)(st * 64 + tg * 8 + i) * D + ch] = (bf16)f2bf(acc[i] * sc);
    __syncthreads();
}

__device__ __forceinline__ void unpack8(const u32x4 w, float (&f)[8]) {
    f[0] = __uint_as_float(w.x << 16); f[1] = __uint_as_float(w.x & 0xffff0000u); f[2] = __uint_as_float(w.y << 16); f[3] = __uint_as_float(w.y & 0xffff0000u);
    f[4] = __uint_as_float(w.z << 16); f[5] = __uint_as_float(w.z & 0xffff0000u); f[6] = __uint_as_float(w.w << 16); f[7] = __uint_as_float(w.w & 0xffff0000u);
}
__device__ __forceinline__ void hgrn_stepA(LAS unsigned char* lds, const bf16* proj, const float* lbl, bf16* dS, float* eblg, int bid, int G, int wave, int lane) {
    constexpr int PK = 144;
    LAS unsigned char* KeT = lds; LAS unsigned char* Vt = lds + 18432; LAS float* qsum = (LAS float*)(lds + 36864);
    const int tq = wave >> 1, k = ((wave & 1) << 6) + lane, r = lane & 15, q = lane >> 4, w = wave;
    unsigned short fv[16], iv[16];
    int it = bid;
    if (it < 1536) { const int bh = it >> 5, c = it & 31, b = bh / 6, h = bh - 6 * b; const unsigned lo_f = 1024u + (unsigned)(h * 128 + k);
        const bf16* prow = proj + (size_t)(b * SEQ + 64 * c + 16 * tq) * NIN0;
#pragma unroll
        for (int i = 0; i < 16; ++i) { const bf16* up = prow + (size_t)i * NIN0; fv[i] = up[lo_f]; iv[i] = up[lo_f + 768u]; } }
    for (; it < 1536; it += G) {
        const int bh = it >> 5, b = bh / 6, h = bh - 6 * b, ch = h * 128 + k;
        const float lbk = lb_of(lbl, ch), oml = 1.0f - lbk;
        float lf[16], kk[16];
#pragma unroll
        for (int i = 0; i < 16; ++i) { float fz = bf2f(fv[i]); fz = fminf(fmaxf(fz, -30.f), 30.f); const float e = fexp2(-fz * LOG2E), sg = frcp(1.0f + e); lf[i] = flog2(lbk + oml * sg); kk[i] = oml * e * sg; }
        float run = 0.f;
#pragma unroll
        for (int i = 0; i < 16; ++i) { run += lf[i]; lf[i] = run; }
        qsum[tq * 128 + k] = run;
        { unsigned vp[8];
#pragma unroll
          for (int i = 0; i < 8; ++i) { const float z0 = bf2f(iv[2 * i]), z1 = bf2f(iv[2 * i + 1]); vp[i] = pk2(z0 * fsigmoid(z0), z1 * fsigmoid(z1)); }
          *(LAS u32x4*)(Vt + k * PK + tq * 32) = (u32x4){vp[0], vp[1], vp[2], vp[3]}; *(LAS u32x4*)(Vt + k * PK + tq * 32 + 16) = (u32x4){vp[4], vp[5], vp[6], vp[7]}; }
        __syncthreads();
        float off = 0.f, tot = 0.f;
#pragma unroll
        for (int j = 0; j < 4; ++j) { const float s = qsum[j * 128 + k]; tot += s; if (j < tq) off += s; }
        if (tq == 0) eblg[(size_t)it * 128 + k] = fexp2(tot);
        { unsigned kp[8];
#pragma unroll
          for (int i = 0; i < 8; ++i) { const float b0 = lf[2 * i] + off, b1 = lf[2 * i + 1] + off; kp[i] = pk2(kk[2 * i] * fexp2(tot - b0), kk[2 * i + 1] * fexp2(tot - b1)); }
          *(LAS u32x4*)(KeT + k * PK + tq * 32) = (u32x4){kp[0], kp[1], kp[2], kp[3]}; *(LAS u32x4*)(KeT + k * PK + tq * 32 + 16) = (u32x4){kp[4], kp[5], kp[6], kp[7]}; }
        { const int nit = it + G;
          if (nit < 1536) { const int nbh = nit >> 5, nc = nit & 31, nb = nbh / 6, nh = nbh - 6 * nb; const unsigned lo_f = 1024u + (unsigned)(nh * 128 + k);
              const bf16* prow = proj + (size_t)(nb * SEQ + 64 * nc + 16 * tq) * NIN0;
#pragma unroll
              for (int i = 0; i < 16; ++i) { const bf16* up = prow + (size_t)i * NIN0; fv[i] = up[lo_f]; iv[i] = up[lo_f + 768u]; } } }
        __syncthreads();
        { bf16x8 aK[2];
#pragma unroll
          for (int ks = 0; ks < 2; ++ks) aK[ks] = *(const LAS bf16x8*)(KeT + (16 * w + r) * PK + ks * 64 + q * 16);
          bf16* dst = dS + (size_t)it * 16384 + (size_t)r * 128 + 16 * w + 4 * q;
#pragma unroll
          for (int n = 0; n < 8; ++n) { f32x4 s = {0.f, 0.f, 0.f, 0.f};
#pragma unroll
              for (int ks = 0; ks < 2; ++ks) { const bf16x8 bv = *(const LAS bf16x8*)(Vt + (16 * n + r) * PK + ks * 64 + q * 16); s = MFMA16(aK[ks], bv, s); }
              *(u32x2*)(dst + n * 2048) = (u32x2){pk2(s[0], s[1]), pk2(s[2], s[3])}; } }
        __syncthreads();
    }
}
__device__ __forceinline__ void hgrn_stepB(bf16* dS, const float* eblg, float* st_out, int bid, int G, int tid) {
    for (int e = bid * NT + tid; e < 48 * 2048; e += G * NT) {
        const int k8 = e & 15, v = (e >> 4) & 127, bh = e >> 11;
        bf16* p = dS + (size_t)bh * 32 * 16384 + (size_t)v * 128 + 8 * k8; const float* eb = eblg + (size_t)bh * 32 * 128 + 8 * k8;
        float S[8];
#pragma unroll
        for (int j = 0; j < 8; ++j) S[j] = 0.f;
        for (int c0 = 0; c0 < 32; c0 += 8) {
            u32x4 d[8]; f32x4 e0[8], e1[8];
#pragma unroll
            for (int u = 0; u < 8; ++u) { d[u] = *(const u32x4*)(p + (size_t)(c0 + u) * 16384); e0[u] = *(const f32x4*)(eb + (c0 + u) * 128); e1[u] = *(const f32x4*)(eb + (c0 + u) * 128 + 4); }
#pragma unroll
            for (int u = 0; u < 8; ++u) { float dv[8]; unpack8(d[u], dv);
                *(u32x4*)(p + (size_t)(c0 + u) * 16384) = (u32x4){pk2(S[0], S[1]), pk2(S[2], S[3]), pk2(S[4], S[5]), pk2(S[6], S[7])};
#pragma unroll
                for (int j = 0; j < 4; ++j) { S[j] = S[j] * e0[u][j] + dv[j]; S[4 + j] = S[4 + j] * e1[u][j] + dv[4 + j]; } }
        }
        float* so = st_out + (size_t)bh * 16384 + (size_t)(8 * k8) * 128 + v;
#pragma unroll
        for (int j = 0; j < 8; ++j) so[j * 128] = S[j];
    }
}
__device__ __forceinline__ void hgrn_stepC(LAS unsigned char* lds, const bf16* proj, const float* lbl, const float* gain, const bf16* dS, bf16* cat, int bid, int G, int tid, int wave, int lane) {
    constexpr int PQ = 272, PK = 144;
    LAS unsigned char* Qd = lds; LAS unsigned char* Kd = lds + 17408; LAS unsigned char* Vt = lds + 34816;
    LAS unsigned char* P = lds + 53248; LAS unsigned char* St = lds + 62464;
    LAS float* qsum = (LAS float*)(lds + 97280); LAS float* part = qsum + 512; LAS float* rsr = part + 512;
    const int tq = wave >> 1, k = ((wave & 1) << 6) + lane, r = lane & 15, q = lane >> 4, w = wave;
    unsigned short qv[16], fv[16], iv[16];
    int it = bid;
    if (it < 1536) { const int bh = it >> 5, c = it & 31, b = bh / 6, h = bh - 6 * b; const unsigned lo_q = 256u + (unsigned)(h * 128 + k);
        const bf16* prow = proj + (size_t)(b * SEQ + 64 * c + 16 * tq) * NIN0;
#pragma unroll
        for (int i = 0; i < 16; ++i) { const bf16* up = prow + (size_t)i * NIN0; qv[i] = up[lo_q]; fv[i] = up[lo_q + 768u]; iv[i] = up[lo_q + 1536u]; } }
    for (; it < 1536; it += G) {
        const int bh = it >> 5, c = it & 31, b = bh / 6, h = bh - 6 * b, ch = h * 128 + k;
        const float lbk = lb_of(lbl, ch), oml = 1.0f - lbk;
        u32x4 sreg[4];
        { const u32x4* sp = (const u32x4*)(dS + (size_t)it * 16384) + tid;
#pragma unroll
          for (int j = 0; j < 4; ++j) sreg[j] = sp[512 * j]; }
        float lf[16], kk[16];
#pragma unroll
        for (int i = 0; i < 16; ++i) { float fz = bf2f(fv[i]); fz = fminf(fmaxf(fz, -30.f), 30.f); const float e = fexp2(-fz * LOG2E), sg = frcp(1.0f + e); lf[i] = flog2(lbk + oml * sg); kk[i] = oml * e * sg; }
        float run = 0.f;
#pragma unroll
        for (int i = 0; i < 16; ++i) { run += lf[i]; lf[i] = run; }
        qsum[tq * 128 + k] = run;
        { unsigned vp[8];
#pragma unroll
          for (int i = 0; i < 8; ++i) { const float z0 = bf2f(iv[2 * i]), z1 = bf2f(iv[2 * i + 1]); vp[i] = pk2(z0 * fsigmoid(z0), z1 * fsigmoid(z1)); }
          *(LAS u32x4*)(Vt + k * PK + tq * 32) = (u32x4){vp[0], vp[1], vp[2], vp[3]}; *(LAS u32x4*)(Vt + k * PK + tq * 32 + 16) = (u32x4){vp[4], vp[5], vp[6], vp[7]}; }
        __syncthreads();
        float off = 0.f;
#pragma unroll
        for (int j = 0; j < 4; ++j) { const float s = qsum[j * 128 + k]; if (j < tq) off += s; }
#pragma unroll
        for (int i = 0; i < 16; ++i) { const float bc = lf[i] + off; const float ed = fexp2(bc), edi = fexp2(-bc);
            *(LAS unsigned short*)(Qd + (16 * tq + i) * PQ + 2 * k) = (unsigned short)f2bf(bf2f(qv[i]) * ed);
            *(LAS unsigned short*)(Kd + (16 * tq + i) * PQ + 2 * k) = (unsigned short)f2bf(kk[i] * edi); }
#pragma unroll
        for (int j = 0; j < 4; ++j) { const int e = tid + 512 * j, v = e >> 4, k8 = e & 15; *(LAS u32x4*)(St + v * PQ + k8 * 16) = sreg[j]; }
        const unsigned lo_g = (unsigned)(4 * q) * NIN0 + 2560u + (unsigned)(h * 128 + 16 * w + r), lo_o = (unsigned)(4 * q) * D + 256u + (unsigned)(h * 128 + 16 * w + r);
        const bf16* crow = proj + (size_t)(b * SEQ + 64 * c) * NIN0;
        unsigned short gv[16];
#pragma unroll
        for (int ti = 0; ti < 4; ++ti)
#pragma unroll
            for (int i = 0; i < 4; ++i) { const bf16* up = crow + (size_t)(16 * ti + i) * NIN0; gv[ti * 4 + i] = up[lo_g]; }
        { const int nit = it + G;
          if (nit < 1536) { const int nbh = nit >> 5, nc = nit & 31, nb = nbh / 6, nh = nbh - 6 * nb; const unsigned lo_q = 256u + (unsigned)(nh * 128 + k);
              const bf16* prow = proj + (size_t)(nb * SEQ + 64 * nc + 16 * tq) * NIN0;
#pragma unroll
              for (int i = 0; i < 16; ++i) { const bf16* up = prow + (size_t)i * NIN0; qv[i] = up[lo_q]; fv[i] = up[lo_q + 768u]; iv[i] = up[lo_q + 1536u]; } } }
        __syncthreads();
        { const int ti = w >> 1;
#pragma unroll
          for (int sj = 0; sj < 2; ++sj) { const int si = 2 * (w & 1) + sj; f32x4 acc = {0.f, 0.f, 0.f, 0.f};
              if (si <= ti) {
#pragma unroll
                  for (int ks = 0; ks < 4; ++ks) { const bf16x8 av = *(const LAS bf16x8*)(Qd + (16 * ti + r) * PQ + ks * 64 + q * 16), bv = *(const LAS bf16x8*)(Kd + (16 * si + r) * PQ + ks * 64 + q * 16); acc = MFMA16(av, bv, acc); } }
#pragma unroll
              for (int i = 0; i < 4; ++i) { const int t = 16 * ti + 4 * q + i, s = 16 * si + r; *(LAS unsigned short*)(P + t * PK + 2 * s) = (unsigned short)f2bf(s <= t ? acc[i] : 0.f); } } }
        f32x4 o[4];
#pragma unroll
        for (int ti = 0; ti < 4; ++ti) o[ti] = (f32x4){0.f, 0.f, 0.f, 0.f};
        { bf16x8 bS[4];
#pragma unroll
          for (int ks = 0; ks < 4; ++ks) bS[ks] = *(const LAS bf16x8*)(St + (16 * w + r) * PQ + ks * 64 + q * 16);
#pragma unroll
          for (int ti = 0; ti < 4; ++ti)
#pragma unroll
              for (int ks = 0; ks < 4; ++ks) { const bf16x8 av = *(const LAS bf16x8*)(Qd + (16 * ti + r) * PQ + ks * 64 + q * 16); o[ti] = MFMA16(av, bS[ks], o[ti]); } }
        __syncthreads();
        { bf16x8 bV[2];
#pragma unroll
          for (int ks = 0; ks < 2; ++ks) bV[ks] = *(const LAS bf16x8*)(Vt + (16 * w + r) * PK + ks * 64 + q * 16);
#pragma unroll
          for (int ti = 0; ti < 4; ++ti)
#pragma unroll
              for (int ks = 0; ks < 2; ++ks) { const bf16x8 av = *(const LAS bf16x8*)(P + (16 * ti + r) * PK + ks * 64 + q * 16); o[ti] = MFMA16(av, bV[ks], o[ti]); } }
#pragma unroll
        for (int ti = 0; ti < 4; ++ti)
#pragma unroll
            for (int i = 0; i < 4; ++i) { float p = o[ti][i] * o[ti][i]; p += __shfl_xor(p, 1); p += __shfl_xor(p, 2); p += __shfl_xor(p, 4); p += __shfl_xor(p, 8);
                if (r == 0) part[w * 64 + 16 * ti + 4 * q + i] = p; }
        __syncthreads();
        if (tid < 64) { float s = 0.f;
#pragma unroll
            for (int j = 0; j < 8; ++j) s += part[j * 64 + tid];
            rsr[tid] = __builtin_amdgcn_rsqf(s * (1.0f / 128.0f) + EPS); }
        __syncthreads();
        const float gain_v = gain[h * 128 + 16 * w + r];
        bf16* orow = cat + (size_t)(b * SEQ + 64 * c) * D;
#pragma unroll
        for (int ti = 0; ti < 4; ++ti)
#pragma unroll
            for (int i = 0; i < 4; ++i) { const int t = 16 * ti + 4 * q + i; const float val = o[ti][i] * rsr[t] * gain_v * fsigmoid(bf2f(gv[ti * 4 + i]));
                bf16* up = orow + (size_t)(16 * ti + i) * D; up[lo_o] = (bf16)f2bf(val); }
    }
    __syncthreads();
}

__device__ __forceinline__ void conv_phase(const PArgs& a, int bid, int G, int tid) {
    unsigned char* ws = a.ws;
    const bf16* proj = (const bf16*)(ws + WS_SH); bf16* cat = (bf16*)(ws + WS_CAT); const float* cw = a.in[15];
    for (int gt = bid * NT + tid; gt < 1024 * 128; gt += G * NT) {
        const int cgp = gt & 127, rb = gt >> 7, b = rb >> 7, tl0 = (rb & 127) * 16, c0 = 8 * cgp;
        float w0[8], w1[8], w2[8], zm2[8], zm1[8];
#pragma unroll
        for (int e = 0; e < 8; ++e) { w0[e] = cw[c0 + e]; w1[e] = cw[1024 + c0 + e]; w2[e] = cw[2048 + c0 + e]; zm2[e] = 0.f; zm1[e] = 0.f; }
        const bf16* pr = proj + (size_t)(b * SEQ + tl0) * NIN1 + c0;
        if (tl0 > 0) { float cgv[8], hvv[8];
            unpack8(*(const u32x4*)(pr - 2 * NIN1 + 1024), cgv); unpack8(*(const u32x4*)(pr - 2 * NIN1 + 2048), hvv);
#pragma unroll
            for (int e = 0; e < 8; ++e) zm2[e] = cgv[e] * hvv[e];
            unpack8(*(const u32x4*)(pr - NIN1 + 1024), cgv); unpack8(*(const u32x4*)(pr - NIN1 + 2048), hvv);
#pragma unroll
            for (int e = 0; e < 8; ++e) zm1[e] = cgv[e] * hvv[e]; }
#pragma unroll 1
        for (int i = 0; i < 16; ++i) { float bgv[8], cgv[8], hvv[8], o[8];
            unpack8(*(const u32x4*)(pr + (size_t)i * NIN1), bgv); unpack8(*(const u32x4*)(pr + (size_t)i * NIN1 + 1024), cgv); unpack8(*(const u32x4*)(pr + (size_t)i * NIN1 + 2048), hvv);
#pragma unroll
            for (int e = 0; e < 8; ++e) { const float z = cgv[e] * hvv[e]; o[e] = bgv[e] * (w0[e] * zm2[e] + w1[e] * zm1[e] + w2[e] * z); zm2[e] = zm1[e]; zm1[e] = z; }
            *(u32x4*)(cat + (size_t)(b * SEQ + tl0 + i) * D + c0) = (u32x4){pk2(o[0], o[1]), pk2(o[2], o[3]), pk2(o[4], o[5]), pk2(o[6], o[7])};
            const int t = tl0 + i;
            if (t >= SEQ - 2) { float* co = a.out + O_CONVP + (size_t)(b * 2 + (t - (SEQ - 2))) * 1024 + c0;
                *(f32x4*)co = (f32x4){zm1[0], zm1[1], zm1[2], zm1[3]}; *(f32x4*)(co + 4) = (f32x4){zm1[4], zm1[5], zm1[6], zm1[7]}; } }
    }
    const bf16* projs = (const bf16*)(ws + WS_PROJS); bf16* cats = (bf16*)(ws + WS_CATS); const float* sc = a.in[4];
    for (int gt = bid * NT + tid; gt < MS * 128; gt += G * NT) {
        const int cgp = gt & 127, b = gt >> 7, c0 = 8 * cgp; float bgv[8], cgv[8], hvv[8], o[8], z[8];
        const bf16* pr = projs + (size_t)b * NIN1 + c0;
        unpack8(*(const u32x4*)pr, bgv); unpack8(*(const u32x4*)(pr + 1024), cgv); unpack8(*(const u32x4*)(pr + 2048), hvv);
        const float* p0 = sc + (size_t)(b * 2) * 1024 + c0; const float* p1 = p0 + 1024;
        float* co = a.out + O_CONVS + (size_t)(b * 2) * 1024 + c0;
#pragma unroll
        for (int e = 0; e < 8; ++e) { z[e] = cgv[e] * hvv[e]; o[e] = bgv[e] * (cw[c0 + e] * p0[e] + cw[1024 + c0 + e] * p1[e] + cw[2048 + c0 + e] * z[e]); co[e] = p1[e]; co[1024 + e] = z[e]; }
        *(u32x4*)(cats + (size_t)b * D + c0) = (u32x4){pk2(o[0], o[1]), pk2(o[2], o[3]), pk2(o[4], o[5]), pk2(o[6], o[7])};
    }
}

__device__ __forceinline__ void final_norm(const PArgs& a, int bid, int G, int wave, int lane) {
    const int gw = bid * NWAVES + wave, NGW = G * NWAVES; const float* gf = a.in[7]; const float* ss4 = (const float*)(a.ws + WS_SS) + 4 * MP;
    f32x4 gv[4];
#pragma unroll
    for (int j = 0; j < 4; ++j) gv[j] = ((const f32x4*)gf)[lane + 64 * j];
    for (int m = gw; m < MP + MS; m += NGW) {
        if (m < MP) { f32x4* yr = (f32x4*)(a.out + O_Y + (size_t)m * D) + lane; const u32x2* xr = (const u32x2*)((const bf16*)(a.ws + WS_XB) + (size_t)m * D) + lane;
            const float rs = __builtin_amdgcn_rsqf(ss4[m] * (1.0f / 1024.0f) + EPS);
#pragma unroll
            for (int j = 0; j < 4; ++j) { const u32x2 w = xr[64 * j]; const f32x4 v = {__uint_as_float(w.x << 16), __uint_as_float(w.x & 0xffff0000u), __uint_as_float(w.y << 16), __uint_as_float(w.y & 0xffff0000u)}; yr[64 * j] = v * rs * gv[j]; } }
        else { const int sr = m - MP; const f32x4* xr = (const f32x4*)((const float*)(a.ws + WS_XS) + (size_t)sr * D) + lane; f32x4* yr = (f32x4*)(a.out + O_YS + (size_t)sr * D) + lane;
            f32x4 v[4]; float s = 0.f;
#pragma unroll
            for (int j = 0; j < 4; ++j) { v[j] = xr[64 * j]; s += (v[j].x * v[j].x + v[j].y * v[j].y) + (v[j].z * v[j].z + v[j].w * v[j].w); }
            const float rs = __builtin_amdgcn_rsqf(wave_sum(s) * (1.0f / 1024.0f) + EPS);
#pragma unroll
            for (int j = 0; j < 4; ++j) yr[64 * j] = v[j] * rs * gv[j]; }
    }
}

#define XB_TMO      128
#define XB_XCNT(j)  (256  + 64 * (j))
#define XB_XSUB(j)  (1280 + 64 * (j))
#define XB_XGEN(j)  (2304 + 64 * (j))
#define XB_TOP      3328
#define XB_TOPGEN   3392
#define XCD_BAR_WORDS 3456
#define XB_SPIN_CAP (1u << 18)

__device__ __forceinline__ unsigned xb_ld(unsigned* p)              { return __hip_atomic_load(p, __ATOMIC_RELAXED, __HIP_MEMORY_SCOPE_AGENT); }
__device__ __forceinline__ unsigned xb_add(unsigned* p, unsigned v) { return __hip_atomic_fetch_add(p, v, __ATOMIC_RELAXED, __HIP_MEMORY_SCOPE_AGENT); }
__device__ __forceinline__ unsigned xb_xcc_id() { return (unsigned)__builtin_amdgcn_s_getreg((3 << 11) | 20) & 0xFu; }
#define XB_SPIN(cond, bar) do { unsigned _sp = 0; while (cond) { __builtin_amdgcn_s_sleep(1); \
    if ((++_sp & 255u) == 0u) { if (xb_ld(&(bar)[XB_TMO])) break; if (_sp > XB_SPIN_CAP) { atomicAdd(&(bar)[XB_TMO], 1u); break; } } } } while (0)

struct XcdBarrier {
    unsigned* bar; unsigned x;
    volatile LAS unsigned* st;
};

__device__ __forceinline__ XcdBarrier xcd_barrier_post(unsigned* bar, volatile LAS unsigned* st) {
    XcdBarrier b; b.bar = bar; b.x = xb_xcc_id(); b.st = st;
    if (threadIdx.x == 0) (void)xb_add(&bar[XB_XCNT(b.x)], 1u);
    return b;
}
__device__ __forceinline__ void xcd_barrier_complete(unsigned* bar, unsigned x, unsigned& nloc, unsigned& nx) {
    const unsigned G = gridDim.x * gridDim.y * gridDim.z;
    unsigned sum, cnt, mine, sp = 0u;
    for (;;) {
        sum = 0u; cnt = 0u; mine = 0u;
#pragma unroll
        for (unsigned j = 0; j < 16; ++j) { const unsigned c = xb_ld(&bar[XB_XCNT(j)]); sum += c; cnt += (c > 0u) ? 1u : 0u; mine = (j == x) ? c : mine; }
        if (sum == G) break;
        __builtin_amdgcn_s_sleep(1);
        if ((++sp & 255u) == 0u) { if (xb_ld(&bar[XB_TMO])) break; if (sp > XB_SPIN_CAP) { atomicAdd(&bar[XB_TMO], 1u); break; } }
    }
    nloc = mine > 0u ? mine : 1u; nx = cnt > 0u ? cnt : 1u;
}

__device__ __forceinline__ void xcd_barrier(const XcdBarrier& b) {
    asm volatile("s_waitcnt vmcnt(0)" ::: "memory");
    __syncthreads();
    if (threadIdx.x == 0) {
        unsigned* bar = b.bar;
        __builtin_amdgcn_s_waitcnt(0);
        unsigned nloc = b.st[0], nx = b.st[1];
        if (nloc == 0u) { xcd_barrier_complete(bar, b.x, nloc, nx); b.st[0] = nloc; b.st[1] = nx; }
        const unsigned old = xb_add(&bar[XB_XSUB(b.x)], 1u);
        const unsigned gen = old / nloc;
        if (old + 1u == (gen + 1u) * nloc) {
            __builtin_amdgcn_fence(__ATOMIC_RELEASE, "agent");
            asm volatile("s_waitcnt vmcnt(0)" ::: "memory");
            const unsigned og = xb_add(&bar[XB_TOP], 1u);
            const unsigned tg = og / nx;
            if (og + 1u == (tg + 1u) * nx) xb_add(&bar[XB_TOPGEN], 1u);
            else XB_SPIN(xb_ld(&bar[XB_TOPGEN]) == tg, bar);
            __builtin_amdgcn_fence(__ATOMIC_ACQUIRE, "agent");
            xb_add(&bar[XB_XGEN(b.x)], 1u);
            asm volatile("s_waitcnt vmcnt(0)" ::: "memory");
        } else {
            XB_SPIN(xb_ld(&bar[XB_XGEN(b.x)]) == gen, bar);
            __builtin_amdgcn_fence(__ATOMIC_ACQUIRE, "agent");
            asm volatile("s_waitcnt vmcnt(0)" ::: "memory");
        }
    }
    __syncthreads();
}

#ifndef DIS_GEMM
#define DIS_GEMM 0
#endif
#ifndef DIS_SGEMM
#define DIS_SGEMM 0
#endif
#ifndef DIS_HGRN
#define DIS_HGRN 0
#endif
#ifndef DIS_OTHER
#define DIS_OTHER 0
#endif
#ifndef DBG_O
#define DBG_O 15
#endif
#ifndef DUPK
#define DUPK 0
#endif
#ifndef DBG_XSYNC
#define DBG_XSYNC 0
#endif
#ifndef DBG_COL
#define DBG_COL 2304
#endif
#ifndef DBG_HI
#define DBG_HI 12
#endif
#ifndef MK_MULTI
#define MK_MULTI 0
#endif
constexpr int N_PHASES = 12;
#define IN(k) (lo <= (k) && (k) < hi)
#define SEAM(k) do { if (IN(k) && IN((k) + 1)) xcd_barrier(xbar); } while (0)
template <int L>
__device__ __forceinline__ void layer_phases(const PArgs& a, LAS unsigned char* lds, const XcdBarrier& xbar, int lo, int hi, int bid, int G, int tid, int wave, int lane) {
    unsigned char* ws = a.ws;
    float* ss = (float*)(ws + WS_SS);
    bf16* CAT = (bf16*)(ws + WS_CAT); bf16* SH = (bf16*)(ws + WS_SH); bf16* XB = (bf16*)(ws + WS_XB);
    float* xs = (float*)(ws + WS_XS); bf16* projs = (bf16*)(ws + WS_PROJS); bf16* cats = (bf16*)(ws + WS_CATS); bf16* hs = (bf16*)(ws + WS_HS);
    float* Y = a.out + O_Y;
    constexpr int pb = 1 + 5 * L;
    const bf16* Win = (const bf16*)(ws + (L ? WS_WIN1 : WS_WIN0)); const bf16* Wout = (const bf16*)(ws + (L ? WS_WOUT1 : WS_WOUT0));
    const bf16* W1 = (const bf16*)(ws + (L ? WS_W11 : WS_W10)); const bf16* W2 = (const bf16*)(ws + (L ? WS_W21 : WS_W20));
    constexpr int Nin = L ? NIN1 : NIN0;
    if (IN(pb)) {
        pg8::Gemm g{L ? XB : CAT, Win, MP, Nin, D}; pg8::StaticOrder S; S.init(MP, Nin, G, bid);
        pg8::EpiScaleBf16<0> E{SH, Nin, ss + (L ? 2 : 0) * MP};
        for (int rep = 0; rep < (DUPK == 5 ? 2 : 1); ++rep) pg8::gemm_phase<pg8::EpiScaleBf16<0>, pg8::StaticOrder, true, true>(lds, g, S, E);
        for (int rep = 0; rep < (DUPK == 1 ? 2 : 1); ++rep) sgemm<true, 0, 4>(lds, L ? (const void*)xs : (const void*)a.in[1], D, Win, Nin, D, 1, projs, Nin, xs, G, bid, tid, wave, lane, (L == 0 && G == 256) ? 64 : 0);
    }
    SEAM(pb);
    if (IN(pb + 1)) {
        if (L == 0) {
            bf16* dS = (bf16*)(ws + WS_DS); float* eblg = (float*)(ws + WS_EBL);
            if (bid & 1) for (int it = bid; it < MS * 6; it += 3 * G) hgrn_sample3(lds, projs, a.in[3], a.in[11], a.in[12], cats, a.out + O_HGS, it, G, tid, wave, lane);
            hgrn_stepA(lds, SH, a.in[11], dS, eblg, bid, G, wave, lane);
            if (!(bid & 1)) for (int it = bid; it < MS * 6; it += 3 * G) hgrn_sample3(lds, projs, a.in[3], a.in[11], a.in[12], cats, a.out + O_HGS, it, G, tid, wave, lane);
            pool_prompt_all(lds, SH, a.in[9], a.in[10], CAT, a.out + O_POOLP, bid, G, tid, wave, lane);
            xcd_barrier(xbar);
            if (!DIS_HGRN) hgrn_stepB(dS, eblg, a.out + O_HGP, bid, G, tid);
            if (bid >= 192) for (int it = bid - 192; it < 8; it += G - 192) pool_sample(lds, projs, a.in[2], a.in[9], a.in[10], cats, a.out + O_POOLS, it, tid);
            else if (G <= 192) for (int it = bid; it < 8; it += G) pool_sample(lds, projs, a.in[2], a.in[9], a.in[10], cats, a.out + O_POOLS, it, tid);
            xcd_barrier(xbar);
            if (!DIS_HGRN) hgrn_stepC(lds, SH, a.in[11], a.in[12], dS, CAT, bid, G, tid, wave, lane);
        } else { conv_phase(a, bid, G, tid); }
    }
    SEAM(pb + 1);
    if (IN(pb + 2)) {
        pg8::Gemm g{CAT, Wout, MP, D, D}; pg8::StaticOrder S; S.init(MP, D, G, bid);
        pg8::EpiResid E{L ? (const float*)nullptr : a.in[0], XB, ss + (L ? 3 : 1) * MP};
        if (DUPK == 6) { pg8::EpiNull EN{Y, a.ph_lo}; pg8::gemm_phase<pg8::EpiNull, pg8::StaticOrder, true, true>(lds, g, S, EN); }
        if (!DIS_GEMM) pg8::gemm_phase<pg8::EpiResid, pg8::StaticOrder, false, true>(lds, g, S, E);
        if (!DIS_SGEMM) sgemm<false, 2, 1>(lds, cats, D, Wout, D, D, 4, nullptr, 0, xs, G, bid, tid, wave, lane);
    }
    SEAM(pb + 2);
    if (IN(pb + 3)) {
        pg8::Gemm g{XB, W1, MP, FF, D}; pg8::StaticOrder S; S.init(MP, FF, G, bid);
        pg8::EpiScaleBf16<1> E{SH, FF, ss + (L ? 3 : 1) * MP};
        for (int rep = 0; rep < (DUPK == 2 ? 2 : 1); ++rep) pg8::gemm_phase<pg8::EpiScaleBf16<1>, pg8::StaticOrder, true, true>(lds, g, S, E);
        for (int rep = 0; rep < (DUPK == 1 ? 2 : 1); ++rep) sgemm<true, 1, 4>(lds, xs, D, W1, FF, D, 1, hs, FF, xs, G, bid, tid, wave, lane);
    }
    SEAM(pb + 3);
    if (IN(pb + 4)) {
        pg8::Gemm g{SH, W2, MP, D, FF}; pg8::StaticOrder S; S.init(MP, D, G, bid);
        pg8::EpiResid E{nullptr, XB, ss + (L ? 4 : 2) * MP};
        if (DUPK == 7) { pg8::EpiNull EN{Y, a.ph_lo}; pg8::gemm_phase<pg8::EpiNull, pg8::StaticOrder, true, true>(lds, g, S, EN); }
        if (!DIS_GEMM) pg8::gemm_phase<pg8::EpiResid, pg8::StaticOrder, false, true>(lds, g, S, E);
        if (!DIS_SGEMM) sgemm<false, 2, 4>(lds, hs, FF, W2, D, FF, 4, nullptr, 0, xs, G, bid, tid, wave, lane);
    }
    SEAM(pb + 4);
}
__global__ void __launch_bounds__(NT, 2) mk_fwd(PArgs a) {
    extern __shared__ __attribute__((aligned(16))) unsigned char lds_raw[];
    LAS unsigned char* lds = (LAS unsigned char*)lds_raw;
    const int tid = threadIdx.x, lane = tid & 63, wave = __builtin_amdgcn_readfirstlane(tid >> 6), bid = blockIdx.x, G = gridDim.x;
    const int lo = a.ph_lo, hi = a.ph_hi;
    volatile LAS unsigned* xst = (volatile LAS unsigned*)(lds + 131072 + 64);
    if (tid < 2) xst[tid] = 0u;
    __syncthreads();
    const XcdBarrier xbar = xcd_barrier_post((unsigned*)a.ws, xst);
    if (lo < 0) cg::this_grid().sync();
    if (IN(0)) { for (int rep = 0; rep < (DUPK == 3 ? 2 : 1); ++rep) { p0_prologue(a, lds, bid, G, tid, wave, lane); __syncthreads(); } }
    SEAM(0);
    layer_phases<0>(a, lds, xbar, lo, hi, bid, G, tid, wave, lane);
    layer_phases<1>(a, lds, xbar, lo, hi, bid, G, tid, wave, lane);
    for (int xx = 0; xx < DBG_XSYNC; ++xx) xcd_barrier(xbar);
    if (IN(11)) final_norm(a, bid, G, wave, lane);
    if (hi < 12) {
        if (hi <= 3) { cg::this_grid().sync(); const bf16* C = (const bf16*)(a.ws + WS_CAT); for (size_t i = (size_t)bid * NT + tid; i < O_YS; i += (size_t)G * NT) a.out[i] = ((i & 1023) >= 256) ? bf2f(C[i]) : 0.f; }
        for (size_t i = (size_t)bid * NT + tid; i < 131072; i += (size_t)G * NT) a.out[O_YS + i] = 0.f;
        if (hi <= 2) for (size_t i = (size_t)bid * NT + tid + O_POOLP; i < O_CONVS; i += (size_t)G * NT) a.out[i] = 0.f;
        if (hi <= 7) { for (size_t i = (size_t)bid * NT + tid; i < 16384; i += (size_t)G * NT) a.out[O_CONVP + i] = 0.f;
                       for (size_t i = (size_t)bid * NT + tid; i < 262144; i += (size_t)G * NT) a.out[O_CONVS + i] = 0.f; }
    }
}
#undef IN
#undef SEAM

extern "C" void kernel_launch(void* const* d_in, const int* in_sizes, int n_in, void* d_out, int out_size, void* d_ws, size_t ws_size, hipStream_t stream) {
    static int grid = 0;
    if (grid == 0) {
        if (n_in != 19 || ws_size < WS_END) { fprintf(stderr, "kernel_launch: unexpected inputs (n_in %d, ws %zu)\n", n_in, ws_size); grid = -1; return; }
        int dev = 0, cus = 0, per_cu = 0;
        if (hipGetDevice(&dev) != hipSuccess || hipDeviceGetAttribute(&cus, hipDeviceAttributeMultiprocessorCount, dev) != hipSuccess) { grid = -1; return; }
        if (hipFuncSetAttribute((const void*)mk_fwd, hipFuncAttributeMaxDynamicSharedMemorySize, LDS_BYTES) != hipSuccess) { fprintf(stderr, "kernel_launch: hipFuncSetAttribute failed\n"); grid = -1; return; }
        if (hipOccupancyMaxActiveBlocksPerMultiprocessor(&per_cu, (const void*)mk_fwd, NT, LDS_BYTES) != hipSuccess || per_cu < 1) { fprintf(stderr, "kernel_launch: occupancy query says %d\n", per_cu); per_cu = 1; }
        (void)hipGetLastError();
        grid = cus;
    }
    if (grid < 0) return;
    PArgs a{};
    for (int i = 0; i < 19; ++i) a.in[i] = (const float*)d_in[i];
    a.out = (float*)d_out; a.ws = (unsigned char*)d_ws;
#if MK_MULTI
    for (int k = 0; k < DBG_HI; ++k) { a.ph_lo = k; a.ph_hi = k + 1; hipLaunchKernelGGL(mk_fwd, dim3(grid), dim3(NT), LDS_BYTES, stream, a); }
#else
    a.ph_lo = 0; a.ph_hi = DBG_HI;
    if (hipMemsetAsync(d_ws, 0, 16384, stream) != hipSuccess) { fprintf(stderr, "kernel_launch: hipMemsetAsync failed\n"); return; }
    void* args[] = {&a};
    hipError_t e = hipLaunchCooperativeKernel((const void*)mk_fwd, dim3(grid), dim3(NT), args, LDS_BYTES, stream);
    if (e != hipSuccess) fprintf(stderr, "cooperative launch failed: %s (grid %d)\n", hipGetErrorString(e), grid);
#endif
}
```

```cpp
#include <hip/hip_runtime.h>
#include <hip/hip_cooperative_groups.h>
#include <cstdio>
#include <cstdint>
namespace cg = cooperative_groups;
#ifndef DBG_O
#define DBG_O 15
#endif
namespace pg8 {
#define PG8_LAS __attribute__((address_space(3)))
typedef unsigned short bf16_t;
typedef short bf16x8 __attribute__((ext_vector_type(8)));
typedef float f32x4 __attribute__((ext_vector_type(4)));
typedef unsigned u32x4 __attribute__((ext_vector_type(4)));
typedef unsigned u32x2 __attribute__((ext_vector_type(2)));
constexpr int BM = 256, BK = 64, HALF = 128, HTB = HALF * BK * 2  , STAGE_BYTES = 8 * HTB, NXCD = 8, WGM = 8;

__host__ __device__ __forceinline__ int lds_byte(int r, int c) { const int st = (r >> 4) * 2 + (c >> 5), rr = r & 15, cc = c & 31, ob = rr * 64 + cc * 2; return st * 1024 + (ob ^ (((ob >> 9) & 1) << 5)); }
__host__ __device__ __forceinline__ void stage_rc(int b, int& R, int& C) { const int st = b / 1024, sb = b % 1024, swz = sb ^ (((sb >> 9) & 1) << 5); R = (st >> 1) * 16 + swz / 64; C = (st & 1) * 32 + (swz % 64) / 2; }
__host__ __device__ __forceinline__ int perm32(int rho) { const int n = rho >> 4, i = rho & 15; return 8 * (i >> 2) + 4 * n + (i & 3); }

struct Unit { int pm, pn; };
struct Gemm { const bf16_t* A; const bf16_t* Bt; int M, N, K; };

struct StaticOrder {
    int nM, nN, nwg, G, c;
    __host__ __device__ void init(int M, int N, int G_, int c_) { nM = M / BM; nN = N / BM; nwg = nM * nN; G = G_; c = c_; }
    __host__ __device__ bool next(int i, Unit& u) const {
        const long L = (long)i * G + c; if (L >= nwg) return false;
        int wgid = (int)L; { const int q = nwg / NXCD, r = nwg % NXCD, xcd = wgid % NXCD, off = wgid / NXCD; wgid = (xcd < r ? xcd * (q + 1) : r * (q + 1) + (xcd - r) * q) + off; }
        const int nig = WGM * nN, gid = wgid / nig, fm = gid * WGM, gsz = (nM - fm) < WGM ? (nM - fm) : WGM;
        u.pm = fm + ((wgid % nig) % gsz); u.pn = (wgid % nig) / gsz; return true;
    }
    __device__ __forceinline__ void a_ready(const Unit&) const {}
    __device__ __forceinline__ void done(const Unit&) const {}
};

__device__ __forceinline__ unsigned cvt_pk_bf16(float lo, float hi) { unsigned r; asm volatile("v_cvt_pk_bf16_f32 %0, %1, %2" : "=v"(r) : "v"(lo), "v"(hi)); return r; }
template <int ACT  > struct EpiScaleBf16 {
    static constexpr bool PERM = true, AFTER_DRAIN = false;
    bf16_t* O; int ldc; const float* ss;
    __device__ __forceinline__ void operator()(const f32x4 (&acc)[2][2][4][2], const Unit& u, int wr, int wc, int fr, int fq) const {
        const int row0 = u.pm * BM + wr * 64 + fr, col0 = u.pn * BM + wc * 32 + 8 * fq;
#pragma unroll
        for (int ai = 0; ai < 2; ++ai)
#pragma unroll
            for (int m = 0; m < 4; ++m) { const int row = row0 + ai * HALF + m * 16; const float rs = __builtin_amdgcn_rsqf(ss[row] * (1.0f / 1024.0f) + 1e-6f);
                bf16_t* rowp = O + (size_t)row * ldc + col0;
#pragma unroll
                for (int bj = 0; bj < 2; ++bj) { f32x4 v0 = acc[ai][bj][m][0] * rs, v1 = acc[ai][bj][m][1] * rs;
                    if (ACT == 1) {
#pragma unroll
                        for (int e = 0; e < 4; ++e) { const float a = fmaxf(v0[e], 0.f), b = fmaxf(v1[e], 0.f); v0[e] = a * a; v1[e] = b * b; } }
                    u32x4 w; w.x = cvt_pk_bf16(v0[0], v0[1]); w.y = cvt_pk_bf16(v0[2], v0[3]); w.z = cvt_pk_bf16(v1[0], v1[1]); w.w = cvt_pk_bf16(v1[2], v1[3]);
                    *(u32x4*)(rowp + bj * HALF) = w; } }
    }
};
struct EpiNull {
    static constexpr bool PERM = true, AFTER_DRAIN = false;
    float* out; int never;
    __device__ __forceinline__ void operator()(const f32x4 (&acc)[2][2][4][2], const Unit& u, int wr, int wc, int fr, int fq) const {
        if (never) {
#pragma unroll
            for (int ai = 0; ai < 2; ++ai)
#pragma unroll
                for (int m = 0; m < 4; ++m)
#pragma unroll
                    for (int bj = 0; bj < 2; ++bj) { *(f32x4*)(out + (size_t)(u.pm * BM + wr * 64 + fr + ai * HALF + m * 16) * 1024 + u.pn * BM + wc * 32 + 8 * fq + bj * HALF) = acc[ai][bj][m][0] + acc[ai][bj][m][1]; } }
    }
};
struct EpiResid {
    static constexpr bool PERM = true, AFTER_DRAIN = false;
    const float* base32; bf16_t* xb; float* ss;
    __device__ __forceinline__ void operator()(const f32x4 (&acc)[2][2][4][2], const Unit& u, int wr, int wc, int fr, int fq) const {
        typedef float f32x2v __attribute__((ext_vector_type(2))); typedef __bf16 bf16x2v __attribute__((ext_vector_type(2)));
        const int row0 = u.pm * BM + wr * 64 + fr, col0 = u.pn * BM + wc * 32 + 8 * fq;
#pragma unroll
        for (int ai = 0; ai < 2; ++ai) {
            f32x4 bv[4][2][2];
            if (base32) {
#pragma unroll
                for (int m = 0; m < 4; ++m)
#pragma unroll
                    for (int bj = 0; bj < 2; ++bj)
#pragma unroll
                        for (int n = 0; n < 2; ++n) bv[m][bj][n] = *(const f32x4*)(base32 + (size_t)(row0 + ai * HALF + m * 16) * 1024 + col0 + bj * HALF + n * 4);
            } else {
                u32x4 raw[4][2];
#pragma unroll
                for (int m = 0; m < 4; ++m)
#pragma unroll
                    for (int bj = 0; bj < 2; ++bj) raw[m][bj] = *(const u32x4*)(xb + (size_t)(row0 + ai * HALF + m * 16) * 1024 + col0 + bj * HALF);
#pragma unroll
                for (int m = 0; m < 4; ++m)
#pragma unroll
                    for (int bj = 0; bj < 2; ++bj) { const u32x4 w = raw[m][bj];
                        bv[m][bj][0] = (f32x4){__uint_as_float(w.x << 16), __uint_as_float(w.x & 0xffff0000u), __uint_as_float(w.y << 16), __uint_as_float(w.y & 0xffff0000u)};
                        bv[m][bj][1] = (f32x4){__uint_as_float(w.z << 16), __uint_as_float(w.z & 0xffff0000u), __uint_as_float(w.w << 16), __uint_as_float(w.w & 0xffff0000u)}; }
            }
#pragma unroll
            for (int m = 0; m < 4; ++m) { const int row = row0 + ai * HALF + m * 16; const size_t off = (size_t)row * 1024 + col0; float sq = 0.f;
#pragma unroll
                for (int bj = 0; bj < 2; ++bj) { const f32x4 x0 = bv[m][bj][0] + acc[ai][bj][m][0], x1 = bv[m][bj][1] + acc[ai][bj][m][1];
                    sq += (x0[0] * x0[0] + x0[1] * x0[1]) + (x0[2] * x0[2] + x0[3] * x0[3]) + (x1[0] * x1[0] + x1[1] * x1[1]) + (x1[2] * x1[2] + x1[3] * x1[3]);
                    const f32x2v a0 = {x0[0], x0[1]}, a1 = {x0[2], x0[3]}, a2 = {x1[0], x1[1]}, a3 = {x1[2], x1[3]}; u32x4 w;
                    w.x = __builtin_bit_cast(unsigned, __builtin_convertvector(a0, bf16x2v)); w.y = __builtin_bit_cast(unsigned, __builtin_convertvector(a1, bf16x2v));
                    w.z = __builtin_bit_cast(unsigned, __builtin_convertvector(a2, bf16x2v)); w.w = __builtin_bit_cast(unsigned, __builtin_convertvector(a3, bf16x2v));
                    *(u32x4*)(xb + off + bj * HALF) = w; }
                sq += __shfl_xor(sq, 16); sq += __shfl_xor(sq, 32);
                if (fq == 0) atomicAdd(ss + row, sq); }
            asm volatile("" ::: "memory"); }
    }
};
template <class Epi, class Sched, bool ALIGN_EPI = false, bool SP2 = false>
__device__ __forceinline__ void gemm_phase(PG8_LAS unsigned char* lds, const Gemm g, const Sched& S, const Epi& E) {
    const int tid = threadIdx.x, wid = __builtin_amdgcn_readfirstlane(tid >> 6), lane = tid & 63, wr = wid >> 2, wc = wid & 3, fr = lane & 15, fq = lane >> 4;
    const int K = g.K, nt = K / BK;
    unsigned voffA[2], voffB[2];
#pragma unroll
    for (int i = 0; i < 2; ++i) { int R, C; stage_rc(tid * 16 + i * 8192, R, C); const int Rb = Epi::PERM ? ((R & ~31) + perm32(R & 31)) : R;
        voffA[i] = (unsigned)(R * K + C) * 2u; voffB[i] = (unsigned)(Rb * K + C) * 2u; }
    const size_t kstep = (size_t)(BK * 2);
    const size_t hstep = (size_t)HALF * K * 2;
    const size_t tstep = 2 * hstep;
    const unsigned ldsw = (unsigned)wid * 1024u;
    const int aoff = lds_byte(wr * 64 + fr, fq * 8), boff = lds_byte(wc * 32 + fr, fq * 8);
#define PG8_SA(b, h) (((b) * 2 + (h)) * HTB)
#define PG8_SB(b, h) ((4 + (b) * 2 + (h)) * HTB)
#define PG8_STAGE(bufoff, gbase, voff) do { _Pragma("unroll") for (int _i = 0; _i < 2; ++_i) \
        __builtin_amdgcn_global_load_lds((const unsigned*)((const char*)(gbase) + (voff)[_i]), (PG8_LAS unsigned*)(lds + (bufoff) + ldsw + _i * 8192), 16, 0, 0); } while (0)
#define PG8_LDA(dst, b, h) do { _Pragma("unroll") for (int m = 0; m < 4; ++m) _Pragma("unroll") for (int k = 0; k < 2; ++k) dst[m][k] = *(const PG8_LAS bf16x8*)(lds + PG8_SA(b, h) + aoff + m * 2048 + k * 1024); } while (0)
#define PG8_LDB(dst, b, h) do { _Pragma("unroll") for (int n = 0; n < 2; ++n) _Pragma("unroll") for (int k = 0; k < 2; ++k) dst[n][k] = *(const PG8_LAS bf16x8*)(lds + PG8_SB(b, h) + boff + n * 2048 + k * 1024); } while (0)
#define PG8_MMA(ai, bj, At, Bt) do { __builtin_amdgcn_s_setprio(1); _Pragma("unroll") for (int m = 0; m < 4; ++m) _Pragma("unroll") for (int n = 0; n < 2; ++n) _Pragma("unroll") for (int k = 0; k < 2; ++k) \
        acc[ai][bj][m][n] = __builtin_amdgcn_mfma_f32_16x16x32_bf16(Bt[n][k], At[m][k], acc[ai][bj][m][n], 0, 0, 0); __builtin_amdgcn_s_setprio(0); } while (0)
#define PG8_WAIT_V(n) asm volatile("s_waitcnt vmcnt(" #n ")" ::: "memory")
#define PG8_WAIT_L(n) asm volatile("s_waitcnt lgkmcnt(" #n ")" ::: "memory")
#define PG8_BAR __builtin_amdgcn_s_barrier()
#define PG8_SCHED __builtin_amdgcn_sched_barrier(0)
    Unit cur, nxt; int ui = 0;
    if (!S.next(0, cur)) return;
    f32x4 acc[2][2][4][2];
#pragma unroll
    for (int a = 0; a < 2; ++a)
#pragma unroll
        for (int b = 0; b < 2; ++b)
#pragma unroll
            for (int m = 0; m < 4; ++m)
#pragma unroll
                for (int n = 0; n < 2; ++n) acc[a][b][m][n] = (f32x4){0.f, 0.f, 0.f, 0.f};
    bf16x8 At[4][2], B0[2][2], B1[2][2];
    const char* cA = (const char*)g.A + (size_t)cur.pm * tstep; const char* cB = (const char*)g.Bt + (size_t)cur.pn * tstep;
    S.a_ready(cur);
    if constexpr (SP2) {
        PG8_STAGE(PG8_SB(0, 0), cB, voffB); PG8_STAGE(PG8_SB(0, 1), cB + hstep, voffB); PG8_STAGE(PG8_SA(0, 0), cA, voffA); PG8_STAGE(PG8_SA(0, 1), cA + hstep, voffA);
        if (wr == 1) PG8_BAR;
        PG8_WAIT_V(2); PG8_BAR;
        PG8_STAGE(PG8_SB(1, 0), cB + kstep, voffB); PG8_STAGE(PG8_SA(1, 0), cA + kstep, voffA); PG8_STAGE(PG8_SB(1, 1), cB + hstep + kstep, voffB);
        PG8_WAIT_V(6); PG8_BAR;
    } else {
        PG8_STAGE(PG8_SB(0, 0), cB, voffB); PG8_STAGE(PG8_SA(0, 0), cA, voffA); PG8_STAGE(PG8_SB(0, 1), cB + hstep, voffB); PG8_STAGE(PG8_SA(0, 1), cA + hstep, voffA);
        if (wr == 1) PG8_BAR;
        PG8_WAIT_V(4); PG8_BAR;
        PG8_STAGE(PG8_SB(1, 0), cB + kstep, voffB); PG8_STAGE(PG8_SA(1, 0), cA + kstep, voffA); PG8_STAGE(PG8_SB(1, 1), cB + hstep + kstep, voffB);
        PG8_WAIT_V(6); PG8_BAR;
    }
    for (;;) {
        const bool has_next = S.next(ui + 1, nxt);
        const char* nA = has_next ? (const char*)g.A + (size_t)nxt.pm * tstep : cA; const char* nB = has_next ? (const char*)g.Bt + (size_t)nxt.pn * tstep : cB;
        for (int t = 0; t < nt; t += 2) {
            const bool last = (t == nt - 2);
            const char* a1 = cA + (size_t)(t + 1) * kstep;
            const char* a2 = last ? nA : cA + (size_t)(t + 2) * kstep; const char* b2 = last ? nB : cB + (size_t)(t + 2) * kstep;
            const char* a3 = a2 + kstep; const char* b3 = b2 + kstep;
            if (last && has_next) S.a_ready(nxt);
            if constexpr (SP2) {
            PG8_LDB(B0, 0, 0); PG8_LDB(B1, 0, 1); PG8_SCHED; PG8_LDA(At, 0, 0); PG8_STAGE(PG8_SA(1, 1), a1 + hstep, voffA);
            PG8_WAIT_V(8); PG8_WAIT_L(0); PG8_BAR; PG8_MMA(0, 0, At, B0); PG8_MMA(0, 1, At, B1); PG8_BAR; PG8_SCHED;
            PG8_LDA(At, 0, 1); PG8_STAGE(PG8_SB(0, 0), b2, voffB); PG8_STAGE(PG8_SB(0, 1), b2 + hstep, voffB); PG8_STAGE(PG8_SA(0, 0), a2, voffA);
            PG8_WAIT_V(8); PG8_WAIT_L(0); PG8_BAR; PG8_MMA(1, 0, At, B0); PG8_MMA(1, 1, At, B1); PG8_BAR; PG8_SCHED;
            PG8_LDB(B0, 1, 0); PG8_LDB(B1, 1, 1); PG8_SCHED; PG8_LDA(At, 1, 0); PG8_STAGE(PG8_SA(0, 1), a2 + hstep, voffA);
            PG8_WAIT_V(8); PG8_WAIT_L(0); PG8_BAR; PG8_MMA(0, 0, At, B0); PG8_MMA(0, 1, At, B1); PG8_BAR; PG8_SCHED;
            PG8_LDA(At, 1, 1); PG8_STAGE(PG8_SB(1, 0), b3, voffB); PG8_STAGE(PG8_SB(1, 1), b3 + hstep, voffB); PG8_STAGE(PG8_SA(1, 0), a3, voffA);
            PG8_WAIT_V(8); PG8_WAIT_L(0); PG8_BAR; PG8_MMA(1, 0, At, B0); PG8_MMA(1, 1, At, B1); PG8_BAR; PG8_SCHED;
            } else {
            PG8_LDB(B0, 0, 0); PG8_SCHED; PG8_LDA(At, 0, 0); PG8_STAGE(PG8_SA(1, 1), a1 + hstep, voffA);
            PG8_WAIT_L(8); PG8_BAR; PG8_WAIT_L(0); PG8_MMA(0, 0, At, B0); PG8_BAR; PG8_SCHED;
            PG8_LDB(B1, 0, 1); PG8_STAGE(PG8_SB(0, 0), b2, voffB);
            PG8_BAR; PG8_WAIT_L(0); PG8_MMA(0, 1, At, B1); PG8_BAR;
            PG8_LDA(At, 0, 1); PG8_STAGE(PG8_SA(0, 0), a2, voffA);
            PG8_BAR; PG8_WAIT_L(0); PG8_MMA(1, 0, At, B0); PG8_BAR; PG8_SCHED;
            PG8_STAGE(PG8_SB(0, 1), b2 + hstep, voffB);
            PG8_WAIT_V(6); PG8_BAR; PG8_MMA(1, 1, At, B1); PG8_BAR;
            PG8_LDB(B0, 1, 0); PG8_SCHED; PG8_LDA(At, 1, 0); PG8_STAGE(PG8_SA(0, 1), a2 + hstep, voffA);
            PG8_WAIT_L(8); PG8_BAR; PG8_WAIT_L(0); PG8_MMA(0, 0, At, B0); PG8_BAR; PG8_SCHED;
            PG8_LDB(B1, 1, 1); PG8_STAGE(PG8_SB(1, 0), b3, voffB);
            PG8_BAR; PG8_WAIT_L(0); PG8_MMA(0, 1, At, B1); PG8_BAR;
            PG8_LDA(At, 1, 1); PG8_STAGE(PG8_SA(1, 0), a3, voffA);
            PG8_BAR; PG8_WAIT_L(0); PG8_MMA(1, 0, At, B0); PG8_BAR; PG8_SCHED;
            PG8_STAGE(PG8_SB(1, 1), b3 + hstep, voffB);
            PG8_WAIT_V(6); PG8_BAR; PG8_MMA(1, 1, At, B1); PG8_BAR;
            }
        }
        if constexpr (ALIGN_EPI) { if (wr == 0) PG8_BAR; }
        if constexpr (!Epi::AFTER_DRAIN) { E(acc, cur, wr, wc, fr, fq); S.done(cur); }
        if (!has_next) break;
#pragma unroll
        for (int a = 0; a < 2; ++a)
#pragma unroll
            for (int b = 0; b < 2; ++b)
#pragma unroll
                for (int m = 0; m < 4; ++m)
#pragma unroll
                    for (int n = 0; n < 2; ++n) acc[a][b][m][n] = (f32x4){0.f, 0.f, 0.f, 0.f};
        cur = nxt; cA = nA; cB = nB; ++ui;
        if constexpr (ALIGN_EPI) { if (wr == 1) PG8_BAR; }
    }
    PG8_WAIT_V(0);
    if constexpr (!ALIGN_EPI) { if (wr == 0) PG8_BAR; }
    PG8_BAR;
    if constexpr (Epi::AFTER_DRAIN) { E.fused(acc, cur, wr, wc, fr, fq, lds, wid, lane); S.done(cur); }
#undef PG8_SA
#undef PG8_SB
#undef PG8_STAGE
#undef PG8_LDA
#undef PG8_LDB
#undef PG8_MMA
#undef PG8_WAIT_V
#undef PG8_WAIT_L
#undef PG8_BAR
#undef PG8_SCHED
}
}

constexpr int NWAVES = 8, NT = 512;
constexpr int D = 1024, MP = 16384, SEQ = 2048, MS = 128, FF = 4096;
constexpr int NIN0 = 3328, NIN1 = 3072;
constexpr float EPS = 1e-6f, LOG2E = 1.4426950408889634f;
constexpr size_t MiB = 1u << 20;
constexpr size_t WS_SS = 1 * MiB, WS_XS = 2 * MiB, WS_PROJS = 3 * MiB, WS_CATS = 4 * MiB, WS_HS = 5 * MiB;
constexpr size_t WS_WIN0 = 8 * MiB, WS_WOUT0 = 15 * MiB, WS_W10 = 17 * MiB, WS_W20 = 25 * MiB, WS_WIN1 = 33 * MiB, WS_WOUT1 = 39 * MiB, WS_W11 = 41 * MiB, WS_W21 = 49 * MiB;
constexpr size_t WS_CAT = 58 * MiB, WS_SH = 90 * MiB, WS_XB = 218 * MiB, WS_END = 250 * MiB;
constexpr size_t WS_DS = 194 * MiB, WS_EBL = 6 * MiB;
constexpr size_t O_Y = 0, O_YS = 16777216, O_POOLP = 16908288, O_HGP = 16939008, O_CONVP = 17725440, O_POOLS = 17741824, O_HGS = 18233344, O_CONVS = 30816256;
constexpr int LDS_BYTES = 143360;

#define LAS __attribute__((address_space(3)))
typedef unsigned short bf16;
typedef float f32x4 __attribute__((ext_vector_type(4)));
typedef short bf16x8 __attribute__((ext_vector_type(8)));
typedef unsigned u32x4 __attribute__((ext_vector_type(4)));
typedef unsigned u32x2 __attribute__((ext_vector_type(2)));
typedef unsigned short us2 __attribute__((ext_vector_type(2)));
__device__ __forceinline__ float bf2f(unsigned h) { return __uint_as_float(h << 16); }
__device__ __forceinline__ unsigned f2bf(float f) { unsigned u = __float_as_uint(f); return (u + 0x7fffu + ((u >> 16) & 1u)) >> 16; }
typedef float f32x2_t __attribute__((ext_vector_type(2)));
typedef __bf16 bf16x2_t __attribute__((ext_vector_type(2)));
__device__ __forceinline__ unsigned pk2(float lo, float hi) { const f32x2_t v = {lo, hi}; const bf16x2_t b = __builtin_convertvector(v, bf16x2_t); return __builtin_bit_cast(unsigned, b); }
__device__ __forceinline__ float fexp2(float x) { return __builtin_amdgcn_exp2f(x); }
__device__ __forceinline__ float flog2(float x) { return __builtin_amdgcn_logf(x); }
__device__ __forceinline__ float frcp(float x) { return __builtin_amdgcn_rcpf(x); }
__device__ __forceinline__ float fsigmoid(float x) { return frcp(1.0f + fexp2(-x * LOG2E)); }
__device__ __forceinline__ float wave_sum(float v) {
#pragma unroll
    for (int o = 1; o < 64; o <<= 1) v += __shfl_xor(v, o);
    return v;
}
#define MFMA16(a, b, c) __builtin_amdgcn_mfma_f32_16x16x32_bf16((a), (b), (c), 0, 0, 0)
#define LBAR() do { asm volatile("s_waitcnt lgkmcnt(0)" ::: "memory"); __builtin_amdgcn_s_barrier(); asm volatile("" ::: "memory"); } while (0)

struct PArgs { const float* in[19]; float* out; unsigned char* ws; int ph_lo, ph_hi; };

__device__ __forceinline__ void transpose_item(const float* W, const float* gk, int K, int N, bf16* WT, LAS float* scr, int item, int lane) {
    const int nblk = N / 32, kb = item / nblk, nb = item % nblk, k0 = 64 * kb, n0 = 32 * nb;
#pragma unroll 8
    for (int i = 0; i < 32; ++i) { const int kk = 2 * i + (lane >> 5); const float g = gk ? gk[k0 + kk] : 1.0f; scr[kk * 33 + (lane & 31)] = W[(size_t)(k0 + kk) * N + n0 + (lane & 31)] * g; }
    asm volatile("s_waitcnt lgkmcnt(0)" ::: "memory");
    const int c = lane & 7;
#pragma unroll
    for (int j = 0; j < 4; ++j) { const int n = (lane >> 3) + 8 * j; const LAS float* s = scr + (8 * c) * 33 + n;
        u32x4 o; o.x = pk2(s[0 * 33], s[1 * 33]); o.y = pk2(s[2 * 33], s[3 * 33]); o.z = pk2(s[4 * 33], s[5 * 33]); o.w = pk2(s[6 * 33], s[7 * 33]);
        *(u32x4*)(WT + (size_t)(n0 + n) * K + k0 + 8 * c) = o; }
    asm volatile("s_waitcnt lgkmcnt(0)" ::: "memory");
}
__device__ __forceinline__ void p0_prologue(const PArgs& a, LAS unsigned char* lds, int bid, int G, int tid, int wave, int lane) {
    LAS float* scr = (LAS float*)(lds + wave * 16384);
    const int gw = bid * NWAVES + wave, NGW = G * NWAVES;
    unsigned char* ws = a.ws;
    constexpr int I_IN0 = 16 * 104, I_O = 16 * 32, I_1 = 16 * 128, I_2 = 64 * 32, I_IN1 = 16 * 96;
    constexpr int NITEMS = I_IN0 + I_O + I_1 + I_2 + I_IN1 + I_O + I_1 + I_2;
    for (int it = gw; it < NITEMS; it += NGW) {
        int r = it;
        if (r < I_IN0) { transpose_item(a.in[8], a.in[5], D, NIN0, (bf16*)(ws + WS_WIN0), scr, r, lane); continue; } r -= I_IN0;
        if (r < I_O) { transpose_item(a.in[13], nullptr, D, D, (bf16*)(ws + WS_WOUT0), scr, r, lane); continue; } r -= I_O;
        if (r < I_1) { transpose_item(a.in[17], a.in[6], D, FF, (bf16*)(ws + WS_W10), scr, r, lane); continue; } r -= I_1;
        if (r < I_2) { transpose_item(a.in[18], nullptr, FF, D, (bf16*)(ws + WS_W20), scr, r, lane); continue; } r -= I_2;
        if (r < I_IN1) { transpose_item(a.in[14], a.in[5] + D, D, NIN1, (bf16*)(ws + WS_WIN1), scr, r, lane); continue; } r -= I_IN1;
        if (r < I_O) { transpose_item(a.in[16], nullptr, D, D, (bf16*)(ws + WS_WOUT1), scr, r, lane); continue; } r -= I_O;
        if (r < I_1) { transpose_item(a.in[17] + (size_t)D * FF, a.in[6] + D, D, FF, (bf16*)(ws + WS_W11), scr, r, lane); continue; } r -= I_1;
        transpose_item(a.in[18] + (size_t)FF * D, nullptr, FF, D, (bf16*)(ws + WS_W21), scr, r, lane);
    }
    bf16* xb0 = (bf16*)(ws + WS_CAT); float* ss = (float*)(ws + WS_SS);
    for (int m = gw; m < MP; m += NGW) {
        const f32x4* xr = (const f32x4*)(a.in[0] + (size_t)m * D) + lane; f32x4 v[4]; float s = 0.f;
#pragma unroll
        for (int j = 0; j < 4; ++j) { v[j] = xr[64 * j]; s += (v[j].x * v[j].x + v[j].y * v[j].y) + (v[j].z * v[j].z + v[j].w * v[j].w); }
        s = wave_sum(s);
        u32x2* o8 = (u32x2*)(xb0 + (size_t)m * D) + lane;
#pragma unroll
        for (int j = 0; j < 4; ++j) { u32x2 w; w.x = pk2(v[j].x, v[j].y); w.y = pk2(v[j].z, v[j].w); o8[64 * j] = w; }
        if (lane == 0) ss[m] = s;
    }
    const int gt = bid * NT + tid, NGT = G * NT;
    for (int i = gt; i < 4 * MP; i += NGT) ss[MP + i] = 0.f;
    float* xs = (float*)(ws + WS_XS);
    for (int i = gt; i < MS * D / 4; i += NGT) ((f32x4*)xs)[i] = ((const f32x4*)a.in[1])[i];
}

template <bool AF32, int EPI, int SU>
__device__ __forceinline__ void sgemm(LAS unsigned char* lds, const void* Ap, int lda, const bf16* Bt, int N, int K, int ksplit, bf16* O, int ldo, float* xs, int G, int bid, int tid, int wave, int lane, int skip = 0) {
    constexpr int NKS = SU;
    LAS float* red = (LAS float*)lds;
    LAS float* sqp = red + 16384;
    const int r = lane & 15, q = lane >> 4;
    const int nstrip = N / 64, npiece = 4 * nstrip * ksplit, klen = K / ksplit;
    for (int p = (bid >= skip) ? G - 1 - bid : npiece; p < npiece; p += G - skip) {
        const int rb = p & 3, strip = (p >> 2) % nstrip, ks = (p >> 2) / nstrip, n0 = strip * 64, k0 = ks * klen + wave * (klen >> 3), row0 = 32 * rb;
        bf16x8 bv[4][NKS], av[2][NKS]; f32x4 af[2][NKS][2];
#pragma unroll
        for (int c = 0; c < 4; ++c)
#pragma unroll
            for (int u = 0; u < NKS; ++u) bv[c][u] = *(const bf16x8*)(Bt + (size_t)(n0 + 16 * c + r) * K + k0 + 32 * u + 8 * q);
#pragma unroll
        for (int t = 0; t < 2; ++t)
#pragma unroll
            for (int u = 0; u < NKS; ++u) {
                if (AF32) { const float* ap = (const float*)Ap + (size_t)(row0 + 16 * t + r) * lda + k0 + 32 * u + 8 * q; af[t][u][0] = *(const f32x4*)ap; af[t][u][1] = *(const f32x4*)(ap + 4); }
                else av[t][u] = *(const bf16x8*)((const bf16*)Ap + (size_t)(row0 + 16 * t + r) * lda + k0 + 32 * u + 8 * q); }
        __builtin_amdgcn_sched_barrier(0);
        float sq[2] = {0.f, 0.f};
        if (AF32) {
#pragma unroll
            for (int t = 0; t < 2; ++t)
#pragma unroll
                for (int u = 0; u < NKS; ++u) { const f32x4 x0 = af[t][u][0], x1 = af[t][u][1];
                    sq[t] += (x0[0] * x0[0] + x0[1] * x0[1]) + (x0[2] * x0[2] + x0[3] * x0[3]) + (x1[0] * x1[0] + x1[1] * x1[1]) + (x1[2] * x1[2] + x1[3] * x1[3]);
                    u32x4 w; w.x = pk2(x0[0], x0[1]); w.y = pk2(x0[2], x0[3]); w.z = pk2(x1[0], x1[1]); w.w = pk2(x1[2], x1[3]); av[t][u] = __builtin_bit_cast(bf16x8, w); } }
#pragma unroll
        for (int t = 0; t < 2; ++t)
#pragma unroll
            for (int c = 0; c < 4; ++c) { f32x4 acc = {0.f, 0.f, 0.f, 0.f};
#pragma unroll
                for (int u = 0; u < NKS; ++u) acc = MFMA16(av[t][u], bv[c][u], acc);
                *(LAS f32x4*)(red + ((wave * 8 + (c * 2 + t)) * 64 + lane) * 4) = acc; }
        if (AF32) {
#pragma unroll
            for (int t = 0; t < 2; ++t) { float v = sq[t]; v += __shfl_xor(v, 16); v += __shfl_xor(v, 32); if (q == 0) sqp[(wave * 2 + t) * 16 + r] = v; } }
        __syncthreads();
        const int t = wave & 1, c = wave >> 1;
        f32x4 acc = {0.f, 0.f, 0.f, 0.f};
#pragma unroll
        for (int w = 0; w < 8; ++w) acc += *(const LAS f32x4*)(red + ((w * 8 + wave) * 64 + lane) * 4);
        const int orow = row0 + 16 * t + 4 * q, ocol = n0 + 16 * c + r;
        if (EPI == 2) {
#pragma unroll
            for (int i = 0; i < 4; ++i) atomicAdd(xs + (size_t)(orow + i) * D + ocol, acc[i]);
        } else {
#pragma unroll
            for (int i = 0; i < 4; ++i) { float ssr = 0.f;
#pragma unroll
                for (int w = 0; w < 8; ++w) ssr += sqp[(w * 2 + t) * 16 + 4 * q + i];
                float v = acc[i] * __builtin_amdgcn_rsqf(ssr * (1.0f / 1024.0f) + EPS);
                if (EPI == 1) { v = fmaxf(v, 0.f); v = v * v; }
                O[(size_t)(orow + i) * ldo + ocol] = (bf16)f2bf(v); }
        }
        __syncthreads();
    }
}

__device__ __forceinline__ float lb_of(const float* lg, int c) { const float e0 = __expf(lg[c]), e1 = __expf(lg[768 + c]), e2 = __expf(lg[1536 + c]); return e0 / (e0 + e1 + e2); }

__device__ __forceinline__ void hgrn_sample3(LAS unsigned char* lds, const bf16* projs, const float* S0all, const float* lbl, const float* gain, bf16* cats, float* st_out, int it0, int G, int tid, int wave, int lane) {
    constexpr int STR = 2624;
    LAS float* L = (LAS float*)lds;
#pragma unroll
    for (int j = 0; j < 3; ++j) { const int it = it0 + j * G;
        if (it < MS * 6 && tid < 128) { const int b = it / 6, h = it - 6 * b, c = h * 128 + tid; const bf16* pr = projs + (size_t)b * NIN0; LAS float* B = L + j * STR;
            const float lbk = lb_of(lbl, c); float fz = bf2f(pr[1024 + c]); fz = fminf(fmaxf(fz, -30.f), 30.f);
            const float e = fexp2(-fz * LOG2E), sg = frcp(1.0f + e); B[tid] = lbk + (1.0f - lbk) * sg; B[128 + tid] = (1.0f - lbk) * e * sg; B[256 + tid] = bf2f(pr[256 + c]);
            const float z = bf2f(pr[1792 + c]); B[384 + tid] = z * fsigmoid(z); } }
    const int vq = tid & 31, kg = tid >> 5;
    f32x4 sv[3][8];
#pragma unroll
    for (int j = 0; j < 3; ++j) { const int it = it0 + j * G;
        if (it < MS * 6) { const float* S0 = S0all + (size_t)it * 16384;
#pragma unroll
            for (int i = 0; i < 8; ++i) sv[j][i] = *(const f32x4*)(S0 + (size_t)(kg * 8 + i) * 128 + 4 * vq); } }
    LBAR();
#pragma unroll
    for (int j = 0; j < 3; ++j) { const int it = it0 + j * G;
        if (it < MS * 6) { LAS float* B = L + j * STR; float* So = st_out + (size_t)it * 16384; const f32x4 v4 = *(const LAS f32x4*)(B + 384 + 4 * vq); f32x4 op = {0.f, 0.f, 0.f, 0.f};
#pragma unroll
            for (int i = 0; i < 8; ++i) { const int kx = kg * 8 + i; const f32x4 sn = sv[j][i] * B[kx] + v4 * B[128 + kx]; *(f32x4*)(So + (size_t)kx * 128 + 4 * vq) = sn; op += sn * B[256 + kx]; }
            *(LAS f32x4*)(B + 512 + kg * 128 + 4 * vq) = op; } }
    LBAR();
    float o[3];
#pragma unroll
    for (int j = 0; j < 3; ++j) { o[j] = 0.f;
        if (tid < 128) { LAS float* B = L + j * STR;
#pragma unroll
            for (int i = 0; i < 16; ++i) o[j] += B[512 + i * 128 + tid];
            const float ssum = wave_sum(o[j] * o[j]); if (lane == 0) B[2560 + wave] = ssum; } }
    LBAR();
#pragma unroll
    for (int j = 0; j < 3; ++j) { const int it = it0 + j * G;
        if (it < MS * 6 && tid < 128) { const int b = it / 6, h = it - 6 * b, c = h * 128 + tid; LAS float* B = L + j * STR;
            const float rs = __builtin_amdgcn_rsqf((B[2560] + B[2561]) * (1.0f / 128.0f) + EPS);
            cats[(size_t)b * D + 256 + c] = (bf16)f2bf(o[j] * rs * gain[c] * fsigmoid(bf2f(projs[(size_t)b * NIN0 + 2560 + c]))); } }
    LBAR();
}

__device__ __forceinline__ void pool_mm(const LAS float* W, const LAS float* df, float (&acc)[8], int c, int tg) {
#pragma unroll
    for (int i = 0; i < 8; ++i) acc[i] = 0.f;
#pragma unroll 4
    for (int cc = 0; cc < 64; cc += 4) { const float w0 = W[cc * 64 + c], w1 = W[(cc + 1) * 64 + c], w2 = W[(cc + 2) * 64 + c], w3 = W[(cc + 3) * 64 + c];
#pragma unroll
        for (int i = 0; i < 8; ++i) { const f32x4 dv = *(const LAS f32x4*)(df + (tg * 8 + i) * 64 + cc); acc[i] += (dv.x * w0 + dv.y * w1) + (dv.z * w2 + dv.w * w3); } }
}
__device__ __forceinline__ void pool_prompt_all(LAS unsigned char* lds, const bf16* proj, const float* pw, const float* pscale, bf16* cat, float* pool_out, int bid, int G, int tid, int wave, int lane) {
    constexpr int PK = 144;
    LAS float* ue = (LAS float*)lds;
    LAS unsigned char* Dfb = lds + 20224;
    LAS unsigned char* Wtb = lds + 20224 + 9216;
    const int r = lane & 15, q = lane >> 4, c = tid & 63, tg = tid >> 6;
    unsigned short uv[10]; f32x4 wv[2];
    int it = bid;
    if (it < 1024) { const int g = it & 3, tt = it >> 2, b = tt >> 5, t0 = (tt & 31) * 64;
#pragma unroll
        for (int j10 = 0; j10 < 10; ++j10) { const int e = tid + NT * j10, j = e >> 6, t = t0 - 15 + j; uv[j10] = (e < 79 * 64 && t >= 0) ? proj[(size_t)(b * SEQ + t) * NIN0 + g * 64 + (e & 63)] : (unsigned short)0; }
#pragma unroll
        for (int j2 = 0; j2 < 2; ++j2) wv[j2] = ((const f32x4*)(pw + g * 4096))[tid + NT * j2]; }
    for (; it < 1024; it += G) {
        const int g = it & 3, tt = it >> 2, b = tt >> 5, t0 = (tt & 31) * 64, wlen = 2 << g;
#pragma unroll
        for (int j10 = 0; j10 < 10; ++j10) { const int e = tid + NT * j10; if (e < 79 * 64) ue[e] = bf2f(uv[j10]); }
#pragma unroll
        for (int j2 = 0; j2 < 2; ++j2) { const int e4 = tid + NT * j2, cc = e4 >> 4, d0 = (e4 & 15) * 4;
#pragma unroll
            for (int k = 0; k < 4; ++k) *(LAS unsigned short*)(Wtb + (d0 + k) * PK + 2 * cc) = (unsigned short)f2bf(wv[j2][k]); }
        { const int nit = it + G;
          if (nit < 1024) { const int ng = nit & 3, ntt = nit >> 2, nb = ntt >> 5, nt0 = (ntt & 31) * 64;
#pragma unroll
              for (int j10 = 0; j10 < 10; ++j10) { const int e = tid + NT * j10, j = e >> 6, t = nt0 - 15 + j; uv[j10] = (e < 79 * 64 && t >= 0) ? proj[(size_t)(nb * SEQ + t) * NIN0 + ng * 64 + (e & 63)] : (unsigned short)0; }
#pragma unroll
              for (int j2 = 0; j2 < 2; ++j2) wv[j2] = ((const f32x4*)(pw + ng * 4096))[tid + NT * j2]; } }
        __syncthreads();
#pragma unroll
        for (int i = 0; i < 8; ++i) { const int t = tg * 8 + i; float s = 0.f;
#pragma unroll
            for (int j = 0; j < 16; ++j) { const float x = ue[(15 + t - j) * 64 + c]; s += (j < wlen) ? x : 0.f; }
            const int pos = t0 + t; const float rc = (pos + 1 >= wlen) ? 1.0f / (float)wlen : 1.0f / (float)(pos + 1); const float u = ue[(15 + t) * 64 + c];
            *(LAS unsigned short*)(Dfb + t * PK + 2 * c) = (unsigned short)f2bf(s * rc - u);
            if (pos >= SEQ - 15) pool_out[(size_t)(b * 15 + (pos - (SEQ - 15))) * 256 + g * 64 + c] = u; }
        __syncthreads();
        { const int ti = wave >> 1;
#pragma unroll
          for (int dj2 = 0; dj2 < 2; ++dj2) { const int dj = 2 * (wave & 1) + dj2; f32x4 acc = {0.f, 0.f, 0.f, 0.f};
#pragma unroll
              for (int ks = 0; ks < 2; ++ks) { const bf16x8 av = *(const LAS bf16x8*)(Dfb + (16 * ti + r) * PK + ks * 64 + q * 16), bv = *(const LAS bf16x8*)(Wtb + (16 * dj + r) * PK + ks * 64 + q * 16); acc = MFMA16(av, bv, acc); }
              const float sc = pscale[g * 64 + 16 * dj + r];
#pragma unroll
              for (int i = 0; i < 4; ++i) cat[(size_t)(b * SEQ + t0 + 16 * ti + 4 * q + i) * D + g * 64 + 16 * dj + r] = (bf16)f2bf(acc[i] * sc); } }
        __syncthreads();
    }
}
template <int W>
__device__ __forceinline__ void pool_wave_diff(LAS unsigned char* Dfb, const bf16* proj, float* pool_out, int b, int t0, int g, int lane) {
    constexpr int PK = 144;
    const bf16* up = proj + (size_t)(b * SEQ + t0) * NIN0 + g * 64;
    float u[79];
#pragma unroll
    for (int j = 0; j < 79; ++j) { const int t = t0 - 15 + j; u[j] = (t >= 0) ? bf2f((up + (ptrdiff_t)(j - 15) * NIN0)[lane]) : 0.f; }
    float run = 0.f;
#pragma unroll
    for (int j = 1; j < W; ++j) run += u[15 - j];
#pragma unroll
    for (int t = 0; t < 64; ++t) { run += u[15 + t]; const int pos = t0 + t; const float rc = (pos + 1 >= W) ? 1.0f / (float)W : 1.0f / (float)(pos + 1);
        *(LAS unsigned short*)(Dfb + t * PK + 2 * lane) = (unsigned short)f2bf(run * rc - u[15 + t]);
        if (pos >= SEQ - 15) pool_out[(size_t)(b * 15 + (pos - (SEQ - 15))) * 256 + g * 64 + lane] = u[15 + t];
        run -= u[15 + t - (W - 1)]; }
}
__device__ __forceinline__ void pool_prompt_wave(LAS unsigned char* lds, const bf16* proj, const float* pw, const float* pscale, bf16* cat, float* pool_out, int bid, int G, int tid, int wave, int lane) {
    constexpr int PK = 144;
    LAS unsigned char* Wtb = lds;
    LAS unsigned char* Dfb = lds + 36864 + wave * 9216;
    const int r = lane & 15, q = lane >> 4;
#pragma unroll
    for (int j = 0; j < 8; ++j) { const int e4 = tid + NT * j, g = e4 >> 10, cc = (e4 >> 4) & 63, d0 = (e4 & 15) * 4; const f32x4 v = ((const f32x4*)pw)[e4];
#pragma unroll
        for (int k = 0; k < 4; ++k) *(LAS unsigned short*)(Wtb + g * 9216 + (d0 + k) * PK + 2 * cc) = (unsigned short)f2bf(v[k]); }
    __syncthreads();
    for (int it = wave * G + bid; it < 1024; it += NWAVES * G) {
        const int g = it & 3, tt = it >> 2, b = tt >> 5, t0 = (tt & 31) * 64;
        if (g == 0) pool_wave_diff<2>(Dfb, proj, pool_out, b, t0, g, lane);
        else if (g == 1) pool_wave_diff<4>(Dfb, proj, pool_out, b, t0, g, lane);
        else if (g == 2) pool_wave_diff<8>(Dfb, proj, pool_out, b, t0, g, lane);
        else pool_wave_diff<16>(Dfb, proj, pool_out, b, t0, g, lane);
        asm volatile("s_waitcnt lgkmcnt(0)" ::: "memory");
        const LAS unsigned char* Wg = Wtb + g * 9216;
#pragma unroll
        for (int ti = 0; ti < 4; ++ti) { bf16x8 av[2];
#pragma unroll
            for (int ks = 0; ks < 2; ++ks) av[ks] = *(const LAS bf16x8*)(Dfb + (16 * ti + r) * PK + ks * 64 + q * 16);
#pragma unroll
            for (int dj = 0; dj < 4; ++dj) { f32x4 acc = {0.f, 0.f, 0.f, 0.f};
#pragma unroll
                for (int ks = 0; ks < 2; ++ks) { const bf16x8 bv = *(const LAS bf16x8*)(Wg + (16 * dj + r) * PK + ks * 64 + q * 16); acc = MFMA16(av[ks], bv, acc); }
                const float sc = pscale[g * 64 + 16 * dj + r];
#pragma unroll
                for (int i = 0; i < 4; ++i) cat[(size_t)(b * SEQ + t0 + 16 * ti + 4 * q + i) * D + g * 64 + 16 * dj + r] = (bf16)f2bf(acc[i] * sc); } }
        asm volatile("s_waitcnt lgkmcnt(0)" ::: "memory");
    }
    __syncthreads();
}
__device__ __forceinline__ void pool_sample(LAS unsigned char* lds, const bf16* projs, const float* spool, const float* pw, const float* pscale, bf16* cats, float* pool_out, int item, int tid) {
    LAS float* W = (LAS float*)lds + 79 * 64; LAS float* df = W + 4096;
    const int g = item & 3, st = item >> 2, wlen = 2 << g, c = tid & 63, tg = tid >> 6, ch = g * 64 + c;
#pragma unroll
    for (int j2 = 0; j2 < 2; ++j2) ((LAS f32x4*)W)[tid + NT * j2] = ((const f32x4*)(pw + g * 4096))[tid + NT * j2];
#pragma unroll
    for (int i = 0; i < 8; ++i) { const int t = tg * 8 + i, b = st * 64 + t; const float u = bf2f(projs[(size_t)b * NIN0 + ch]);
        float pv[15];
#pragma unroll
        for (int j = 0; j < 15; ++j) pv[j] = spool[(size_t)(b * 15 + j) * 256 + ch];
        float s = u;
#pragma unroll
        for (int j = 0; j < 15; ++j) if (j < wlen - 1) s += pv[14 - j];
        df[t * 64 + c] = s / (float)wlen - u;
#pragma unroll
        for (int j = 0; j < 14; ++j) pool_out[(size_t)(b * 15 + j) * 256 + ch] = pv[j + 1];
        pool_out[(size_t)(b * 15 + 14) * 256 + ch] = u; }
    LBAR();
    float acc[8]; pool_mm(W, df, acc, c, tg);
    const float sc = pscale[ch];
#pragma unroll
    for (int i = 0; i < 8; ++i) cats[(size_t)(st * 64 + tg * 8 + i) * D + ch] = (bf16)f2bf(acc[i] * sc);
    LBAR();
}

__device__ __forceinline__ void unpack8(const u32x4 w, float (&f)[8]) {
    f[0] = __uint_as_float(w.x << 16); f[1] = __uint_as_float(w.x & 0xffff0000u); f[2] = __uint_as_float(w.y << 16); f[3] = __uint_as_float(w.y & 0xffff0000u);
    f[4] = __uint_as_float(w.z << 16); f[5] = __uint_as_float(w.z & 0xffff0000u); f[6] = __uint_as_float(w.w << 16); f[7] = __uint_as_float(w.w & 0xffff0000u);
}
__device__ __forceinline__ void hgrn_stepA(LAS unsigned char* lds, const bf16* proj, const float* lbl, bf16* dS, float* eblg, int bid, int G, int wave, int lane) {
    constexpr int PK = 144;
    LAS unsigned char* KeT = lds; LAS unsigned char* Vt = lds + 18432; LAS float* qsum = (LAS float*)(lds + 36864);
    const int tq = wave >> 1, k = ((wave & 1) << 6) + lane, r = lane & 15, q = lane >> 4, w = wave;
    LAS float* lbt = qsum + 512;
    for (int c2 = wave * 64 + lane; c2 < 768; c2 += NT) lbt[c2] = lb_of(lbl, c2);
    LBAR();
    unsigned fv[16], iv[16];
    int it = bid;
    if (it < 1536) { const int bh = it >> 5, c = it & 31, b = bh / 6, h = bh - 6 * b; const unsigned lo_f = 1024u + (unsigned)(h * 128 + k);
        const bf16* prow = proj + (size_t)(b * SEQ + 64 * c + 16 * tq) * NIN0;
#pragma unroll
        for (int i = 0; i < 16; ++i) { const bf16* up = prow + (size_t)i * NIN0; fv[i] = up[lo_f]; iv[i] = up[lo_f + 768u]; } }
    for (; it < 1536; it += G) {
        const int bh = it >> 5, b = bh / 6, h = bh - 6 * b, ch = h * 128 + k;
        const float lbk = lbt[ch], oml = 1.0f - lbk;
#pragma unroll
        for (int i = 0; i < 16; ++i) asm volatile("" : "+v"(fv[i]), "+v"(iv[i]));
        float lf[16], kk[16];
#pragma unroll
        for (int i = 0; i < 16; ++i) { float fz = bf2f(fv[i]); fz = fminf(fmaxf(fz, -30.f), 30.f); const float e = fexp2(-fz * LOG2E), sg = frcp(1.0f + e); lf[i] = flog2(lbk + oml * sg); kk[i] = oml * e * sg; }
        float run = 0.f;
#pragma unroll
        for (int i = 0; i < 16; ++i) { run += lf[i]; lf[i] = run; }
        qsum[tq * 128 + k] = run;
        { unsigned vp[8];
#pragma unroll
          for (int i = 0; i < 8; ++i) { const float z0 = bf2f(iv[2 * i]), z1 = bf2f(iv[2 * i + 1]); vp[i] = pk2(z0 * fsigmoid(z0), z1 * fsigmoid(z1)); }
          *(LAS u32x4*)(Vt + k * PK + tq * 32) = (u32x4){vp[0], vp[1], vp[2], vp[3]}; *(LAS u32x4*)(Vt + k * PK + tq * 32 + 16) = (u32x4){vp[4], vp[5], vp[6], vp[7]}; }
        LBAR();
        float off = 0.f, tot = 0.f;
#pragma unroll
        for (int j = 0; j < 4; ++j) { const float s = qsum[j * 128 + k]; tot += s; if (j < tq) off += s; }
        if (tq == 0) eblg[(size_t)it * 128 + k] = fexp2(tot);
        { unsigned kp[8];
#pragma unroll
          for (int i = 0; i < 8; ++i) { const float b0 = lf[2 * i] + off, b1 = lf[2 * i + 1] + off; kp[i] = pk2(kk[2 * i] * fexp2(tot - b0), kk[2 * i + 1] * fexp2(tot - b1)); }
          *(LAS u32x4*)(KeT + k * PK + tq * 32) = (u32x4){kp[0], kp[1], kp[2], kp[3]}; *(LAS u32x4*)(KeT + k * PK + tq * 32 + 16) = (u32x4){kp[4], kp[5], kp[6], kp[7]}; }
        { const int nit = it + G;
          if (nit < 1536) { const int nbh = nit >> 5, nc = nit & 31, nb = nbh / 6, nh = nbh - 6 * nb; const unsigned lo_f = 1024u + (unsigned)(nh * 128 + k);
              const bf16* prow = proj + (size_t)(nb * SEQ + 64 * nc + 16 * tq) * NIN0;
#pragma unroll
              for (int i = 0; i < 16; ++i) { const bf16* up = prow + (size_t)i * NIN0; fv[i] = up[lo_f]; iv[i] = up[lo_f + 768u]; } } }
        LBAR();
        { bf16x8 aK[2];
#pragma unroll
          for (int ks = 0; ks < 2; ++ks) aK[ks] = *(const LAS bf16x8*)(KeT + (16 * w + r) * PK + ks * 64 + q * 16);
          bf16* dst = dS + (size_t)it * 16384 + (size_t)r * 128 + 16 * w + 4 * q;
#pragma unroll
          for (int n = 0; n < 8; ++n) { f32x4 s = {0.f, 0.f, 0.f, 0.f};
#pragma unroll
              for (int ks = 0; ks < 2; ++ks) { const bf16x8 bv = *(const LAS bf16x8*)(Vt + (16 * n + r) * PK + ks * 64 + q * 16); s = MFMA16(aK[ks], bv, s); }
              *(u32x2*)(dst + n * 2048) = (u32x2){pk2(s[0], s[1]), pk2(s[2], s[3])}; } }
        LBAR();
    }
}
__device__ __forceinline__ void hgrn_stepB(bf16* dS, const float* eblg, float* st_out, int bid, int G, int tid) {
    for (int e = bid * NT + tid; e < 48 * 2048; e += G * NT) {
        const int k8 = e & 15, v = (e >> 4) & 127, bh = e >> 11;
        bf16* p = dS + (size_t)bh * 32 * 16384 + (size_t)v * 128 + 8 * k8; const float* eb = eblg + (size_t)bh * 32 * 128 + 8 * k8;
        float S[8];
#pragma unroll
        for (int j = 0; j < 8; ++j) S[j] = 0.f;
        for (int c0 = 0; c0 < 32; c0 += 8) {
            u32x4 d[8]; f32x4 e0[8], e1[8];
#pragma unroll
            for (int u = 0; u < 8; ++u) { d[u] = *(const u32x4*)(p + (size_t)(c0 + u) * 16384); e0[u] = *(const f32x4*)(eb + (c0 + u) * 128); e1[u] = *(const f32x4*)(eb + (c0 + u) * 128 + 4); }
#pragma unroll
            for (int u = 0; u < 8; ++u) { float dv[8]; unpack8(d[u], dv);
                *(u32x4*)(p + (size_t)(c0 + u) * 16384) = (u32x4){pk2(S[0], S[1]), pk2(S[2], S[3]), pk2(S[4], S[5]), pk2(S[6], S[7])};
#pragma unroll
                for (int j = 0; j < 4; ++j) { S[j] = S[j] * e0[u][j] + dv[j]; S[4 + j] = S[4 + j] * e1[u][j] + dv[4 + j]; } }
        }
        float* so = st_out + (size_t)bh * 16384 + (size_t)(8 * k8) * 128 + v;
#pragma unroll
        for (int j = 0; j < 8; ++j) so[j * 128] = S[j];
    }
}
__device__ __forceinline__ void hgrn_stepC(LAS unsigned char* lds, const bf16* proj, const float* lbl, const float* gain, const bf16* dS, bf16* cat, int bid, int G, int tid, int wave, int lane) {
    constexpr int PQ = 272, PK = 144;
    LAS unsigned char* Qd = lds; LAS unsigned char* Kd = lds + 17408; LAS unsigned char* Vt = lds + 34816;
    LAS unsigned char* P = lds + 53248; LAS unsigned char* St = lds + 62464;
    LAS float* qsum = (LAS float*)(lds + 97280); LAS float* part = qsum + 512; LAS float* rsr = part + 512;
    const int tq = wave >> 1, k = ((wave & 1) << 6) + lane, r = lane & 15, q = lane >> 4, w = wave;
    LAS float* lbt = rsr + 64; LAS float* gnt = lbt + 768;
    for (int c2 = wave * 64 + lane; c2 < 768; c2 += NT) { lbt[c2] = lb_of(lbl, c2); gnt[c2] = gain[c2]; }
    LBAR();
    unsigned qv[16], fv[16], iv[16]; u32x4 sreg[4];
    int it = bid;
    if (it < 1536) { const int bh = it >> 5, c = it & 31, b = bh / 6, h = bh - 6 * b; const unsigned lo_q = 256u + (unsigned)(h * 128 + k);
        const bf16* prow = proj + (size_t)(b * SEQ + 64 * c + 16 * tq) * NIN0;
#pragma unroll
        for (int i = 0; i < 16; ++i) { const bf16* up = prow + (size_t)i * NIN0; qv[i] = up[lo_q]; fv[i] = up[lo_q + 768u]; iv[i] = up[lo_q + 1536u]; }
        const u32x4* sp = (const u32x4*)(dS + (size_t)it * 16384) + tid;
#pragma unroll
        for (int j = 0; j < 4; ++j) sreg[j] = sp[512 * j]; }
    for (; it < 1536; it += G) {
        const int bh = it >> 5, c = it & 31, b = bh / 6, h = bh - 6 * b, ch = h * 128 + k;
        const float lbk = lbt[ch], oml = 1.0f - lbk;
#pragma unroll
        for (int i = 0; i < 16; ++i) asm volatile("" : "+v"(qv[i]), "+v"(fv[i]), "+v"(iv[i]));
        float lf[16], kk[16];
#pragma unroll
        for (int i = 0; i < 16; ++i) { float fz = bf2f(fv[i]); fz = fminf(fmaxf(fz, -30.f), 30.f); const float e = fexp2(-fz * LOG2E), sg = frcp(1.0f + e); lf[i] = flog2(lbk + oml * sg); kk[i] = oml * e * sg; }
        float run = 0.f;
#pragma unroll
        for (int i = 0; i < 16; ++i) { run += lf[i]; lf[i] = run; }
        qsum[tq * 128 + k] = run;
        { unsigned vp[8];
#pragma unroll
          for (int i = 0; i < 8; ++i) { const float z0 = bf2f(iv[2 * i]), z1 = bf2f(iv[2 * i + 1]); vp[i] = pk2(z0 * fsigmoid(z0), z1 * fsigmoid(z1)); }
          *(LAS u32x4*)(Vt + k * PK + tq * 32) = (u32x4){vp[0], vp[1], vp[2], vp[3]}; *(LAS u32x4*)(Vt + k * PK + tq * 32 + 16) = (u32x4){vp[4], vp[5], vp[6], vp[7]}; }
        LBAR();
        float off = 0.f;
#pragma unroll
        for (int j = 0; j < 4; ++j) { const float s = qsum[j * 128 + k]; if (j < tq) off += s; }
#pragma unroll
        for (int i = 0; i < 16; ++i) { const float bc = lf[i] + off; const float ed = fexp2(bc), edi = fexp2(-bc);
            *(LAS unsigned short*)(Qd + (16 * tq + i) * PQ + 2 * k) = (unsigned short)f2bf(bf2f(qv[i]) * ed);
            *(LAS unsigned short*)(Kd + (16 * tq + i) * PQ + 2 * k) = (unsigned short)f2bf(kk[i] * edi); }
#pragma unroll
        for (int j = 0; j < 4; ++j) { const int e = tid + 512 * j, v = e >> 4, k8 = e & 15; *(LAS u32x4*)(St + v * PQ + k8 * 16) = sreg[j]; }
        const unsigned lo_g = (unsigned)(4 * q) * NIN0 + 2560u + (unsigned)(h * 128 + 16 * w + r), lo_o = (unsigned)(4 * q) * D + 256u + (unsigned)(h * 128 + 16 * w + r);
        const bf16* crow = proj + (size_t)(b * SEQ + 64 * c) * NIN0;
        unsigned gv[16];
#pragma unroll
        for (int ti = 0; ti < 4; ++ti)
#pragma unroll
            for (int i = 0; i < 4; ++i) { const bf16* up = crow + (size_t)(16 * ti + i) * NIN0; gv[ti * 4 + i] = up[lo_g]; }
        { const int nit = it + G;
          if (nit < 1536) { const int nbh = nit >> 5, nc = nit & 31, nb = nbh / 6, nh = nbh - 6 * nb; const unsigned lo_q = 256u + (unsigned)(nh * 128 + k);
              const bf16* prow = proj + (size_t)(nb * SEQ + 64 * nc + 16 * tq) * NIN0;
#pragma unroll
              for (int i = 0; i < 16; ++i) { const bf16* up = prow + (size_t)i * NIN0; qv[i] = up[lo_q]; fv[i] = up[lo_q + 768u]; iv[i] = up[lo_q + 1536u]; }
              const u32x4* sp = (const u32x4*)(dS + (size_t)nit * 16384) + tid;
#pragma unroll
              for (int j = 0; j < 4; ++j) sreg[j] = sp[512 * j]; } }
        LBAR();
        { const int ti = w >> 1;
#pragma unroll
          for (int sj = 0; sj < 2; ++sj) { const int si = 2 * (w & 1) + sj; f32x4 acc = {0.f, 0.f, 0.f, 0.f};
              if (si <= ti) {
#pragma unroll
                  for (int ks = 0; ks < 4; ++ks) { const bf16x8 av = *(const LAS bf16x8*)(Qd + (16 * ti + r) * PQ + ks * 64 + q * 16), bv = *(const LAS bf16x8*)(Kd + (16 * si + r) * PQ + ks * 64 + q * 16); acc = MFMA16(av, bv, acc); } }
#pragma unroll
              for (int i = 0; i < 4; ++i) { const int t = 16 * ti + 4 * q + i, s = 16 * si + r; *(LAS unsigned short*)(P + t * PK + 2 * s) = (unsigned short)f2bf(s <= t ? acc[i] : 0.f); } } }
        f32x4 o[4];
#pragma unroll
        for (int ti = 0; ti < 4; ++ti) o[ti] = (f32x4){0.f, 0.f, 0.f, 0.f};
        { bf16x8 bS[4];
#pragma unroll
          for (int ks = 0; ks < 4; ++ks) bS[ks] = *(const LAS bf16x8*)(St + (16 * w + r) * PQ + ks * 64 + q * 16);
#pragma unroll
          for (int ti = 0; ti < 4; ++ti)
#pragma unroll
              for (int ks = 0; ks < 4; ++ks) { const bf16x8 av = *(const LAS bf16x8*)(Qd + (16 * ti + r) * PQ + ks * 64 + q * 16); o[ti] = MFMA16(av, bS[ks], o[ti]); } }
        LBAR();
        { bf16x8 bV[2];
#pragma unroll
          for (int ks = 0; ks < 2; ++ks) bV[ks] = *(const LAS bf16x8*)(Vt + (16 * w + r) * PK + ks * 64 + q * 16);
#pragma unroll
          for (int ti = 0; ti < 4; ++ti)
#pragma unroll
              for (int ks = 0; ks < 2; ++ks) { const bf16x8 av = *(const LAS bf16x8*)(P + (16 * ti + r) * PK + ks * 64 + q * 16); o[ti] = MFMA16(av, bV[ks], o[ti]); } }
#pragma unroll
        for (int ti = 0; ti < 4; ++ti)
#pragma unroll
            for (int i = 0; i < 4; ++i) { float p = o[ti][i] * o[ti][i]; p += __shfl_xor(p, 1); p += __shfl_xor(p, 2); p += __shfl_xor(p, 4); p += __shfl_xor(p, 8);
                if (r == 0) part[w * 64 + 16 * ti + 4 * q + i] = p; }
        LBAR();
        if (tid < 64) { float s = 0.f;
#pragma unroll
            for (int j = 0; j < 8; ++j) s += part[j * 64 + tid];
            rsr[tid] = __builtin_amdgcn_rsqf(s * (1.0f / 128.0f) + EPS); }
        LBAR();
        const float gain_v = gnt[h * 128 + 16 * w + r];
        bf16* orow = cat + (size_t)(b * SEQ + 64 * c) * D;
#pragma unroll
        for (int ti = 0; ti < 4; ++ti)
#pragma unroll
            for (int i = 0; i < 4; ++i) { const int t = 16 * ti + 4 * q + i; const float val = o[ti][i] * rsr[t] * gain_v * fsigmoid(bf2f(gv[ti * 4 + i]));
                bf16* up = orow + (size_t)(16 * ti + i) * D; up[lo_o] = (bf16)f2bf(val); }
    }
    LBAR();
}

template <bool OUT>
__device__ __forceinline__ void hgrn_seg(LAS unsigned char* lds, const bf16* proj, const float* lbl, const float* gain, bf16* cat, float* st_out, float* segS, float* segD, int b, int h, int seg, int tid, int wave, int lane) {
    constexpr int PQ = 272, PK = 144;
    LAS unsigned char* Qd = lds; LAS unsigned char* Kd = lds + 17408; LAS unsigned char* KeT = lds + 34816; LAS unsigned char* Vt = lds + 53248;
    LAS unsigned char* P = lds + 71680; LAS unsigned char* St = lds + 80896;
    LAS float* qsum = (LAS float*)(lds + 115712); LAS float* ebl = qsum + 512; LAS float* part = ebl + 128; LAS float* rsr = part + 512;
    const int tq = wave >> 1, k = ((wave & 1) << 6) + lane, r = lane & 15, q = lane >> 4, w = wave;
    const int ch = h * 128 + k;
    const unsigned lo_q = 256u + (unsigned)ch, lo_f = 1024u + (unsigned)ch, lo_i = 1792u + (unsigned)ch;
    const unsigned lo_g = (unsigned)(4 * q) * NIN0 + 2560u + (unsigned)(h * 128 + 16 * w + r), lo_o = (unsigned)(4 * q) * D + 256u + (unsigned)(h * 128 + 16 * w + r);
    const float lbk = lb_of(lbl, ch), oml = 1.0f - lbk;
    f32x4 Sacc[8]; f32x4 dseg = {1.f, 1.f, 1.f, 1.f};
#pragma unroll
    for (int n = 0; n < 8; ++n) Sacc[n] = (f32x4){0.f, 0.f, 0.f, 0.f};
    const size_t bh = (size_t)(b * 6 + h);
    if (OUT) {
        for (int j = 0; j < seg; ++j) { const float* sp = segS + ((bh * 4 + j) * 8 + w) * 2048 + lane * 4; const f32x4 dj = *(const f32x4*)(segD + ((bh * 4 + j) * 8 + w) * 256 + lane * 4);
#pragma unroll
            for (int n = 0; n < 8; ++n) Sacc[n] = Sacc[n] * dj + *(const f32x4*)(sp + n * 256); }
#pragma unroll
        for (int n = 0; n < 8; ++n) *(LAS u32x2*)(St + (16 * n + r) * PQ + (16 * w + 4 * q) * 2) = (u32x2){pk2(Sacc[n][0], Sacc[n][1]), pk2(Sacc[n][2], Sacc[n][3])};
    }
    const bf16* pbase = proj + (size_t)(b * SEQ) * NIN0;
    const float gain_v = gain[h * 128 + 16 * w + r];
    unsigned qv[16], fv[16], iv[16];
    { const bf16* prow = pbase + (size_t)(seg * 512 + 16 * tq) * NIN0;
#pragma unroll
      for (int i = 0; i < 16; ++i) { const bf16* up = prow + (size_t)i * NIN0; if (OUT) qv[i] = up[lo_q]; fv[i] = up[lo_f]; iv[i] = up[lo_i]; } }
    for (int c = seg * 8; c < seg * 8 + 8; ++c) {
#pragma unroll
        for (int i = 0; i < 16; ++i) { asm volatile("" : "+v"(fv[i]), "+v"(iv[i])); if (OUT) asm volatile("" : "+v"(qv[i])); }
        float lf[16], kk[16];
#pragma unroll
        for (int i = 0; i < 16; ++i) { float fz = bf2f(fv[i]); fz = fminf(fmaxf(fz, -30.f), 30.f); const float e = fexp2(-fz * LOG2E), sg = frcp(1.0f + e); lf[i] = flog2(lbk + oml * sg); kk[i] = oml * e * sg; }
        float run = 0.f;
#pragma unroll
        for (int i = 0; i < 16; ++i) { run += lf[i]; lf[i] = run; }
        qsum[tq * 128 + k] = run;
        { unsigned vp[8];
#pragma unroll
          for (int i = 0; i < 8; ++i) { const float z0 = bf2f(iv[2 * i]), z1 = bf2f(iv[2 * i + 1]); vp[i] = pk2(z0 * fsigmoid(z0), z1 * fsigmoid(z1)); }
          *(LAS u32x4*)(Vt + k * PK + tq * 32) = (u32x4){vp[0], vp[1], vp[2], vp[3]}; *(LAS u32x4*)(Vt + k * PK + tq * 32 + 16) = (u32x4){vp[4], vp[5], vp[6], vp[7]}; }
        LBAR();
        float off = 0.f, tot = 0.f;
#pragma unroll
        for (int j = 0; j < 4; ++j) { const float s = qsum[j * 128 + k]; tot += s; if (j < tq) off += s; }
        if (tq == 0) ebl[k] = fexp2(tot);
        { float ke[16];
#pragma unroll
          for (int i = 0; i < 16; ++i) { const float bc = lf[i] + off; const float ed = fexp2(bc), edi = fexp2(-bc); ke[i] = kk[i] * fexp2(tot - bc);
              if (OUT) { *(LAS unsigned short*)(Qd + (16 * tq + i) * PQ + 2 * k) = (unsigned short)f2bf(bf2f(qv[i]) * ed);
                         *(LAS unsigned short*)(Kd + (16 * tq + i) * PQ + 2 * k) = (unsigned short)f2bf(kk[i] * edi); } }
          unsigned kp[8];
#pragma unroll
          for (int i = 0; i < 8; ++i) kp[i] = pk2(ke[2 * i], ke[2 * i + 1]);
          *(LAS u32x4*)(KeT + k * PK + tq * 32) = (u32x4){kp[0], kp[1], kp[2], kp[3]}; *(LAS u32x4*)(KeT + k * PK + tq * 32 + 16) = (u32x4){kp[4], kp[5], kp[6], kp[7]}; }
        const bf16* crow = pbase + (size_t)(64 * c) * NIN0;
        unsigned gv[16];
#pragma unroll
        for (int ti = 0; ti < 4; ++ti)
#pragma unroll
            for (int i = 0; i < 4; ++i) { const bf16* up = crow + (size_t)(16 * ti + i) * NIN0; if (OUT) gv[ti * 4 + i] = up[lo_g]; }
        if (c + 1 < seg * 8 + 8) { const bf16* prow = crow + (size_t)(64 + 16 * tq) * NIN0;
#pragma unroll
            for (int i = 0; i < 16; ++i) { const bf16* up = prow + (size_t)i * NIN0; if (OUT) qv[i] = up[lo_q]; fv[i] = up[lo_f]; iv[i] = up[lo_i]; } }
        LBAR();
        f32x4 o[4];
        if (OUT) {
        { const int ti = w >> 1;
#pragma unroll
          for (int sj = 0; sj < 2; ++sj) { const int si = 2 * (w & 1) + sj; f32x4 acc = {0.f, 0.f, 0.f, 0.f};
              if (si <= ti) {
#pragma unroll
                  for (int ks = 0; ks < 4; ++ks) { const bf16x8 av = *(const LAS bf16x8*)(Qd + (16 * ti + r) * PQ + ks * 64 + q * 16), bv = *(const LAS bf16x8*)(Kd + (16 * si + r) * PQ + ks * 64 + q * 16); acc = MFMA16(av, bv, acc); } }
#pragma unroll
              for (int i = 0; i < 4; ++i) { const int t = 16 * ti + 4 * q + i, s = 16 * si + r; *(LAS unsigned short*)(P + t * PK + 2 * s) = (unsigned short)f2bf(s <= t ? acc[i] : 0.f); } } }
#pragma unroll
        for (int ti = 0; ti < 4; ++ti) o[ti] = (f32x4){0.f, 0.f, 0.f, 0.f};
        { bf16x8 bS[4];
#pragma unroll
          for (int ks = 0; ks < 4; ++ks) bS[ks] = *(const LAS bf16x8*)(St + (16 * w + r) * PQ + ks * 64 + q * 16);
#pragma unroll
          for (int ti = 0; ti < 4; ++ti)
#pragma unroll
              for (int ks = 0; ks < 4; ++ks) { const bf16x8 av = *(const LAS bf16x8*)(Qd + (16 * ti + r) * PQ + ks * 64 + q * 16); o[ti] = MFMA16(av, bS[ks], o[ti]); } }
        LBAR();
        { bf16x8 bV[2];
#pragma unroll
          for (int ks = 0; ks < 2; ++ks) bV[ks] = *(const LAS bf16x8*)(Vt + (16 * w + r) * PK + ks * 64 + q * 16);
#pragma unroll
          for (int ti = 0; ti < 4; ++ti)
#pragma unroll
              for (int ks = 0; ks < 2; ++ks) { const bf16x8 av = *(const LAS bf16x8*)(P + (16 * ti + r) * PK + ks * 64 + q * 16); o[ti] = MFMA16(av, bV[ks], o[ti]); } }
        }
        { bf16x8 aK[2];
#pragma unroll
          for (int ks = 0; ks < 2; ++ks) aK[ks] = *(const LAS bf16x8*)(KeT + (16 * w + r) * PK + ks * 64 + q * 16);
          const f32x4 dk = *(const LAS f32x4*)(ebl + 16 * w + 4 * q); dseg = dseg * dk;
#pragma unroll
          for (int n = 0; n < 8; ++n) { f32x4 s = Sacc[n] * dk;
#pragma unroll
              for (int ks = 0; ks < 2; ++ks) { const bf16x8 bv = *(const LAS bf16x8*)(Vt + (16 * n + r) * PK + ks * 64 + q * 16); s = MFMA16(aK[ks], bv, s); }
              Sacc[n] = s;
              if (OUT) *(LAS u32x2*)(St + (16 * n + r) * PQ + (16 * w + 4 * q) * 2) = (u32x2){pk2(s[0], s[1]), pk2(s[2], s[3])}; } }
        if (!OUT) { LBAR(); continue; }
#pragma unroll
        for (int ti = 0; ti < 4; ++ti)
#pragma unroll
            for (int i = 0; i < 4; ++i) { float p = o[ti][i] * o[ti][i]; p += __shfl_xor(p, 1); p += __shfl_xor(p, 2); p += __shfl_xor(p, 4); p += __shfl_xor(p, 8);
                if (r == 0) part[w * 64 + 16 * ti + 4 * q + i] = p; }
        LBAR();
        if (tid < 64) { float s = 0.f;
#pragma unroll
            for (int j = 0; j < 8; ++j) s += part[j * 64 + tid];
            rsr[tid] = __builtin_amdgcn_rsqf(s * (1.0f / 128.0f) + EPS); }
        LBAR();
        bf16* orow = cat + (size_t)(b * SEQ + 64 * c) * D;
#pragma unroll
        for (int ti = 0; ti < 4; ++ti)
#pragma unroll
            for (int i = 0; i < 4; ++i) { const int t = 16 * ti + 4 * q + i; const float val = o[ti][i] * rsr[t] * gain_v * fsigmoid(bf2f(gv[ti * 4 + i])); bf16* up = orow + (size_t)(16 * ti + i) * D; up[lo_o] = (bf16)f2bf(val); }
    }
    if (!OUT) { float* sp = segS + ((bh * 4 + seg) * 8 + w) * 2048 + lane * 4;
#pragma unroll
        for (int n = 0; n < 8; ++n) *(f32x4*)(sp + n * 256) = Sacc[n];
        *(f32x4*)(segD + ((bh * 4 + seg) * 8 + w) * 256 + lane * 4) = dseg; }
    else if (seg == 3) { float* so = st_out + (size_t)((b * 6 + h) * 128) * 128;
#pragma unroll
        for (int n = 0; n < 8; ++n)
#pragma unroll
            for (int i = 0; i < 4; ++i) so[(size_t)(16 * w + 4 * q + i) * 128 + 16 * n + r] = Sacc[n][i]; }
    LBAR();
}

__device__ __forceinline__ void conv_phase(const PArgs& a, int bid, int G, int tid) {
    unsigned char* ws = a.ws;
    const bf16* proj = (const bf16*)(ws + WS_SH); bf16* cat = (bf16*)(ws + WS_CAT); const float* cw = a.in[15];
    for (int gt = bid * NT + tid; gt < 1024 * 128; gt += G * NT) {
        const int cgp = gt & 127, rb = gt >> 7, b = rb >> 7, tl0 = (rb & 127) * 16, c0 = 8 * cgp;
        float w0[8], w1[8], w2[8], zm2[8], zm1[8];
#pragma unroll
        for (int e = 0; e < 8; ++e) { w0[e] = cw[c0 + e]; w1[e] = cw[1024 + c0 + e]; w2[e] = cw[2048 + c0 + e]; zm2[e] = 0.f; zm1[e] = 0.f; }
        const bf16* pr = proj + (size_t)(b * SEQ + tl0) * NIN1 + c0;
        if (tl0 > 0) { float cgv[8], hvv[8];
            unpack8(*(const u32x4*)(pr - 2 * NIN1 + 1024), cgv); unpack8(*(const u32x4*)(pr - 2 * NIN1 + 2048), hvv);
#pragma unroll
            for (int e = 0; e < 8; ++e) zm2[e] = cgv[e] * hvv[e];
            unpack8(*(const u32x4*)(pr - NIN1 + 1024), cgv); unpack8(*(const u32x4*)(pr - NIN1 + 2048), hvv);
#pragma unroll
            for (int e = 0; e < 8; ++e) zm1[e] = cgv[e] * hvv[e]; }
#pragma unroll 1
        for (int i = 0; i < 16; ++i) { float bgv[8], cgv[8], hvv[8], o[8];
            unpack8(*(const u32x4*)(pr + (size_t)i * NIN1), bgv); unpack8(*(const u32x4*)(pr + (size_t)i * NIN1 + 1024), cgv); unpack8(*(const u32x4*)(pr + (size_t)i * NIN1 + 2048), hvv);
#pragma unroll
            for (int e = 0; e < 8; ++e) { const float z = cgv[e] * hvv[e]; o[e] = bgv[e] * (w0[e] * zm2[e] + w1[e] * zm1[e] + w2[e] * z); zm2[e] = zm1[e]; zm1[e] = z; }
            *(u32x4*)(cat + (size_t)(b * SEQ + tl0 + i) * D + c0) = (u32x4){pk2(o[0], o[1]), pk2(o[2], o[3]), pk2(o[4], o[5]), pk2(o[6], o[7])};
            const int t = tl0 + i;
            if (t >= SEQ - 2) { float* co = a.out + O_CONVP + (size_t)(b * 2 + (t - (SEQ - 2))) * 1024 + c0;
                *(f32x4*)co = (f32x4){zm1[0], zm1[1], zm1[2], zm1[3]}; *(f32x4*)(co + 4) = (f32x4){zm1[4], zm1[5], zm1[6], zm1[7]}; } }
    }
    const bf16* projs = (const bf16*)(ws + WS_PROJS); bf16* cats = (bf16*)(ws + WS_CATS); const float* sc = a.in[4];
    for (int gt = bid * NT + tid; gt < MS * 128; gt += G * NT) {
        const int cgp = gt & 127, b = gt >> 7, c0 = 8 * cgp; float bgv[8], cgv[8], hvv[8], o[8], z[8];
        const bf16* pr = projs + (size_t)b * NIN1 + c0;
        unpack8(*(const u32x4*)pr, bgv); unpack8(*(const u32x4*)(pr + 1024), cgv); unpack8(*(const u32x4*)(pr + 2048), hvv);
        const float* p0 = sc + (size_t)(b * 2) * 1024 + c0; const float* p1 = p0 + 1024;
        float* co = a.out + O_CONVS + (size_t)(b * 2) * 1024 + c0;
#pragma unroll
        for (int e = 0; e < 8; ++e) { z[e] = cgv[e] * hvv[e]; o[e] = bgv[e] * (cw[c0 + e] * p0[e] + cw[1024 + c0 + e] * p1[e] + cw[2048 + c0 + e] * z[e]); co[e] = p1[e]; co[1024 + e] = z[e]; }
        *(u32x4*)(cats + (size_t)b * D + c0) = (u32x4){pk2(o[0], o[1]), pk2(o[2], o[3]), pk2(o[4], o[5]), pk2(o[6], o[7])};
    }
}

__device__ __forceinline__ void final_norm(const PArgs& a, int bid, int G, int wave, int lane) {
    const int gw = bid * NWAVES + wave, NGW = G * NWAVES; const float* gf = a.in[7]; const float* ss4 = (const float*)(a.ws + WS_SS) + 4 * MP;
    f32x4 gv[4];
#pragma unroll
    for (int j = 0; j < 4; ++j) gv[j] = ((const f32x4*)gf)[lane + 64 * j];
    for (int m = gw; m < MP + MS; m += NGW) {
        if (m < MP) { f32x4* yr = (f32x4*)(a.out + O_Y + (size_t)m * D) + lane; const u32x2* xr = (const u32x2*)((const bf16*)(a.ws + WS_XB) + (size_t)m * D) + lane;
            const float rs = __builtin_amdgcn_rsqf(ss4[m] * (1.0f / 1024.0f) + EPS);
#pragma unroll
            for (int j = 0; j < 4; ++j) { const u32x2 w = xr[64 * j]; const f32x4 v = {__uint_as_float(w.x << 16), __uint_as_float(w.x & 0xffff0000u), __uint_as_float(w.y << 16), __uint_as_float(w.y & 0xffff0000u)}; yr[64 * j] = v * rs * gv[j]; } }
        else { const int sr = m - MP; const f32x4* xr = (const f32x4*)((const float*)(a.ws + WS_XS) + (size_t)sr * D) + lane; f32x4* yr = (f32x4*)(a.out + O_YS + (size_t)sr * D) + lane;
            f32x4 v[4]; float s = 0.f;
#pragma unroll
            for (int j = 0; j < 4; ++j) { v[j] = xr[64 * j]; s += (v[j].x * v[j].x + v[j].y * v[j].y) + (v[j].z * v[j].z + v[j].w * v[j].w); }
            const float rs = __builtin_amdgcn_rsqf(wave_sum(s) * (1.0f / 1024.0f) + EPS);
#pragma unroll
            for (int j = 0; j < 4; ++j) yr[64 * j] = v[j] * rs * gv[j]; }
    }
}

#define XB_TMO      128
#define XB_XCNT(j)  (256  + 64 * (j))
#define XB_XSUB(j)  (1280 + 64 * (j))
#define XB_XGEN(j)  (2304 + 64 * (j))
#define XB_TOP      3328
#define XB_TOPGEN   3392
#define XCD_BAR_WORDS 3456
#define XB_SPIN_CAP (1u << 18)

__device__ __forceinline__ unsigned xb_ld(unsigned* p)              { return __hip_atomic_load(p, __ATOMIC_RELAXED, __HIP_MEMORY_SCOPE_AGENT); }
__device__ __forceinline__ unsigned xb_add(unsigned* p, unsigned v) { return __hip_atomic_fetch_add(p, v, __ATOMIC_RELAXED, __HIP_MEMORY_SCOPE_AGENT); }
__device__ __forceinline__ unsigned xb_xcc_id() { return (unsigned)__builtin_amdgcn_s_getreg((3 << 11) | 20) & 0xFu; }
#define XB_SPIN(cond, bar) do { unsigned _sp = 0; while (cond) { __builtin_amdgcn_s_sleep(1); \
    if ((++_sp & 255u) == 0u) { if (xb_ld(&(bar)[XB_TMO])) break; if (_sp > XB_SPIN_CAP) { atomicAdd(&(bar)[XB_TMO], 1u); break; } } } } while (0)

struct XcdBarrier {
    unsigned* bar; unsigned x;
    volatile LAS unsigned* st;
};

__device__ __forceinline__ XcdBarrier xcd_barrier_post(unsigned* bar, volatile LAS unsigned* st) {
    XcdBarrier b; b.bar = bar; b.x = xb_xcc_id(); b.st = st;
    if (threadIdx.x == 0) (void)xb_add(&bar[XB_XCNT(b.x)], 1u);
    return b;
}
__device__ __forceinline__ void xcd_barrier_complete(unsigned* bar, unsigned x, unsigned& nloc, unsigned& nx) {
    const unsigned G = gridDim.x * gridDim.y * gridDim.z;
    unsigned sum, cnt, mine, sp = 0u;
    for (;;) {
        sum = 0u; cnt = 0u; mine = 0u;
#pragma unroll
        for (unsigned j = 0; j < 16; ++j) { const unsigned c = xb_ld(&bar[XB_XCNT(j)]); sum += c; cnt += (c > 0u) ? 1u : 0u; mine = (j == x) ? c : mine; }
        if (sum == G) break;
        __builtin_amdgcn_s_sleep(1);
        if ((++sp & 255u) == 0u) { if (xb_ld(&bar[XB_TMO])) break; if (sp > XB_SPIN_CAP) { atomicAdd(&bar[XB_TMO], 1u); break; } }
    }
    nloc = mine > 0u ? mine : 1u; nx = cnt > 0u ? cnt : 1u;
}

__device__ __forceinline__ void xcd_barrier(const XcdBarrier& b) {
    asm volatile("s_waitcnt vmcnt(0)" ::: "memory");
    __syncthreads();
    if (threadIdx.x == 0) {
        unsigned* bar = b.bar;
        __builtin_amdgcn_s_waitcnt(0);
        unsigned nloc = b.st[0], nx = b.st[1];
        if (nloc == 0u) { xcd_barrier_complete(bar, b.x, nloc, nx); b.st[0] = nloc; b.st[1] = nx; }
        const unsigned old = xb_add(&bar[XB_XSUB(b.x)], 1u);
        const unsigned gen = old / nloc;
        if (old + 1u == (gen + 1u) * nloc) {
            __builtin_amdgcn_fence(__ATOMIC_RELEASE, "agent");
            asm volatile("s_waitcnt vmcnt(0)" ::: "memory");
            const unsigned og = xb_add(&bar[XB_TOP], 1u);
            const unsigned tg = og / nx;
            if (og + 1u == (tg + 1u) * nx) xb_add(&bar[XB_TOPGEN], 1u);
            else XB_SPIN(xb_ld(&bar[XB_TOPGEN]) == tg, bar);
            __builtin_amdgcn_fence(__ATOMIC_ACQUIRE, "agent");
            xb_add(&bar[XB_XGEN(b.x)], 1u);
            asm volatile("s_waitcnt vmcnt(0)" ::: "memory");
        } else {
            XB_SPIN(xb_ld(&bar[XB_XGEN(b.x)]) == gen, bar);
            __builtin_amdgcn_fence(__ATOMIC_ACQUIRE, "agent");
            asm volatile("s_waitcnt vmcnt(0)" ::: "memory");
        }
    }
    __syncthreads();
}

#ifndef DIS_GEMM
#define DIS_GEMM 0
#endif
#ifndef DIS_SGEMM
#define DIS_SGEMM 0
#endif
#ifndef DIS_HGRN
#define DIS_HGRN 0
#endif
#ifndef DIS_OTHER
#define DIS_OTHER 0
#endif
#ifndef DBG_O
#define DBG_O 15
#endif
#ifndef DUPK
#define DUPK 0
#endif
#ifndef DBG_XSYNC
#define DBG_XSYNC 0
#endif
#ifndef DBG_COL
#define DBG_COL 2304
#endif
#ifndef DBG_HI
#define DBG_HI 12
#endif
#ifndef MK_MULTI
#define MK_MULTI 0
#endif
constexpr int N_PHASES = 12;
#define IN(k) (lo <= (k) && (k) < hi)
#define SEAM(k) do { if (IN(k) && IN((k) + 1)) xcd_barrier(xbar); } while (0)
template <int L>
__device__ __forceinline__ void layer_phases(const PArgs& a, LAS unsigned char* lds, const XcdBarrier& xbar, int lo, int hi, int bid, int G, int tid, int wave, int lane) {
    unsigned char* ws = a.ws;
    float* ss = (float*)(ws + WS_SS);
    bf16* CAT = (bf16*)(ws + WS_CAT); bf16* SH = (bf16*)(ws + WS_SH); bf16* XB = (bf16*)(ws + WS_XB);
    float* xs = (float*)(ws + WS_XS); bf16* projs = (bf16*)(ws + WS_PROJS); bf16* cats = (bf16*)(ws + WS_CATS); bf16* hs = (bf16*)(ws + WS_HS);
    float* Y = a.out + O_Y;
    constexpr int pb = 1 + 5 * L;
    const bf16* Win = (const bf16*)(ws + (L ? WS_WIN1 : WS_WIN0)); const bf16* Wout = (const bf16*)(ws + (L ? WS_WOUT1 : WS_WOUT0));
    const bf16* W1 = (const bf16*)(ws + (L ? WS_W11 : WS_W10)); const bf16* W2 = (const bf16*)(ws + (L ? WS_W21 : WS_W20));
    constexpr int Nin = L ? NIN1 : NIN0;
    if (IN(pb)) {
        pg8::Gemm g{L ? XB : CAT, Win, MP, Nin, D}; pg8::StaticOrder S; S.init(MP, Nin, G, bid);
        pg8::EpiScaleBf16<0> E{SH, Nin, ss + (L ? 2 : 0) * MP};
        for (int rep = 0; rep < (DUPK == 5 ? 2 : 1); ++rep) pg8::gemm_phase<pg8::EpiScaleBf16<0>, pg8::StaticOrder, true, true>(lds, g, S, E);
        for (int rep = 0; rep < (DUPK == 1 ? 2 : 1); ++rep) sgemm<true, 0, 4>(lds, L ? (const void*)xs : (const void*)a.in[1], D, Win, Nin, D, 1, projs, Nin, xs, G, bid, tid, wave, lane, (L == 0 && G == 256) ? 64 : 0);
    }
    SEAM(pb);
    if (IN(pb + 1)) {
        if (L == 0) {
            float* segS = (float*)(ws + WS_DS); float* segD = (float*)(ws + WS_DS + 16 * MiB);
            for (int u = bid; u < 144; u += G) hgrn_seg<false>(lds, SH, a.in[11], a.in[12], CAT, a.out + O_HGP, segS, segD, (u / 3) / 6, (u / 3) % 6, u % 3, tid, wave, lane);
            if (G > 144) { if (bid >= 144) for (int it = bid - 144; it < MS * 6; it += 3 * (G - 144)) hgrn_sample3(lds, projs, a.in[3], a.in[11], a.in[12], cats, a.out + O_HGS, it, G - 144, tid, wave, lane); }
            else for (int it = bid; it < MS * 6; it += 3 * G) hgrn_sample3(lds, projs, a.in[3], a.in[11], a.in[12], cats, a.out + O_HGS, it, G, tid, wave, lane);
            pool_prompt_wave(lds, SH, a.in[9], a.in[10], CAT, a.out + O_POOLP, bid, G, tid, wave, lane);
            xcd_barrier(xbar);
            for (int u = bid; u < 192; u += G) hgrn_seg<true>(lds, SH, a.in[11], a.in[12], CAT, a.out + O_HGP, segS, segD, (u / 4) / 6, (u / 4) % 6, u % 4, tid, wave, lane);
            if (bid >= 192) for (int it = bid - 192; it < 8; it += G - 192) pool_sample(lds, projs, a.in[2], a.in[9], a.in[10], cats, a.out + O_POOLS, it, tid);
            else if (G <= 192) for (int it = bid; it < 8; it += G) pool_sample(lds, projs, a.in[2], a.in[9], a.in[10], cats, a.out + O_POOLS, it, tid);
        } else { conv_phase(a, bid, G, tid); }
    }
    SEAM(pb + 1);
    if (IN(pb + 2)) {
        pg8::Gemm g{CAT, Wout, MP, D, D}; pg8::StaticOrder S; S.init(MP, D, G, bid);
        pg8::EpiResid E{L ? (const float*)nullptr : a.in[0], XB, ss + (L ? 3 : 1) * MP};
        if (DUPK == 6) { pg8::EpiNull EN{Y, a.ph_lo}; pg8::gemm_phase<pg8::EpiNull, pg8::StaticOrder, true, true>(lds, g, S, EN); }
        if (!DIS_GEMM) pg8::gemm_phase<pg8::EpiResid, pg8::StaticOrder, false, true>(lds, g, S, E);
        if (!DIS_SGEMM) sgemm<false, 2, 1>(lds, cats, D, Wout, D, D, 4, nullptr, 0, xs, G, bid, tid, wave, lane);
    }
    SEAM(pb + 2);
    if (IN(pb + 3)) {
        pg8::Gemm g{XB, W1, MP, FF, D}; pg8::StaticOrder S; S.init(MP, FF, G, bid);
        pg8::EpiScaleBf16<1> E{SH, FF, ss + (L ? 3 : 1) * MP};
        for (int rep = 0; rep < (DUPK == 2 ? 2 : 1); ++rep) pg8::gemm_phase<pg8::EpiScaleBf16<1>, pg8::StaticOrder, true, true>(lds, g, S, E);
        for (int rep = 0; rep < (DUPK == 1 ? 2 : 1); ++rep) sgemm<true, 1, 4>(lds, xs, D, W1, FF, D, 1, hs, FF, xs, G, bid, tid, wave, lane);
    }
    SEAM(pb + 3);
    if (IN(pb + 4)) {
        pg8::Gemm g{SH, W2, MP, D, FF}; pg8::StaticOrder S; S.init(MP, D, G, bid);
        pg8::EpiResid E{nullptr, XB, ss + (L ? 4 : 2) * MP};
        if (DUPK == 7) { pg8::EpiNull EN{Y, a.ph_lo}; pg8::gemm_phase<pg8::EpiNull, pg8::StaticOrder, true, true>(lds, g, S, EN); }
        if (!DIS_GEMM) pg8::gemm_phase<pg8::EpiResid, pg8::StaticOrder, false, true>(lds, g, S, E);
        if (!DIS_SGEMM) sgemm<false, 2, 4>(lds, hs, FF, W2, D, FF, 4, nullptr, 0, xs, G, bid, tid, wave, lane);
    }
    SEAM(pb + 4);
}
__global__ void __launch_bounds__(NT, 2) mk_fwd(PArgs a) {
    extern __shared__ __attribute__((aligned(16))) unsigned char lds_raw[];
    LAS unsigned char* lds = (LAS unsigned char*)lds_raw;
    const int tid = threadIdx.x, lane = tid & 63, wave = __builtin_amdgcn_readfirstlane(tid >> 6), bid = blockIdx.x, G = gridDim.x;
    const int lo = a.ph_lo, hi = a.ph_hi;
    volatile LAS unsigned* xst = (volatile LAS unsigned*)(lds + 131072 + 64);
    if (tid < 2) xst[tid] = 0u;
    __syncthreads();
    const XcdBarrier xbar = xcd_barrier_post((unsigned*)a.ws, xst);
    if (lo < 0) cg::this_grid().sync();
    if (IN(0)) { for (int rep = 0; rep < (DUPK == 3 ? 2 : 1); ++rep) { p0_prologue(a, lds, bid, G, tid, wave, lane); __syncthreads(); } }
    SEAM(0);
    layer_phases<0>(a, lds, xbar, lo, hi, bid, G, tid, wave, lane);
    layer_phases<1>(a, lds, xbar, lo, hi, bid, G, tid, wave, lane);
    for (int xx = 0; xx < DBG_XSYNC; ++xx) xcd_barrier(xbar);
    if (IN(11)) final_norm(a, bid, G, wave, lane);
    if (hi < 12) {
        if (hi <= 3) { cg::this_grid().sync(); const bf16* C = (const bf16*)(a.ws + WS_CAT); for (size_t i = (size_t)bid * NT + tid; i < O_YS; i += (size_t)G * NT) a.out[i] = ((i & 1023) >= 256) ? bf2f(C[i]) : 0.f; }
        for (size_t i = (size_t)bid * NT + tid; i < 131072; i += (size_t)G * NT) a.out[O_YS + i] = 0.f;
        if (hi <= 2) for (size_t i = (size_t)bid * NT + tid + O_POOLP; i < O_CONVS; i += (size_t)G * NT) a.out[i] = 0.f;
        if (hi <= 7) { for (size_t i = (size_t)bid * NT + tid; i < 16384; i += (size_t)G * NT) a.out[O_CONVP + i] = 0.f;
                       for (size_t i = (size_t)bid * NT + tid; i < 262144; i += (size_t)G * NT) a.out[O_CONVS + i] = 0.f; }
    }
}
#undef IN
#undef SEAM

extern "C" void kernel_launch(void* const* d_in, const int* in_sizes, int n_in, void* d_out, int out_size, void* d_ws, size_t ws_size, hipStream_t stream) {
    static int grid = 0;
    if (grid == 0) {
        if (n_in != 19 || ws_size < WS_END) { fprintf(stderr, "kernel_launch: unexpected inputs (n_in %d, ws %zu)\n", n_in, ws_size); grid = -1; return; }
        int dev = 0, cus = 0, per_cu = 0;
        if (hipGetDevice(&dev) != hipSuccess || hipDeviceGetAttribute(&cus, hipDeviceAttributeMultiprocessorCount, dev) != hipSuccess) { grid = -1; return; }
        if (hipFuncSetAttribute((const void*)mk_fwd, hipFuncAttributeMaxDynamicSharedMemorySize, LDS_BYTES) != hipSuccess) { fprintf(stderr, "kernel_launch: hipFuncSetAttribute failed\n"); grid = -1; return; }
        if (hipOccupancyMaxActiveBlocksPerMultiprocessor(&per_cu, (const void*)mk_fwd, NT, LDS_BYTES) != hipSuccess || per_cu < 1) { fprintf(stderr, "kernel_launch: occupancy query says %d\n", per_cu); per_cu = 1; }
        (void)hipGetLastError();
        grid = cus;
    }
    if (grid < 0) return;
    PArgs a{};
    for (int i = 0; i < 19; ++i) a.in[i] = (const float*)d_in[i];
    a.out = (float*)d_out; a.ws = (unsigned char*)d_ws;
#if MK_MULTI
    for (int k = 0; k < DBG_HI; ++k) { a.ph_lo = k; a.ph_hi = k + 1; hipLaunchKernelGGL(mk_fwd, dim3(grid), dim3(NT), LDS_BYTES, stream, a); }
#else
    a.ph_lo = 0; a.ph_hi = DBG_HI;
    if (hipMemsetAsync(d_ws, 0, 16384, stream) != hipSuccess) { fprintf(stderr, "kernel_launch: hipMemsetAsync failed\n"); return; }
    void* args[] = {&a};
    hipError_t e = hipLaunchCooperativeKernel((const void*)mk_fwd, dim3(grid), dim3(NT), args, LDS_BYTES, stream);
    if (e != hipSuccess) fprintf(stderr, "cooperative launch failed: %s (grid %d)\n", hipGetErrorString(e), grid);
#endif
}
```

```cpp
#include <hip/hip_runtime.h>
#include <hip/hip_cooperative_groups.h>
#include <cstdio>
#include <cstdint>
namespace cg = cooperative_groups;
#ifndef DBG_O
#define DBG_O 15
#endif
namespace pg8 {
#define PG8_LAS __attribute__((address_space(3)))
typedef unsigned short bf16_t;
typedef short bf16x8 __attribute__((ext_vector_type(8)));
typedef float f32x4 __attribute__((ext_vector_type(4)));
typedef unsigned u32x4 __attribute__((ext_vector_type(4)));
typedef unsigned u32x2 __attribute__((ext_vector_type(2)));
constexpr int BM = 256, BK = 64, HALF = 128, HTB = HALF * BK * 2  , STAGE_BYTES = 8 * HTB, NXCD = 8, WGM = 8;

__host__ __device__ __forceinline__ int lds_byte(int r, int c) { const int st = (r >> 4) * 2 + (c >> 5), rr = r & 15, cc = c & 31, ob = rr * 64 + cc * 2; return st * 1024 + (ob ^ (((ob >> 9) & 1) << 5)); }
__host__ __device__ __forceinline__ void stage_rc(int b, int& R, int& C) { const int st = b / 1024, sb = b % 1024, swz = sb ^ (((sb >> 9) & 1) << 5); R = (st >> 1) * 16 + swz / 64; C = (st & 1) * 32 + (swz % 64) / 2; }
__host__ __device__ __forceinline__ int perm32(int rho) { const int n = rho >> 4, i = rho & 15; return 8 * (i >> 2) + 4 * n + (i & 3); }

struct Unit { int pm, pn; };
struct Gemm { const bf16_t* A; const bf16_t* Bt; int M, N, K; };

struct StaticOrder {
    int nM, nN, nwg, G, c;
    __host__ __device__ void init(int M, int N, int G_, int c_) { nM = M / BM; nN = N / BM; nwg = nM * nN; G = G_; c = c_; }
    __host__ __device__ bool next(int i, Unit& u) const {
        const long L = (long)i * G + c; if (L >= nwg) return false;
        int wgid = (int)L; { const int q = nwg / NXCD, r = nwg % NXCD, xcd = wgid % NXCD, off = wgid / NXCD; wgid = (xcd < r ? xcd * (q + 1) : r * (q + 1) + (xcd - r) * q) + off; }
        const int nig = WGM * nN, gid = wgid / nig, fm = gid * WGM, gsz = (nM - fm) < WGM ? (nM - fm) : WGM;
        u.pm = fm + ((wgid % nig) % gsz); u.pn = (wgid % nig) / gsz; return true;
    }
    __device__ __forceinline__ void a_ready(const Unit&) const {}
    __device__ __forceinline__ void done(const Unit&) const {}
};

__device__ __forceinline__ unsigned cvt_pk_bf16(float lo, float hi) { unsigned r; asm volatile("v_cvt_pk_bf16_f32 %0, %1, %2" : "=v"(r) : "v"(lo), "v"(hi)); return r; }
template <int ACT  > struct EpiScaleBf16 {
    static constexpr bool PERM = true, AFTER_DRAIN = false;
    bf16_t* O; int ldc; const float* ss;
    __device__ __forceinline__ void operator()(const f32x4 (&acc)[2][2][4][2], const Unit& u, int wr, int wc, int fr, int fq) const {
        const int row0 = u.pm * BM + wr * 64 + fr, col0 = u.pn * BM + wc * 32 + 8 * fq;
#pragma unroll
        for (int ai = 0; ai < 2; ++ai)
#pragma unroll
            for (int m = 0; m < 4; ++m) { const int row = row0 + ai * HALF + m * 16; const float rs = __builtin_amdgcn_rsqf(ss[row] * (1.0f / 1024.0f) + 1e-6f);
                bf16_t* rowp = O + (size_t)row * ldc + col0;
#pragma unroll
                for (int bj = 0; bj < 2; ++bj) { f32x4 v0 = acc[ai][bj][m][0] * rs, v1 = acc[ai][bj][m][1] * rs;
                    if (ACT == 1) {
#pragma unroll
                        for (int e = 0; e < 4; ++e) { const float a = fmaxf(v0[e], 0.f), b = fmaxf(v1[e], 0.f); v0[e] = a * a; v1[e] = b * b; } }
                    u32x4 w; w.x = cvt_pk_bf16(v0[0], v0[1]); w.y = cvt_pk_bf16(v0[2], v0[3]); w.z = cvt_pk_bf16(v1[0], v1[1]); w.w = cvt_pk_bf16(v1[2], v1[3]);
                    *(u32x4*)(rowp + bj * HALF) = w; } }
    }
};
struct EpiNull {
    static constexpr bool PERM = true, AFTER_DRAIN = false;
    float* out; int never;
    __device__ __forceinline__ void operator()(const f32x4 (&acc)[2][2][4][2], const Unit& u, int wr, int wc, int fr, int fq) const {
        if (never) {
#pragma unroll
            for (int ai = 0; ai < 2; ++ai)
#pragma unroll
                for (int m = 0; m < 4; ++m)
#pragma unroll
                    for (int bj = 0; bj < 2; ++bj) { *(f32x4*)(out + (size_t)(u.pm * BM + wr * 64 + fr + ai * HALF + m * 16) * 1024 + u.pn * BM + wc * 32 + 8 * fq + bj * HALF) = acc[ai][bj][m][0] + acc[ai][bj][m][1]; } }
    }
};
struct EpiResid {
    static constexpr bool PERM = true, AFTER_DRAIN = false;
    const float* base32; bf16_t* xb; float* ss;
    __device__ __forceinline__ void operator()(const f32x4 (&acc)[2][2][4][2], const Unit& u, int wr, int wc, int fr, int fq) const {
        typedef float f32x2v __attribute__((ext_vector_type(2))); typedef __bf16 bf16x2v __attribute__((ext_vector_type(2)));
        const int row0 = u.pm * BM + wr * 64 + fr, col0 = u.pn * BM + wc * 32 + 8 * fq;
#pragma unroll
        for (int ai = 0; ai < 2; ++ai) {
            f32x4 bv[4][2][2];
            if (base32) {
#pragma unroll
                for (int m = 0; m < 4; ++m)
#pragma unroll
                    for (int bj = 0; bj < 2; ++bj)
#pragma unroll
                        for (int n = 0; n < 2; ++n) bv[m][bj][n] = *(const f32x4*)(base32 + (size_t)(row0 + ai * HALF + m * 16) * 1024 + col0 + bj * HALF + n * 4);
            } else {
                u32x4 raw[4][2];
#pragma unroll
                for (int m = 0; m < 4; ++m)
#pragma unroll
                    for (int bj = 0; bj < 2; ++bj) raw[m][bj] = *(const u32x4*)(xb + (size_t)(row0 + ai * HALF + m * 16) * 1024 + col0 + bj * HALF);
#pragma unroll
                for (int m = 0; m < 4; ++m)
#pragma unroll
                    for (int bj = 0; bj < 2; ++bj) { const u32x4 w = raw[m][bj];
                        bv[m][bj][0] = (f32x4){__uint_as_float(w.x << 16), __uint_as_float(w.x & 0xffff0000u), __uint_as_float(w.y << 16), __uint_as_float(w.y & 0xffff0000u)};
                        bv[m][bj][1] = (f32x4){__uint_as_float(w.z << 16), __uint_as_float(w.z & 0xffff0000u), __uint_as_float(w.w << 16), __uint_as_float(w.w & 0xffff0000u)}; }
            }
#pragma unroll
            for (int m = 0; m < 4; ++m) { const int row = row0 + ai * HALF + m * 16; const size_t off = (size_t)row * 1024 + col0; float sq = 0.f;
#pragma unroll
                for (int bj = 0; bj < 2; ++bj) { const f32x4 x0 = bv[m][bj][0] + acc[ai][bj][m][0], x1 = bv[m][bj][1] + acc[ai][bj][m][1];
                    sq += (x0[0] * x0[0] + x0[1] * x0[1]) + (x0[2] * x0[2] + x0[3] * x0[3]) + (x1[0] * x1[0] + x1[1] * x1[1]) + (x1[2] * x1[2] + x1[3] * x1[3]);
                    const f32x2v a0 = {x0[0], x0[1]}, a1 = {x0[2], x0[3]}, a2 = {x1[0], x1[1]}, a3 = {x1[2], x1[3]}; u32x4 w;
                    w.x = __builtin_bit_cast(unsigned, __builtin_convertvector(a0, bf16x2v)); w.y = __builtin_bit_cast(unsigned, __builtin_convertvector(a1, bf16x2v));
                    w.z = __builtin_bit_cast(unsigned, __builtin_convertvector(a2, bf16x2v)); w.w = __builtin_bit_cast(unsigned, __builtin_convertvector(a3, bf16x2v));
                    *(u32x4*)(xb + off + bj * HALF) = w; }
                sq += __shfl_xor(sq, 16); sq += __shfl_xor(sq, 32);
                if (fq == 0) atomicAdd(ss + row, sq); }
            asm volatile("" ::: "memory"); }
    }
};
template <class Epi, class Sched, bool ALIGN_EPI = false, bool SP2 = false>
__device__ __forceinline__ void gemm_phase(PG8_LAS unsigned char* lds, const Gemm g, const Sched& S, const Epi& E) {
    const int tid = threadIdx.x, wid = __builtin_amdgcn_readfirstlane(tid >> 6), lane = tid & 63, wr = wid >> 2, wc = wid & 3, fr = lane & 15, fq = lane >> 4;
    const int K = g.K, nt = K / BK;
    unsigned voffA[2], voffB[2];
#pragma unroll
    for (int i = 0; i < 2; ++i) { int R, C; stage_rc(tid * 16 + i * 8192, R, C); const int Rb = Epi::PERM ? ((R & ~31) + perm32(R & 31)) : R;
        voffA[i] = (unsigned)(R * K + C) * 2u; voffB[i] = (unsigned)(Rb * K + C) * 2u; }
    const size_t kstep = (size_t)(BK * 2);
    const size_t hstep = (size_t)HALF * K * 2;
    const size_t tstep = 2 * hstep;
    const unsigned ldsw = (unsigned)wid * 1024u;
    const int aoff = lds_byte(wr * 64 + fr, fq * 8), boff = lds_byte(wc * 32 + fr, fq * 8);
#define PG8_SA(b, h) (((b) * 2 + (h)) * HTB)
#define PG8_SB(b, h) ((4 + (b) * 2 + (h)) * HTB)
#define PG8_STAGE(bufoff, gbase, voff) do { _Pragma("unroll") for (int _i = 0; _i < 2; ++_i) \
        __builtin_amdgcn_global_load_lds((const unsigned*)((const char*)(gbase) + (voff)[_i]), (PG8_LAS unsigned*)(lds + (bufoff) + ldsw + _i * 8192), 16, 0, 0); } while (0)
#define PG8_LDA(dst, b, h) do { _Pragma("unroll") for (int m = 0; m < 4; ++m) _Pragma("unroll") for (int k = 0; k < 2; ++k) dst[m][k] = *(const PG8_LAS bf16x8*)(lds + PG8_SA(b, h) + aoff + m * 2048 + k * 1024); } while (0)
#define PG8_LDB(dst, b, h) do { _Pragma("unroll") for (int n = 0; n < 2; ++n) _Pragma("unroll") for (int k = 0; k < 2; ++k) dst[n][k] = *(const PG8_LAS bf16x8*)(lds + PG8_SB(b, h) + boff + n * 2048 + k * 1024); } while (0)
#define PG8_MMA(ai, bj, At, Bt) do { __builtin_amdgcn_s_setprio(1); _Pragma("unroll") for (int m = 0; m < 4; ++m) _Pragma("unroll") for (int n = 0; n < 2; ++n) _Pragma("unroll") for (int k = 0; k < 2; ++k) \
        acc[ai][bj][m][n] = __builtin_amdgcn_mfma_f32_16x16x32_bf16(Bt[n][k], At[m][k], acc[ai][bj][m][n], 0, 0, 0); __builtin_amdgcn_s_setprio(0); } while (0)
#define PG8_WAIT_V(n) asm volatile("s_waitcnt vmcnt(" #n ")" ::: "memory")
#define PG8_WAIT_L(n) asm volatile("s_waitcnt lgkmcnt(" #n ")" ::: "memory")
#define PG8_BAR __builtin_amdgcn_s_barrier()
#define PG8_SCHED __builtin_amdgcn_sched_barrier(0)
    Unit cur, nxt; int ui = 0;
    if (!S.next(0, cur)) return;
    f32x4 acc[2][2][4][2];
#pragma unroll
    for (int a = 0; a < 2; ++a)
#pragma unroll
        for (int b = 0; b < 2; ++b)
#pragma unroll
            for (int m = 0; m < 4; ++m)
#pragma unroll
                for (int n = 0; n < 2; ++n) acc[a][b][m][n] = (f32x4){0.f, 0.f, 0.f, 0.f};
    bf16x8 At[4][2], B0[2][2], B1[2][2];
    const char* cA = (const char*)g.A + (size_t)cur.pm * tstep; const char* cB = (const char*)g.Bt + (size_t)cur.pn * tstep;
    S.a_ready(cur);
    if constexpr (SP2) {
        PG8_STAGE(PG8_SB(0, 0), cB, voffB); PG8_STAGE(PG8_SB(0, 1), cB + hstep, voffB); PG8_STAGE(PG8_SA(0, 0), cA, voffA); PG8_STAGE(PG8_SA(0, 1), cA + hstep, voffA);
        if (wr == 1) PG8_BAR;
        PG8_WAIT_V(2); PG8_BAR;
        PG8_STAGE(PG8_SB(1, 0), cB + kstep, voffB); PG8_STAGE(PG8_SA(1, 0), cA + kstep, voffA); PG8_STAGE(PG8_SB(1, 1), cB + hstep + kstep, voffB);
        PG8_WAIT_V(6); PG8_BAR;
    } else {
        PG8_STAGE(PG8_SB(0, 0), cB, voffB); PG8_STAGE(PG8_SA(0, 0), cA, voffA); PG8_STAGE(PG8_SB(0, 1), cB + hstep, voffB); PG8_STAGE(PG8_SA(0, 1), cA + hstep, voffA);
        if (wr == 1) PG8_BAR;
        PG8_WAIT_V(4); PG8_BAR;
        PG8_STAGE(PG8_SB(1, 0), cB + kstep, voffB); PG8_STAGE(PG8_SA(1, 0), cA + kstep, voffA); PG8_STAGE(PG8_SB(1, 1), cB + hstep + kstep, voffB);
        PG8_WAIT_V(6); PG8_BAR;
    }
    for (;;) {
        const bool has_next = S.next(ui + 1, nxt);
        const char* nA = has_next ? (const char*)g.A + (size_t)nxt.pm * tstep : cA; const char* nB = has_next ? (const char*)g.Bt + (size_t)nxt.pn * tstep : cB;
        for (int t = 0; t < nt; t += 2) {
            const bool last = (t == nt - 2);
            const char* a1 = cA + (size_t)(t + 1) * kstep;
            const char* a2 = last ? nA : cA + (size_t)(t + 2) * kstep; const char* b2 = last ? nB : cB + (size_t)(t + 2) * kstep;
            const char* a3 = a2 + kstep; const char* b3 = b2 + kstep;
            if (last && has_next) S.a_ready(nxt);
            if constexpr (SP2) {
            PG8_LDB(B0, 0, 0); PG8_LDB(B1, 0, 1); PG8_SCHED; PG8_LDA(At, 0, 0); PG8_STAGE(PG8_SA(1, 1), a1 + hstep, voffA);
            PG8_WAIT_V(8); PG8_WAIT_L(0); PG8_BAR; PG8_MMA(0, 0, At, B0); PG8_MMA(0, 1, At, B1); PG8_BAR; PG8_SCHED;
            PG8_LDA(At, 0, 1); PG8_STAGE(PG8_SB(0, 0), b2, voffB); PG8_STAGE(PG8_SB(0, 1), b2 + hstep, voffB); PG8_STAGE(PG8_SA(0, 0), a2, voffA);
            PG8_WAIT_V(8); PG8_WAIT_L(0); PG8_BAR; PG8_MMA(1, 0, At, B0); PG8_MMA(1, 1, At, B1); PG8_BAR; PG8_SCHED;
            PG8_LDB(B0, 1, 0); PG8_LDB(B1, 1, 1); PG8_SCHED; PG8_LDA(At, 1, 0); PG8_STAGE(PG8_SA(0, 1), a2 + hstep, voffA);
            PG8_WAIT_V(8); PG8_WAIT_L(0); PG8_BAR; PG8_MMA(0, 0, At, B0); PG8_MMA(0, 1, At, B1); PG8_BAR; PG8_SCHED;
            PG8_LDA(At, 1, 1); PG8_STAGE(PG8_SB(1, 0), b3, voffB); PG8_STAGE(PG8_SB(1, 1), b3 + hstep, voffB); PG8_STAGE(PG8_SA(1, 0), a3, voffA);
            PG8_WAIT_V(8); PG8_WAIT_L(0); PG8_BAR; PG8_MMA(1, 0, At, B0); PG8_MMA(1, 1, At, B1); PG8_BAR; PG8_SCHED;
            } else {
            PG8_LDB(B0, 0, 0); PG8_SCHED; PG8_LDA(At, 0, 0); PG8_STAGE(PG8_SA(1, 1), a1 + hstep, voffA);
            PG8_WAIT_L(8); PG8_BAR; PG8_WAIT_L(0); PG8_MMA(0, 0, At, B0); PG8_BAR; PG8_SCHED;
            PG8_LDB(B1, 0, 1); PG8_STAGE(PG8_SB(0, 0), b2, voffB);
            PG8_BAR; PG8_WAIT_L(0); PG8_MMA(0, 1, At, B1); PG8_BAR;
            PG8_LDA(At, 0, 1); PG8_STAGE(PG8_SA(0, 0), a2, voffA);
            PG8_BAR; PG8_WAIT_L(0); PG8_MMA(1, 0, At, B0); PG8_BAR; PG8_SCHED;
            PG8_STAGE(PG8_SB(0, 1), b2 + hstep, voffB);
            PG8_WAIT_V(6); PG8_BAR; PG8_MMA(1, 1, At, B1); PG8_BAR;
            PG8_LDB(B0, 1, 0); PG8_SCHED; PG8_LDA(At, 1, 0); PG8_STAGE(PG8_SA(0, 1), a2 + hstep, voffA);
            PG8_WAIT_L(8); PG8_BAR; PG8_WAIT_L(0); PG8_MMA(0, 0, At, B0); PG8_BAR; PG8_SCHED;
            PG8_LDB(B1, 1, 1); PG8_STAGE(PG8_SB(1, 0), b3, voffB);
            PG8_BAR; PG8_WAIT_L(0); PG8_MMA(0, 1, At, B1); PG8_BAR;
            PG8_LDA(At, 1, 1); PG8_STAGE(PG8_SA(1, 0), a3, voffA);
            PG8_BAR; PG8_WAIT_L(0); PG8_MMA(1, 0, At, B0); PG8_BAR; PG8_SCHED;
            PG8_STAGE(PG8_SB(1, 1), b3 + hstep, voffB);
            PG8_WAIT_V(6); PG8_BAR; PG8_MMA(1, 1, At, B1); PG8_BAR;
            }
        }
        if constexpr (ALIGN_EPI) { if (wr == 0) PG8_BAR; }
        if constexpr (!Epi::AFTER_DRAIN) { E(acc, cur, wr, wc, fr, fq); S.done(cur); }
        if (!has_next) break;
#pragma unroll
        for (int a = 0; a < 2; ++a)
#pragma unroll
            for (int b = 0; b < 2; ++b)
#pragma unroll
                for (int m = 0; m < 4; ++m)
#pragma unroll
                    for (int n = 0; n < 2; ++n) acc[a][b][m][n] = (f32x4){0.f, 0.f, 0.f, 0.f};
        cur = nxt; cA = nA; cB = nB; ++ui;
        if constexpr (ALIGN_EPI) { if (wr == 1) PG8_BAR; }
    }
    PG8_WAIT_V(0);
    if constexpr (!ALIGN_EPI) { if (wr == 0) PG8_BAR; }
    PG8_BAR;
    if constexpr (Epi::AFTER_DRAIN) { E.fused(acc, cur, wr, wc, fr, fq, lds, wid, lane); S.done(cur); }
#undef PG8_SA
#undef PG8_SB
#undef PG8_STAGE
#undef PG8_LDA
#undef PG8_LDB
#undef PG8_MMA
#undef PG8_WAIT_V
#undef PG8_WAIT_L
#undef PG8_BAR
#undef PG8_SCHED
}
}

constexpr int NWAVES = 8, NT = 512;
constexpr int D = 1024, MP = 16384, SEQ = 2048, MS = 128, FF = 4096;
constexpr int NIN0 = 3328, NIN1 = 3072;
constexpr float EPS = 1e-6f, LOG2E = 1.4426950408889634f;
constexpr size_t MiB = 1u << 20;
constexpr size_t WS_SS = 1 * MiB, WS_XS = 2 * MiB, WS_PROJS = 3 * MiB, WS_CATS = 4 * MiB, WS_HS = 5 * MiB;
constexpr size_t WS_WIN0 = 8 * MiB, WS_WOUT0 = 15 * MiB, WS_W10 = 17 * MiB, WS_W20 = 25 * MiB, WS_WIN1 = 33 * MiB, WS_WOUT1 = 39 * MiB, WS_W11 = 41 * MiB, WS_W21 = 49 * MiB;
constexpr size_t WS_CAT = 58 * MiB, WS_SH = 90 * MiB, WS_XB = 218 * MiB, WS_END = 250 * MiB;
constexpr size_t WS_DS = 194 * MiB, WS_EBL = 6 * MiB;
constexpr size_t O_Y = 0, O_YS = 16777216, O_POOLP = 16908288, O_HGP = 16939008, O_CONVP = 17725440, O_POOLS = 17741824, O_HGS = 18233344, O_CONVS = 30816256;
constexpr int LDS_BYTES = 143360;

#define LAS __attribute__((address_space(3)))
typedef unsigned short bf16;
typedef float f32x4 __attribute__((ext_vector_type(4)));
typedef short bf16x8 __attribute__((ext_vector_type(8)));
typedef unsigned u32x4 __attribute__((ext_vector_type(4)));
typedef unsigned u32x2 __attribute__((ext_vector_type(2)));
typedef unsigned short us2 __attribute__((ext_vector_type(2)));
__device__ __forceinline__ float bf2f(unsigned h) { return __uint_as_float(h << 16); }
__device__ __forceinline__ unsigned f2bf(float f) { unsigned u = __float_as_uint(f); return (u + 0x7fffu + ((u >> 16) & 1u)) >> 16; }
typedef float f32x2_t __attribute__((ext_vector_type(2)));
typedef __bf16 bf16x2_t __attribute__((ext_vector_type(2)));
__device__ __forceinline__ unsigned pk2(float lo, float hi) { const f32x2_t v = {lo, hi}; const bf16x2_t b = __builtin_convertvector(v, bf16x2_t); return __builtin_bit_cast(unsigned, b); }
__device__ __forceinline__ float fexp2(float x) { return __builtin_amdgcn_exp2f(x); }
__device__ __forceinline__ float flog2(float x) { return __builtin_amdgcn_logf(x); }
__device__ __forceinline__ float frcp(float x) { return __builtin_amdgcn_rcpf(x); }
__device__ __forceinline__ float fsigmoid(float x) { return frcp(1.0f + fexp2(-x * LOG2E)); }
__device__ __forceinline__ float wave_sum(float v) {
#pragma unroll
    for (int o = 1; o < 64; o <<= 1) v += __shfl_xor(v, o);
    return v;
}
#define MFMA16(a, b, c) __builtin_amdgcn_mfma_f32_16x16x32_bf16((a), (b), (c), 0, 0, 0)
#define LBAR() do { asm volatile("s_waitcnt lgkmcnt(0)" ::: "memory"); __builtin_amdgcn_s_barrier(); asm volatile("" ::: "memory"); } while (0)

struct PArgs { const float* in[19]; float* out; unsigned char* ws; int ph_lo, ph_hi; };

__device__ __forceinline__ void transpose_item(const float* W, const float* gk, int K, int N, bf16* WT, LAS float* scr, int item, int lane) {
    const int nblk = N / 32, kb = item / nblk, nb = item % nblk, k0 = 64 * kb, n0 = 32 * nb;
#pragma unroll 8
    for (int i = 0; i < 32; ++i) { const int kk = 2 * i + (lane >> 5); const float g = gk ? gk[k0 + kk] : 1.0f; scr[kk * 33 + (lane & 31)] = W[(size_t)(k0 + kk) * N + n0 + (lane & 31)] * g; }
    asm volatile("s_waitcnt lgkmcnt(0)" ::: "memory");
    const int c = lane & 7;
#pragma unroll
    for (int j = 0; j < 4; ++j) { const int n = (lane >> 3) + 8 * j; const LAS float* s = scr + (8 * c) * 33 + n;
        u32x4 o; o.x = pk2(s[0 * 33], s[1 * 33]); o.y = pk2(s[2 * 33], s[3 * 33]); o.z = pk2(s[4 * 33], s[5 * 33]); o.w = pk2(s[6 * 33], s[7 * 33]);
        *(u32x4*)(WT + (size_t)(n0 + n) * K + k0 + 8 * c) = o; }
    asm volatile("s_waitcnt lgkmcnt(0)" ::: "memory");
}
__device__ __forceinline__ void p0_prologue(const PArgs& a, LAS unsigned char* lds, int bid, int G, int tid, int wave, int lane) {
    LAS float* scr = (LAS float*)(lds + wave * 16384);
    const int gw = bid * NWAVES + wave, NGW = G * NWAVES;
    unsigned char* ws = a.ws;
    constexpr int I_IN0 = 16 * 104, I_O = 16 * 32, I_1 = 16 * 128, I_2 = 64 * 32, I_IN1 = 16 * 96;
    constexpr int NITEMS = I_IN0 + I_O + I_1 + I_2 + I_IN1 + I_O + I_1 + I_2;
    for (int it = gw; it < NITEMS; it += NGW) {
        int r = it;
        if (r < I_IN0) { transpose_item(a.in[8], a.in[5], D, NIN0, (bf16*)(ws + WS_WIN0), scr, r, lane); continue; } r -= I_IN0;
        if (r < I_O) { transpose_item(a.in[13], nullptr, D, D, (bf16*)(ws + WS_WOUT0), scr, r, lane); continue; } r -= I_O;
        if (r < I_1) { transpose_item(a.in[17], a.in[6], D, FF, (bf16*)(ws + WS_W10), scr, r, lane); continue; } r -= I_1;
        if (r < I_2) { transpose_item(a.in[18], nullptr, FF, D, (bf16*)(ws + WS_W20), scr, r, lane); continue; } r -= I_2;
        if (r < I_IN1) { transpose_item(a.in[14], a.in[5] + D, D, NIN1, (bf16*)(ws + WS_WIN1), scr, r, lane); continue; } r -= I_IN1;
        if (r < I_O) { transpose_item(a.in[16], nullptr, D, D, (bf16*)(ws + WS_WOUT1), scr, r, lane); continue; } r -= I_O;
        if (r < I_1) { transpose_item(a.in[17] + (size_t)D * FF, a.in[6] + D, D, FF, (bf16*)(ws + WS_W11), scr, r, lane); continue; } r -= I_1;
        transpose_item(a.in[18] + (size_t)FF * D, nullptr, FF, D, (bf16*)(ws + WS_W21), scr, r, lane);
    }
    bf16* xb0 = (bf16*)(ws + WS_CAT); float* ss = (float*)(ws + WS_SS);
    for (int m = gw; m < MP; m += NGW) {
        const f32x4* xr = (const f32x4*)(a.in[0] + (size_t)m * D) + lane; f32x4 v[4]; float s = 0.f;
#pragma unroll
        for (int j = 0; j < 4; ++j) { v[j] = xr[64 * j]; s += (v[j].x * v[j].x + v[j].y * v[j].y) + (v[j].z * v[j].z + v[j].w * v[j].w); }
        s = wave_sum(s);
        u32x2* o8 = (u32x2*)(xb0 + (size_t)m * D) + lane;
#pragma unroll
        for (int j = 0; j < 4; ++j) { u32x2 w; w.x = pk2(v[j].x, v[j].y); w.y = pk2(v[j].z, v[j].w); o8[64 * j] = w; }
        if (lane == 0) ss[m] = s;
    }
    const int gt = bid * NT + tid, NGT = G * NT;
    for (int i = gt; i < 4 * MP; i += NGT) ss[MP + i] = 0.f;
    float* xs = (float*)(ws + WS_XS);
    for (int i = gt; i < MS * D / 4; i += NGT) ((f32x4*)xs)[i] = ((const f32x4*)a.in[1])[i];
}

template <bool AF32, int EPI, int SU>
__device__ __forceinline__ void sgemm(LAS unsigned char* lds, const void* Ap, int lda, const bf16* Bt, int N, int K, int ksplit, bf16* O, int ldo, float* xs, int G, int bid, int tid, int wave, int lane, int skip = 0) {
    constexpr int NKS = SU;
    LAS float* red = (LAS float*)lds;
    LAS float* sqp = red + 16384;
    const int r = lane & 15, q = lane >> 4;
    const int nstrip = N / 64, npiece = 4 * nstrip * ksplit, klen = K / ksplit;
    for (int p = (bid >= skip) ? G - 1 - bid : npiece; p < npiece; p += G - skip) {
        const int rb = p & 3, strip = (p >> 2) % nstrip, ks = (p >> 2) / nstrip, n0 = strip * 64, k0 = ks * klen + wave * (klen >> 3), row0 = 32 * rb;
        bf16x8 bv[4][NKS], av[2][NKS]; f32x4 af[2][NKS][2];
#pragma unroll
        for (int c = 0; c < 4; ++c)
#pragma unroll
            for (int u = 0; u < NKS; ++u) bv[c][u] = *(const bf16x8*)(Bt + (size_t)(n0 + 16 * c + r) * K + k0 + 32 * u + 8 * q);
#pragma unroll
        for (int t = 0; t < 2; ++t)
#pragma unroll
            for (int u = 0; u < NKS; ++u) {
                if (AF32) { const float* ap = (const float*)Ap + (size_t)(row0 + 16 * t + r) * lda + k0 + 32 * u + 8 * q; af[t][u][0] = *(const f32x4*)ap; af[t][u][1] = *(const f32x4*)(ap + 4); }
                else av[t][u] = *(const bf16x8*)((const bf16*)Ap + (size_t)(row0 + 16 * t + r) * lda + k0 + 32 * u + 8 * q); }
        __builtin_amdgcn_sched_barrier(0);
        float sq[2] = {0.f, 0.f};
        if (AF32) {
#pragma unroll
            for (int t = 0; t < 2; ++t)
#pragma unroll
                for (int u = 0; u < NKS; ++u) { const f32x4 x0 = af[t][u][0], x1 = af[t][u][1];
                    sq[t] += (x0[0] * x0[0] + x0[1] * x0[1]) + (x0[2] * x0[2] + x0[3] * x0[3]) + (x1[0] * x1[0] + x1[1] * x1[1]) + (x1[2] * x1[2] + x1[3] * x1[3]);
                    u32x4 w; w.x = pk2(x0[0], x0[1]); w.y = pk2(x0[2], x0[3]); w.z = pk2(x1[0], x1[1]); w.w = pk2(x1[2], x1[3]); av[t][u] = __builtin_bit_cast(bf16x8, w); } }
#pragma unroll
        for (int t = 0; t < 2; ++t)
#pragma unroll
            for (int c = 0; c < 4; ++c) { f32x4 acc = {0.f, 0.f, 0.f, 0.f};
#pragma unroll
                for (int u = 0; u < NKS; ++u) acc = MFMA16(av[t][u], bv[c][u], acc);
                *(LAS f32x4*)(red + ((wave * 8 + (c * 2 + t)) * 64 + lane) * 4) = acc; }
        if (AF32) {
#pragma unroll
            for (int t = 0; t < 2; ++t) { float v = sq[t]; v += __shfl_xor(v, 16); v += __shfl_xor(v, 32); if (q == 0) sqp[(wave * 2 + t) * 16 + r] = v; } }
        __syncthreads();
        const int t = wave & 1, c = wave >> 1;
        f32x4 acc = {0.f, 0.f, 0.f, 0.f};
#pragma unroll
        for (int w = 0; w < 8; ++w) acc += *(const LAS f32x4*)(red + ((w * 8 + wave) * 64 + lane) * 4);
        const int orow = row0 + 16 * t + 4 * q, ocol = n0 + 16 * c + r;
        if (EPI == 2) {
#pragma unroll
            for (int i = 0; i < 4; ++i) atomicAdd(xs + (size_t)(orow + i) * D + ocol, acc[i]);
        } else {
#pragma unroll
            for (int i = 0; i < 4; ++i) { float ssr = 0.f;
#pragma unroll
                for (int w = 0; w < 8; ++w) ssr += sqp[(w * 2 + t) * 16 + 4 * q + i];
                float v = acc[i] * __builtin_amdgcn_rsqf(ssr * (1.0f / 1024.0f) + EPS);
                if (EPI == 1) { v = fmaxf(v, 0.f); v = v * v; }
                O[(size_t)(orow + i) * ldo + ocol] = (bf16)f2bf(v); }
        }
        __syncthreads();
    }
}

__device__ __forceinline__ float lb_of(const float* lg, int c) { const float e0 = __expf(lg[c]), e1 = __expf(lg[768 + c]), e2 = __expf(lg[1536 + c]); return e0 / (e0 + e1 + e2); }

__device__ __forceinline__ void hgrn_sample3(LAS unsigned char* lds, const bf16* projs, const float* S0all, const float* lbl, const float* gain, bf16* cats, float* st_out, int it0, int G, int tid, int wave, int lane) {
    constexpr int STR = 2624;
    LAS float* L = (LAS float*)lds;
#pragma unroll
    for (int j = 0; j < 3; ++j) { const int it = it0 + j * G;
        if (it < MS * 6 && tid < 128) { const int b = it / 6, h = it - 6 * b, c = h * 128 + tid; const bf16* pr = projs + (size_t)b * NIN0; LAS float* B = L + j * STR;
            const float lbk = lb_of(lbl, c); float fz = bf2f(pr[1024 + c]); fz = fminf(fmaxf(fz, -30.f), 30.f);
            const float e = fexp2(-fz * LOG2E), sg = frcp(1.0f + e); B[tid] = lbk + (1.0f - lbk) * sg; B[128 + tid] = (1.0f - lbk) * e * sg; B[256 + tid] = bf2f(pr[256 + c]);
            const float z = bf2f(pr[1792 + c]); B[384 + tid] = z * fsigmoid(z); } }
    const int vq = tid & 31, kg = tid >> 5;
    f32x4 sv[3][8];
#pragma unroll
    for (int j = 0; j < 3; ++j) { const int it = it0 + j * G;
        if (it < MS * 6) { const float* S0 = S0all + (size_t)it * 16384;
#pragma unroll
            for (int i = 0; i < 8; ++i) sv[j][i] = *(const f32x4*)(S0 + (size_t)(kg * 8 + i) * 128 + 4 * vq); } }
    LBAR();
#pragma unroll
    for (int j = 0; j < 3; ++j) { const int it = it0 + j * G;
        if (it < MS * 6) { LAS float* B = L + j * STR; float* So = st_out + (size_t)it * 16384; const f32x4 v4 = *(const LAS f32x4*)(B + 384 + 4 * vq); f32x4 op = {0.f, 0.f, 0.f, 0.f};
#pragma unroll
            for (int i = 0; i < 8; ++i) { const int kx = kg * 8 + i; const f32x4 sn = sv[j][i] * B[kx] + v4 * B[128 + kx]; *(f32x4*)(So + (size_t)kx * 128 + 4 * vq) = sn; op += sn * B[256 + kx]; }
            *(LAS f32x4*)(B + 512 + kg * 128 + 4 * vq) = op; } }
    LBAR();
    float o[3];
#pragma unroll
    for (int j = 0; j < 3; ++j) { o[j] = 0.f;
        if (tid < 128) { LAS float* B = L + j * STR;
#pragma unroll
            for (int i = 0; i < 16; ++i) o[j] += B[512 + i * 128 + tid];
            const float ssum = wave_sum(o[j] * o[j]); if (lane == 0) B[2560 + wave] = ssum; } }
    LBAR();
#pragma unroll
    for (int j = 0; j < 3; ++j) { const int it = it0 + j * G;
        if (it < MS * 6 && tid < 128) { const int b = it / 6, h = it - 6 * b, c = h * 128 + tid; LAS float* B = L + j * STR;
            const float rs = __builtin_amdgcn_rsqf((B[2560] + B[2561]) * (1.0f / 128.0f) + EPS);
            cats[(size_t)b * D + 256 + c] = (bf16)f2bf(o[j] * rs * gain[c] * fsigmoid(bf2f(projs[(size_t)b * NIN0 + 2560 + c]))); } }
    LBAR();
}

__device__ __forceinline__ void pool_mm(const LAS float* W, const LAS float* df, float (&acc)[8], int c, int tg) {
#pragma unroll
    for (int i = 0; i < 8; ++i) acc[i] = 0.f;
#pragma unroll 4
    for (int cc = 0; cc < 64; cc += 4) { const float w0 = W[cc * 64 + c], w1 = W[(cc + 1) * 64 + c], w2 = W[(cc + 2) * 64 + c], w3 = W[(cc + 3) * 64 + c];
#pragma unroll
        for (int i = 0; i < 8; ++i) { const f32x4 dv = *(const LAS f32x4*)(df + (tg * 8 + i) * 64 + cc); acc[i] += (dv.x * w0 + dv.y * w1) + (dv.z * w2 + dv.w * w3); } }
}
__device__ __forceinline__ void pool_prompt_all(LAS unsigned char* lds, const bf16* proj, const float* pw, const float* pscale, bf16* cat, float* pool_out, int bid, int G, int tid, int wave, int lane) {
    constexpr int PK = 144;
    LAS float* ue = (LAS float*)lds;
    LAS unsigned char* Dfb = lds + 20224;
    LAS unsigned char* Wtb = lds + 20224 + 9216;
    const int r = lane & 15, q = lane >> 4, c = tid & 63, tg = tid >> 6;
    unsigned short uv[10]; f32x4 wv[2];
    int it = bid;
    if (it < 1024) { const int g = it & 3, tt = it >> 2, b = tt >> 5, t0 = (tt & 31) * 64;
#pragma unroll
        for (int j10 = 0; j10 < 10; ++j10) { const int e = tid + NT * j10, j = e >> 6, t = t0 - 15 + j; uv[j10] = (e < 79 * 64 && t >= 0) ? proj[(size_t)(b * SEQ + t) * NIN0 + g * 64 + (e & 63)] : (unsigned short)0; }
#pragma unroll
        for (int j2 = 0; j2 < 2; ++j2) wv[j2] = ((const f32x4*)(pw + g * 4096))[tid + NT * j2]; }
    for (; it < 1024; it += G) {
        const int g = it & 3, tt = it >> 2, b = tt >> 5, t0 = (tt & 31) * 64, wlen = 2 << g;
#pragma unroll
        for (int j10 = 0; j10 < 10; ++j10) { const int e = tid + NT * j10; if (e < 79 * 64) ue[e] = bf2f(uv[j10]); }
#pragma unroll
        for (int j2 = 0; j2 < 2; ++j2) { const int e4 = tid + NT * j2, cc = e4 >> 4, d0 = (e4 & 15) * 4;
#pragma unroll
            for (int k = 0; k < 4; ++k) *(LAS unsigned short*)(Wtb + (d0 + k) * PK + 2 * cc) = (unsigned short)f2bf(wv[j2][k]); }
        { const int nit = it + G;
          if (nit < 1024) { const int ng = nit & 3, ntt = nit >> 2, nb = ntt >> 5, nt0 = (ntt & 31) * 64;
#pragma unroll
              for (int j10 = 0; j10 < 10; ++j10) { const int e = tid + NT * j10, j = e >> 6, t = nt0 - 15 + j; uv[j10] = (e < 79 * 64 && t >= 0) ? proj[(size_t)(nb * SEQ + t) * NIN0 + ng * 64 + (e & 63)] : (unsigned short)0; }
#pragma unroll
              for (int j2 = 0; j2 < 2; ++j2) wv[j2] = ((const f32x4*)(pw + ng * 4096))[tid + NT * j2]; } }
        __syncthreads();
#pragma unroll
        for (int i = 0; i < 8; ++i) { const int t = tg * 8 + i; float s = 0.f;
#pragma unroll
            for (int j = 0; j < 16; ++j) { const float x = ue[(15 + t - j) * 64 + c]; s += (j < wlen) ? x : 0.f; }
            const int pos = t0 + t; const float rc = (pos + 1 >= wlen) ? 1.0f / (float)wlen : 1.0f / (float)(pos + 1); const float u = ue[(15 + t) * 64 + c];
            *(LAS unsigned short*)(Dfb + t * PK + 2 * c) = (unsigned short)f2bf(s * rc - u);
            if (pos >= SEQ - 15) pool_out[(size_t)(b * 15 + (pos - (SEQ - 15))) * 256 + g * 64 + c] = u; }
        __syncthreads();
        { const int ti = wave >> 1;
#pragma unroll
          for (int dj2 = 0; dj2 < 2; ++dj2) { const int dj = 2 * (wave & 1) + dj2; f32x4 acc = {0.f, 0.f, 0.f, 0.f};
#pragma unroll
              for (int ks = 0; ks < 2; ++ks) { const bf16x8 av = *(const LAS bf16x8*)(Dfb + (16 * ti + r) * PK + ks * 64 + q * 16), bv = *(const LAS bf16x8*)(Wtb + (16 * dj + r) * PK + ks * 64 + q * 16); acc = MFMA16(av, bv, acc); }
              const float sc = pscale[g * 64 + 16 * dj + r];
#pragma unroll
              for (int i = 0; i < 4; ++i) cat[(size_t)(b * SEQ + t0 + 16 * ti + 4 * q + i) * D + g * 64 + 16 * dj + r] = (bf16)f2bf(acc[i] * sc); } }
        __syncthreads();
    }
}
template <int W>
__device__ __forceinline__ void pool_wave_diff(LAS unsigned char* Dfb, const bf16* proj, float* pool_out, int b, int t0, int g, int lane) {
    constexpr int PK = 144;
    const bf16* up = proj + (size_t)(b * SEQ + t0) * NIN0 + g * 64;
    float u[79];
#pragma unroll
    for (int j = 0; j < 79; ++j) { const int t = t0 - 15 + j; u[j] = (t >= 0) ? bf2f((up + (ptrdiff_t)(j - 15) * NIN0)[lane]) : 0.f; }
    float run = 0.f;
#pragma unroll
    for (int j = 1; j < W; ++j) run += u[15 - j];
#pragma unroll
    for (int t = 0; t < 64; ++t) { run += u[15 + t]; const int pos = t0 + t; const float rc = (pos + 1 >= W) ? 1.0f / (float)W : 1.0f / (float)(pos + 1);
        *(LAS unsigned short*)(Dfb + t * PK + 2 * lane) = (unsigned short)f2bf(run * rc - u[15 + t]);
        if (pos >= SEQ - 15) pool_out[(size_t)(b * 15 + (pos - (SEQ - 15))) * 256 + g * 64 + lane] = u[15 + t];
        run -= u[15 + t - (W - 1)]; }
}
__device__ __forceinline__ void pool_prompt_wave(LAS unsigned char* lds, const bf16* proj, const float* pw, const float* pscale, bf16* cat, float* pool_out, int bid, int G, int tid, int wave, int lane) {
    constexpr int PK = 144;
    LAS unsigned char* Wtb = lds;
    LAS unsigned char* Dfb = lds + 36864 + wave * 9216;
    const int r = lane & 15, q = lane >> 4;
#pragma unroll
    for (int j = 0; j < 8; ++j) { const int e4 = tid + NT * j, g = e4 >> 10, cc = (e4 >> 4) & 63, d0 = (e4 & 15) * 4; const f32x4 v = ((const f32x4*)pw)[e4];
#pragma unroll
        for (int k = 0; k < 4; ++k) *(LAS unsigned short*)(Wtb + g * 9216 + (d0 + k) * PK + 2 * cc) = (unsigned short)f2bf(v[k]); }
    __syncthreads();
    for (int it = wave * G + bid; it < 1024; it += NWAVES * G) {
        const int g = it & 3, tt = it >> 2, b = tt >> 5, t0 = (tt & 31) * 64;
        if (g == 0) pool_wave_diff<2>(Dfb, proj, pool_out, b, t0, g, lane);
        else if (g == 1) pool_wave_diff<4>(Dfb, proj, pool_out, b, t0, g, lane);
        else if (g == 2) pool_wave_diff<8>(Dfb, proj, pool_out, b, t0, g, lane);
        else pool_wave_diff<16>(Dfb, proj, pool_out, b, t0, g, lane);
        asm volatile("s_waitcnt lgkmcnt(0)" ::: "memory");
        const LAS unsigned char* Wg = Wtb + g * 9216;
#pragma unroll
        for (int ti = 0; ti < 4; ++ti) { bf16x8 av[2];
#pragma unroll
            for (int ks = 0; ks < 2; ++ks) av[ks] = *(const LAS bf16x8*)(Dfb + (16 * ti + r) * PK + ks * 64 + q * 16);
#pragma unroll
            for (int dj = 0; dj < 4; ++dj) { f32x4 acc = {0.f, 0.f, 0.f, 0.f};
#pragma unroll
                for (int ks = 0; ks < 2; ++ks) { const bf16x8 bv = *(const LAS bf16x8*)(Wg + (16 * dj + r) * PK + ks * 64 + q * 16); acc = MFMA16(av[ks], bv, acc); }
                const float sc = pscale[g * 64 + 16 * dj + r];
#pragma unroll
                for (int i = 0; i < 4; ++i) cat[(size_t)(b * SEQ + t0 + 16 * ti + 4 * q + i) * D + g * 64 + 16 * dj + r] = (bf16)f2bf(acc[i] * sc); } }
        asm volatile("s_waitcnt lgkmcnt(0)" ::: "memory");
    }
    __syncthreads();
}
__device__ __forceinline__ void pool_sample(LAS unsigned char* lds, const bf16* projs, const float* spool, const float* pw, const float* pscale, bf16* cats, float* pool_out, int item, int tid) {
    LAS float* W = (LAS float*)lds + 79 * 64; LAS float* df = W + 4096;
    const int g = item & 3, st = item >> 2, wlen = 2 << g, c = tid & 63, tg = tid >> 6, ch = g * 64 + c;
#pragma unroll
    for (int j2 = 0; j2 < 2; ++j2) ((LAS f32x4*)W)[tid + NT * j2] = ((const f32x4*)(pw + g * 4096))[tid + NT * j2];
#pragma unroll
    for (int i = 0; i < 8; ++i) { const int t = tg * 8 + i, b = st * 64 + t; const float u = bf2f(projs[(size_t)b * NIN0 + ch]);
        float pv[15];
#pragma unroll
        for (int j = 0; j < 15; ++j) pv[j] = spool[(size_t)(b * 15 + j) * 256 + ch];
        float s = u;
#pragma unroll
        for (int j = 0; j < 15; ++j) if (j < wlen - 1) s += pv[14 - j];
        df[t * 64 + c] = s / (float)wlen - u;
#pragma unroll
        for (int j = 0; j < 14; ++j) pool_out[(size_t)(b * 15 + j) * 256 + ch] = pv[j + 1];
        pool_out[(size_t)(b * 15 + 14) * 256 + ch] = u; }
    LBAR();
    float acc[8]; pool_mm(W, df, acc, c, tg);
    const float sc = pscale[ch];
#pragma unroll
    for (int i = 0; i < 8; ++i) cats[(size_t)(st * 64 + tg * 8 + i) * D + ch] = (bf16)f2bf(acc[i] * sc);
    LBAR();
}

__device__ __forceinline__ void unpack8(const u32x4 w, float (&f)[8]) {
    f[0] = __uint_as_float(w.x << 16); f[1] = __uint_as_float(w.x & 0xffff0000u); f[2] = __uint_as_float(w.y << 16); f[3] = __uint_as_float(w.y & 0xffff0000u);
    f[4] = __uint_as_float(w.z << 16); f[5] = __uint_as_float(w.z & 0xffff0000u); f[6] = __uint_as_float(w.w << 16); f[7] = __uint_as_float(w.w & 0xffff0000u);
}
__device__ __forceinline__ void hgrn_stepA(LAS unsigned char* lds, const bf16* proj, const float* lbl, bf16* dS, float* eblg, int bid, int G, int wave, int lane) {
    constexpr int PK = 144;
    LAS unsigned char* KeT = lds; LAS unsigned char* Vt = lds + 18432; LAS float* qsum = (LAS float*)(lds + 36864);
    const int tq = wave >> 1, k = ((wave & 1) << 6) + lane, r = lane & 15, q = lane >> 4, w = wave;
    LAS float* lbt = qsum + 512;
    for (int c2 = wave * 64 + lane; c2 < 768; c2 += NT) lbt[c2] = lb_of(lbl, c2);
    LBAR();
    unsigned fv[16], iv[16];
    int it = bid;
    if (it < 1536) { const int bh = it >> 5, c = it & 31, b = bh / 6, h = bh - 6 * b; const unsigned lo_f = 1024u + (unsigned)(h * 128 + k);
        const bf16* prow = proj + (size_t)(b * SEQ + 64 * c + 16 * tq) * NIN0;
#pragma unroll
        for (int i = 0; i < 16; ++i) { const bf16* up = prow + (size_t)i * NIN0; fv[i] = up[lo_f]; iv[i] = up[lo_f + 768u]; } }
    for (; it < 1536; it += G) {
        const int bh = it >> 5, b = bh / 6, h = bh - 6 * b, ch = h * 128 + k;
        const float lbk = lbt[ch], oml = 1.0f - lbk;
#pragma unroll
        for (int i = 0; i < 16; ++i) asm volatile("" : "+v"(fv[i]), "+v"(iv[i]));
        float lf[16], kk[16];
#pragma unroll
        for (int i = 0; i < 16; ++i) { float fz = bf2f(fv[i]); fz = fminf(fmaxf(fz, -30.f), 30.f); const float e = fexp2(-fz * LOG2E), sg = frcp(1.0f + e); lf[i] = flog2(lbk + oml * sg); kk[i] = oml * e * sg; }
        float run = 0.f;
#pragma unroll
        for (int i = 0; i < 16; ++i) { run += lf[i]; lf[i] = run; }
        qsum[tq * 128 + k] = run;
        { unsigned vp[8];
#pragma unroll
          for (int i = 0; i < 8; ++i) { const float z0 = bf2f(iv[2 * i]), z1 = bf2f(iv[2 * i + 1]); vp[i] = pk2(z0 * fsigmoid(z0), z1 * fsigmoid(z1)); }
          *(LAS u32x4*)(Vt + k * PK + tq * 32) = (u32x4){vp[0], vp[1], vp[2], vp[3]}; *(LAS u32x4*)(Vt + k * PK + tq * 32 + 16) = (u32x4){vp[4], vp[5], vp[6], vp[7]}; }
        LBAR();
        float off = 0.f, tot = 0.f;
#pragma unroll
        for (int j = 0; j < 4; ++j) { const float s = qsum[j * 128 + k]; tot += s; if (j < tq) off += s; }
        if (tq == 0) eblg[(size_t)it * 128 + k] = fexp2(tot);
        { unsigned kp[8];
#pragma unroll
          for (int i = 0; i < 8; ++i) { const float b0 = lf[2 * i] + off, b1 = lf[2 * i + 1] + off; kp[i] = pk2(kk[2 * i] * fexp2(tot - b0), kk[2 * i + 1] * fexp2(tot - b1)); }
          *(LAS u32x4*)(KeT + k * PK + tq * 32) = (u32x4){kp[0], kp[1], kp[2], kp[3]}; *(LAS u32x4*)(KeT + k * PK + tq * 32 + 16) = (u32x4){kp[4], kp[5], kp[6], kp[7]}; }
        { const int nit = it + G;
          if (nit < 1536) { const int nbh = nit >> 5, nc = nit & 31, nb = nbh / 6, nh = nbh - 6 * nb; const unsigned lo_f = 1024u + (unsigned)(nh * 128 + k);
              const bf16* prow = proj + (size_t)(nb * SEQ + 64 * nc + 16 * tq) * NIN0;
#pragma unroll
              for (int i = 0; i < 16; ++i) { const bf16* up = prow + (size_t)i * NIN0; fv[i] = up[lo_f]; iv[i] = up[lo_f + 768u]; } } }
        LBAR();
        { bf16x8 aK[2];
#pragma unroll
          for (int ks = 0; ks < 2; ++ks) aK[ks] = *(const LAS bf16x8*)(KeT + (16 * w + r) * PK + ks * 64 + q * 16);
          bf16* dst = dS + (size_t)it * 16384 + (size_t)r * 128 + 16 * w + 4 * q;
#pragma unroll
          for (int n = 0; n < 8; ++n) { f32x4 s = {0.f, 0.f, 0.f, 0.f};
#pragma unroll
              for (int ks = 0; ks < 2; ++ks) { const bf16x8 bv = *(const LAS bf16x8*)(Vt + (16 * n + r) * PK + ks * 64 + q * 16); s = MFMA16(aK[ks], bv, s); }
              *(u32x2*)(dst + n * 2048) = (u32x2){pk2(s[0], s[1]), pk2(s[2], s[3])}; } }
        LBAR();
    }
}
__device__ __forceinline__ void hgrn_stepB(bf16* dS, const float* eblg, float* st_out, int bid, int G, int tid) {
    for (int e = bid * NT + tid; e < 48 * 2048; e += G * NT) {
        const int k8 = e & 15, v = (e >> 4) & 127, bh = e >> 11;
        bf16* p = dS + (size_t)bh * 32 * 16384 + (size_t)v * 128 + 8 * k8; const float* eb = eblg + (size_t)bh * 32 * 128 + 8 * k8;
        float S[8];
#pragma unroll
        for (int j = 0; j < 8; ++j) S[j] = 0.f;
        for (int c0 = 0; c0 < 32; c0 += 8) {
            u32x4 d[8]; f32x4 e0[8], e1[8];
#pragma unroll
            for (int u = 0; u < 8; ++u) { d[u] = *(const u32x4*)(p + (size_t)(c0 + u) * 16384); e0[u] = *(const f32x4*)(eb + (c0 + u) * 128); e1[u] = *(const f32x4*)(eb + (c0 + u) * 128 + 4); }
#pragma unroll
            for (int u = 0; u < 8; ++u) { float dv[8]; unpack8(d[u], dv);
                *(u32x4*)(p + (size_t)(c0 + u) * 16384) = (u32x4){pk2(S[0], S[1]), pk2(S[2], S[3]), pk2(S[4], S[5]), pk2(S[6], S[7])};
#pragma unroll
                for (int j = 0; j < 4; ++j) { S[j] = S[j] * e0[u][j] + dv[j]; S[4 + j] = S[4 + j] * e1[u][j] + dv[4 + j]; } }
        }
        float* so = st_out + (size_t)bh * 16384 + (size_t)(8 * k8) * 128 + v;
#pragma unroll
        for (int j = 0; j < 8; ++j) so[j * 128] = S[j];
    }
}
__device__ __forceinline__ void hgrn_stepC(LAS unsigned char* lds, const bf16* proj, const float* lbl, const float* gain, const bf16* dS, bf16* cat, int bid, int G, int tid, int wave, int lane) {
    constexpr int PQ = 272, PK = 144;
    LAS unsigned char* Qd = lds; LAS unsigned char* Kd = lds + 17408; LAS unsigned char* Vt = lds + 34816;
    LAS unsigned char* P = lds + 53248; LAS unsigned char* St = lds + 62464;
    LAS float* qsum = (LAS float*)(lds + 97280); LAS float* part = qsum + 512; LAS float* rsr = part + 512;
    const int tq = wave >> 1, k = ((wave & 1) << 6) + lane, r = lane & 15, q = lane >> 4, w = wave;
    LAS float* lbt = rsr + 64; LAS float* gnt = lbt + 768;
    for (int c2 = wave * 64 + lane; c2 < 768; c2 += NT) { lbt[c2] = lb_of(lbl, c2); gnt[c2] = gain[c2]; }
    LBAR();
    unsigned qv[16], fv[16], iv[16]; u32x4 sreg[4];
    int it = bid;
    if (it < 1536) { const int bh = it >> 5, c = it & 31, b = bh / 6, h = bh - 6 * b; const unsigned lo_q = 256u + (unsigned)(h * 128 + k);
        const bf16* prow = proj + (size_t)(b * SEQ + 64 * c + 16 * tq) * NIN0;
#pragma unroll
        for (int i = 0; i < 16; ++i) { const bf16* up = prow + (size_t)i * NIN0; qv[i] = up[lo_q]; fv[i] = up[lo_q + 768u]; iv[i] = up[lo_q + 1536u]; }
        const u32x4* sp = (const u32x4*)(dS + (size_t)it * 16384) + tid;
#pragma unroll
        for (int j = 0; j < 4; ++j) sreg[j] = sp[512 * j]; }
    for (; it < 1536; it += G) {
        const int bh = it >> 5, c = it & 31, b = bh / 6, h = bh - 6 * b, ch = h * 128 + k;
        const float lbk = lbt[ch], oml = 1.0f - lbk;
#pragma unroll
        for (int i = 0; i < 16; ++i) asm volatile("" : "+v"(qv[i]), "+v"(fv[i]), "+v"(iv[i]));
        float lf[16], kk[16];
#pragma unroll
        for (int i = 0; i < 16; ++i) { float fz = bf2f(fv[i]); fz = fminf(fmaxf(fz, -30.f), 30.f); const float e = fexp2(-fz * LOG2E), sg = frcp(1.0f + e); lf[i] = flog2(lbk + oml * sg); kk[i] = oml * e * sg; }
        float run = 0.f;
#pragma unroll
        for (int i = 0; i < 16; ++i) { run += lf[i]; lf[i] = run; }
        qsum[tq * 128 + k] = run;
        { unsigned vp[8];
#pragma unroll
          for (int i = 0; i < 8; ++i) { const float z0 = bf2f(iv[2 * i]), z1 = bf2f(iv[2 * i + 1]); vp[i] = pk2(z0 * fsigmoid(z0), z1 * fsigmoid(z1)); }
          *(LAS u32x4*)(Vt + k * PK + tq * 32) = (u32x4){vp[0], vp[1], vp[2], vp[3]}; *(LAS u32x4*)(Vt + k * PK + tq * 32 + 16) = (u32x4){vp[4], vp[5], vp[6], vp[7]}; }
        LBAR();
        float off = 0.f;
#pragma unroll
        for (int j = 0; j < 4; ++j) { const float s = qsum[j * 128 + k]; if (j < tq) off += s; }
#pragma unroll
        for (int i = 0; i < 16; ++i) { const float bc = lf[i] + off; const float ed = fexp2(bc), edi = fexp2(-bc);
            *(LAS unsigned short*)(Qd + (16 * tq + i) * PQ + 2 * k) = (unsigned short)f2bf(bf2f(qv[i]) * ed);
            *(LAS unsigned short*)(Kd + (16 * tq + i) * PQ + 2 * k) = (unsigned short)f2bf(kk[i] * edi); }
#pragma unroll
        for (int j = 0; j < 4; ++j) { const int e = tid + 512 * j, v = e >> 4, k8 = e & 15; *(LAS u32x4*)(St + v * PQ + k8 * 16) = sreg[j]; }
        const unsigned lo_g = (unsigned)(4 * q) * NIN0 + 2560u + (unsigned)(h * 128 + 16 * w + r), lo_o = (unsigned)(4 * q) * D + 256u + (unsigned)(h * 128 + 16 * w + r);
        const bf16* crow = proj + (size_t)(b * SEQ + 64 * c) * NIN0;
        unsigned gv[16];
#pragma unroll
        for (int ti = 0; ti < 4; ++ti)
#pragma unroll
            for (int i = 0; i < 4; ++i) { const bf16* up = crow + (size_t)(16 * ti + i) * NIN0; gv[ti * 4 + i] = up[lo_g]; }
        { const int nit = it + G;
          if (nit < 1536) { const int nbh = nit >> 5, nc = nit & 31, nb = nbh / 6, nh = nbh - 6 * nb; const unsigned lo_q = 256u + (unsigned)(nh * 128 + k);
              const bf16* prow = proj + (size_t)(nb * SEQ + 64 * nc + 16 * tq) * NIN0;
#pragma unroll
              for (int i = 0; i < 16; ++i) { const bf16* up = prow + (size_t)i * NIN0; qv[i] = up[lo_q]; fv[i] = up[lo_q + 768u]; iv[i] = up[lo_q + 1536u]; }
              const u32x4* sp = (const u32x4*)(dS + (size_t)nit * 16384) + tid;
#pragma unroll
              for (int j = 0; j < 4; ++j) sreg[j] = sp[512 * j]; } }
        LBAR();
        { const int ti = w >> 1;
#pragma unroll
          for (int sj = 0; sj < 2; ++sj) { const int si = 2 * (w & 1) + sj; f32x4 acc = {0.f, 0.f, 0.f, 0.f};
              if (si <= ti) {
#pragma unroll
                  for (int ks = 0; ks < 4; ++ks) { const bf16x8 av = *(const LAS bf16x8*)(Qd + (16 * ti + r) * PQ + ks * 64 + q * 16), bv = *(const LAS bf16x8*)(Kd + (16 * si + r) * PQ + ks * 64 + q * 16); acc = MFMA16(av, bv, acc); } }
#pragma unroll
              for (int i = 0; i < 4; ++i) { const int t = 16 * ti + 4 * q + i, s = 16 * si + r; *(LAS unsigned short*)(P + t * PK + 2 * s) = (unsigned short)f2bf(s <= t ? acc[i] : 0.f); } } }
        f32x4 o[4];
#pragma unroll
        for (int ti = 0; ti < 4; ++ti) o[ti] = (f32x4){0.f, 0.f, 0.f, 0.f};
        { bf16x8 bS[4];
#pragma unroll
          for (int ks = 0; ks < 4; ++ks) bS[ks] = *(const LAS bf16x8*)(St + (16 * w + r) * PQ + ks * 64 + q * 16);
#pragma unroll
          for (int ti = 0; ti < 4; ++ti)
#pragma unroll
              for (int ks = 0; ks < 4; ++ks) { const bf16x8 av = *(const LAS bf16x8*)(Qd + (16 * ti + r) * PQ + ks * 64 + q * 16); o[ti] = MFMA16(av, bS[ks], o[ti]); } }
        LBAR();
        { bf16x8 bV[2];
#pragma unroll
          for (int ks = 0; ks < 2; ++ks) bV[ks] = *(const LAS bf16x8*)(Vt + (16 * w + r) * PK + ks * 64 + q * 16);
#pragma unroll
          for (int ti = 0; ti < 4; ++ti)
#pragma unroll
              for (int ks = 0; ks < 2; ++ks) { const bf16x8 av = *(const LAS bf16x8*)(P + (16 * ti + r) * PK + ks * 64 + q * 16); o[ti] = MFMA16(av, bV[ks], o[ti]); } }
#pragma unroll
        for (int ti = 0; ti < 4; ++ti)
#pragma unroll
            for (int i = 0; i < 4; ++i) { float p = o[ti][i] * o[ti][i]; p += __shfl_xor(p, 1); p += __shfl_xor(p, 2); p += __shfl_xor(p, 4); p += __shfl_xor(p, 8);
                if (r == 0) part[w * 64 + 16 * ti + 4 * q + i] = p; }
        LBAR();
        if (tid < 64) { float s = 0.f;
#pragma unroll
            for (int j = 0; j < 8; ++j) s += part[j * 64 + tid];
            rsr[tid] = __builtin_amdgcn_rsqf(s * (1.0f / 128.0f) + EPS); }
        LBAR();
        const float gain_v = gnt[h * 128 + 16 * w + r];
        bf16* orow = cat + (size_t)(b * SEQ + 64 * c) * D;
#pragma unroll
        for (int ti = 0; ti < 4; ++ti)
#pragma unroll
            for (int i = 0; i < 4; ++i) { const int t = 16 * ti + 4 * q + i; const float val = o[ti][i] * rsr[t] * gain_v * fsigmoid(bf2f(gv[ti * 4 + i]));
                bf16* up = orow + (size_t)(16 * ti + i) * D; up[lo_o] = (bf16)f2bf(val); }
    }
    LBAR();
}

template <bool OUT>
__device__ __forceinline__ void hgrn_seg(LAS unsigned char* lds, const bf16* proj, const float* lbl, const float* gain, bf16* cat, float* st_out, float* segS, float* segD, int b, int h, int seg, int tid, int wave, int lane) {
    constexpr int PQ = 272, PK = 144;
    LAS unsigned char* Qd = lds; LAS unsigned char* Kd = lds + 17408; LAS unsigned char* KeT = lds + 34816; LAS unsigned char* Vt = lds + 53248;
    LAS unsigned char* P = lds + 71680; LAS unsigned char* St = lds + 80896;
    LAS float* qsum = (LAS float*)(lds + 115712); LAS float* ebl = qsum + 512; LAS float* part = ebl + 128; LAS float* rsr = part + 512;
    const int tq = wave >> 1, k = ((wave & 1) << 6) + lane, r = lane & 15, q = lane >> 4, w = wave;
    const int ch = h * 128 + k;
    const unsigned lo_q = 256u + (unsigned)ch, lo_f = 1024u + (unsigned)ch, lo_i = 1792u + (unsigned)ch;
    const unsigned lo_g = (unsigned)(4 * q) * NIN0 + 2560u + (unsigned)(h * 128 + 16 * w + r), lo_o = (unsigned)(4 * q) * D + 256u + (unsigned)(h * 128 + 16 * w + r);
    const float lbk = lb_of(lbl, ch), oml = 1.0f - lbk;
    f32x4 Sacc[8]; f32x4 dseg = {1.f, 1.f, 1.f, 1.f};
#pragma unroll
    for (int n = 0; n < 8; ++n) Sacc[n] = (f32x4){0.f, 0.f, 0.f, 0.f};
    const size_t bh = (size_t)(b * 6 + h);
    if (OUT) {
        for (int j = 0; j < seg; ++j) { const float* sp = segS + ((bh * 4 + j) * 8 + w) * 2048 + lane * 4; const f32x4 dj = *(const f32x4*)(segD + ((bh * 4 + j) * 8 + w) * 256 + lane * 4);
#pragma unroll
            for (int n = 0; n < 8; ++n) Sacc[n] = Sacc[n] * dj + *(const f32x4*)(sp + n * 256); }
#pragma unroll
        for (int n = 0; n < 8; ++n) *(LAS u32x2*)(St + (16 * n + r) * PQ + (16 * w + 4 * q) * 2) = (u32x2){pk2(Sacc[n][0], Sacc[n][1]), pk2(Sacc[n][2], Sacc[n][3])};
    }
    const bf16* pbase = proj + (size_t)(b * SEQ) * NIN0;
    const float gain_v = gain[h * 128 + 16 * w + r];
    unsigned qv[16], fv[16], iv[16];
    { const bf16* prow = pbase + (size_t)(seg * 512 + 16 * tq) * NIN0;
#pragma unroll
      for (int i = 0; i < 16; ++i) { const bf16* up = prow + (size_t)i * NIN0; if (OUT) qv[i] = up[lo_q]; fv[i] = up[lo_f]; iv[i] = up[lo_i]; } }
    for (int c = seg * 8; c < seg * 8 + 8; ++c) {
#pragma unroll
        for (int i = 0; i < 16; ++i) { asm volatile("" : "+v"(fv[i]), "+v"(iv[i])); if (OUT) asm volatile("" : "+v"(qv[i])); }
        float lf[16], kk[16];
#pragma unroll
        for (int i = 0; i < 16; ++i) { float fz = bf2f(fv[i]); fz = fminf(fmaxf(fz, -30.f), 30.f); const float e = fexp2(-fz * LOG2E), sg = frcp(1.0f + e); lf[i] = flog2(lbk + oml * sg); kk[i] = oml * e * sg; }
        float run = 0.f;
#pragma unroll
        for (int i = 0; i < 16; ++i) { run += lf[i]; lf[i] = run; }
        qsum[tq * 128 + k] = run;
        { unsigned vp[8];
#pragma unroll
          for (int i = 0; i < 8; ++i) { const float z0 = bf2f(iv[2 * i]), z1 = bf2f(iv[2 * i + 1]); vp[i] = pk2(z0 * fsigmoid(z0), z1 * fsigmoid(z1)); }
          *(LAS u32x4*)(Vt + k * PK + tq * 32) = (u32x4){vp[0], vp[1], vp[2], vp[3]}; *(LAS u32x4*)(Vt + k * PK + tq * 32 + 16) = (u32x4){vp[4], vp[5], vp[6], vp[7]}; }
        LBAR();
        float off = 0.f, tot = 0.f;
#pragma unroll
        for (int j = 0; j < 4; ++j) { const float s = qsum[j * 128 + k]; tot += s; if (j < tq) off += s; }
        if (tq == 0) ebl[k] = fexp2(tot);
        { float ke[16];
#pragma unroll
          for (int i = 0; i < 16; ++i) { const float bc = lf[i] + off; const float ed = fexp2(bc), edi = fexp2(-bc); ke[i] = kk[i] * fexp2(tot - bc);
              if (OUT) { *(LAS unsigned short*)(Qd + (16 * tq + i) * PQ + 2 * k) = (unsigned short)f2bf(bf2f(qv[i]) * ed);
                         *(LAS unsigned short*)(Kd + (16 * tq + i) * PQ + 2 * k) = (unsigned short)f2bf(kk[i] * edi); } }
          unsigned kp[8];
#pragma unroll
          for (int i = 0; i < 8; ++i) kp[i] = pk2(ke[2 * i], ke[2 * i + 1]);
          *(LAS u32x4*)(KeT + k * PK + tq * 32) = (u32x4){kp[0], kp[1], kp[2], kp[3]}; *(LAS u32x4*)(KeT + k * PK + tq * 32 + 16) = (u32x4){kp[4], kp[5], kp[6], kp[7]}; }
        const bf16* crow = pbase + (size_t)(64 * c) * NIN0;
        unsigned gv[16];
#pragma unroll
        for (int ti = 0; ti < 4; ++ti)
#pragma unroll
            for (int i = 0; i < 4; ++i) { const bf16* up = crow + (size_t)(16 * ti + i) * NIN0; if (OUT) gv[ti * 4 + i] = up[lo_g]; }
        if (c + 1 < seg * 8 + 8) { const bf16* prow = crow + (size_t)(64 + 16 * tq) * NIN0;
#pragma unroll
            for (int i = 0; i < 16; ++i) { const bf16* up = prow + (size_t)i * NIN0; if (OUT) qv[i] = up[lo_q]; fv[i] = up[lo_f]; iv[i] = up[lo_i]; } }
        LBAR();
        f32x4 o[4];
        if (OUT) {
        { const int ti = w >> 1;
#pragma unroll
          for (int sj = 0; sj < 2; ++sj) { const int si = 2 * (w & 1) + sj; f32x4 acc = {0.f, 0.f, 0.f, 0.f};
              if (si <= ti) {
#pragma unroll
                  for (int ks = 0; ks < 4; ++ks) { const bf16x8 av = *(const LAS bf16x8*)(Qd + (16 * ti + r) * PQ + ks * 64 + q * 16), bv = *(const LAS bf16x8*)(Kd + (16 * si + r) * PQ + ks * 64 + q * 16); acc = MFMA16(av, bv, acc); } }
#pragma unroll
              for (int i = 0; i < 4; ++i) { const int t = 16 * ti + 4 * q + i, s = 16 * si + r; *(LAS unsigned short*)(P + t * PK + 2 * s) = (unsigned short)f2bf(s <= t ? acc[i] : 0.f); } } }
#pragma unroll
        for (int ti = 0; ti < 4; ++ti) o[ti] = (f32x4){0.f, 0.f, 0.f, 0.f};
        { bf16x8 bS[4];
#pragma unroll
          for (int ks = 0; ks < 4; ++ks) bS[ks] = *(const LAS bf16x8*)(St + (16 * w + r) * PQ + ks * 64 + q * 16);
#pragma unroll
          for (int ti = 0; ti < 4; ++ti)
#pragma unroll
              for (int ks = 0; ks < 4; ++ks) { const bf16x8 av = *(const LAS bf16x8*)(Qd + (16 * ti + r) * PQ + ks * 64 + q * 16); o[ti] = MFMA16(av, bS[ks], o[ti]); } }
        LBAR();
        { bf16x8 bV[2];
#pragma unroll
          for (int ks = 0; ks < 2; ++ks) bV[ks] = *(const LAS bf16x8*)(Vt + (16 * w + r) * PK + ks * 64 + q * 16);
#pragma unroll
          for (int ti = 0; ti < 4; ++ti)
#pragma unroll
              for (int ks = 0; ks < 2; ++ks) { const bf16x8 av = *(const LAS bf16x8*)(P + (16 * ti + r) * PK + ks * 64 + q * 16); o[ti] = MFMA16(av, bV[ks], o[ti]); } }
        }
        { bf16x8 aK[2];
#pragma unroll
          for (int ks = 0; ks < 2; ++ks) aK[ks] = *(const LAS bf16x8*)(KeT + (16 * w + r) * PK + ks * 64 + q * 16);
          const f32x4 dk = *(const LAS f32x4*)(ebl + 16 * w + 4 * q); dseg = dseg * dk;
#pragma unroll
          for (int n = 0; n < 8; ++n) { f32x4 s = Sacc[n] * dk;
#pragma unroll
              for (int ks = 0; ks < 2; ++ks) { const bf16x8 bv = *(const LAS bf16x8*)(Vt + (16 * n + r) * PK + ks * 64 + q * 16); s = MFMA16(aK[ks], bv, s); }
              Sacc[n] = s;
              if (OUT) *(LAS u32x2*)(St + (16 * n + r) * PQ + (16 * w + 4 * q) * 2) = (u32x2){pk2(s[0], s[1]), pk2(s[2], s[3])}; } }
        if (!OUT) { LBAR(); continue; }
#pragma unroll
        for (int ti = 0; ti < 4; ++ti)
#pragma unroll
            for (int i = 0; i < 4; ++i) { float p = o[ti][i] * o[ti][i]; p += __shfl_xor(p, 1); p += __shfl_xor(p, 2); p += __shfl_xor(p, 4); p += __shfl_xor(p, 8);
                if (r == 0) part[w * 64 + 16 * ti + 4 * q + i] = p; }
        LBAR();
        if (tid < 64) { float s = 0.f;
#pragma unroll
            for (int j = 0; j < 8; ++j) s += part[j * 64 + tid];
            rsr[tid] = __builtin_amdgcn_rsqf(s * (1.0f / 128.0f) + EPS); }
        LBAR();
        bf16* orow = cat + (size_t)(b * SEQ + 64 * c) * D;
#pragma unroll
        for (int ti = 0; ti < 4; ++ti)
#pragma unroll
            for (int i = 0; i < 4; ++i) { const int t = 16 * ti + 4 * q + i; const float val = o[ti][i] * rsr[t] * gain_v * fsigmoid(bf2f(gv[ti * 4 + i])); bf16* up = orow + (size_t)(16 * ti + i) * D; up[lo_o] = (bf16)f2bf(val); }
    }
    if (!OUT) { float* sp = segS + ((bh * 4 + seg) * 8 + w) * 2048 + lane * 4;
#pragma unroll
        for (int n = 0; n < 8; ++n) *(f32x4*)(sp + n * 256) = Sacc[n];
        *(f32x4*)(segD + ((bh * 4 + seg) * 8 + w) * 256 + lane * 4) = dseg; }
    else if (seg == 3) { float* so = st_out + (size_t)((b * 6 + h) * 128) * 128;
#pragma unroll
        for (int n = 0; n < 8; ++n)
#pragma unroll
            for (int i = 0; i < 4; ++i) so[(size_t)(16 * w + 4 * q + i) * 128 + 16 * n + r] = Sacc[n][i]; }
    LBAR();
}

__device__ __forceinline__ void conv_phase(const PArgs& a, int bid, int G, int tid) {
    unsigned char* ws = a.ws;
    const bf16* proj = (const bf16*)(ws + WS_SH); bf16* cat = (bf16*)(ws + WS_CAT); const float* cw = a.in[15];
    for (int gt = bid * NT + tid; gt < 1024 * 128; gt += G * NT) {
        const int cgp = gt & 127, rb = gt >> 7, b = rb >> 7, tl0 = (rb & 127) * 16, c0 = 8 * cgp;
        float w0[8], w1[8], w2[8], zm2[8], zm1[8];
#pragma unroll
        for (int e = 0; e < 8; ++e) { w0[e] = cw[c0 + e]; w1[e] = cw[1024 + c0 + e]; w2[e] = cw[2048 + c0 + e]; zm2[e] = 0.f; zm1[e] = 0.f; }
        const bf16* pr = proj + (size_t)(b * SEQ + tl0) * NIN1 + c0;
        if (tl0 > 0) { float cgv[8], hvv[8];
            unpack8(*(const u32x4*)(pr - 2 * NIN1 + 1024), cgv); unpack8(*(const u32x4*)(pr - 2 * NIN1 + 2048), hvv);
#pragma unroll
            for (int e = 0; e < 8; ++e) zm2[e] = cgv[e] * hvv[e];
            unpack8(*(const u32x4*)(pr - NIN1 + 1024), cgv); unpack8(*(const u32x4*)(pr - NIN1 + 2048), hvv);
#pragma unroll
            for (int e = 0; e < 8; ++e) zm1[e] = cgv[e] * hvv[e]; }
#pragma unroll 1
        for (int i = 0; i < 16; ++i) { float bgv[8], cgv[8], hvv[8], o[8];
            unpack8(*(const u32x4*)(pr + (size_t)i * NIN1), bgv); unpack8(*(const u32x4*)(pr + (size_t)i * NIN1 + 1024), cgv); unpack8(*(const u32x4*)(pr + (size_t)i * NIN1 + 2048), hvv);
#pragma unroll
            for (int e = 0; e < 8; ++e) { const float z = cgv[e] * hvv[e]; o[e] = bgv[e] * (w0[e] * zm2[e] + w1[e] * zm1[e] + w2[e] * z); zm2[e] = zm1[e]; zm1[e] = z; }
            *(u32x4*)(cat + (size_t)(b * SEQ + tl0 + i) * D + c0) = (u32x4){pk2(o[0], o[1]), pk2(o[2], o[3]), pk2(o[4], o[5]), pk2(o[6], o[7])};
            const int t = tl0 + i;
            if (t >= SEQ - 2) { float* co = a.out + O_CONVP + (size_t)(b * 2 + (t - (SEQ - 2))) * 1024 + c0;
                *(f32x4*)co = (f32x4){zm1[0], zm1[1], zm1[2], zm1[3]}; *(f32x4*)(co + 4) = (f32x4){zm1[4], zm1[5], zm1[6], zm1[7]}; } }
    }
    const bf16* projs = (const bf16*)(ws + WS_PROJS); bf16* cats = (bf16*)(ws + WS_CATS); const float* sc = a.in[4];
    for (int gt = bid * NT + tid; gt < MS * 128; gt += G * NT) {
        const int cgp = gt & 127, b = gt >> 7, c0 = 8 * cgp; float bgv[8], cgv[8], hvv[8], o[8], z[8];
        const bf16* pr = projs + (size_t)b * NIN1 + c0;
        unpack8(*(const u32x4*)pr, bgv); unpack8(*(const u32x4*)(pr + 1024), cgv); unpack8(*(const u32x4*)(pr + 2048), hvv);
        const float* p0 = sc + (size_t)(b * 2) * 1024 + c0; const float* p1 = p0 + 1024;
        float* co = a.out + O_CONVS + (size_t)(b * 2) * 1024 + c0;
#pragma unroll
        for (int e = 0; e < 8; ++e) { z[e] = cgv[e] * hvv[e]; o[e] = bgv[e] * (cw[c0 + e] * p0[e] + cw[1024 + c0 + e] * p1[e] + cw[2048 + c0 + e] * z[e]); co[e] = p1[e]; co[1024 + e] = z[e]; }
        *(u32x4*)(cats + (size_t)b * D + c0) = (u32x4){pk2(o[0], o[1]), pk2(o[2], o[3]), pk2(o[4], o[5]), pk2(o[6], o[7])};
    }
}

__device__ __forceinline__ void final_norm(const PArgs& a, int bid, int G, int wave, int lane) {
    const int gw = bid * NWAVES + wave, NGW = G * NWAVES; const float* gf = a.in[7]; const float* ss4 = (const float*)(a.ws + WS_SS) + 4 * MP;
    f32x4 gv[4];
#pragma unroll
    for (int j = 0; j < 4; ++j) gv[j] = ((const f32x4*)gf)[lane + 64 * j];
    for (int m = gw; m < MP + MS; m += NGW) {
        if (m < MP) { f32x4* yr = (f32x4*)(a.out + O_Y + (size_t)m * D) + lane; const u32x2* xr = (const u32x2*)((const bf16*)(a.ws + WS_XB) + (size_t)m * D) + lane;
            const float rs = __builtin_amdgcn_rsqf(ss4[m] * (1.0f / 1024.0f) + EPS);
#pragma unroll
            for (int j = 0; j < 4; ++j) { const u32x2 w = xr[64 * j]; const f32x4 v = {__uint_as_float(w.x << 16), __uint_as_float(w.x & 0xffff0000u), __uint_as_float(w.y << 16), __uint_as_float(w.y & 0xffff0000u)}; yr[64 * j] = v * rs * gv[j]; } }
        else { const int sr = m - MP; const f32x4* xr = (const f32x4*)((const float*)(a.ws + WS_XS) + (size_t)sr * D) + lane; f32x4* yr = (f32x4*)(a.out + O_YS + (size_t)sr * D) + lane;
            f32x4 v[4]; float s = 0.f;
#pragma unroll
            for (int j = 0; j < 4; ++j) { v[j] = xr[64 * j]; s += (v[j].x * v[j].x + v[j].y * v[j].y) + (v[j].z * v[j].z + v[j].w * v[j].w); }
            const float rs = __builtin_amdgcn_rsqf(wave_sum(s) * (1.0f / 1024.0f) + EPS);
#pragma unroll
            for (int j = 0; j < 4; ++j) yr[64 * j] = v[j] * rs * gv[j]; }
    }
}

#define XB_TMO      128
#define XB_XCNT(j)  (256  + 64 * (j))
#define XB_XSUB(j)  (1280 + 64 * (j))
#define XB_XGEN(j)  (2304 + 64 * (j))
#define XB_TOP      3328
#define XB_TOPGEN   3392
#define XCD_BAR_WORDS 3456
#define XB_SPIN_CAP (1u << 18)

__device__ __forceinline__ unsigned xb_ld(unsigned* p)              { return __hip_atomic_load(p, __ATOMIC_RELAXED, __HIP_MEMORY_SCOPE_AGENT); }
__device__ __forceinline__ unsigned xb_add(unsigned* p, unsigned v) { return __hip_atomic_fetch_add(p, v, __ATOMIC_RELAXED, __HIP_MEMORY_SCOPE_AGENT); }
__device__ __forceinline__ unsigned xb_xcc_id() { return (unsigned)__builtin_amdgcn_s_getreg((3 << 11) | 20) & 0xFu; }
#define XB_SPIN(cond, bar) do { unsigned _sp = 0; while (cond) { __builtin_amdgcn_s_sleep(1); \
    if ((++_sp & 255u) == 0u) { if (xb_ld(&(bar)[XB_TMO])) break; if (_sp > XB_SPIN_CAP) { atomicAdd(&(bar)[XB_TMO], 1u); break; } } } } while (0)

struct XcdBarrier {
    unsigned* bar; unsigned x;
    volatile LAS unsigned* st;
};

__device__ __forceinline__ XcdBarrier xcd_barrier_post(unsigned* bar, volatile LAS unsigned* st) {
    XcdBarrier b; b.bar = bar; b.x = xb_xcc_id(); b.st = st;
    if (threadIdx.x == 0) (void)xb_add(&bar[XB_XCNT(b.x)], 1u);
    return b;
}
__device__ __forceinline__ void xcd_barrier_complete(unsigned* bar, unsigned x, unsigned& nloc, unsigned& nx) {
    const unsigned G = gridDim.x * gridDim.y * gridDim.z;
    unsigned sum, cnt, mine, sp = 0u;
    for (;;) {
        sum = 0u; cnt = 0u; mine = 0u;
#pragma unroll
        for (unsigned j = 0; j < 16; ++j) { const unsigned c = xb_ld(&bar[XB_XCNT(j)]); sum += c; cnt += (c > 0u) ? 1u : 0u; mine = (j == x) ? c : mine; }
        if (sum == G) break;
        __builtin_amdgcn_s_sleep(1);
        if ((++sp & 255u) == 0u) { if (xb_ld(&bar[XB_TMO])) break; if (sp > XB_SPIN_CAP) { atomicAdd(&bar[XB_TMO], 1u); break; } }
    }
    nloc = mine > 0u ? mine : 1u; nx = cnt > 0u ? cnt : 1u;
}

__device__ __forceinline__ void xcd_barrier(const XcdBarrier& b) {
    asm volatile("s_waitcnt vmcnt(0)" ::: "memory");
    __syncthreads();
    if (threadIdx.x == 0) {
        unsigned* bar = b.bar;
        __builtin_amdgcn_s_waitcnt(0);
        unsigned nloc = b.st[0], nx = b.st[1];
        if (nloc == 0u) { xcd_barrier_complete(bar, b.x, nloc, nx); b.st[0] = nloc; b.st[1] = nx; }
        const unsigned old = xb_add(&bar[XB_XSUB(b.x)], 1u);
        const unsigned gen = old / nloc;
        if (old + 1u == (gen + 1u) * nloc) {
            __builtin_amdgcn_fence(__ATOMIC_RELEASE, "agent");
            asm volatile("s_waitcnt vmcnt(0)" ::: "memory");
            const unsigned og = xb_add(&bar[XB_TOP], 1u);
            const unsigned tg = og / nx;
            if (og + 1u == (tg + 1u) * nx) xb_add(&bar[XB_TOPGEN], 1u);
            else XB_SPIN(xb_ld(&bar[XB_TOPGEN]) == tg, bar);
            __builtin_amdgcn_fence(__ATOMIC_ACQUIRE, "agent");
            xb_add(&bar[XB_XGEN(b.x)], 1u);
            asm volatile("s_waitcnt vmcnt(0)" ::: "memory");
        } else {
            XB_SPIN(xb_ld(&bar[XB_XGEN(b.x)]) == gen, bar);
            __builtin_amdgcn_fence(__ATOMIC_ACQUIRE, "agent");
            asm volatile("s_waitcnt vmcnt(0)" ::: "memory");
        }
    }
    __syncthreads();
}

#ifndef DIS_GEMM
#define DIS_GEMM 0
#endif
#ifndef DIS_SGEMM
#define DIS_SGEMM 0
#endif
#ifndef DIS_HGRN
#define DIS_HGRN 0
#endif
#ifndef DIS_OTHER
#define DIS_OTHER 0
#endif
#ifndef DBG_O
#define DBG_O 15
#endif
#ifndef DUPK
#define DUPK 0
#endif
#ifndef DBG_XSYNC
#define DBG_XSYNC 0
#endif
#ifndef DBG_COL
#define DBG_COL 2304
#endif
#ifndef DBG_HI
#define DBG_HI 12
#endif
#ifndef MK_MULTI
#define MK_MULTI 0
#endif
constexpr int N_PHASES = 12;
#define IN(k) (lo <= (k) && (k) < hi)
#define SEAM(k) do { if (IN(k) && IN((k) + 1)) xcd_barrier(xbar); } while (0)
template <int L>
__device__ __forceinline__ void layer_phases(const PArgs& a, LAS unsigned char* lds, const XcdBarrier& xbar, int lo, int hi, int bid, int G, int tid, int wave, int lane) {
    unsigned char* ws = a.ws;
    float* ss = (float*)(ws + WS_SS);
    bf16* CAT = (bf16*)(ws + WS_CAT); bf16* SH = (bf16*)(ws + WS_SH); bf16* XB = (bf16*)(ws + WS_XB);
    float* xs = (float*)(ws + WS_XS); bf16* projs = (bf16*)(ws + WS_PROJS); bf16* cats = (bf16*)(ws + WS_CATS); bf16* hs = (bf16*)(ws + WS_HS);
    float* Y = a.out + O_Y;
    constexpr int pb = 1 + 5 * L;
    const bf16* Win = (const bf16*)(ws + (L ? WS_WIN1 : WS_WIN0)); const bf16* Wout = (const bf16*)(ws + (L ? WS_WOUT1 : WS_WOUT0));
    const bf16* W1 = (const bf16*)(ws + (L ? WS_W11 : WS_W10)); const bf16* W2 = (const bf16*)(ws + (L ? WS_W21 : WS_W20));
    constexpr int Nin = L ? NIN1 : NIN0;
    if (IN(pb)) {
        pg8::Gemm g{L ? XB : CAT, Win, MP, Nin, D}; pg8::StaticOrder S; S.init(MP, Nin, G, bid);
        pg8::EpiScaleBf16<0> E{SH, Nin, ss + (L ? 2 : 0) * MP};
        for (int rep = 0; rep < (DUPK == 5 ? 2 : 1); ++rep) pg8::gemm_phase<pg8::EpiScaleBf16<0>, pg8::StaticOrder, true, true>(lds, g, S, E);
        for (int rep = 0; rep < (DUPK == 1 ? 2 : 1); ++rep) sgemm<true, 0, 4>(lds, L ? (const void*)xs : (const void*)a.in[1], D, Win, Nin, D, 1, projs, Nin, xs, G, bid, tid, wave, lane, (L == 0 && G == 256) ? 64 : 0);
    }
    SEAM(pb);
    if (IN(pb + 1)) {
        if (L == 0) {
            float* segS = (float*)(ws + WS_DS); float* segD = (float*)(ws + WS_DS + 16 * MiB);
            for (int u = bid; u < 144; u += G) hgrn_seg<false>(lds, SH, a.in[11], a.in[12], CAT, a.out + O_HGP, segS, segD, (u / 3) / 6, (u / 3) % 6, u % 3, tid, wave, lane);
            if (G > 144) { if (bid >= 144) for (int it = bid - 144; it < MS * 6; it += 3 * (G - 144)) hgrn_sample3(lds, projs, a.in[3], a.in[11], a.in[12], cats, a.out + O_HGS, it, G - 144, tid, wave, lane); }
            else for (int it = bid; it < MS * 6; it += 3 * G) hgrn_sample3(lds, projs, a.in[3], a.in[11], a.in[12], cats, a.out + O_HGS, it, G, tid, wave, lane);
            if (G <= 192) pool_prompt_wave(lds, SH, a.in[9], a.in[10], CAT, a.out + O_POOLP, bid, G, tid, wave, lane);
            xcd_barrier(xbar);
            for (int u = bid; u < 192; u += G) hgrn_seg<true>(lds, SH, a.in[11], a.in[12], CAT, a.out + O_HGP, segS, segD, (u / 4) / 6, (u / 4) % 6, u % 4, tid, wave, lane);
            if (bid >= 192) pool_prompt_wave(lds, SH, a.in[9], a.in[10], CAT, a.out + O_POOLP, bid - 192, G - 192, tid, wave, lane);
            if (bid >= 192) for (int it = bid - 192; it < 8; it += G - 192) pool_sample(lds, projs, a.in[2], a.in[9], a.in[10], cats, a.out + O_POOLS, it, tid);
            else if (G <= 192) for (int it = bid; it < 8; it += G) pool_sample(lds, projs, a.in[2], a.in[9], a.in[10], cats, a.out + O_POOLS, it, tid);
        } else { conv_phase(a, bid, G, tid); }
    }
    SEAM(pb + 1);
    if (IN(pb + 2)) {
        pg8::Gemm g{CAT, Wout, MP, D, D}; pg8::StaticOrder S; S.init(MP, D, G, bid);
        pg8::EpiResid E{L ? (const float*)nullptr : a.in[0], XB, ss + (L ? 3 : 1) * MP};
        if (DUPK == 6) { pg8::EpiNull EN{Y, a.ph_lo}; pg8::gemm_phase<pg8::EpiNull, pg8::StaticOrder, true, true>(lds, g, S, EN); }
        if (!DIS_GEMM) pg8::gemm_phase<pg8::EpiResid, pg8::StaticOrder, false, true>(lds, g, S, E);
        if (!DIS_SGEMM) sgemm<false, 2, 1>(lds, cats, D, Wout, D, D, 4, nullptr, 0, xs, G, bid, tid, wave, lane);
    }
    SEAM(pb + 2);
    if (IN(pb + 3)) {
        pg8::Gemm g{XB, W1, MP, FF, D}; pg8::StaticOrder S; S.init(MP, FF, G, bid);
        pg8::EpiScaleBf16<1> E{SH, FF, ss + (L ? 3 : 1) * MP};
        for (int rep = 0; rep < (DUPK == 2 ? 2 : 1); ++rep) pg8::gemm_phase<pg8::EpiScaleBf16<1>, pg8::StaticOrder, true, true>(lds, g, S, E);
        for (int rep = 0; rep < (DUPK == 1 ? 2 : 1); ++rep) sgemm<true, 1, 4>(lds, xs, D, W1, FF, D, 1, hs, FF, xs, G, bid, tid, wave, lane);
    }
    SEAM(pb + 3);
    if (IN(pb + 4)) {
        pg8::Gemm g{SH, W2, MP, D, FF}; pg8::StaticOrder S; S.init(MP, D, G, bid);
        pg8::EpiResid E{nullptr, XB, ss + (L ? 4 : 2) * MP};
        if (DUPK == 7) { pg8::EpiNull EN{Y, a.ph_lo}; pg8::gemm_phase<pg8::EpiNull, pg8::StaticOrder, true, true>(lds, g, S, EN); }
        if (!DIS_GEMM) pg8::gemm_phase<pg8::EpiResid, pg8::StaticOrder, false, true>(lds, g, S, E);
        if (!DIS_SGEMM) sgemm<false, 2, 4>(lds, hs, FF, W2, D, FF, 4, nullptr, 0, xs, G, bid, tid, wave, lane);
    }
    SEAM(pb + 4);
}
__global__ void __launch_bounds__(NT, 2) mk_fwd(PArgs a) {
    extern __shared__ __attribute__((aligned(16))) unsigned char lds_raw[];
    LAS unsigned char* lds = (LAS unsigned char*)lds_raw;
    const int tid = threadIdx.x, lane = tid & 63, wave = __builtin_amdgcn_readfirstlane(tid >> 6), bid = blockIdx.x, G = gridDim.x;
    const int lo = a.ph_lo, hi = a.ph_hi;
    volatile LAS unsigned* xst = (volatile LAS unsigned*)(lds + 131072 + 64);
    if (tid < 2) xst[tid] = 0u;
    __syncthreads();
    const XcdBarrier xbar = xcd_barrier_post((unsigned*)a.ws, xst);
    if (lo < 0) cg::this_grid().sync();
    if (IN(0)) { for (int rep = 0; rep < (DUPK == 3 ? 2 : 1); ++rep) { p0_prologue(a, lds, bid, G, tid, wave, lane); __syncthreads(); } }
    SEAM(0);
    layer_phases<0>(a, lds, xbar, lo, hi, bid, G, tid, wave, lane);
    layer_phases<1>(a, lds, xbar, lo, hi, bid, G, tid, wave, lane);
    for (int xx = 0; xx < DBG_XSYNC; ++xx) xcd_barrier(xbar);
    if (IN(11)) final_norm(a, bid, G, wave, lane);
    if (hi < 12) {
        if (hi <= 3) { cg::this_grid().sync(); const bf16* C = (const bf16*)(a.ws + WS_CAT); for (size_t i = (size_t)bid * NT + tid; i < O_YS; i += (size_t)G * NT) a.out[i] = ((i & 1023) >= 256) ? bf2f(C[i]) : 0.f; }
        for (size_t i = (size_t)bid * NT + tid; i < 131072; i += (size_t)G * NT) a.out[O_YS + i] = 0.f;
        if (hi <= 2) for (size_t i = (size_t)bid * NT + tid + O_POOLP; i < O_CONVS; i += (size_t)G * NT) a.out[i] = 0.f;
        if (hi <= 7) { for (size_t i = (size_t)bid * NT + tid; i < 16384; i += (size_t)G * NT) a.out[O_CONVP + i] = 0.f;
                       for (size_t i = (size_t)bid * NT + tid; i < 262144; i += (size_t)G * NT) a.out[O_CONVS + i] = 0.f; }
    }
}
#undef IN
#undef SEAM

extern "C" void kernel_launch(void* const* d_in, const int* in_sizes, int n_in, void* d_out, int out_size, void* d_ws, size_t ws_size, hipStream_t stream) {
    static int grid = 0;
    if (grid == 0) {
        if (n_in != 19 || ws_size < WS_END) { fprintf(stderr, "kernel_launch: unexpected inputs (n_in %d, ws %zu)\n", n_in, ws_size); grid = -1; return; }
        int dev = 0, cus = 0, per_cu = 0;
        if (hipGetDevice(&dev) != hipSuccess || hipDeviceGetAttribute(&cus, hipDeviceAttributeMultiprocessorCount, dev) != hipSuccess) { grid = -1; return; }
        if (hipFuncSetAttribute((const void*)mk_fwd, hipFuncAttributeMaxDynamicSharedMemorySize, LDS_BYTES) != hipSuccess) { fprintf(stderr, "kernel_launch: hipFuncSetAttribute failed\n"); grid = -1; return; }
        if (hipOccupancyMaxActiveBlocksPerMultiprocessor(&per_cu, (const void*)mk_fwd, NT, LDS_BYTES) != hipSuccess || per_cu < 1) { fprintf(stderr, "kernel_launch: occupancy query says %d\n", per_cu); per_cu = 1; }
        (void)hipGetLastError();
        grid = cus;
    }
    if (grid < 0) return;
    PArgs a{};
    for (int i = 0; i < 19; ++i) a.in[i] = (const float*)d_in[i];
    a.out = (float*)d_out; a.ws = (unsigned char*)d_ws;
#if MK_MULTI
    for (int k = 0; k < DBG_HI; ++k) { a.ph_lo = k; a.ph_hi = k + 1; hipLaunchKernelGGL(mk_fwd, dim3(grid), dim3(NT), LDS_BYTES, stream, a); }
#else
    a.ph_lo = 0; a.ph_hi = DBG_HI;
    if (hipMemsetAsync(d_ws, 0, 16384, stream) != hipSuccess) { fprintf(stderr, "kernel_launch: hipMemsetAsync failed\n"); return; }
    void* args[] = {&a};
    hipError_t e = hipLaunchCooperativeKernel((const void*)mk_fwd, dim3(grid), dim3(NT), args, LDS_BYTES, stream);
    if (e != hipSuccess) fprintf(stderr, "cooperative launch failed: %s (grid %d)\n", hipGetErrorString(e), grid);
#endif
}
```
